# Optimizing an MI355X kernel written in HIP

```python
import math
import jax, jax.numpy as jnp
from jax import lax
import numpy as np

D_MODEL = 2048
BATCH = 4
SEQ = 4096
DEPTH = 2

GRID_W = 64
CTX_LEN = 256
N_AB = (DEPTH + 1) // 2
N_CD = DEPTH // 2
N_MOD = 9
D_FF = 5632
EPS = 1e-6
ROPE_THETA = 10000.0
Q_BLOCK = 128

A_HEADS = 8
A_KV = 2
A_DH = 128
B_HEADS = 4
B_DQK = 128
B_DV = 256
B_CHUNK = 64
C_WIDTH = 1024
C_GROUP = 16
C_GROUPS = C_WIDTH // C_GROUP
C_STATE = 64
D_HEADS = 16
D_KV = 2
D_DH = 64
D_WINDOW = 128

AB_SIZES = (A_HEADS * A_DH, A_KV * A_DH, A_KV * A_DH, B_HEADS * B_DQK, B_HEADS * B_DQK,
            B_HEADS * B_DV, B_HEADS * B_DV, 4 * B_HEADS)
AB_IN = sum(AB_SIZES)
AB_MIX = A_HEADS * A_DH + B_HEADS * B_DV
CD_SIZES = (C_WIDTH, D_HEADS * D_DH, D_KV * D_DH, D_KV * D_DH)
CD_IN = sum(CD_SIZES)
CD_MIX = C_WIDTH + D_HEADS * D_DH
F32 = jnp.float32

kernel_name = 'hybrid_dit_gqa_mlstm_s5_swa'


def split_cols(z, sizes):
    out, start = [], 0
    for s in sizes:
        out.append(z[..., start:start + s])
        start += s
    return out


def rmsnorm(x, g):
    xf = x.astype(F32)
    y = xf * lax.rsqrt(jnp.mean(xf * xf, axis=-1, keepdims=True) + EPS)
    return (y * g.astype(F32)).astype(x.dtype)


def modulate(x, g, shift, scale):
    return rmsnorm(x, g) * (1 + scale) + shift


def swiglu(h, w1, w3, w2):
    return (jax.nn.silu(h @ w1) * (h @ w3)) @ w2


def to_heads(z, n, dh):
    b, t, _ = z.shape
    return z.reshape(b, t, n, dh).transpose(0, 2, 1, 3)


def from_heads(z):
    b, n, t, dh = z.shape
    return z.transpose(0, 2, 1, 3).reshape(b, t, n * dh)


def axial_rope(rows, head_dim):
    r, cidx = jnp.meshgrid(jnp.arange(rows, dtype=F32), jnp.arange(GRID_W, dtype=F32), indexing='ij')
    r, cidx = r.reshape(-1), cidx.reshape(-1)
    n_freq = head_dim // 4
    inv = ROPE_THETA ** (-jnp.arange(n_freq, dtype=F32) / n_freq)
    ang = jnp.concatenate([r[:, None] * inv, cidx[:, None] * inv], axis=-1)
    return jnp.cos(ang), jnp.sin(ang)


def apply_rope(x, cos, sin):
    half = x.shape[-1] // 2
    xf = x.astype(F32)
    x1, x2 = xf[..., :half], xf[..., half:]
    return jnp.concatenate([x1 * cos - x2 * sin, x2 * cos + x1 * sin], axis=-1).astype(x.dtype)


def attend(q, k, v, scale):
    s = jnp.einsum('bkgqd,bksd->bkgqs', q, k).astype(F32) * scale
    p = jax.nn.softmax(s, axis=-1).astype(v.dtype)
    return jnp.einsum('bkgqs,bksd->bkgqd', p, v)


def attn_a(zq, zk, zv, cq, ck, cv, g_q, g_k, cos, sin, want_ctx):
    b, t, _ = zq.shape
    grp = A_HEADS // A_KV
    scale = A_DH ** -0.5
    q = apply_rope(rmsnorm(to_heads(zq, A_HEADS, A_DH), g_q), cos, sin)
    k = apply_rope(rmsnorm(to_heads(zk, A_KV, A_DH), g_k), cos, sin)
    v = to_heads(zv, A_KV, A_DH)
    kc = rmsnorm(to_heads(ck, A_KV, A_DH), g_k)
    vc = to_heads(cv, A_KV, A_DH)
    k_all = jnp.concatenate([kc, k], axis=2)
    v_all = jnp.concatenate([vc, v], axis=2)
    nb = t // Q_BLOCK
    qb = jnp.moveaxis(q.reshape(b, A_KV, grp, nb, Q_BLOCK, A_DH), 3, 0)
    o = lax.map(lambda qq: attend(qq, k_all, v_all, scale), qb)
    y = from_heads(jnp.moveaxis(o, 0, 3).reshape(b, A_HEADS, t, A_DH))
    yc = None
    if want_ctx:
        tc = cq.shape[1]
        qc = rmsnorm(to_heads(cq, A_HEADS, A_DH), g_q).reshape(b, A_KV, grp, tc, A_DH)
        yc = from_heads(attend(qc, kc, vc, scale).reshape(b, A_HEADS, tc, A_DH))
    return y, yc


def mlstm_chunkwise(q, k, v, li, lf, state):
    b, h, t, _ = q.shape
    L = B_CHUNK
    nc = t // L

    def chunks(a):
        return jnp.moveaxis(a.reshape(a.shape[:2] + (nc, L) + a.shape[3:]), 2, 0)

    causal = jnp.tril(jnp.ones((L, L), dtype=bool))

    def step(carry, xs):
        C, n, m = carry
        qc, kc, vc, ic, fc = xs
        bcum = jnp.cumsum(fc, axis=-1)
        log_d = jnp.where(causal, bcum[..., :, None] - bcum[..., None, :] + ic[..., None, :], -jnp.inf)
        m_inter = bcum + m[..., None]
        m_t = jnp.maximum(m_inter, jnp.max(log_d, axis=-1))
        w_intra = jnp.exp(log_d - m_t[..., None])
        w_inter = jnp.exp(m_inter - m_t)
        s = jnp.einsum('bhtd,bhsd->bhts', qc, kc) * w_intra
        num = jnp.einsum('bhts,bhsv->bhtv', s, vc) + w_inter[..., None] * jnp.einsum('bhvd,bhtd->bhtv', C, qc)
        den = jnp.sum(s, axis=-1) + w_inter * jnp.einsum('bhd,bhtd->bht', n, qc)
        h_out = num / jnp.maximum(jnp.abs(den), jnp.exp(-m_t))[..., None]
        b_last = bcum[..., -1]
        log_w = b_last[..., None] - bcum + ic
        m_new = jnp.maximum(b_last + m, jnp.max(log_w, axis=-1))
        w = jnp.exp(log_w - m_new[..., None])
        decay = jnp.exp(b_last + m - m_new)
        C_new = decay[..., None, None] * C + jnp.einsum('bhsv,bhsd->bhvd', w[..., None] * vc, kc)
        n_new = decay[..., None] * n + jnp.einsum('bhs,bhsd->bhd', w, kc)
        return (C_new, n_new, m_new), h_out

    state, hs = lax.scan(step, state, tuple(chunks(a) for a in (q, k, v, li, lf)))
    return jnp.moveaxis(hs, 0, 2).reshape(b, h, t, v.shape[-1]), state


def mlstm_mixer(zq, zk, zv, zo, zg, cq, ck, cv, co, cg, b_gate, head_g, want_ctx):
    def prep(q, k, v, g):
        bz, tz, _ = q.shape
        qh = to_heads(q.astype(F32), B_HEADS, B_DQK) * (B_DQK ** -0.5)
        kh = to_heads(k.astype(F32), B_HEADS, B_DQK)
        vh = to_heads(v.astype(F32), B_HEADS, B_DV)
        gg = (g.astype(F32) + b_gate.astype(F32)).reshape(bz, tz, 4, B_HEADS).transpose(2, 0, 3, 1)
        return qh, kh, vh, (gg[0], jax.nn.log_sigmoid(gg[1])), (gg[2], jax.nn.log_sigmoid(gg[3]))

    def flip(a):
        return jnp.flip(a, axis=2)

    def bidir(q, k, v, gf, gb, st_f, st_b):
        hf, sf = mlstm_chunkwise(q, k, v, gf[0], gf[1], st_f)
        hb, sb = mlstm_chunkwise(flip(q), flip(k), flip(v), flip(gb[0]), flip(gb[1]), st_b)
        return hf + flip(hb), sf, sb

    def finish(hh, o):
        hn = hh * lax.rsqrt(jnp.mean(hh * hh, axis=-1, keepdims=True) + EPS)
        return (jax.nn.sigmoid(o.astype(F32)) * from_heads(hn) * head_g.astype(F32)).astype(o.dtype)

    bz = zq.shape[0]
    zero = (jnp.zeros((bz, B_HEADS, B_DV, B_DQK), F32), jnp.zeros((bz, B_HEADS, B_DQK), F32),
            jnp.zeros((bz, B_HEADS), F32))
    hc, sf, sb = bidir(*prep(cq, ck, cv, cg), zero, zero)
    h, _, _ = bidir(*prep(zq, zk, zv, zg), sf, sb)
    yc = finish(hc, co) if want_ctx else None
    return finish(h, zo), yc


def s5_combine(e1, e2):
    ar1, ai1, br1, bi1 = e1
    ar2, ai2, br2, bi2 = e2
    return (ar1 * ar2 - ai1 * ai2, ar1 * ai2 + ai1 * ar2,
            ar2 * br1 - ai2 * bi1 + br2, ar2 * bi1 + ai2 * br1 + bi2)


def s5_direction(u, a_re, a_im, log_dt, b_re, b_im, c_re, c_im, x0_re, x0_im):
    dt = jnp.exp(log_dt)[:, None]
    mag = jnp.exp(a_re * dt)
    ab_re, ab_im = mag * jnp.cos(a_im * dt), mag * jnp.sin(a_im * dt)
    den = a_re * a_re + a_im * a_im
    nr, ni = ab_re - 1.0, ab_im
    k_re, k_im = (nr * a_re + ni * a_im) / den, (ni * a_re - nr * a_im) / den
    bb_re = k_re[..., None] * b_re - k_im[..., None] * b_im
    bb_im = k_re[..., None] * b_im + k_im[..., None] * b_re
    bu_re = jnp.einsum('tbgi,gpi->tbgp', u, bb_re)
    bu_im = jnp.einsum('tbgi,gpi->tbgp', u, bb_im)
    bu_re = bu_re.at[0].add(ab_re * x0_re - ab_im * x0_im)
    bu_im = bu_im.at[0].add(ab_re * x0_im + ab_im * x0_re)
    t = u.shape[0]
    a_r = jnp.broadcast_to(ab_re[None, None], (t, 1) + ab_re.shape)
    a_i = jnp.broadcast_to(ab_im[None, None], (t, 1) + ab_im.shape)
    _, _, xr, xi = lax.associative_scan(s5_combine, (a_r, a_i, bu_re, bu_im), axis=0)
    y = jnp.einsum('tbgp,gip->tbgi', xr, c_re) - jnp.einsum('tbgp,gip->tbgi', xi, c_im)
    return y, xr[-1], xi[-1]


def s5_mixer(u, uc, a_re, a_im, log_dt, b_re, b_im, c_re, c_im, d_skip, glu_w, glu_b, want_ctx):
    def to_tbgi(z):
        bz, tz, _ = z.shape
        return z.astype(F32).reshape(bz, tz, C_GROUPS, C_GROUP).transpose(1, 0, 2, 3)

    def prm(d):
        return (a_re[d].astype(F32), a_im[d].astype(F32), log_dt[d].astype(F32), b_re[d].astype(F32),
                b_im[d].astype(F32), c_re[d].astype(F32), c_im[d].astype(F32))

    def flip(a):
        return jnp.flip(a, axis=0)

    def finish(y_f, y_b_rev, z):
        y = (y_f + flip(y_b_rev)).transpose(1, 0, 2, 3).reshape(z.shape) + d_skip.astype(F32) * z.astype(F32)
        g = jax.nn.gelu(y)
        return (g * jax.nn.sigmoid(g @ glu_w.astype(F32) + glu_b.astype(F32))).astype(z.dtype)

    ut, uct = to_tbgi(u), to_tbgi(uc)
    zero = jnp.zeros((u.shape[0], C_GROUPS, C_STATE), F32)
    ycf, sfr, sfi = s5_direction(uct, *prm(0), zero, zero)
    ycb, sbr, sbi = s5_direction(flip(uct), *prm(1), zero, zero)
    yf, _, _ = s5_direction(ut, *prm(0), sfr, sfi)
    yb, _, _ = s5_direction(flip(ut), *prm(1), sbr, sbi)
    yc = finish(ycf, ycb, uc) if want_ctx else None
    return finish(yf, yb, u), yc


def attn_d(zq, zk, zv, cq, ck, cv, sink, cos, sin, want_ctx):
    b, t, _ = zq.shape
    grp = D_HEADS // D_KV
    scale = D_DH ** -0.5
    q = apply_rope(to_heads(zq, D_HEADS, D_DH), cos, sin).reshape(b, D_KV, grp, t, D_DH)
    k = apply_rope(to_heads(zk, D_KV, D_DH), cos, sin)
    v = to_heads(zv, D_KV, D_DH)
    kc, vc = to_heads(ck, D_KV, D_DH), to_heads(cv, D_KV, D_DH)
    n_ctx = kc.shape[2]
    sink_l = sink.astype(F32).reshape(1, D_KV, grp, 1, 1)
    span = Q_BLOCK + 2 * D_WINDOW
    pad = ((0, 0), (0, 0), (D_WINDOW, D_WINDOW), (0, 0))
    kp, vp = jnp.pad(k, pad), jnp.pad(v, pad)

    def block(bi):
        start = bi * Q_BLOCK
        qb = lax.dynamic_slice_in_dim(q, start, Q_BLOCK, axis=3)
        kb = lax.dynamic_slice_in_dim(kp, start, span, axis=2)
        vb = lax.dynamic_slice_in_dim(vp, start, span, axis=2)
        qpos = start + jnp.arange(Q_BLOCK)
        kpos = start - D_WINDOW + jnp.arange(span)
        ok = (kpos[None, :] >= 0) & (kpos[None, :] < t) & (jnp.abs(qpos[:, None] - kpos[None, :]) <= D_WINDOW)
        s_loc = jnp.where(ok, jnp.einsum('bkgqd,bksd->bkgqs', qb, kb).astype(F32) * scale, -jnp.inf)
        s_ctx = jnp.einsum('bkgqd,bksd->bkgqs', qb, kc).astype(F32) * scale
        s = jnp.concatenate([jnp.broadcast_to(sink_l, s_ctx.shape[:-1] + (1,)), s_ctx, s_loc], axis=-1)
        p = jax.nn.softmax(s, axis=-1).astype(v.dtype)
        return (jnp.einsum('bkgqs,bksd->bkgqd', p[..., 1:1 + n_ctx], vc)
                + jnp.einsum('bkgqs,bksd->bkgqd', p[..., 1 + n_ctx:], vb))

    o = lax.map(block, jnp.arange(t // Q_BLOCK))
    y = from_heads(jnp.moveaxis(o, 0, 3).reshape(b, D_HEADS, t, D_DH))
    yc = None
    if want_ctx:
        tc = cq.shape[1]
        qc = to_heads(cq, D_HEADS, D_DH).reshape(b, D_KV, grp, tc, D_DH)
        s = jnp.einsum('bkgqd,bksd->bkgqs', qc, kc).astype(F32) * scale
        s = jnp.concatenate([jnp.broadcast_to(sink_l, s.shape[:-1] + (1,)), s], axis=-1)
        p = jax.nn.softmax(s, axis=-1).astype(vc.dtype)
        oc = jnp.einsum('bkgqs,bksd->bkgqd', p[..., 1:], vc)
        yc = from_heads(oc.reshape(b, D_HEADS, tc, D_DH))
    return y, yc


def ab_mixer(hn, hcn, w_in, b_gate, w_out, g_q, g_k, head_g, cos, sin, want_ctx):
    qa, ka, va, qb, kb, vb, ob, gb = split_cols(hn @ w_in, AB_SIZES)
    cqa, cka, cva, cqb, ckb, cvb, cob, cgb = split_cols(hcn @ w_in, AB_SIZES)
    ya, yac = attn_a(qa, ka, va, cqa, cka, cva, g_q, g_k, cos, sin, want_ctx)
    yb, ybc = mlstm_mixer(qb, kb, vb, ob, gb, cqb, ckb, cvb, cob, cgb, b_gate, head_g, want_ctx)
    y = jnp.concatenate([ya, yb], axis=-1) @ w_out
    yc = jnp.concatenate([yac, ybc], axis=-1) @ w_out if want_ctx else None
    return y, yc


def cd_mixer(hn, hcn, w_in, w_out, a_re, a_im, log_dt, b_re, b_im, c_re, c_im, d_skip, glu_w, glu_b,
             sink, cos, sin, want_ctx):
    u, qd, kd, vd = split_cols(hn @ w_in, CD_SIZES)
    uc, cqd, ckd, cvd = split_cols(hcn @ w_in, CD_SIZES)
    ys, ysc = s5_mixer(u, uc, a_re, a_im, log_dt, b_re, b_im, c_re, c_im, d_skip, glu_w, glu_b, want_ctx)
    yd, ydc = attn_d(qd, kd, vd, cqd, ckd, cvd, sink, cos, sin, want_ctx)
    y = jnp.concatenate([ys, yd], axis=-1) @ w_out
    yc = jnp.concatenate([ysc, ydc], axis=-1) @ w_out if want_ctx else None
    return y, yc


def setup_inputs(seed: int = 0) -> dict:
    key = jax.random.key(seed)
    ks = iter(jax.random.split(key, 40))

    def nrm(shape, scale):
        return jax.random.normal(next(ks), shape, F32) * scale

    D = D_MODEL
    ig = nrm((N_AB, 2, B_HEADS), 0.1)
    fg = jnp.linspace(3.0, 6.0, B_HEADS, dtype=F32)[None, None, :] + nrm((N_AB, 2, B_HEADS), 0.1)
    ab_b_gate = jnp.stack([ig[:, 0], fg[:, 0], ig[:, 1], fg[:, 1]], axis=1).reshape(N_AB, 4 * B_HEADS)
    n_idx = jnp.arange(C_STATE, dtype=F32)
    return {
        'x': nrm((BATCH, SEQ, D), 1.0),
        'c': nrm((BATCH, D), 1.0),
        'ctx': nrm((BATCH, CTX_LEN, D), 1.0),
        'c_ctx': nrm((D,), 1.0),
        'mod_w': nrm((DEPTH, D, N_MOD * D), 0.5 * D ** -0.5),
        'mod_b': nrm((DEPTH, N_MOD * D), 0.02),
        'norm_g': 1.0 + nrm((DEPTH, 3, D), 0.02),
        'ffn_w1': nrm((DEPTH, 2, D, D_FF), D ** -0.5),
        'ffn_w3': nrm((DEPTH, 2, D, D_FF), D ** -0.5),
        'ffn_w2': nrm((DEPTH, 2, D_FF, D), D_FF ** -0.5),
        'ab_w_in': nrm((N_AB, D, AB_IN), D ** -0.5),
        'ab_b_gate': ab_b_gate,
        'ab_w_out': nrm((N_AB, AB_MIX, D), AB_MIX ** -0.5),
        'a_gq': 1.0 + nrm((N_AB, A_DH), 0.02),
        'a_gk': 1.0 + nrm((N_AB, A_DH), 0.02),
        'b_head_g': 1.0 + nrm((N_AB, B_HEADS * B_DV), 0.02),
        'cd_w_in': nrm((N_CD, D, CD_IN), D ** -0.5),
        'cd_w_out': nrm((N_CD, CD_MIX, D), CD_MIX ** -0.5),
        's5_a_re': -0.5 * jnp.exp(nrm((N_CD, 2, C_GROUPS, C_STATE), 0.05)),
        's5_a_im': math.pi * n_idx + nrm((N_CD, 2, C_GROUPS, C_STATE), 0.01),
        's5_log_dt': jax.random.uniform(next(ks), (N_CD, 2, C_GROUPS), F32, math.log(1e-3), math.log(1e-1)),
        's5_b_re': nrm((N_CD, 2, C_GROUPS, C_STATE, C_GROUP), (2 * C_GROUP) ** -0.5),
        's5_b_im': nrm((N_CD, 2, C_GROUPS, C_STATE, C_GROUP), (2 * C_GROUP) ** -0.5),
        's5_c_re': nrm((N_CD, 2, C_GROUPS, C_GROUP, C_STATE), C_STATE ** -0.5),
        's5_c_im': nrm((N_CD, 2, C_GROUPS, C_GROUP, C_STATE), C_STATE ** -0.5),
        's5_d': nrm((N_CD, C_WIDTH), 1.0),
        's5_glu_w': nrm((N_CD, C_WIDTH, C_WIDTH), C_WIDTH ** -0.5),
        's5_glu_b': nrm((N_CD, C_WIDTH), 0.02),
        'd_sink': nrm((N_CD, D_HEADS), 0.5),
        'final_g': 1.0 + nrm((D,), 0.02),
    }


def reference(x, c, ctx, c_ctx, mod_w, mod_b, norm_g, ffn_w1, ffn_w3, ffn_w2, ab_w_in, ab_b_gate,
              ab_w_out, a_gq, a_gk, b_head_g, cd_w_in, cd_w_out, s5_a_re, s5_a_im, s5_log_dt, s5_b_re,
              s5_b_im, s5_c_re, s5_c_im, s5_d, s5_glu_w, s5_glu_b, d_sink, final_g):
    b, t, d = x.shape
    rows = t // GRID_W
    cos_a, sin_a = axial_rope(rows, A_DH)
    cos_d, sin_d = axial_rope(rows, D_DH)
    h, hc = x, ctx
    for l in range(DEPTH):
        want_ctx = l < DEPTH - 1
        m = (jax.nn.silu(c) @ mod_w[l] + mod_b[l]).reshape(b, N_MOD, 1, d)
        mc = (jax.nn.silu(c_ctx) @ mod_w[l] + mod_b[l]).reshape(1, N_MOD, 1, d)
        h = h + 0.5 * m[:, 2] * swiglu(modulate(h, norm_g[l, 0], m[:, 0], m[:, 1]),
                                       ffn_w1[l, 0], ffn_w3[l, 0], ffn_w2[l, 0])
        hc = hc + 0.5 * mc[:, 2] * swiglu(modulate(hc, norm_g[l, 0], mc[:, 0], mc[:, 1]),
                                          ffn_w1[l, 0], ffn_w3[l, 0], ffn_w2[l, 0])
        hn = modulate(h, norm_g[l, 1], m[:, 3], m[:, 4])
        hcn = modulate(hc, norm_g[l, 1], mc[:, 3], mc[:, 4])
        i = l // 2
        if l % 2 == 0:
            y, yc = ab_mixer(hn, hcn, ab_w_in[i], ab_b_gate[i], ab_w_out[i], a_gq[i], a_gk[i], b_head_g[i],
                             cos_a, sin_a, want_ctx)
        else:
            y, yc = cd_mixer(hn, hcn, cd_w_in[i], cd_w_out[i], s5_a_re[i], s5_a_im[i], s5_log_dt[i],
                             s5_b_re[i], s5_b_im[i], s5_c_re[i], s5_c_im[i], s5_d[i], s5_glu_w[i],
                             s5_glu_b[i], d_sink[i], cos_d, sin_d, want_ctx)
        h = h + m[:, 5] * y
        h = h + 0.5 * m[:, 8] * swiglu(modulate(h, norm_g[l, 2], m[:, 6], m[:, 7]),
                                       ffn_w1[l, 1], ffn_w3[l, 1], ffn_w2[l, 1])
        if want_ctx:
            hc = hc + mc[:, 5] * yc
            hc = hc + 0.5 * mc[:, 8] * swiglu(modulate(hc, norm_g[l, 2], mc[:, 6], mc[:, 7]),
                                              ffn_w1[l, 1], ffn_w3[l, 1], ffn_w2[l, 1])
    return rmsnorm(h, final_g)
```

```cpp
#include <hip/hip_runtime.h>
#include <cstdio>
#include <cstdint>
#include <cmath>
namespace pg8 {
#define PG8_LAS __attribute__((address_space(3)))
typedef unsigned short bf16_t;
typedef short bf16x8 __attribute__((ext_vector_type(8)));
typedef float f32x4 __attribute__((ext_vector_type(4)));
typedef unsigned u32x4 __attribute__((ext_vector_type(4)));
constexpr int BM = 256, BK = 64, HALF = 128, HTB = HALF * BK * 2  , STAGE_BYTES = 8 * HTB, NXCD = 8, WGM = 8;

__host__ __device__ __forceinline__ int lds_byte(int r, int c) { const int st = (r >> 4) * 2 + (c >> 5), rr = r & 15, cc = c & 31, ob = rr * 64 + cc * 2; return st * 1024 + (ob ^ (((ob >> 9) & 1) << 5)); }
__host__ __device__ __forceinline__ void stage_rc(int b, int& R, int& C) { const int st = b / 1024, sb = b % 1024, swz = sb ^ (((sb >> 9) & 1) << 5); R = (st >> 1) * 16 + swz / 64; C = (st & 1) * 32 + (swz % 64) / 2; }
__host__ __device__ __forceinline__ int perm32(int rho) { const int n = rho >> 4, i = rho & 15; return 8 * (i >> 2) + 4 * n + (i & 3); }

struct Unit { int pm, pn; };
struct Gemm { const bf16_t* A; const bf16_t* Bt; int M, N, K; };

struct StaticOrder {
    int nM, nN, nwg, G, c;
    __host__ __device__ void init(int M, int N, int G_, int c_) { nM = M / BM; nN = N / BM; nwg = nM * nN; G = G_; c = c_; }
    __host__ __device__ bool next(int i, Unit& u) const {
        const long L = (long)i * G + c; if (L >= nwg) return false;
        int wgid = (int)L; { const int q = nwg / NXCD, r = nwg % NXCD, xcd = wgid % NXCD, off = wgid / NXCD; wgid = (xcd < r ? xcd * (q + 1) : r * (q + 1) + (xcd - r) * q) + off; }
        const int nig = WGM * nN, gid = wgid / nig, fm = gid * WGM, gsz = (nM - fm) < WGM ? (nM - fm) : WGM;
        u.pm = fm + ((wgid % nig) % gsz); u.pn = (wgid % nig) / gsz; return true;
    }
    __device__ __forceinline__ void a_ready(const Unit&) const {}
    __device__ __forceinline__ void done(const Unit&) const {}
};

__device__ __forceinline__ unsigned cvt_pk_bf16(float lo, float hi) { unsigned r; asm volatile("v_cvt_pk_bf16_f32 %0, %1, %2" : "=v"(r) : "v"(lo), "v"(hi)); return r; }
typedef float f32x2 __attribute__((ext_vector_type(2)));
__device__ __forceinline__ float fast_sigmoid(float a) { return __builtin_amdgcn_rcpf(1.f + __builtin_amdgcn_exp2f(-1.4426950408889634f * a)); }
struct EpiPlain {
    static constexpr bool PERM = true, AFTER_DRAIN = false;
    bf16_t* O; int ldc; float* gates; int gate_pn;
    __device__ __forceinline__ void operator()(const f32x4 (&acc)[2][2][4][2], const Unit& u, int wr, int wc, int fr, int fq) const {
        const int row0 = u.pm * BM + wr * 64 + fr, col0 = u.pn * BM + wc * 32 + 8 * fq;
#pragma unroll
        for (int ai = 0; ai < 2; ++ai)
#pragma unroll
            for (int m = 0; m < 4; ++m) { const int row = row0 + ai * HALF + m * 16; bf16_t* rowp = O + (size_t)row * ldc + col0;
#pragma unroll
                for (int bj = 0; bj < 2; ++bj) { const f32x4 v0 = acc[ai][bj][m][0], v1 = acc[ai][bj][m][1];
                    u32x4 w; w.x = cvt_pk_bf16(v0[0], v0[1]); w.y = cvt_pk_bf16(v0[2], v0[3]); w.z = cvt_pk_bf16(v1[0], v1[1]); w.w = cvt_pk_bf16(v1[2], v1[3]);
                    *(u32x4*)(rowp + bj * HALF) = w;
                    if (bj == 0 && u.pn == gate_pn && wc == 0 && fq < 2) { float* gp = gates + (size_t)row * 16 + 8 * fq; *(f32x4*)gp = v0; *(f32x4*)(gp + 4) = v1; } } }
    }
};
struct EpiSwiglu {
    static constexpr bool PERM = true, AFTER_DRAIN = false;
    bf16_t* O; int ldc;
    __device__ __forceinline__ void operator()(const f32x4 (&acc)[2][2][4][2], const Unit& u, int wr, int wc, int fr, int fq) const {
        const int row0 = u.pm * BM + wr * 64 + fr, col0 = u.pn * HALF + wc * 32 + 8 * fq;
#pragma unroll
        for (int ai = 0; ai < 2; ++ai)
#pragma unroll
            for (int m = 0; m < 4; ++m) { bf16_t* rowp = O + (size_t)(row0 + ai * HALF + m * 16) * ldc + col0;
                float r[8];
#pragma unroll
                for (int n = 0; n < 2; ++n)
#pragma unroll
                    for (int j = 0; j < 4; ++j) { const float a = acc[ai][0][m][n][j], b = acc[ai][1][m][n][j]; r[4 * n + j] = a * fast_sigmoid(a) * b; }
                u32x4 w; w.x = cvt_pk_bf16(r[0], r[1]); w.y = cvt_pk_bf16(r[2], r[3]); w.z = cvt_pk_bf16(r[4], r[5]); w.w = cvt_pk_bf16(r[6], r[7]);
                *(u32x4*)rowp = w; }
    }
};
struct EpiResid {
    static constexpr bool PERM = true, AFTER_DRAIN = false;
    float* H; const float* gate; int gstride; float coef;
    __device__ __forceinline__ void operator()(const f32x4 (&acc)[2][2][4][2], const Unit& u, int wr, int wc, int fr, int fq) const {
        const int row0 = u.pm * BM + wr * 64 + fr, col0 = u.pn * BM + wc * 32 + 8 * fq;
        const int sel = u.pm < 64 ? (u.pm >> 4) : 4;
        const float* gp = gate + (size_t)sel * gstride + col0;
        f32x4 gv[2][2];
#pragma unroll
        for (int bj = 0; bj < 2; ++bj)
#pragma unroll
            for (int n = 0; n < 2; ++n) gv[bj][n] = *(const f32x4*)(gp + bj * HALF + 4 * n) * coef;
#pragma unroll
        for (int ai = 0; ai < 2; ++ai)
#pragma unroll
            for (int m = 0; m < 4; ++m) { float* rowp = H + (size_t)(row0 + ai * HALF + m * 16) * 2048 + col0;
#pragma unroll
                for (int bj = 0; bj < 2; ++bj)
#pragma unroll
                    for (int n = 0; n < 2; ++n) { f32x4* p = (f32x4*)(rowp + bj * HALF + 4 * n); *p = *p + gv[bj][n] * acc[ai][bj][m][n]; } }
    }
};
struct EpiGlu {
    static constexpr bool PERM = true, AFTER_DRAIN = false;
    bf16_t* O; int ldc; const bf16_t* G; const float* bias;
    __device__ __forceinline__ void operator()(const f32x4 (&acc)[2][2][4][2], const Unit& u, int wr, int wc, int fr, int fq) const {
        const int row0 = u.pm * BM + wr * 64 + fr, col0 = u.pn * BM + wc * 32 + 8 * fq;
#pragma unroll
        for (int ai = 0; ai < 2; ++ai)
#pragma unroll
            for (int m = 0; m < 4; ++m) { const int row = row0 + ai * HALF + m * 16;
#pragma unroll
                for (int bj = 0; bj < 2; ++bj) { const int col = col0 + bj * HALF;
                    const u32x4 gw = *(const u32x4*)(G + (size_t)row * 1024 + col);
                    const f32x4 b0 = *(const f32x4*)(bias + col), b1 = *(const f32x4*)(bias + col + 4);
                    float r[8];
#pragma unroll
                    for (int j = 0; j < 4; ++j) { r[j] = fast_sigmoid(acc[ai][bj][m][0][j] + b0[j]); r[4 + j] = fast_sigmoid(acc[ai][bj][m][1][j] + b1[j]); }
                    const unsigned gws[4] = {gw.x, gw.y, gw.z, gw.w};
#pragma unroll
                    for (int q = 0; q < 4; ++q) { r[2 * q] *= __builtin_bit_cast(float, gws[q] << 16); r[2 * q + 1] *= __builtin_bit_cast(float, gws[q] & 0xffff0000u); }
                    u32x4 w; w.x = cvt_pk_bf16(r[0], r[1]); w.y = cvt_pk_bf16(r[2], r[3]); w.z = cvt_pk_bf16(r[4], r[5]); w.w = cvt_pk_bf16(r[6], r[7]);
                    *(u32x4*)(O + (size_t)row * ldc + col) = w; } }
    }
};
template <class Epi, class Sched, bool ALIGN_EPI = false, bool SP2 = false>
__device__ __forceinline__ void gemm_phase(PG8_LAS unsigned char* lds, const Gemm g, const Sched& S, const Epi& E) {
    int tid = threadIdx.x; asm volatile("" : "+v"(tid));
    const int wid = __builtin_amdgcn_readfirstlane(tid >> 6), lane = tid & 63, wr = wid >> 2, wc = wid & 3, fr = lane & 15, fq = lane >> 4;
    const int K = g.K, nt = K / BK;
    unsigned voffA[2], voffB[2];
#pragma unroll
    for (int i = 0; i < 2; ++i) { int R, C; stage_rc(tid * 16 + i * 8192, R, C); const int Rb = Epi::PERM ? ((R & ~31) + perm32(R & 31)) : R;
        voffA[i] = (unsigned)(R * K + C) * 2u; voffB[i] = (unsigned)(Rb * K + C) * 2u; }
    const size_t kstep = (size_t)(BK * 2);
    const size_t hstep = (size_t)HALF * K * 2;
    const size_t tstep = 2 * hstep;
    const unsigned ldsw = (unsigned)wid * 1024u;
    const int aoff = lds_byte(wr * 64 + fr, fq * 8), boff = lds_byte(wc * 32 + fr, fq * 8);
#define PG8_SA(b, h) (((b) * 2 + (h)) * HTB)
#define PG8_SB(b, h) ((4 + (b) * 2 + (h)) * HTB)
#define PG8_STAGE(bufoff, gbase, voff) do { _Pragma("unroll") for (int _i = 0; _i < 2; ++_i) \
        __builtin_amdgcn_global_load_lds((const unsigned*)((const char*)(gbase) + (voff)[_i]), (PG8_LAS unsigned*)(lds + (bufoff) + ldsw + _i * 8192), 16, 0, 0); } while (0)
#define PG8_LDA(dst, b, h) do { _Pragma("unroll") for (int m = 0; m < 4; ++m) _Pragma("unroll") for (int k = 0; k < 2; ++k) dst[m][k] = *(const PG8_LAS bf16x8*)(lds + PG8_SA(b, h) + aoff + m * 2048 + k * 1024); } while (0)
#define PG8_LDB(dst, b, h) do { _Pragma("unroll") for (int n = 0; n < 2; ++n) _Pragma("unroll") for (int k = 0; k < 2; ++k) dst[n][k] = *(const PG8_LAS bf16x8*)(lds + PG8_SB(b, h) + boff + n * 2048 + k * 1024); } while (0)
#define PG8_MMA(ai, bj, At, Bt) do { __builtin_amdgcn_s_setprio(1); _Pragma("unroll") for (int m = 0; m < 4; ++m) _Pragma("unroll") for (int n = 0; n < 2; ++n) _Pragma("unroll") for (int k = 0; k < 2; ++k) \
        acc[ai][bj][m][n] = __builtin_amdgcn_mfma_f32_16x16x32_bf16(Bt[n][k], At[m][k], acc[ai][bj][m][n], 0, 0, 0); __builtin_amdgcn_s_setprio(0); } while (0)
#define PG8_WAIT_V(n) asm volatile("s_waitcnt vmcnt(" #n ")" ::: "memory")
#define PG8_WAIT_L(n) asm volatile("s_waitcnt lgkmcnt(" #n ")" ::: "memory")
#define PG8_BAR __builtin_amdgcn_s_barrier()
#define PG8_SCHED __builtin_amdgcn_sched_barrier(0)
    Unit cur, nxt; int ui = 0;
    if (!S.next(0, cur)) return;
    f32x4 acc[2][2][4][2];
#pragma unroll
    for (int a = 0; a < 2; ++a)
#pragma unroll
        for (int b = 0; b < 2; ++b)
#pragma unroll
            for (int m = 0; m < 4; ++m)
#pragma unroll
                for (int n = 0; n < 2; ++n) acc[a][b][m][n] = (f32x4){0.f, 0.f, 0.f, 0.f};
    bf16x8 At[4][2], B0[2][2], B1[2][2];
    const char* cA = (const char*)g.A + (size_t)cur.pm * tstep; const char* cB = (const char*)g.Bt + (size_t)cur.pn * tstep;
    S.a_ready(cur);
    if constexpr (SP2) {
        PG8_STAGE(PG8_SB(0, 0), cB, voffB); PG8_STAGE(PG8_SB(0, 1), cB + hstep, voffB); PG8_STAGE(PG8_SA(0, 0), cA, voffA); PG8_STAGE(PG8_SA(0, 1), cA + hstep, voffA);
        if (wr == 1) PG8_BAR;
        PG8_WAIT_V(2); PG8_BAR;
        PG8_STAGE(PG8_SB(1, 0), cB + kstep, voffB); PG8_STAGE(PG8_SA(1, 0), cA + kstep, voffA); PG8_STAGE(PG8_SB(1, 1), cB + hstep + kstep, voffB);
        PG8_WAIT_V(6); PG8_BAR;
    } else {
        PG8_STAGE(PG8_SB(0, 0), cB, voffB); PG8_STAGE(PG8_SA(0, 0), cA, voffA); PG8_STAGE(PG8_SB(0, 1), cB + hstep, voffB); PG8_STAGE(PG8_SA(0, 1), cA + hstep, voffA);
        if (wr == 1) PG8_BAR;
        PG8_WAIT_V(4); PG8_BAR;
        PG8_STAGE(PG8_SB(1, 0), cB + kstep, voffB); PG8_STAGE(PG8_SA(1, 0), cA + kstep, voffA); PG8_STAGE(PG8_SB(1, 1), cB + hstep + kstep, voffB);
        PG8_WAIT_V(6); PG8_BAR;
    }
    for (;;) {
        const bool has_next = S.next(ui + 1, nxt);
        const char* nA = has_next ? (const char*)g.A + (size_t)nxt.pm * tstep : cA; const char* nB = has_next ? (const char*)g.Bt + (size_t)nxt.pn * tstep : cB;
        for (int t = 0; t < nt; t += 2) {
            const bool last = (t == nt - 2);
            const char* a1 = cA + (size_t)(t + 1) * kstep;
            const char* a2 = last ? nA : cA + (size_t)(t + 2) * kstep; const char* b2 = last ? nB : cB + (size_t)(t + 2) * kstep;
            const char* a3 = a2 + kstep; const char* b3 = b2 + kstep;
            if (last && has_next) S.a_ready(nxt);
            if constexpr (SP2) {
            PG8_LDB(B0, 0, 0); PG8_LDB(B1, 0, 1); PG8_SCHED; PG8_LDA(At, 0, 0); PG8_STAGE(PG8_SA(1, 1), a1 + hstep, voffA);
            PG8_WAIT_V(8); PG8_WAIT_L(0); PG8_BAR; PG8_MMA(0, 0, At, B0); PG8_MMA(0, 1, At, B1); PG8_BAR; PG8_SCHED;
            PG8_LDA(At, 0, 1); PG8_STAGE(PG8_SB(0, 0), b2, voffB); PG8_STAGE(PG8_SB(0, 1), b2 + hstep, voffB); PG8_STAGE(PG8_SA(0, 0), a2, voffA);
            PG8_WAIT_V(8); PG8_WAIT_L(0); PG8_BAR; PG8_MMA(1, 0, At, B0); PG8_MMA(1, 1, At, B1); PG8_BAR; PG8_SCHED;
            PG8_LDB(B0, 1, 0); PG8_LDB(B1, 1, 1); PG8_SCHED; PG8_LDA(At, 1, 0); PG8_STAGE(PG8_SA(0, 1), a2 + hstep, voffA);
            PG8_WAIT_V(8); PG8_WAIT_L(0); PG8_BAR; PG8_MMA(0, 0, At, B0); PG8_MMA(0, 1, At, B1); PG8_BAR; PG8_SCHED;
            PG8_LDA(At, 1, 1); PG8_STAGE(PG8_SB(1, 0), b3, voffB); PG8_STAGE(PG8_SB(1, 1), b3 + hstep, voffB); PG8_STAGE(PG8_SA(1, 0), a3, voffA);
            PG8_WAIT_V(8); PG8_WAIT_L(0); PG8_BAR; PG8_MMA(1, 0, At, B0); PG8_MMA(1, 1, At, B1); PG8_BAR; PG8_SCHED;
            } else {
            PG8_LDB(B0, 0, 0); PG8_SCHED; PG8_LDA(At, 0, 0); PG8_STAGE(PG8_SA(1, 1), a1 + hstep, voffA);
            PG8_WAIT_L(8); PG8_BAR; PG8_WAIT_L(0); PG8_MMA(0, 0, At, B0); PG8_BAR; PG8_SCHED;
            PG8_LDB(B1, 0, 1); PG8_STAGE(PG8_SB(0, 0), b2, voffB);
            PG8_BAR; PG8_WAIT_L(0); PG8_MMA(0, 1, At, B1); PG8_BAR;
            PG8_LDA(At, 0, 1); PG8_STAGE(PG8_SA(0, 0), a2, voffA);
            PG8_BAR; PG8_WAIT_L(0); PG8_MMA(1, 0, At, B0); PG8_BAR; PG8_SCHED;
            PG8_STAGE(PG8_SB(0, 1), b2 + hstep, voffB);
            PG8_WAIT_V(6); PG8_BAR; PG8_MMA(1, 1, At, B1); PG8_BAR;
            PG8_LDB(B0, 1, 0); PG8_SCHED; PG8_LDA(At, 1, 0); PG8_STAGE(PG8_SA(0, 1), a2 + hstep, voffA);
            PG8_WAIT_L(8); PG8_BAR; PG8_WAIT_L(0); PG8_MMA(0, 0, At, B0); PG8_BAR; PG8_SCHED;
            PG8_LDB(B1, 1, 1); PG8_STAGE(PG8_SB(1, 0), b3, voffB);
            PG8_BAR; PG8_WAIT_L(0); PG8_MMA(0, 1, At, B1); PG8_BAR;
            PG8_LDA(At, 1, 1); PG8_STAGE(PG8_SA(1, 0), a3, voffA);
            PG8_BAR; PG8_WAIT_L(0); PG8_MMA(1, 0, At, B0); PG8_BAR; PG8_SCHED;
            PG8_STAGE(PG8_SB(1, 1), b3 + hstep, voffB);
            PG8_WAIT_V(6); PG8_BAR; PG8_MMA(1, 1, At, B1); PG8_BAR;
            }
        }
        if constexpr (ALIGN_EPI) { if (wr == 0) PG8_BAR; }
        if constexpr (!Epi::AFTER_DRAIN) { E(acc, cur, wr, wc, fr, fq); S.done(cur); }
        if (!has_next) break;
#pragma unroll
        for (int a = 0; a < 2; ++a)
#pragma unroll
            for (int b = 0; b < 2; ++b)
#pragma unroll
                for (int m = 0; m < 4; ++m)
#pragma unroll
                    for (int n = 0; n < 2; ++n) acc[a][b][m][n] = (f32x4){0.f, 0.f, 0.f, 0.f};
        cur = nxt; cA = nA; cB = nB; ++ui;
        if constexpr (ALIGN_EPI) { if (wr == 1) PG8_BAR; }
    }
    PG8_WAIT_V(0);
    if constexpr (!ALIGN_EPI) { if (wr == 0) PG8_BAR; }
    PG8_BAR;
    if constexpr (Epi::AFTER_DRAIN) { E.fused(acc, cur, wr, wc, fr, fq, lds, wid, lane); S.done(cur); }
#undef PG8_SA
#undef PG8_SB
#undef PG8_STAGE
#undef PG8_LDA
#undef PG8_LDB
#undef PG8_MMA
#undef PG8_WAIT_V
#undef PG8_WAIT_L
#undef PG8_BAR
#undef PG8_SCHED
}
}
#define GAS __attribute__((address_space(1)))
#define LAS __attribute__((address_space(3)))
typedef unsigned short bf16;
typedef unsigned v4u __attribute__((ext_vector_type(4)));
typedef float f32x4 __attribute__((ext_vector_type(4)));
typedef short bf16x8 __attribute__((ext_vector_type(8)));
typedef GAS unsigned gu32;
typedef GAS unsigned long long gu64;
#define RLX_AGENT __ATOMIC_RELAXED, __HIP_MEMORY_SCOPE_AGENT
#define LDS_WAIT() asm volatile("s_waitcnt lgkmcnt(0)" ::: "memory")
#define VM_WAIT() asm volatile("s_waitcnt vmcnt(0)" ::: "memory")
__device__ __forceinline__ unsigned long long rt() { return __builtin_amdgcn_s_memrealtime(); }
__device__ __forceinline__ unsigned f2bf(float f) { unsigned u = __builtin_bit_cast(unsigned, f); return (u + 0x7fffu + ((u >> 16) & 1u)) >> 16; }
__device__ __forceinline__ unsigned pk2(float lo, float hi) { return f2bf(lo) | (f2bf(hi) << 16); }

#define XB_TMO      128
#define XB_XCNT(j)  (256  + 64 * (j))
#define XB_XSUB(j)  (1280 + 64 * (j))
#define XB_XGEN(j)  (2304 + 64 * (j))
#define XB_TOP      3328
#define XB_TOPGEN   3392
#define XCD_BAR_WORDS 3456
#define XB_SPIN_CAP (1u << 18)

__device__ __forceinline__ unsigned xb_ld(unsigned* p)              { return __hip_atomic_load(p, __ATOMIC_RELAXED, __HIP_MEMORY_SCOPE_AGENT); }
__device__ __forceinline__ unsigned xb_add(unsigned* p, unsigned v) { return __hip_atomic_fetch_add(p, v, __ATOMIC_RELAXED, __HIP_MEMORY_SCOPE_AGENT); }
__device__ __forceinline__ unsigned xb_xcc_id() { return (unsigned)__builtin_amdgcn_s_getreg((3 << 11) | 20) & 0xFu; }
#define XB_SPIN(cond, bar) do { unsigned _sp = 0; while (cond) { __builtin_amdgcn_s_sleep(1); \
    if ((++_sp & 255u) == 0u) { if (xb_ld(&(bar)[XB_TMO])) break; if (_sp > XB_SPIN_CAP) { atomicAdd(&(bar)[XB_TMO], 1u); break; } } } } while (0)

struct XcdBarrier {
    unsigned* bar; unsigned x;
    volatile LAS unsigned* st;
};

__device__ __forceinline__ XcdBarrier xcd_barrier_post(unsigned* bar, volatile LAS unsigned* st) {
    XcdBarrier b; b.bar = bar; b.x = xb_xcc_id(); b.st = st;
    if (threadIdx.x == 0) (void)xb_add(&bar[XB_XCNT(b.x)], 1u);
    return b;
}
__device__ __forceinline__ void xcd_barrier_complete(unsigned* bar, unsigned x, unsigned& nloc, unsigned& nx) {
    const unsigned G = gridDim.x * gridDim.y * gridDim.z;
    unsigned sum, cnt, mine, sp = 0u;
    for (;;) {
        sum = 0u; cnt = 0u; mine = 0u;
#pragma unroll
        for (unsigned j = 0; j < 16; ++j) { const unsigned c = xb_ld(&bar[XB_XCNT(j)]); sum += c; cnt += (c > 0u) ? 1u : 0u; mine = (j == x) ? c : mine; }
        if (sum == G) break;
        __builtin_amdgcn_s_sleep(1);
        if ((++sp & 255u) == 0u) { if (xb_ld(&bar[XB_TMO])) break; if (sp > XB_SPIN_CAP) { atomicAdd(&bar[XB_TMO], 1u); break; } }
    }
    nloc = mine > 0u ? mine : 1u; nx = cnt > 0u ? cnt : 1u;
}

__device__ __forceinline__ void xcd_barrier(const XcdBarrier& b) {
    asm volatile("s_waitcnt vmcnt(0)" ::: "memory");
    __syncthreads();
    if (threadIdx.x == 0) {
        unsigned* bar = b.bar;
        __builtin_amdgcn_s_waitcnt(0);
        unsigned nloc = b.st[0], nx = b.st[1];
        if (nloc == 0u) { xcd_barrier_complete(bar, b.x, nloc, nx); b.st[0] = nloc; b.st[1] = nx; }
        const unsigned old = xb_add(&bar[XB_XSUB(b.x)], 1u);
        const unsigned gen = old / nloc;
        if (old + 1u == (gen + 1u) * nloc) {
            __builtin_amdgcn_fence(__ATOMIC_RELEASE, "agent");
            asm volatile("s_waitcnt vmcnt(0)" ::: "memory");
            const unsigned og = xb_add(&bar[XB_TOP], 1u);
            const unsigned tg = og / nx;
            if (og + 1u == (tg + 1u) * nx) xb_add(&bar[XB_TOPGEN], 1u);
            else XB_SPIN(xb_ld(&bar[XB_TOPGEN]) == tg, bar);
            __builtin_amdgcn_fence(__ATOMIC_ACQUIRE, "agent");
            xb_add(&bar[XB_XGEN(b.x)], 1u);
            asm volatile("s_waitcnt vmcnt(0)" ::: "memory");
        } else {
            XB_SPIN(xb_ld(&bar[XB_XGEN(b.x)]) == gen, bar);
            __builtin_amdgcn_fence(__ATOMIC_ACQUIRE, "agent");
            asm volatile("s_waitcnt vmcnt(0)" ::: "memory");
        }
    }
    __syncthreads();
}
constexpr int NWAVES = 8;
constexpr int DM = 2048, NB = 4, TT = 4096, CT = 256, SB = 4352, MR = NB * SB  , FF = 5632;
constexpr int AB_IN = 4624, ZLD = 4864, CD_IN = 2304, NMOD = 9, MODN = NMOD * DM  ;
constexpr float EPS = 1e-6f;
constexpr int ZA_Q = 0, ZA_K = 1024, ZA_V = 1280, ZB_Q = 1536, ZB_K = 2048, ZB_V = 2560, ZB_O = 3584, ZB_G = 4608;
constexpr int ZC_U = 0, ZD_Q = 1024, ZD_K = 2048, ZD_V = 2176;
constexpr int KSPLIT = 32;
constexpr size_t MiB = 1u << 20;
constexpr size_t WS_CTL = 0, CTL_ZERO_BYTES = 1 * MiB;
constexpr size_t WS_WUP = 1 * MiB;
constexpr size_t WS_WDN = WS_WUP + 4 * 44 * MiB;
constexpr size_t WS_WABIN = WS_WDN + 4 * 22 * MiB;
constexpr size_t WS_WABOUT = WS_WABIN + 19 * MiB;
constexpr size_t WS_WCDIN = WS_WABOUT + 8 * MiB;
constexpr size_t WS_WCDOUT = WS_WCDIN + 9 * MiB;
constexpr size_t WS_WGLU = WS_WCDOUT + 8 * MiB;
constexpr size_t WS_MODP = WS_WGLU + 2 * MiB;
constexpr size_t WS_MODV = WS_MODP + 23 * MiB;
constexpr size_t WS_NRM = WS_MODV + 1 * MiB;
constexpr size_t WS_TAB = WS_NRM + 1 * MiB;
constexpr size_t WS_H = WS_TAB + 4 * MiB;
constexpr size_t WS_HN = WS_H + 136 * MiB;
constexpr size_t WS_X = WS_HN + 68 * MiB;
constexpr size_t WS_Z = WS_X, WS_ZT = WS_X + 163 * MiB, WS_HID = WS_X;
constexpr size_t WS_CAT = WS_X + 216 * MiB;
constexpr size_t WS_GATES = WS_CAT + 68 * MiB;
constexpr size_t WS_KA = WS_GATES + 2 * MiB;
constexpr size_t WS_G = WS_KA + 10 * MiB;
constexpr size_t WS_SC1 = WS_G + 34 * MiB;
constexpr size_t WS_SC2 = WS_SC1 + 68 * MiB;
constexpr size_t WS_END = WS_SC2 + 68 * MiB;
static_assert((size_t)MR * ZLD * 2 <= 163 * MiB && (size_t)1536 * MR * 2 <= 53 * MiB && (size_t)MR * FF * 2 <= 216 * MiB, "overlay");
constexpr size_t TB_ROPEA = 0;
constexpr size_t TB_ROPED = 16384;
constexpr size_t TB_S5AB = 32768;
constexpr size_t TB_S5BB = TB_S5AB + 65536;
constexpr size_t TB_END = TB_S5BB + 1048576;
static_assert(TB_END <= 4 * MiB, "tables");
constexpr int CW_TMO = 0, CW_BAR = 4096;
constexpr int RING_OFF = 0, RING_BYTES = 131072;
constexpr int LDSCTL_OFF = RING_BYTES, MISC_OFF = LDSCTL_OFF + 320;
constexpr int LDS_BYTES = 147456;
static_assert(MISC_OFF + 128 <= LDS_BYTES, "LDS map");
__device__ __forceinline__ float bf2f(bf16 v) { return __builtin_bit_cast(float, (unsigned)v << 16); }
__device__ __forceinline__ float wave_sum(float v) {
#pragma unroll
    for (int o = 1; o < 64; o <<= 1) v += __shfl_xor(v, o);
    return v;
}
__device__ __forceinline__ float wave_sum_l(float v, int lane) {
#pragma unroll
    for (int o = 1; o < 64; o <<= 1) v += __builtin_bit_cast(float, __builtin_amdgcn_ds_bpermute((lane ^ o) << 2, __builtin_bit_cast(int, v)));
    return v;
}
#define OPAQUE(x) asm volatile("" : "+v"(x))
__device__ __forceinline__ float silu_acc(float x) { return x / (1.f + expf(-x)); }
__device__ __forceinline__ float logsigmoid_acc(float x) { return x >= 0.f ? -log1pf(expf(-x)) : x - log1pf(expf(x)); }
__device__ __forceinline__ float gelu_tanh(float x) { const float u = 0.7978845608028654f * (x + 0.044715f * x * x * x); return 0.5f * x * (1.f + tanhf(u)); }
__device__ __forceinline__ int row_sel(int m) { return m < NB * TT ? (m >> 12) : 4; }

struct Frame {
    LAS unsigned char* lds;
    volatile LAS unsigned* MISC;
    gu32* ctl;
    int tid, lane, wave, G;
    const float* in[30]; float* out; unsigned char* ws;
};

__device__ __forceinline__ void p0_transpose_item(const float* W, int K, int N, int Nvalid, bf16* WT, int drow0, int k0, int n0, LAS float* scr, int lane) {
    const int nn = n0 + (lane & 31); const bool ok = nn < Nvalid;
#pragma unroll 8
    for (int i = 0; i < 32; ++i) { const int kk = 2 * i + (lane >> 5); scr[kk * 33 + (lane & 31)] = ok ? W[(size_t)(k0 + kk) * N + nn] : 0.f; }
    LDS_WAIT(); asm volatile("" ::: "memory");
    const int c = lane & 7;
#pragma unroll
    for (int j = 0; j < 4; ++j) { const int n = (lane >> 3) + 8 * j; const LAS float* s = scr + (8 * c) * 33 + n;
        v4u o; o.x = pk2(s[0 * 33], s[1 * 33]); o.y = pk2(s[2 * 33], s[3 * 33]); o.z = pk2(s[4 * 33], s[5 * 33]); o.w = pk2(s[6 * 33], s[7 * 33]);
        *(GAS v4u*)(WT + (size_t)(drow0 + n) * K + k0 + 8 * c) = o; }
    LDS_WAIT(); asm volatile("" ::: "memory");
}
__device__ __forceinline__ bool p0_mat(int& r, const float* W, int K, int N, int Npad, bf16* WT, int mode  , LAS float* scr, int lane) {
    const int nblk = Npad / 32, items = (K / 64) * nblk;
    if (r >= items) { r -= items; return false; }
    const int kb = r / nblk, nb = r % nblk, n0 = 32 * nb;
    int drow0 = n0; if (mode) drow0 = (n0 >> 7) * 256 + (n0 & 127) + (mode == 2 ? 128 : 0);
    p0_transpose_item(W, K, N, N, WT, drow0, 64 * kb, n0, scr, lane);
    return true;
}
__device__ __forceinline__ void p0_prologue(Frame& F) {
    LAS float* scr = (LAS float*)(F.lds + RING_OFF + F.wave * 16384);
    int lane = F.lane; OPAQUE(lane);
    const int gw = blockIdx.x * NWAVES + F.wave, NGW = F.G * NWAVES;
    unsigned char* ws = F.ws;
    {
        constexpr int NCH = MODN / 256, NIT = 2 * KSPLIT * NCH, KPER = DM / KSPLIT;
        for (int it = gw; it < NIT; it += NGW) {
            const int cc = it % NCH, ks = (it / NCH) % KSPLIT, l = it / (NCH * KSPLIT);
            const float* W = F.in[4] + (size_t)l * DM * MODN + (size_t)(ks * KPER) * MODN + cc * 256 + lane * 4;
            f32x4 a0 = {0, 0, 0, 0}, a1 = a0, a2 = a0, a3 = a0, a4 = a0;
#pragma unroll 4
            for (int k = 0; k < KPER; ++k) {
                const f32x4 w = *(const f32x4*)(W + (size_t)k * MODN); const int kk = ks * KPER + k;
                const float s0 = silu_acc(F.in[1][kk]), s1 = silu_acc(F.in[1][DM + kk]), s2 = silu_acc(F.in[1][2 * DM + kk]), s3 = silu_acc(F.in[1][3 * DM + kk]), s4 = silu_acc(F.in[3][kk]);
                a0 += w * s0; a1 += w * s1; a2 += w * s2; a3 += w * s3; a4 += w * s4;
            }
            float* P = (float*)(ws + WS_MODP) + ((size_t)(l * KSPLIT + ks) * 5) * MODN + cc * 256 + lane * 4;
            *(f32x4*)(P) = a0; *(f32x4*)(P + MODN) = a1; *(f32x4*)(P + 2 * MODN) = a2; *(f32x4*)(P + 3 * MODN) = a3; *(f32x4*)(P + 4 * MODN) = a4;
        }
    }
    {
        constexpr int I_UP = (DM / 64) * (FF / 32), I_DN = (FF / 64) * (DM / 32);
        constexpr int NIT = 8 * I_UP + 4 * I_DN + (DM / 64) * (ZLD / 32) + 2 * (DM / 64) * (DM / 32) + (DM / 64) * (CD_IN / 32) + (1024 / 64) * (1024 / 32);
        for (int it = gw; it < NIT; it += NGW) {
            int r = it; bool done = false;
#pragma unroll 1
            for (int lh = 0; lh < 4 && !done; ++lh) {
                bf16* up = (bf16*)(ws + WS_WUP + (size_t)lh * 44 * MiB);
                done = p0_mat(r, F.in[7] + (size_t)lh * DM * FF, DM, FF, FF, up, 1, scr, lane); if (done) break;
                done = p0_mat(r, F.in[8] + (size_t)lh * DM * FF, DM, FF, FF, up, 2, scr, lane); if (done) break;
                done = p0_mat(r, F.in[9] + (size_t)lh * FF * DM, FF, DM, DM, (bf16*)(ws + WS_WDN + (size_t)lh * 22 * MiB), 0, scr, lane);
            }
            if (done) continue;
            {
                const int nblk = ZLD / 32, items = (DM / 64) * nblk;
                if (r < items) { const int kb = r / nblk, nb = r % nblk; p0_transpose_item(F.in[10], DM, AB_IN, AB_IN, (bf16*)(ws + WS_WABIN), 32 * nb, 64 * kb, 32 * nb, scr, lane); continue; }
                r -= items;
            }
            if (p0_mat(r, F.in[12], DM, DM, DM, (bf16*)(ws + WS_WABOUT), 0, scr, lane)) continue;
            if (p0_mat(r, F.in[16], DM, CD_IN, CD_IN, (bf16*)(ws + WS_WCDIN), 0, scr, lane)) continue;
            if (p0_mat(r, F.in[17], DM, DM, DM, (bf16*)(ws + WS_WCDOUT), 0, scr, lane)) continue;
            p0_mat(r, F.in[26], 1024, 1024, 1024, (bf16*)(ws + WS_WGLU), 0, scr, lane);
        }
    }
    {
        int tid_ = F.tid; OPAQUE(tid_); const int gt = blockIdx.x * (NWAVES * 64) + tid_, NT = F.G * NWAVES * 64;
        float* ropeA = (float*)(ws + WS_TAB + TB_ROPEA); float* ropeD = (float*)(ws + WS_TAB + TB_ROPED);
        for (int i = gt; i < 64 * 32; i += NT) { const int pos = i >> 5, f = i & 31; const float inv = powf(10000.f, -(float)f / 32.f), a = (float)pos * inv; ropeA[2 * i] = cosf(a); ropeA[2 * i + 1] = sinf(a); }
        for (int i = gt; i < 64 * 16; i += NT) { const int pos = i >> 4, f = i & 15; const float inv = powf(10000.f, -(float)f / 16.f), a = (float)pos * inv; ropeD[2 * i] = cosf(a); ropeD[2 * i + 1] = sinf(a); }
        float* s5ab = (float*)(ws + WS_TAB + TB_S5AB); float* s5bb = (float*)(ws + WS_TAB + TB_S5BB);
        for (int i = gt; i < 2 * 64 * 64; i += NT) {
            const int dg = i >> 6;
            const float are = F.in[18][i], aim = F.in[19][i], dt = expf(F.in[20][dg]);
            const float mag = expf(are * dt), abr = mag * cosf(aim * dt), abi = mag * sinf(aim * dt);
            const float den = are * are + aim * aim, nr = abr - 1.f, ni = abi;
            const float kre = (nr * are + ni * aim) / den, kim = (ni * are - nr * aim) / den;
            s5ab[2 * i] = abr; s5ab[2 * i + 1] = abi;
            for (int q = 0; q < 16; ++q) { const float br = F.in[21][(size_t)i * 16 + q], bi = F.in[22][(size_t)i * 16 + q];
                s5bb[((size_t)i * 16 + q) * 2] = kre * br - kim * bi; s5bb[((size_t)i * 16 + q) * 2 + 1] = kre * bi + kim * br; }
        }
    }
}
__device__ __forceinline__ void p1_modreduce(Frame& F) {
    int tid_ = F.tid; OPAQUE(tid_); const int gt = blockIdx.x * (NWAVES * 64) + tid_, NT = F.G * NWAVES * 64;
    const float* P = (const float*)(F.ws + WS_MODP); float* MV = (float*)(F.ws + WS_MODV); float* NR = (float*)(F.ws + WS_NRM);
    for (int i = gt; i < 2 * 5 * DM; i += NT) {
        const int c = i % DM, sel = (i / DM) % 5, l = i / (5 * DM);
        float mv[9];
#pragma unroll
        for (int idx = 0; idx < 9; ++idx) { float s = 0.f;
            for (int ks = 0; ks < KSPLIT; ++ks) s += P[((size_t)(l * KSPLIT + ks) * 5 + sel) * MODN + idx * DM + c];
            s += F.in[5][l * MODN + idx * DM + c]; mv[idx] = s; MV[((size_t)(l * 5 + sel) * 9 + idx) * DM + c] = s; }
#pragma unroll
        for (int w = 0; w < 3; ++w) { const float g = F.in[6][(l * 3 + w) * DM + c];
            NR[(((size_t)(l * 5 + sel) * 3 + w) * 2) * DM + c] = g * (1.f + mv[3 * w + 1]);
            NR[(((size_t)(l * 5 + sel) * 3 + w) * 2 + 1) * DM + c] = mv[3 * w]; }
    }
}
__device__ __forceinline__ void norm_phase(Frame& F, int l, int which, bool first, int nrows) {
    int lane = F.lane; OPAQUE(lane);
    const int gw = blockIdx.x * NWAVES + F.wave, NGW = F.G * NWAVES;
    float* H = (float*)(F.ws + WS_H); bf16* HN = (bf16*)(F.ws + WS_HN); const float* NR = (const float*)(F.ws + WS_NRM);
    for (int m = gw; m < nrows; m += NGW) {
        const float* src = first ? (m < NB * TT ? F.in[0] + (size_t)m * DM : F.in[2] + (size_t)(m - NB * TT) * DM) : H + (size_t)m * DM;
        const GAS f32x4* xr = (const GAS f32x4*)src + lane;
        f32x4 v[8]; float s = 0.f;
#pragma unroll
        for (int j = 0; j < 8; ++j) { v[j] = xr[64 * j]; s += (v[j].x * v[j].x + v[j].y * v[j].y) + (v[j].z * v[j].z + v[j].w * v[j].w); }
        const float rstd = 1.f / sqrtf(wave_sum_l(s, lane) * (1.f / DM) + EPS);
        if (first) { GAS f32x4* hw = (GAS f32x4*)(H + (size_t)m * DM) + lane;
#pragma unroll
            for (int j = 0; j < 8; ++j) hw[64 * j] = v[j]; }
        const int sel = row_sel(m);
        const GAS f32x4* Ap = (const GAS f32x4*)(NR + (((size_t)(l * 5 + sel) * 3 + which) * 2) * DM) + lane; const GAS f32x4* Bp = Ap + DM / 4;
        GAS unsigned long long* o8 = (GAS unsigned long long*)(HN + (size_t)m * DM) + lane;
#pragma unroll
        for (int j = 0; j < 8; ++j) { const f32x4 a = Ap[64 * j], b = Bp[64 * j]; const f32x4 y = v[j] * rstd * a + b;
            o8[64 * j] = (unsigned long long)pk2(y.x, y.y) | ((unsigned long long)pk2(y.z, y.w) << 32); }
    }
}
__device__ __forceinline__ void final_norm_phase(Frame& F) {
    int lane = F.lane; OPAQUE(lane);
    const int gw = blockIdx.x * NWAVES + F.wave, NGW = F.G * NWAVES;
    const float* H = (const float*)(F.ws + WS_H);
    for (int m = gw; m < NB * TT; m += NGW) {
        const GAS f32x4* xr = (const GAS f32x4*)(H + (size_t)m * DM) + lane;
        f32x4 v[8]; float s = 0.f;
#pragma unroll
        for (int j = 0; j < 8; ++j) { v[j] = xr[64 * j]; s += (v[j].x * v[j].x + v[j].y * v[j].y) + (v[j].z * v[j].z + v[j].w * v[j].w); }
        const float rstd = 1.f / sqrtf(wave_sum_l(s, lane) * (1.f / DM) + EPS);
        const GAS f32x4* gp = (const GAS f32x4*)F.in[29] + lane; GAS f32x4* o = (GAS f32x4*)(F.out + (size_t)m * DM) + lane;
#pragma unroll
        for (int j = 0; j < 8; ++j) o[64 * j] = v[j] * rstd * gp[64 * j];
    }
}
struct Args { const float* in[30]; float* out; unsigned char* ws; int ph_lo, ph_hi, li, pad; };
constexpr int PH_P0 = 0, PH_P1 = 1, PH_L0 = 2, PH_PER_LAYER = 12, PH_FINAL = 26, N_PHASES = 27;
enum { O_F1N = 0, O_F1U, O_F1D, O_MN, O_MI, O_MP, O_MA, O_MG, O_MO, O_F2N, O_F2U, O_F2D };

__global__ void __launch_bounds__(NWAVES * 64, 2) fwd(Args args) {
    extern __shared__ __attribute__((aligned(16))) unsigned char lds[];
    Frame F;
    F.lds = (LAS unsigned char*)lds;
    F.MISC = (volatile LAS unsigned*)(F.lds + MISC_OFF);
    F.tid = threadIdx.x; F.lane = F.tid & 63; F.wave = __builtin_amdgcn_readfirstlane(F.tid >> 6);
    F.G = gridDim.x;
    unsigned char* ws = args.ws; F.ws = ws; F.out = args.out;
#pragma unroll
    for (int i = 0; i < 30; ++i) F.in[i] = args.in[i];
    F.ctl = (gu32*)(ws + WS_CTL);
    for (int u = F.tid; u < (LDS_BYTES - LDSCTL_OFF) / 4; u += NWAVES * 64) ((LAS unsigned*)(F.lds + LDSCTL_OFF))[u] = 0u;
    __syncthreads();
    const int lo = args.ph_lo, hi = args.ph_hi;
    XcdBarrier bar; bar.bar = (unsigned*)(F.ctl + CW_BAR) + args.li * XCD_BAR_WORDS; bar.x = 0; bar.st = nullptr;
    if (hi - lo > 1) bar = xcd_barrier_post((unsigned*)(F.ctl + CW_BAR) + args.li * XCD_BAR_WORDS, F.MISC + 8);
#define IN(k) (lo <= (k) && (k) < hi)
#define SEAM(k) do { if (IN(k) && IN((k) + 1)) xcd_barrier(bar); } while (0)
    bf16* HN = (bf16*)(ws + WS_HN); bf16* HID = (bf16*)(ws + WS_HID); float* H = (float*)(ws + WS_H); bf16* CAT = (bf16*)(ws + WS_CAT);
    const float* MV = (const float*)(ws + WS_MODV);

    if (IN(PH_P0)) { p0_prologue(F); } SEAM(PH_P0);
    if (IN(PH_P1)) { p1_modreduce(F); } SEAM(PH_P1);
#pragma unroll 1
    for (int l = 0; l < 2; ++l) {
        const int pb = PH_L0 + PH_PER_LAYER * l;
        const int MLAT = NB * TT;
        const int m_post = (l == 1) ? MLAT : MR;
        if (IN(pb + O_F1N)) { norm_phase(F, l, 0, l == 0, MR); } SEAM(pb + O_F1N);
        if (IN(pb + O_F1U)) { pg8::Gemm g{HN, (const bf16*)(ws + WS_WUP + (size_t)(l * 2) * 44 * MiB), MR, 2 * FF, DM}; pg8::StaticOrder S; S.init(MR, 2 * FF, F.G, (int)blockIdx.x);
            pg8::EpiSwiglu E{HID, FF}; pg8::gemm_phase<pg8::EpiSwiglu, pg8::StaticOrder, true, true>(F.lds + RING_OFF, g, S, E); } SEAM(pb + O_F1U);
        if (IN(pb + O_F1D)) { pg8::Gemm g{HID, (const bf16*)(ws + WS_WDN + (size_t)(l * 2) * 22 * MiB), MR, DM, FF}; pg8::StaticOrder S; S.init(MR, DM, F.G, (int)blockIdx.x);
            pg8::EpiResid E{H, MV + (size_t)l * 5 * MODN + 2 * DM, MODN, 0.5f}; pg8::gemm_phase<pg8::EpiResid, pg8::StaticOrder, true, true>(F.lds + RING_OFF, g, S, E); } SEAM(pb + O_F1D);
        if (IN(pb + O_MN)) { norm_phase(F, l, 1, false, MR); } SEAM(pb + O_MN);
        if (IN(pb + O_MI)) {
            if (l == 0) { pg8::Gemm g{HN, (const bf16*)(ws + WS_WABIN), MR, ZLD, DM}; pg8::StaticOrder S; S.init(MR, ZLD, F.G, (int)blockIdx.x);
                pg8::EpiPlain E{(bf16*)(ws + WS_Z), ZLD, (float*)(ws + WS_GATES), ZB_G / 256}; pg8::gemm_phase<pg8::EpiPlain, pg8::StaticOrder, true, true>(F.lds + RING_OFF, g, S, E); }
            else { pg8::Gemm g{HN, (const bf16*)(ws + WS_WCDIN), MR, CD_IN, DM}; pg8::StaticOrder S; S.init(MR, CD_IN, F.G, (int)blockIdx.x);
                pg8::EpiPlain E{(bf16*)(ws + WS_Z), CD_IN, nullptr, -1}; pg8::gemm_phase<pg8::EpiPlain, pg8::StaticOrder, true, true>(F.lds + RING_OFF, g, S, E); }
        } SEAM(pb + O_MI);
        if (IN(pb + O_MP)) { } SEAM(pb + O_MP);
        if (IN(pb + O_MA)) { } SEAM(pb + O_MA);
        if (IN(pb + O_MG)) {
            if (l == 1) { pg8::Gemm g{(const bf16*)(ws + WS_G), (const bf16*)(ws + WS_WGLU), MLAT, 1024, 1024}; pg8::StaticOrder S; S.init(MLAT, 1024, F.G, (int)blockIdx.x);
                pg8::EpiGlu E{CAT, DM, (const bf16*)(ws + WS_G), F.in[27]}; pg8::gemm_phase<pg8::EpiGlu, pg8::StaticOrder, true, true>(F.lds + RING_OFF, g, S, E); }
        } SEAM(pb + O_MG);
        if (IN(pb + O_MO)) { pg8::Gemm g{CAT, (const bf16*)(ws + (l == 0 ? WS_WABOUT : WS_WCDOUT)), m_post, DM, DM}; pg8::StaticOrder S; S.init(m_post, DM, F.G, (int)blockIdx.x);
            pg8::EpiResid E{H, MV + (size_t)l * 5 * MODN + 5 * DM, MODN, 1.0f}; pg8::gemm_phase<pg8::EpiResid, pg8::StaticOrder, true, true>(F.lds + RING_OFF, g, S, E); } SEAM(pb + O_MO);
        if (IN(pb + O_F2N)) { norm_phase(F, l, 2, false, m_post); } SEAM(pb + O_F2N);
        if (IN(pb + O_F2U)) { pg8::Gemm g{HN, (const bf16*)(ws + WS_WUP + (size_t)(l * 2 + 1) * 44 * MiB), m_post, 2 * FF, DM}; pg8::StaticOrder S; S.init(m_post, 2 * FF, F.G, (int)blockIdx.x);
            pg8::EpiSwiglu E{HID, FF}; pg8::gemm_phase<pg8::EpiSwiglu, pg8::StaticOrder, true, true>(F.lds + RING_OFF, g, S, E); } SEAM(pb + O_F2U);
        if (IN(pb + O_F2D)) { pg8::Gemm g{HID, (const bf16*)(ws + WS_WDN + (size_t)(l * 2 + 1) * 22 * MiB), m_post, DM, FF}; pg8::StaticOrder S; S.init(m_post, DM, F.G, (int)blockIdx.x);
            pg8::EpiResid E{H, MV + (size_t)l * 5 * MODN + 8 * DM, MODN, 0.5f}; pg8::gemm_phase<pg8::EpiResid, pg8::StaticOrder, true, true>(F.lds + RING_OFF, g, S, E); } SEAM(pb + O_F2D);
    }
    if (IN(PH_FINAL)) { final_norm_phase(F); }
#undef IN
#undef SEAM
}
template <int MODE> __global__ void __launch_bounds__(256) naive_kprep(const bf16* Z, bf16* KO, const float* gk, const float* rope) {
    const int gw = (blockIdx.x * 256 + threadIdx.x) >> 6, lane = threadIdx.x & 63;
    if (MODE == 0) {
        if (gw >= MR * 2) return;
        const int m = gw >> 1, kvh = gw & 1; const bf16* zr = Z + (size_t)m * ZLD + ZA_K + kvh * 128;
        float x1 = bf2f(zr[lane]), x2 = bf2f(zr[64 + lane]);
        const float rstd = 1.f / sqrtf(wave_sum(x1 * x1 + x2 * x2) * (1.f / 128.f) + EPS);
        x1 *= rstd * gk[lane]; x2 *= rstd * gk[64 + lane];
        if (m < NB * TT) { const int t = m & (TT - 1), pos = lane < 32 ? (t >> 6) : (t & 63), f = lane & 31; const float c = rope[2 * (pos * 32 + f)], s = rope[2 * (pos * 32 + f) + 1];
            const float o1 = x1 * c - x2 * s, o2 = x2 * c + x1 * s; x1 = o1; x2 = o2; }
        KO[(size_t)m * 256 + kvh * 128 + lane] = (bf16)f2bf(x1); KO[(size_t)m * 256 + kvh * 128 + 64 + lane] = (bf16)f2bf(x2);
    } else {
        if (gw >= MR) return;
        const int m = gw, kvh = lane >> 5, j = lane & 31; const bf16* zr = Z + (size_t)m * CD_IN + ZD_K + kvh * 64;
        float x1 = bf2f(zr[j]), x2 = bf2f(zr[32 + j]);
        if (m < NB * TT) { const int t = m & (TT - 1), pos = j < 16 ? (t >> 6) : (t & 63), f = j & 15; const float c = rope[2 * (pos * 16 + f)], s = rope[2 * (pos * 16 + f) + 1];
            const float o1 = x1 * c - x2 * s, o2 = x2 * c + x1 * s; x1 = o1; x2 = o2; }
        KO[(size_t)m * 128 + kvh * 64 + j] = (bf16)f2bf(x1); KO[(size_t)m * 128 + kvh * 64 + 32 + j] = (bf16)f2bf(x2);
    }
}
template <int DH, int MODE> __global__ void __launch_bounds__(256) naive_attn(const bf16* Z, const bf16* KB, bf16* CAT, const float* gq, const float* rope, const float* sink) {
    constexpr int H2 = DH / 2, NF = DH / 4, NH = (MODE == 2) ? 16 : 8, QPB = 128;
    constexpr int NQ = (MODE == 1) ? CT : TT, LDZ = (MODE == 2) ? CD_IN : ZLD, LDK = (MODE == 2) ? 128 : 256;
    constexpr int QCOL = (MODE == 2) ? ZD_Q : ZA_Q, VCOL = (MODE == 2) ? ZD_V : ZA_V, OCOL = (MODE == 2) ? 1024 : 0;
    const int nchunk = NQ / QPB; int bid = blockIdx.x; const int qc = bid % nchunk; bid /= nchunk; const int head = bid % NH, b = bid / NH;
    const int kvh = head / (NH / 2), part = threadIdx.x & 1, r = threadIdx.x >> 1, qi = qc * QPB + r;
    const int m = (MODE == 1) ? (NB * TT + b * CT + qi) : (b * TT + qi);
    float q[H2], acc[H2];
    const bf16* qp = Z + (size_t)m * LDZ + QCOL + head * DH + part * H2;
#pragma unroll
    for (int i = 0; i < H2; ++i) { q[i] = bf2f(qp[i]); acc[i] = 0.f; }
    if (MODE != 2) { float ss = 0.f;
#pragma unroll
        for (int i = 0; i < H2; ++i) ss += q[i] * q[i];
        ss += __shfl_xor(ss, 1); const float rstd = 1.f / sqrtf(ss * (1.f / DH) + EPS);
#pragma unroll
        for (int i = 0; i < H2; ++i) q[i] *= rstd * gq[part * H2 + i]; }
    if (MODE != 1) { const int t = qi;
#pragma unroll
        for (int i = 0; i < H2; ++i) { const int pos = i < NF ? (t >> 6) : (t & 63), f = i % NF; const float c = rope[2 * (pos * NF + f)], s = rope[2 * (pos * NF + f) + 1];
            const float other = __shfl_xor(q[i], 1); q[i] = part == 0 ? (q[i] * c - other * s) : (q[i] * c + other * s); } }
    const float scale = (DH == 128) ? 0.08838834764831845f : 0.125f;
#pragma unroll
    for (int i = 0; i < H2; ++i) q[i] *= scale;
    float mx = (MODE == 2) ? sink[head] : -1e30f, l = (MODE == 2) ? 1.f : 0.f;
    const int lat_lo = (MODE == 0) ? 0 : (MODE == 2 ? max(0, qc * QPB - 128) : 0), lat_hi = (MODE == 0) ? TT : (MODE == 2 ? min(TT, qc * QPB + QPB + 128) : 0);
    const int nkeys = CT + (lat_hi - lat_lo);
    for (int kk = 0; kk < nkeys; ++kk) {
        const int kpos = kk - CT + lat_lo;
        const int km = kk < CT ? (NB * TT + b * CT + kk) : (b * TT + kpos);
        const bf16* kp = KB + (size_t)km * LDK + kvh * DH + part * H2;
        float s = 0.f;
#pragma unroll
        for (int i = 0; i < H2; ++i) s += q[i] * bf2f(kp[i]);
        s += __shfl_xor(s, 1);
        if (MODE == 2 && kk >= CT && abs(kpos - qi) > 128) continue;
        const float mn = fmaxf(mx, s), al = expf(mx - mn), p = expf(s - mn);
        l = l * al + p; mx = mn;
        const bf16* vp = Z + (size_t)km * LDZ + VCOL + kvh * DH + part * H2;
#pragma unroll
        for (int i = 0; i < H2; ++i) acc[i] = acc[i] * al + p * bf2f(vp[i]);
    }
    const float il = 1.f / l;
    bf16* op = CAT + (size_t)m * DM + OCOL + head * DH + part * H2;
#pragma unroll
    for (int i = 0; i < H2; ++i) op[i] = (bf16)f2bf(acc[i] * il);
}
__global__ void __launch_bounds__(512) naive_mlstm(const bf16* Z, const float* GATES, const float* bgate, float* HF, float* HB) {
    const int seq = blockIdx.x, b = seq >> 3, h = (seq >> 1) & 3, dir = seq & 1;
    __shared__ float sq[128], sk[128], sred[2];
    const int tid = threadIdx.x, v = tid >> 1, half = tid & 1, lane = tid & 63, wave = tid >> 6;
    float C[64];
#pragma unroll
    for (int j = 0; j < 64; ++j) C[j] = 0.f;
    float nreg = 0.f, mstate = 0.f;
    const float bi = bgate[(2 * dir) * 4 + h], bfg = bgate[(2 * dir + 1) * 4 + h];
    float* HO = dir ? HB : HF;
    for (int p = 0; p < SB; ++p) {
        const int s = dir == 0 ? p : (p < CT ? CT - 1 - p : CT + (SB - 1 - p));
        const int m = s < CT ? (NB * TT + b * CT + s) : (b * TT + s - CT);
        const bf16* zr = Z + (size_t)m * ZLD;
        if (tid < 128) sq[tid] = bf2f(zr[ZB_Q + h * 128 + tid]) * 0.08838834764831845f; else if (tid < 256) sk[tid - 128] = bf2f(zr[ZB_K + h * 128 + tid - 128]);
        const float vv = bf2f(zr[ZB_V + h * 256 + v]);
        const float ig = GATES[(size_t)m * 16 + (2 * dir) * 4 + h] + bi, lf = logsigmoid_acc(GATES[(size_t)m * 16 + (2 * dir + 1) * 4 + h] + bfg);
        const float mn = fmaxf(lf + mstate, ig), ip = expf(ig - mn), fp = expf(lf + mstate - mn); mstate = mn;
        __syncthreads();
        float dpart = 0.f; if (tid < 128) { nreg = fp * nreg + ip * sk[tid]; dpart = nreg * sq[tid]; }
        if (wave < 2) { dpart = wave_sum(dpart); if (lane == 0) sred[wave] = dpart; }
        float np = 0.f; const float iv = ip * vv;
#pragma unroll
        for (int j = 0; j < 64; ++j) { C[j] = fp * C[j] + iv * sk[64 * half + j]; np += C[j] * sq[64 * half + j]; }
        np += __shfl_xor(np, 1);
        __syncthreads();
        const float den = sred[0] + sred[1];
        if (half == 0) HO[(size_t)m * 1024 + h * 256 + v] = np / fmaxf(fabsf(den), expf(-mn));
        __syncthreads();
    }
}
__global__ void __launch_bounds__(256) naive_mlstm_finish(const bf16* Z, const float* HF, const float* HB, const float* headg, bf16* CAT) {
    const int gw = (blockIdx.x * 256 + threadIdx.x) >> 6, lane = threadIdx.x & 63; if (gw >= MR * 4) return;
    const int m = gw >> 2, h = gw & 3; const size_t o = (size_t)m * 1024 + h * 256 + lane * 4;
    const f32x4 a = *(const f32x4*)(HF + o), bb = *(const f32x4*)(HB + o); const f32x4 hh = a + bb;
    const float rstd = 1.f / sqrtf(wave_sum((hh.x * hh.x + hh.y * hh.y) + (hh.z * hh.z + hh.w * hh.w)) * (1.f / 256.f) + EPS);
    const bf16* og = Z + (size_t)m * ZLD + ZB_O + h * 256 + lane * 4; bf16* cp = CAT + (size_t)m * DM + 1024 + h * 256 + lane * 4;
#pragma unroll
    for (int j = 0; j < 4; ++j) { const float sg = 1.f / (1.f + expf(-bf2f(og[j]))); cp[j] = (bf16)f2bf(sg * hh[j] * rstd * headg[h * 256 + lane * 4 + j]); }
}
__global__ void __launch_bounds__(64) naive_s5(const bf16* Z, const float* s5ab, const float* s5bb, const float* cre_in, const float* cim_in, float* YF, float* YB) {
    const int id = blockIdx.x, b = id >> 7, g = (id >> 1) & 63, dir = id & 1, lane = threadIdx.x;
    const int i = (dir * 64 + g) * 64 + lane;
    const float ar = s5ab[2 * i], ai = s5ab[2 * i + 1];
    float Br[16], Bi[16], cr[16], ci[16];
#pragma unroll
    for (int q = 0; q < 16; ++q) { Br[q] = s5bb[((size_t)i * 16 + q) * 2]; Bi[q] = s5bb[((size_t)i * 16 + q) * 2 + 1];
        cr[q] = cre_in[((size_t)(dir * 64 + g) * 16 + q) * 64 + lane]; ci[q] = cim_in[((size_t)(dir * 64 + g) * 16 + q) * 64 + lane]; }
    float xr = 0.f, xi = 0.f; float* Y = dir ? YB : YF;
    for (int p = 0; p < SB; ++p) {
        const int s = dir == 0 ? p : (p < CT ? CT - 1 - p : CT + (SB - 1 - p));
        const int m = s < CT ? (NB * TT + b * CT + s) : (b * TT + s - CT);
        const bf16* up = Z + (size_t)m * CD_IN + ZC_U + g * 16;
        float bur = 0.f, bui = 0.f;
#pragma unroll
        for (int q = 0; q < 16; ++q) { const float u = bf2f(up[q]); bur += Br[q] * u; bui += Bi[q] * u; }
        const float nxr = ar * xr - ai * xi + bur, nxi = ar * xi + ai * xr + bui; xr = nxr; xi = nxi;
        if (s >= CT) { float yo = 0.f;
#pragma unroll
            for (int q = 0; q < 16; ++q) { const float val = wave_sum(cr[q] * xr - ci[q] * xi); if (lane == q) yo = val; }
            if (lane < 16) Y[(size_t)m * 1024 + g * 16 + lane] = yo; }
    }
}
__global__ void __launch_bounds__(256) naive_s5_finish(const bf16* Z, const float* YF, const float* YB, const float* dskip, bf16* G) {
    const size_t i = (size_t)blockIdx.x * 256 + threadIdx.x; if (i >= (size_t)NB * TT * 1024) return;
    const int m = (int)(i >> 10), c = (int)(i & 1023);
    const float y = YF[i] + YB[i] + dskip[c] * bf2f(Z[(size_t)m * CD_IN + ZC_U + c]);
    G[i] = (bf16)f2bf(gelu_tanh(y));
}
extern "C" void kernel_launch(void* const* d_in, const int* in_sizes, int n_in, void* d_out, int out_size, void* d_ws, size_t ws_size, hipStream_t stream) {
    static int grid = 0;
    if (grid == 0) {
        if (n_in != 30 || out_size != NB * TT * DM || ws_size < WS_END) { fprintf(stderr, "kernel_launch: unexpected shapes: n_in %d out %d ws %zu (need %zu)\n", n_in, out_size, ws_size, (size_t)WS_END); grid = -1; return; }
        int dev = 0, cus = 0;
        if (hipGetDevice(&dev) != hipSuccess || hipDeviceGetAttribute(&cus, hipDeviceAttributeMultiprocessorCount, dev) != hipSuccess) { grid = -1; return; }
        if (hipFuncSetAttribute((const void*)fwd, hipFuncAttributeMaxDynamicSharedMemorySize, LDS_BYTES) != hipSuccess) { fprintf(stderr, "kernel_launch: hipFuncSetAttribute failed\n"); grid = -1; return; }
        int per_cu = 0; (void)hipOccupancyMaxActiveBlocksPerMultiprocessor(&per_cu, (const void*)fwd, NWAVES * 64, LDS_BYTES); (void)hipGetLastError();
        if (per_cu < 1) fprintf(stderr, "kernel_launch: occupancy query says %d\n", per_cu);
        grid = cus;
    }
    if (grid < 0) return;
    (void)hipMemsetAsync((char*)d_ws + WS_CTL, 0, CTL_ZERO_BYTES, stream);
    Args a{};
    for (int i = 0; i < 30; ++i) a.in[i] = (const float*)d_in[i];
    a.out = (float*)d_out; a.ws = (unsigned char*)d_ws;
    unsigned char* ws = (unsigned char*)d_ws;
    int li = 0;
    auto run = [&](int lo, int hi) { a.ph_lo = lo; a.ph_hi = hi; a.li = li++; a.pad = 0; hipLaunchKernelGGL(fwd, dim3(grid), dim3(NWAVES * 64), LDS_BYTES, stream, a); };
    const bf16* Z = (const bf16*)(ws + WS_Z); bf16* CAT = (bf16*)(ws + WS_CAT); bf16* KA = (bf16*)(ws + WS_KA);
    float* SC1 = (float*)(ws + WS_SC1); float* SC2 = (float*)(ws + WS_SC2);
    const float* ropeA = (const float*)(ws + WS_TAB + TB_ROPEA); const float* ropeD = (const float*)(ws + WS_TAB + TB_ROPED);
    for (int ph = 0; ph <= PH_L0 + O_MI; ++ph) run(ph, ph + 1);
    hipLaunchKernelGGL(naive_kprep<0>, dim3(MR * 2 / 4), dim3(256), 0, stream, Z, KA, (const float*)d_in[14], ropeA);
    hipLaunchKernelGGL((naive_attn<128, 0>), dim3(NB * 8 * (TT / 128)), dim3(256), 0, stream, Z, (const bf16*)KA, CAT, (const float*)d_in[13], ropeA, (const float*)nullptr);
    hipLaunchKernelGGL((naive_attn<128, 1>), dim3(NB * 8 * (CT / 128)), dim3(256), 0, stream, Z, (const bf16*)KA, CAT, (const float*)d_in[13], ropeA, (const float*)nullptr);
    hipLaunchKernelGGL(naive_mlstm, dim3(32), dim3(512), 0, stream, Z, (const float*)(ws + WS_GATES), (const float*)d_in[11], SC1, SC2);
    hipLaunchKernelGGL(naive_mlstm_finish, dim3(MR * 4 / 4), dim3(256), 0, stream, Z, (const float*)SC1, (const float*)SC2, (const float*)d_in[15], CAT);
    for (int ph = PH_L0 + O_MO; ph <= PH_L0 + PH_PER_LAYER + O_MI; ++ph) run(ph, ph + 1);
    hipLaunchKernelGGL(naive_kprep<1>, dim3(MR / 4), dim3(256), 0, stream, Z, KA, (const float*)nullptr, ropeD);
    hipLaunchKernelGGL((naive_attn<64, 2>), dim3(NB * 16 * (TT / 128)), dim3(256), 0, stream, Z, (const bf16*)KA, CAT, (const float*)nullptr, ropeD, (const float*)d_in[28]);
    hipLaunchKernelGGL(naive_s5, dim3(NB * 64 * 2), dim3(64), 0, stream, Z, (const float*)(ws + WS_TAB + TB_S5AB), (const float*)(ws + WS_TAB + TB_S5BB), (const float*)d_in[23], (const float*)d_in[24], SC1, SC2);
    hipLaunchKernelGGL(naive_s5_finish, dim3(NB * TT * 1024 / 256), dim3(256), 0, stream, Z, (const float*)SC1, (const float*)SC2, (const float*)d_in[25], (bf16*)(ws + WS_G));
    for (int ph = PH_L0 + PH_PER_LAYER + O_MG; ph <= PH_FINAL; ++ph) run(ph, ph + 1);
    const hipError_t le = hipPeekAtLastError();
    if (le != hipSuccess) fprintf(stderr, "kernel_launch: launch failed: %s\n", hipGetErrorName(le));
}
```

```cpp
#include <hip/hip_runtime.h>
#include <cstdio>
#include <cstdint>
#include <cmath>
namespace pg8 {
#define PG8_LAS __attribute__((address_space(3)))
typedef unsigned short bf16_t;
typedef short bf16x8 __attribute__((ext_vector_type(8)));
typedef float f32x4 __attribute__((ext_vector_type(4)));
typedef unsigned u32x4 __attribute__((ext_vector_type(4)));
constexpr int BM = 256, BK = 64, HALF = 128, HTB = HALF * BK * 2  , STAGE_BYTES = 8 * HTB, NXCD = 8, WGM = 8;

__host__ __device__ __forceinline__ int lds_byte(int r, int c) { const int st = (r >> 4) * 2 + (c >> 5), rr = r & 15, cc = c & 31, ob = rr * 64 + cc * 2; return st * 1024 + (ob ^ (((ob >> 9) & 1) << 5)); }
__host__ __device__ __forceinline__ void stage_rc(int b, int& R, int& C) { const int st = b / 1024, sb = b % 1024, swz = sb ^ (((sb >> 9) & 1) << 5); R = (st >> 1) * 16 + swz / 64; C = (st & 1) * 32 + (swz % 64) / 2; }
__host__ __device__ __forceinline__ int perm32(int rho) { const int n = rho >> 4, i = rho & 15; return 8 * (i >> 2) + 4 * n + (i & 3); }

struct Unit { int pm, pn; };
struct Gemm { const bf16_t* A; const bf16_t* Bt; int M, N, K; };

struct StaticOrder {
    int nM, nN, nwg, G, c;
    __host__ __device__ void init(int M, int N, int G_, int c_) { nM = M / BM; nN = N / BM; nwg = nM * nN; G = G_; c = c_; }
    __host__ __device__ bool next(int i, Unit& u) const {
        const long L = (long)i * G + c; if (L >= nwg) return false;
        int wgid = (int)L; { const int q = nwg / NXCD, r = nwg % NXCD, xcd = wgid % NXCD, off = wgid / NXCD; wgid = (xcd < r ? xcd * (q + 1) : r * (q + 1) + (xcd - r) * q) + off; }
        const int nig = WGM * nN, gid = wgid / nig, fm = gid * WGM, gsz = (nM - fm) < WGM ? (nM - fm) : WGM;
        u.pm = fm + ((wgid % nig) % gsz); u.pn = (wgid % nig) / gsz; return true;
    }
    __device__ __forceinline__ void a_ready(const Unit&) const {}
    __device__ __forceinline__ void done(const Unit&) const {}
};

__device__ __forceinline__ unsigned cvt_pk_bf16(float lo, float hi) { unsigned r; asm volatile("v_cvt_pk_bf16_f32 %0, %1, %2" : "=v"(r) : "v"(lo), "v"(hi)); return r; }
typedef float f32x2 __attribute__((ext_vector_type(2)));
__device__ __forceinline__ float fast_sigmoid(float a) { return __builtin_amdgcn_rcpf(1.f + __builtin_amdgcn_exp2f(-1.4426950408889634f * a)); }
struct EpiPlain {
    static constexpr bool PERM = true, AFTER_DRAIN = false;
    bf16_t* O; int ldc; float* gates; int gate_pn;
    __device__ __forceinline__ void operator()(const f32x4 (&acc)[2][2][4][2], const Unit& u, int wr, int wc, int fr, int fq) const {
        const int row0 = u.pm * BM + wr * 64 + fr, col0 = u.pn * BM + wc * 32 + 8 * fq;
#pragma unroll
        for (int ai = 0; ai < 2; ++ai)
#pragma unroll
            for (int m = 0; m < 4; ++m) { const int row = row0 + ai * HALF + m * 16; bf16_t* rowp = O + (size_t)row * ldc + col0;
#pragma unroll
                for (int bj = 0; bj < 2; ++bj) { const f32x4 v0 = acc[ai][bj][m][0], v1 = acc[ai][bj][m][1];
                    u32x4 w; w.x = cvt_pk_bf16(v0[0], v0[1]); w.y = cvt_pk_bf16(v0[2], v0[3]); w.z = cvt_pk_bf16(v1[0], v1[1]); w.w = cvt_pk_bf16(v1[2], v1[3]);
                    *(u32x4*)(rowp + bj * HALF) = w;
                    if (bj == 0 && u.pn == gate_pn && wc == 0 && fq < 2) { float* gp = gates + (size_t)row * 16 + 8 * fq; *(f32x4*)gp = v0; *(f32x4*)(gp + 4) = v1; } } }
    }
};
struct EpiSwiglu {
    static constexpr bool PERM = true, AFTER_DRAIN = false;
    bf16_t* O; int ldc;
    __device__ __forceinline__ void operator()(const f32x4 (&acc)[2][2][4][2], const Unit& u, int wr, int wc, int fr, int fq) const {
        const int row0 = u.pm * BM + wr * 64 + fr, col0 = u.pn * HALF + wc * 32 + 8 * fq;
#pragma unroll
        for (int ai = 0; ai < 2; ++ai)
#pragma unroll
            for (int m = 0; m < 4; ++m) { bf16_t* rowp = O + (size_t)(row0 + ai * HALF + m * 16) * ldc + col0;
                float r[8];
#pragma unroll
                for (int n = 0; n < 2; ++n)
#pragma unroll
                    for (int j = 0; j < 4; ++j) { const float a = acc[ai][0][m][n][j], b = acc[ai][1][m][n][j]; r[4 * n + j] = a * fast_sigmoid(a) * b; }
                u32x4 w; w.x = cvt_pk_bf16(r[0], r[1]); w.y = cvt_pk_bf16(r[2], r[3]); w.z = cvt_pk_bf16(r[4], r[5]); w.w = cvt_pk_bf16(r[6], r[7]);
                *(u32x4*)rowp = w; }
    }
};
struct EpiResid {
    static constexpr bool PERM = true, AFTER_DRAIN = false;
    float* H; const float* gate; int gstride; float coef;
    __device__ __forceinline__ void operator()(const f32x4 (&acc)[2][2][4][2], const Unit& u, int wr, int wc, int fr, int fq) const {
        const int row0 = u.pm * BM + wr * 64 + fr, col0 = u.pn * BM + wc * 32 + 8 * fq;
        const int sel = u.pm < 64 ? (u.pm >> 4) : 4;
        const float* gp = gate + (size_t)sel * gstride + col0;
        f32x4 gv[2][2];
#pragma unroll
        for (int bj = 0; bj < 2; ++bj)
#pragma unroll
            for (int n = 0; n < 2; ++n) gv[bj][n] = *(const f32x4*)(gp + bj * HALF + 4 * n) * coef;
#pragma unroll
        for (int ai = 0; ai < 2; ++ai)
#pragma unroll
            for (int m = 0; m < 4; ++m) { float* rowp = H + (size_t)(row0 + ai * HALF + m * 16) * 2048 + col0;
#pragma unroll
                for (int bj = 0; bj < 2; ++bj)
#pragma unroll
                    for (int n = 0; n < 2; ++n) { f32x4* p = (f32x4*)(rowp + bj * HALF + 4 * n); *p = *p + gv[bj][n] * acc[ai][bj][m][n]; } }
    }
};
struct EpiGlu {
    static constexpr bool PERM = true, AFTER_DRAIN = false;
    bf16_t* O; int ldc; const bf16_t* G; const float* bias;
    __device__ __forceinline__ void operator()(const f32x4 (&acc)[2][2][4][2], const Unit& u, int wr, int wc, int fr, int fq) const {
        const int row0 = u.pm * BM + wr * 64 + fr, col0 = u.pn * BM + wc * 32 + 8 * fq;
#pragma unroll
        for (int ai = 0; ai < 2; ++ai)
#pragma unroll
            for (int m = 0; m < 4; ++m) { const int row = row0 + ai * HALF + m * 16;
#pragma unroll
                for (int bj = 0; bj < 2; ++bj) { const int col = col0 + bj * HALF;
                    const u32x4 gw = *(const u32x4*)(G + (size_t)row * 1024 + col);
                    const f32x4 b0 = *(const f32x4*)(bias + col), b1 = *(const f32x4*)(bias + col + 4);
                    float r[8];
#pragma unroll
                    for (int j = 0; j < 4; ++j) { r[j] = fast_sigmoid(acc[ai][bj][m][0][j] + b0[j]); r[4 + j] = fast_sigmoid(acc[ai][bj][m][1][j] + b1[j]); }
                    const unsigned gws[4] = {gw.x, gw.y, gw.z, gw.w};
#pragma unroll
                    for (int q = 0; q < 4; ++q) { r[2 * q] *= __builtin_bit_cast(float, gws[q] << 16); r[2 * q + 1] *= __builtin_bit_cast(float, gws[q] & 0xffff0000u); }
                    u32x4 w; w.x = cvt_pk_bf16(r[0], r[1]); w.y = cvt_pk_bf16(r[2], r[3]); w.z = cvt_pk_bf16(r[4], r[5]); w.w = cvt_pk_bf16(r[6], r[7]);
                    *(u32x4*)(O + (size_t)row * ldc + col) = w; } }
    }
};
template <class Epi, class Sched, bool ALIGN_EPI = false, bool SP2 = false>
__device__ __forceinline__ void gemm_phase(PG8_LAS unsigned char* lds, const Gemm g, const Sched& S, const Epi& E) {
    int tid = threadIdx.x; asm volatile("" : "+v"(tid));
    const int wid = __builtin_amdgcn_readfirstlane(tid >> 6), lane = tid & 63, wr = wid >> 2, wc = wid & 3, fr = lane & 15, fq = lane >> 4;
    const int K = g.K, nt = K / BK;
    unsigned voffA[2], voffB[2];
#pragma unroll
    for (int i = 0; i < 2; ++i) { int R, C; stage_rc(tid * 16 + i * 8192, R, C); const int Rb = Epi::PERM ? ((R & ~31) + perm32(R & 31)) : R;
        voffA[i] = (unsigned)(R * K + C) * 2u; voffB[i] = (unsigned)(Rb * K + C) * 2u; }
    const size_t kstep = (size_t)(BK * 2);
    const size_t hstep = (size_t)HALF * K * 2;
    const size_t tstep = 2 * hstep;
    const unsigned ldsw = (unsigned)wid * 1024u;
    const int aoff = lds_byte(wr * 64 + fr, fq * 8), boff = lds_byte(wc * 32 + fr, fq * 8);
#define PG8_SA(b, h) (((b) * 2 + (h)) * HTB)
#define PG8_SB(b, h) ((4 + (b) * 2 + (h)) * HTB)
#define PG8_STAGE(bufoff, gbase, voff) do { _Pragma("unroll") for (int _i = 0; _i < 2; ++_i) \
        __builtin_amdgcn_global_load_lds((const unsigned*)((const char*)(gbase) + (voff)[_i]), (PG8_LAS unsigned*)(lds + (bufoff) + ldsw + _i * 8192), 16, 0, 0); } while (0)
#define PG8_LDA(dst, b, h) do { _Pragma("unroll") for (int m = 0; m < 4; ++m) _Pragma("unroll") for (int k = 0; k < 2; ++k) dst[m][k] = *(const PG8_LAS bf16x8*)(lds + PG8_SA(b, h) + aoff + m * 2048 + k * 1024); } while (0)
#define PG8_LDB(dst, b, h) do { _Pragma("unroll") for (int n = 0; n < 2; ++n) _Pragma("unroll") for (int k = 0; k < 2; ++k) dst[n][k] = *(const PG8_LAS bf16x8*)(lds + PG8_SB(b, h) + boff + n * 2048 + k * 1024); } while (0)
#define PG8_MMA(ai, bj, At, Bt) do { __builtin_amdgcn_s_setprio(1); _Pragma("unroll") for (int m = 0; m < 4; ++m) _Pragma("unroll") for (int n = 0; n < 2; ++n) _Pragma("unroll") for (int k = 0; k < 2; ++k) \
        acc[ai][bj][m][n] = __builtin_amdgcn_mfma_f32_16x16x32_bf16(Bt[n][k], At[m][k], acc[ai][bj][m][n], 0, 0, 0); __builtin_amdgcn_s_setprio(0); } while (0)
#define PG8_WAIT_V(n) asm volatile("s_waitcnt vmcnt(" #n ")" ::: "memory")
#define PG8_WAIT_L(n) asm volatile("s_waitcnt lgkmcnt(" #n ")" ::: "memory")
#define PG8_BAR __builtin_amdgcn_s_barrier()
#define PG8_SCHED __builtin_amdgcn_sched_barrier(0)
    Unit cur, nxt; int ui = 0;
    if (!S.next(0, cur)) return;
    f32x4 acc[2][2][4][2];
#pragma unroll
    for (int a = 0; a < 2; ++a)
#pragma unroll
        for (int b = 0; b < 2; ++b)
#pragma unroll
            for (int m = 0; m < 4; ++m)
#pragma unroll
                for (int n = 0; n < 2; ++n) acc[a][b][m][n] = (f32x4){0.f, 0.f, 0.f, 0.f};
    bf16x8 At[4][2], B0[2][2], B1[2][2];
    const char* cA = (const char*)g.A + (size_t)cur.pm * tstep; const char* cB = (const char*)g.Bt + (size_t)cur.pn * tstep;
    S.a_ready(cur);
    if constexpr (SP2) {
        PG8_STAGE(PG8_SB(0, 0), cB, voffB); PG8_STAGE(PG8_SB(0, 1), cB + hstep, voffB); PG8_STAGE(PG8_SA(0, 0), cA, voffA); PG8_STAGE(PG8_SA(0, 1), cA + hstep, voffA);
        if (wr == 1) PG8_BAR;
        PG8_WAIT_V(2); PG8_BAR;
        PG8_STAGE(PG8_SB(1, 0), cB + kstep, voffB); PG8_STAGE(PG8_SA(1, 0), cA + kstep, voffA); PG8_STAGE(PG8_SB(1, 1), cB + hstep + kstep, voffB);
        PG8_WAIT_V(6); PG8_BAR;
    } else {
        PG8_STAGE(PG8_SB(0, 0), cB, voffB); PG8_STAGE(PG8_SA(0, 0), cA, voffA); PG8_STAGE(PG8_SB(0, 1), cB + hstep, voffB); PG8_STAGE(PG8_SA(0, 1), cA + hstep, voffA);
        if (wr == 1) PG8_BAR;
        PG8_WAIT_V(4); PG8_BAR;
        PG8_STAGE(PG8_SB(1, 0), cB + kstep, voffB); PG8_STAGE(PG8_SA(1, 0), cA + kstep, voffA); PG8_STAGE(PG8_SB(1, 1), cB + hstep + kstep, voffB);
        PG8_WAIT_V(6); PG8_BAR;
    }
    for (;;) {
        const bool has_next = S.next(ui + 1, nxt);
        const char* nA = has_next ? (const char*)g.A + (size_t)nxt.pm * tstep : cA; const char* nB = has_next ? (const char*)g.Bt + (size_t)nxt.pn * tstep : cB;
        for (int t = 0; t < nt; t += 2) {
            const bool last = (t == nt - 2);
            const char* a1 = cA + (size_t)(t + 1) * kstep;
            const char* a2 = last ? nA : cA + (size_t)(t + 2) * kstep; const char* b2 = last ? nB : cB + (size_t)(t + 2) * kstep;
            const char* a3 = a2 + kstep; const char* b3 = b2 + kstep;
            if (last && has_next) S.a_ready(nxt);
            if constexpr (SP2) {
            PG8_LDB(B0, 0, 0); PG8_LDB(B1, 0, 1); PG8_SCHED; PG8_LDA(At, 0, 0); PG8_STAGE(PG8_SA(1, 1), a1 + hstep, voffA);
            PG8_WAIT_V(8); PG8_WAIT_L(0); PG8_BAR; PG8_MMA(0, 0, At, B0); PG8_MMA(0, 1, At, B1); PG8_BAR; PG8_SCHED;
            PG8_LDA(At, 0, 1); PG8_STAGE(PG8_SB(0, 0), b2, voffB); PG8_STAGE(PG8_SB(0, 1), b2 + hstep, voffB); PG8_STAGE(PG8_SA(0, 0), a2, voffA);
            PG8_WAIT_V(8); PG8_WAIT_L(0); PG8_BAR; PG8_MMA(1, 0, At, B0); PG8_MMA(1, 1, At, B1); PG8_BAR; PG8_SCHED;
            PG8_LDB(B0, 1, 0); PG8_LDB(B1, 1, 1); PG8_SCHED; PG8_LDA(At, 1, 0); PG8_STAGE(PG8_SA(0, 1), a2 + hstep, voffA);
            PG8_WAIT_V(8); PG8_WAIT_L(0); PG8_BAR; PG8_MMA(0, 0, At, B0); PG8_MMA(0, 1, At, B1); PG8_BAR; PG8_SCHED;
            PG8_LDA(At, 1, 1); PG8_STAGE(PG8_SB(1, 0), b3, voffB); PG8_STAGE(PG8_SB(1, 1), b3 + hstep, voffB); PG8_STAGE(PG8_SA(1, 0), a3, voffA);
            PG8_WAIT_V(8); PG8_WAIT_L(0); PG8_BAR; PG8_MMA(1, 0, At, B0); PG8_MMA(1, 1, At, B1); PG8_BAR; PG8_SCHED;
            } else {
            PG8_LDB(B0, 0, 0); PG8_SCHED; PG8_LDA(At, 0, 0); PG8_STAGE(PG8_SA(1, 1), a1 + hstep, voffA);
            PG8_WAIT_L(8); PG8_BAR; PG8_WAIT_L(0); PG8_MMA(0, 0, At, B0); PG8_BAR; PG8_SCHED;
            PG8_LDB(B1, 0, 1); PG8_STAGE(PG8_SB(0, 0), b2, voffB);
            PG8_BAR; PG8_WAIT_L(0); PG8_MMA(0, 1, At, B1); PG8_BAR;
            PG8_LDA(At, 0, 1); PG8_STAGE(PG8_SA(0, 0), a2, voffA);
            PG8_BAR; PG8_WAIT_L(0); PG8_MMA(1, 0, At, B0); PG8_BAR; PG8_SCHED;
            PG8_STAGE(PG8_SB(0, 1), b2 + hstep, voffB);
            PG8_WAIT_V(6); PG8_BAR; PG8_MMA(1, 1, At, B1); PG8_BAR;
            PG8_LDB(B0, 1, 0); PG8_SCHED; PG8_LDA(At, 1, 0); PG8_STAGE(PG8_SA(0, 1), a2 + hstep, voffA);
            PG8_WAIT_L(8); PG8_BAR; PG8_WAIT_L(0); PG8_MMA(0, 0, At, B0); PG8_BAR; PG8_SCHED;
            PG8_LDB(B1, 1, 1); PG8_STAGE(PG8_SB(1, 0), b3, voffB);
            PG8_BAR; PG8_WAIT_L(0); PG8_MMA(0, 1, At, B1); PG8_BAR;
            PG8_LDA(At, 1, 1); PG8_STAGE(PG8_SA(1, 0), a3, voffA);
            PG8_BAR; PG8_WAIT_L(0); PG8_MMA(1, 0, At, B0); PG8_BAR; PG8_SCHED;
            PG8_STAGE(PG8_SB(1, 1), b3 + hstep, voffB);
            PG8_WAIT_V(6); PG8_BAR; PG8_MMA(1, 1, At, B1); PG8_BAR;
            }
        }
        if constexpr (ALIGN_EPI) { if (wr == 0) PG8_BAR; }
        if constexpr (!Epi::AFTER_DRAIN) { E(acc, cur, wr, wc, fr, fq); S.done(cur); }
        if (!has_next) break;
#pragma unroll
        for (int a = 0; a < 2; ++a)
#pragma unroll
            for (int b = 0; b < 2; ++b)
#pragma unroll
                for (int m = 0; m < 4; ++m)
#pragma unroll
                    for (int n = 0; n < 2; ++n) acc[a][b][m][n] = (f32x4){0.f, 0.f, 0.f, 0.f};
        cur = nxt; cA = nA; cB = nB; ++ui;
        if constexpr (ALIGN_EPI) { if (wr == 1) PG8_BAR; }
    }
    PG8_WAIT_V(0);
    if constexpr (!ALIGN_EPI) { if (wr == 0) PG8_BAR; }
    PG8_BAR;
    if constexpr (Epi::AFTER_DRAIN) { E.fused(acc, cur, wr, wc, fr, fq, lds, wid, lane); S.done(cur); }
#undef PG8_SA
#undef PG8_SB
#undef PG8_STAGE
#undef PG8_LDA
#undef PG8_LDB
#undef PG8_MMA
#undef PG8_WAIT_V
#undef PG8_WAIT_L
#undef PG8_BAR
#undef PG8_SCHED
}
}
#define GAS __attribute__((address_space(1)))
#define LAS __attribute__((address_space(3)))
typedef unsigned short bf16;
typedef unsigned v4u __attribute__((ext_vector_type(4)));
typedef float f32x4 __attribute__((ext_vector_type(4)));
typedef short bf16x8 __attribute__((ext_vector_type(8)));
typedef GAS unsigned gu32;
typedef GAS unsigned long long gu64;
#define RLX_AGENT __ATOMIC_RELAXED, __HIP_MEMORY_SCOPE_AGENT
#define LDS_WAIT() asm volatile("s_waitcnt lgkmcnt(0)" ::: "memory")
#define VM_WAIT() asm volatile("s_waitcnt vmcnt(0)" ::: "memory")
__device__ __forceinline__ unsigned long long rt() { return __builtin_amdgcn_s_memrealtime(); }
__device__ __forceinline__ unsigned f2bf(float f) { unsigned u = __builtin_bit_cast(unsigned, f); return (u + 0x7fffu + ((u >> 16) & 1u)) >> 16; }
__device__ __forceinline__ unsigned pk2(float lo, float hi) { return f2bf(lo) | (f2bf(hi) << 16); }

#define XB_TMO      128
#define XB_XCNT(j)  (256  + 64 * (j))
#define XB_XSUB(j)  (1280 + 64 * (j))
#define XB_XGEN(j)  (2304 + 64 * (j))
#define XB_TOP      3328
#define XB_TOPGEN   3392
#define XCD_BAR_WORDS 3456
#define XB_SPIN_CAP (1u << 18)

__device__ __forceinline__ unsigned xb_ld(unsigned* p)              { return __hip_atomic_load(p, __ATOMIC_RELAXED, __HIP_MEMORY_SCOPE_AGENT); }
__device__ __forceinline__ unsigned xb_add(unsigned* p, unsigned v) { return __hip_atomic_fetch_add(p, v, __ATOMIC_RELAXED, __HIP_MEMORY_SCOPE_AGENT); }
__device__ __forceinline__ unsigned xb_xcc_id() { return (unsigned)__builtin_amdgcn_s_getreg((3 << 11) | 20) & 0xFu; }
#define XB_SPIN(cond, bar) do { unsigned _sp = 0; while (cond) { __builtin_amdgcn_s_sleep(1); \
    if ((++_sp & 255u) == 0u) { if (xb_ld(&(bar)[XB_TMO])) break; if (_sp > XB_SPIN_CAP) { atomicAdd(&(bar)[XB_TMO], 1u); break; } } } } while (0)

struct XcdBarrier {
    unsigned* bar; unsigned x;
    volatile LAS unsigned* st;
};

__device__ __forceinline__ XcdBarrier xcd_barrier_post(unsigned* bar, volatile LAS unsigned* st) {
    XcdBarrier b; b.bar = bar; b.x = xb_xcc_id(); b.st = st;
    if (threadIdx.x == 0) (void)xb_add(&bar[XB_XCNT(b.x)], 1u);
    return b;
}
__device__ __forceinline__ void xcd_barrier_complete(unsigned* bar, unsigned x, unsigned& nloc, unsigned& nx) {
    const unsigned G = gridDim.x * gridDim.y * gridDim.z;
    unsigned sum, cnt, mine, sp = 0u;
    for (;;) {
        sum = 0u; cnt = 0u; mine = 0u;
#pragma unroll
        for (unsigned j = 0; j < 16; ++j) { const unsigned c = xb_ld(&bar[XB_XCNT(j)]); sum += c; cnt += (c > 0u) ? 1u : 0u; mine = (j == x) ? c : mine; }
        if (sum == G) break;
        __builtin_amdgcn_s_sleep(1);
        if ((++sp & 255u) == 0u) { if (xb_ld(&bar[XB_TMO])) break; if (sp > XB_SPIN_CAP) { atomicAdd(&bar[XB_TMO], 1u); break; } }
    }
    nloc = mine > 0u ? mine : 1u; nx = cnt > 0u ? cnt : 1u;
}

__device__ __forceinline__ void xcd_barrier(const XcdBarrier& b) {
    asm volatile("s_waitcnt vmcnt(0)" ::: "memory");
    __syncthreads();
    if (threadIdx.x == 0) {
        unsigned* bar = b.bar;
        __builtin_amdgcn_s_waitcnt(0);
        unsigned nloc = b.st[0], nx = b.st[1];
        if (nloc == 0u) { xcd_barrier_complete(bar, b.x, nloc, nx); b.st[0] = nloc; b.st[1] = nx; }
        const unsigned old = xb_add(&bar[XB_XSUB(b.x)], 1u);
        const unsigned gen = old / nloc;
        if (old + 1u == (gen + 1u) * nloc) {
            __builtin_amdgcn_fence(__ATOMIC_RELEASE, "agent");
            asm volatile("s_waitcnt vmcnt(0)" ::: "memory");
            const unsigned og = xb_add(&bar[XB_TOP], 1u);
            const unsigned tg = og / nx;
            if (og + 1u == (tg + 1u) * nx) xb_add(&bar[XB_TOPGEN], 1u);
            else XB_SPIN(xb_ld(&bar[XB_TOPGEN]) == tg, bar);
            __builtin_amdgcn_fence(__ATOMIC_ACQUIRE, "agent");
            xb_add(&bar[XB_XGEN(b.x)], 1u);
            asm volatile("s_waitcnt vmcnt(0)" ::: "memory");
        } else {
            XB_SPIN(xb_ld(&bar[XB_XGEN(b.x)]) == gen, bar);
            __builtin_amdgcn_fence(__ATOMIC_ACQUIRE, "agent");
            asm volatile("s_waitcnt vmcnt(0)" ::: "memory");
        }
    }
    __syncthreads();
}
constexpr int NWAVES = 8;
constexpr int DM = 2048, NB = 4, TT = 4096, CT = 256, SB = 4352, MR = NB * SB  , FF = 5632;
constexpr int AB_IN = 4624, ZLD = 4864, CD_IN = 2304, NMOD = 9, MODN = NMOD * DM  ;
constexpr float EPS = 1e-6f;
constexpr int ZA_Q = 0, ZA_K = 1024, ZA_V = 1280, ZB_Q = 1536, ZB_K = 2048, ZB_V = 2560, ZB_O = 3584, ZB_G = 4608;
constexpr int ZC_U = 0, ZD_Q = 1024, ZD_K = 2048, ZD_V = 2176;
constexpr int KSPLIT = 32;
constexpr size_t MiB = 1u << 20;
constexpr size_t WS_CTL = 0, CTL_ZERO_BYTES = 1 * MiB;
constexpr size_t WS_WUP = 1 * MiB;
constexpr size_t WS_WDN = WS_WUP + 4 * 44 * MiB;
constexpr size_t WS_WABIN = WS_WDN + 4 * 22 * MiB;
constexpr size_t WS_WABOUT = WS_WABIN + 19 * MiB;
constexpr size_t WS_WCDIN = WS_WABOUT + 8 * MiB;
constexpr size_t WS_WCDOUT = WS_WCDIN + 9 * MiB;
constexpr size_t WS_WGLU = WS_WCDOUT + 8 * MiB;
constexpr size_t WS_MODP = WS_WGLU + 2 * MiB;
constexpr size_t WS_MODV = WS_MODP + 23 * MiB;
constexpr size_t WS_NRM = WS_MODV + 1 * MiB;
constexpr size_t WS_TAB = WS_NRM + 1 * MiB;
constexpr size_t WS_H = WS_TAB + 4 * MiB;
constexpr size_t WS_HN = WS_H + 136 * MiB;
constexpr size_t WS_X = WS_HN + 68 * MiB;
constexpr size_t WS_Z = WS_X, WS_ZT = WS_X + 163 * MiB, WS_HID = WS_X;
constexpr size_t WS_CAT = WS_X + 216 * MiB;
constexpr size_t WS_GATES = WS_CAT + 68 * MiB;
constexpr size_t WS_KA = WS_GATES + 2 * MiB;
constexpr size_t WS_G = WS_KA + 10 * MiB;
constexpr size_t WS_SC1 = WS_G + 34 * MiB;
constexpr size_t WS_SC2 = WS_SC1 + 68 * MiB;
constexpr size_t WS_END = WS_SC2 + 68 * MiB;
static_assert((size_t)MR * ZLD * 2 <= 163 * MiB && (size_t)1536 * MR * 2 <= 53 * MiB && (size_t)MR * FF * 2 <= 216 * MiB, "overlay");
constexpr size_t TB_ROPEA = 0;
constexpr size_t TB_ROPED = 16384;
constexpr size_t TB_S5AB = 32768;
constexpr size_t TB_S5BB = TB_S5AB + 65536;
constexpr size_t TB_VEC = TB_S5BB + 1048576;
constexpr int TV_GK = 0, TV_GQ = 128, TV_BGATE = 256, TV_SINK = 272, TV_HEADG = 512, TV_DSKIP = 1536, TV_GLUB = 2560, TV_FINALG = 3584, TV_N = 5632;
constexpr size_t TB_S5C = TB_VEC + 32768;
constexpr size_t TB_END = TB_S5C + 1048576;
static_assert(TB_END <= 4 * MiB, "tables");
constexpr int CW_TMO = 0, CW_BAR = 4096;
constexpr int RING_OFF = 0, RING_BYTES = 131072;
constexpr int LDSCTL_OFF = RING_BYTES, MISC_OFF = LDSCTL_OFF + 320;
constexpr int LDS_BYTES = 147456;
static_assert(MISC_OFF + 128 <= LDS_BYTES, "LDS map");
__device__ __forceinline__ float bf2f(bf16 v) { return __builtin_bit_cast(float, (unsigned)v << 16); }
__device__ __forceinline__ float wave_sum(float v) {
#pragma unroll
    for (int o = 1; o < 64; o <<= 1) v += __shfl_xor(v, o);
    return v;
}
__device__ __forceinline__ float wave_sum_l(float v, int lane) {
#pragma unroll
    for (int o = 1; o < 64; o <<= 1) v += __builtin_bit_cast(float, __builtin_amdgcn_ds_bpermute((lane ^ o) << 2, __builtin_bit_cast(int, v)));
    return v;
}
#define OPAQUE(x) asm volatile("" : "+v"(x))
__device__ __forceinline__ float silu_acc(float x) { return x / (1.f + expf(-x)); }
__device__ __forceinline__ float logsigmoid_acc(float x) { return x >= 0.f ? -log1pf(expf(-x)) : x - log1pf(expf(x)); }
__device__ __forceinline__ float gelu_tanh(float x) { const float u = 0.7978845608028654f * (x + 0.044715f * x * x * x); return 0.5f * x * (1.f + tanhf(u)); }
__device__ __forceinline__ int row_sel(int m) { return m < NB * TT ? (m >> 12) : 4; }

struct Frame {
    LAS unsigned char* lds;
    volatile LAS unsigned* MISC;
    gu32* ctl;
    int tid, lane, wave, G;
    float* out; unsigned char* ws;
};

__device__ __forceinline__ void p0_transpose_item(const float* W, int K, int N, int Nvalid, bf16* WT, int drow0, int k0, int n0, LAS float* scr, int lane) {
    const int nn = n0 + (lane & 31); const bool ok = nn < Nvalid;
#pragma unroll 8
    for (int i = 0; i < 32; ++i) { const int kk = 2 * i + (lane >> 5); scr[kk * 33 + (lane & 31)] = ok ? W[(size_t)(k0 + kk) * N + nn] : 0.f; }
    LDS_WAIT(); asm volatile("" ::: "memory");
    const int c = lane & 7;
#pragma unroll
    for (int j = 0; j < 4; ++j) { const int n = (lane >> 3) + 8 * j; const LAS float* s = scr + (8 * c) * 33 + n;
        v4u o; o.x = pk2(s[0 * 33], s[1 * 33]); o.y = pk2(s[2 * 33], s[3 * 33]); o.z = pk2(s[4 * 33], s[5 * 33]); o.w = pk2(s[6 * 33], s[7 * 33]);
        *(GAS v4u*)(WT + (size_t)(drow0 + n) * K + k0 + 8 * c) = o; }
    LDS_WAIT(); asm volatile("" ::: "memory");
}
__device__ __forceinline__ bool p0_mat(int& r, const float* W, int K, int N, int Npad, bf16* WT, int mode  , LAS float* scr, int lane) {
    const int nblk = Npad / 32, items = (K / 64) * nblk;
    if (r >= items) { r -= items; return false; }
    const int kb = r / nblk, nb = r % nblk, n0 = 32 * nb;
    int drow0 = n0; if (mode) drow0 = (n0 >> 7) * 256 + (n0 & 127) + (mode == 2 ? 128 : 0);
    p0_transpose_item(W, K, N, N, WT, drow0, 64 * kb, n0, scr, lane);
    return true;
}
__device__ __forceinline__ void p0_prologue(Frame& F, const float* const (&in)[30]) {
    LAS float* scr = (LAS float*)(F.lds + RING_OFF + F.wave * 16384);
    int lane = F.lane; OPAQUE(lane);
    const int gw = blockIdx.x * NWAVES + F.wave, NGW = F.G * NWAVES;
    unsigned char* ws = F.ws;
    {
        constexpr int NCH = MODN / 256, NIT = 2 * KSPLIT * NCH, KPER = DM / KSPLIT;
        for (int it = gw; it < NIT; it += NGW) {
            const int cc = it % NCH, ks = (it / NCH) % KSPLIT, l = it / (NCH * KSPLIT);
            const float* W = in[4] + (size_t)l * DM * MODN + (size_t)(ks * KPER) * MODN + cc * 256 + lane * 4;
            f32x4 a0 = {0, 0, 0, 0}, a1 = a0, a2 = a0, a3 = a0, a4 = a0;
#pragma unroll 4
            for (int k = 0; k < KPER; ++k) {
                const f32x4 w = *(const f32x4*)(W + (size_t)k * MODN); const int kk = ks * KPER + k;
                const float s0 = silu_acc(in[1][kk]), s1 = silu_acc(in[1][DM + kk]), s2 = silu_acc(in[1][2 * DM + kk]), s3 = silu_acc(in[1][3 * DM + kk]), s4 = silu_acc(in[3][kk]);
                a0 += w * s0; a1 += w * s1; a2 += w * s2; a3 += w * s3; a4 += w * s4;
            }
            float* P = (float*)(ws + WS_MODP) + ((size_t)(l * KSPLIT + ks) * 5) * MODN + cc * 256 + lane * 4;
            *(f32x4*)(P) = a0; *(f32x4*)(P + MODN) = a1; *(f32x4*)(P + 2 * MODN) = a2; *(f32x4*)(P + 3 * MODN) = a3; *(f32x4*)(P + 4 * MODN) = a4;
        }
    }
    {
        constexpr int I_UP = (DM / 64) * (FF / 32), I_DN = (FF / 64) * (DM / 32);
        constexpr int NIT = 8 * I_UP + 4 * I_DN + (DM / 64) * (ZLD / 32) + 2 * (DM / 64) * (DM / 32) + (DM / 64) * (CD_IN / 32) + (1024 / 64) * (1024 / 32);
        for (int it = gw; it < NIT; it += NGW) {
            int r = it; bool done = false;
#pragma unroll 1
            for (int lh = 0; lh < 4 && !done; ++lh) {
                bf16* up = (bf16*)(ws + WS_WUP + (size_t)lh * 44 * MiB);
                done = p0_mat(r, in[7] + (size_t)lh * DM * FF, DM, FF, FF, up, 1, scr, lane); if (done) break;
                done = p0_mat(r, in[8] + (size_t)lh * DM * FF, DM, FF, FF, up, 2, scr, lane); if (done) break;
                done = p0_mat(r, in[9] + (size_t)lh * FF * DM, FF, DM, DM, (bf16*)(ws + WS_WDN + (size_t)lh * 22 * MiB), 0, scr, lane);
            }
            if (done) continue;
            {
                const int nblk = ZLD / 32, items = (DM / 64) * nblk;
                if (r < items) { const int kb = r / nblk, nb = r % nblk; p0_transpose_item(in[10], DM, AB_IN, AB_IN, (bf16*)(ws + WS_WABIN), 32 * nb, 64 * kb, 32 * nb, scr, lane); continue; }
                r -= items;
            }
            if (p0_mat(r, in[12], DM, DM, DM, (bf16*)(ws + WS_WABOUT), 0, scr, lane)) continue;
            if (p0_mat(r, in[16], DM, CD_IN, CD_IN, (bf16*)(ws + WS_WCDIN), 0, scr, lane)) continue;
            if (p0_mat(r, in[17], DM, DM, DM, (bf16*)(ws + WS_WCDOUT), 0, scr, lane)) continue;
            p0_mat(r, in[26], 1024, 1024, 1024, (bf16*)(ws + WS_WGLU), 0, scr, lane);
        }
    }
    {
        int tid_ = F.tid; OPAQUE(tid_); const int gt = blockIdx.x * (NWAVES * 64) + tid_, NT = F.G * NWAVES * 64;
        float* ropeA = (float*)(ws + WS_TAB + TB_ROPEA); float* ropeD = (float*)(ws + WS_TAB + TB_ROPED);
        for (int i = gt; i < 64 * 32; i += NT) { const int pos = i >> 5, f = i & 31; const float inv = powf(10000.f, -(float)f / 32.f), a = (float)pos * inv; ropeA[2 * i] = cosf(a); ropeA[2 * i + 1] = sinf(a); }
        for (int i = gt; i < 64 * 16; i += NT) { const int pos = i >> 4, f = i & 15; const float inv = powf(10000.f, -(float)f / 16.f), a = (float)pos * inv; ropeD[2 * i] = cosf(a); ropeD[2 * i + 1] = sinf(a); }
        float* s5ab = (float*)(ws + WS_TAB + TB_S5AB); float* s5bb = (float*)(ws + WS_TAB + TB_S5BB);
        for (int i = gt; i < 2 * 64 * 64; i += NT) {
            const int dg = i >> 6;
            const float are = in[18][i], aim = in[19][i], dt = expf(in[20][dg]);
            const float mag = expf(are * dt), abr = mag * cosf(aim * dt), abi = mag * sinf(aim * dt);
            const float den = are * are + aim * aim, nr = abr - 1.f, ni = abi;
            const float kre = (nr * are + ni * aim) / den, kim = (ni * are - nr * aim) / den;
            s5ab[2 * i] = abr; s5ab[2 * i + 1] = abi;
            for (int q = 0; q < 16; ++q) { const float br = in[21][(size_t)i * 16 + q], bi = in[22][(size_t)i * 16 + q];
                s5bb[((size_t)i * 16 + q) * 2] = kre * br - kim * bi; s5bb[((size_t)i * 16 + q) * 2 + 1] = kre * bi + kim * br; }
        }
        float* tv = (float*)(ws + WS_TAB + TB_VEC);
        for (int i = gt; i < TV_N; i += NT) { float v = 0.f;
            if (i < TV_GQ) v = in[14][i]; else if (i < TV_BGATE) v = in[13][i - TV_GQ]; else if (i < TV_SINK) v = in[11][i - TV_BGATE]; else if (i < TV_SINK + 16) v = in[28][i - TV_SINK];
            else if (i >= TV_HEADG && i < TV_DSKIP) v = in[15][i - TV_HEADG]; else if (i >= TV_DSKIP && i < TV_GLUB) v = in[25][i - TV_DSKIP];
            else if (i >= TV_GLUB && i < TV_FINALG) v = in[27][i - TV_GLUB]; else if (i >= TV_FINALG) v = in[29][i - TV_FINALG];
            tv[i] = v; }
        float* s5c = (float*)(ws + WS_TAB + TB_S5C);
        for (int i = gt; i < 2 * 131072; i += NT) s5c[i] = i < 131072 ? in[23][i] : in[24][i - 131072];
    }
}
__device__ __forceinline__ void p1_modreduce(Frame& F, const float* modb, const float* normg) {
    int tid_ = F.tid; OPAQUE(tid_); const int gt = blockIdx.x * (NWAVES * 64) + tid_, NT = F.G * NWAVES * 64;
    const float* P = (const float*)(F.ws + WS_MODP); float* MV = (float*)(F.ws + WS_MODV); float* NR = (float*)(F.ws + WS_NRM);
    for (int i = gt; i < 2 * 5 * DM; i += NT) {
        const int c = i % DM, sel = (i / DM) % 5, l = i / (5 * DM);
        float mv[9];
#pragma unroll
        for (int idx = 0; idx < 9; ++idx) { float s = 0.f;
            for (int ks = 0; ks < KSPLIT; ++ks) s += P[((size_t)(l * KSPLIT + ks) * 5 + sel) * MODN + idx * DM + c];
            s += modb[l * MODN + idx * DM + c]; mv[idx] = s; MV[((size_t)(l * 5 + sel) * 9 + idx) * DM + c] = s; }
#pragma unroll
        for (int w = 0; w < 3; ++w) { const float g = normg[(l * 3 + w) * DM + c];
            NR[(((size_t)(l * 5 + sel) * 3 + w) * 2) * DM + c] = g * (1.f + mv[3 * w + 1]);
            NR[(((size_t)(l * 5 + sel) * 3 + w) * 2 + 1) * DM + c] = mv[3 * w]; }
    }
}
__device__ __forceinline__ void norm_phase(Frame& F, unsigned char* ws, const float* xin, const float* cin, int l, int which, bool first, int nrows) {
    int lane = F.lane; OPAQUE(lane);
    const int gw = blockIdx.x * NWAVES + F.wave, NGW = F.G * NWAVES;
    float* H = (float*)(ws + WS_H); bf16* HN = (bf16*)(ws + WS_HN); const float* NR = (const float*)(ws + WS_NRM);
    for (int m = gw; m < nrows; m += NGW) {
        const float* src = first ? (m < NB * TT ? xin + (size_t)m * DM : cin + (size_t)(m - NB * TT) * DM) : H + (size_t)m * DM;
        const GAS f32x4* xr = (const GAS f32x4*)src + lane;
        f32x4 v[8]; float s = 0.f;
#pragma unroll
        for (int j = 0; j < 8; ++j) { v[j] = xr[64 * j]; s += (v[j].x * v[j].x + v[j].y * v[j].y) + (v[j].z * v[j].z + v[j].w * v[j].w); }
        const float rstd = 1.f / sqrtf(wave_sum_l(s, lane) * (1.f / DM) + EPS);
        if (first) { GAS f32x4* hw = (GAS f32x4*)(H + (size_t)m * DM) + lane;
#pragma unroll
            for (int j = 0; j < 8; ++j) hw[64 * j] = v[j]; }
        const int sel = row_sel(m);
        const GAS f32x4* Ap = (const GAS f32x4*)(NR + (((size_t)(l * 5 + sel) * 3 + which) * 2) * DM) + lane; const GAS f32x4* Bp = Ap + DM / 4;
        GAS unsigned long long* o8 = (GAS unsigned long long*)(HN + (size_t)m * DM) + lane;
#pragma unroll
        for (int j = 0; j < 8; ++j) { const f32x4 a = Ap[64 * j], b = Bp[64 * j]; const f32x4 y = v[j] * rstd * a + b;
            o8[64 * j] = (unsigned long long)pk2(y.x, y.y) | ((unsigned long long)pk2(y.z, y.w) << 32); }
    }
}
__device__ __forceinline__ void final_norm_phase(Frame& F, unsigned char* ws) {
    int lane = F.lane; OPAQUE(lane);
    const int gw = blockIdx.x * NWAVES + F.wave, NGW = F.G * NWAVES;
    const float* H = (const float*)(ws + WS_H);
    for (int m = gw; m < NB * TT; m += NGW) {
        const GAS f32x4* xr = (const GAS f32x4*)(H + (size_t)m * DM) + lane;
        f32x4 v[8]; float s = 0.f;
#pragma unroll
        for (int j = 0; j < 8; ++j) { v[j] = xr[64 * j]; s += (v[j].x * v[j].x + v[j].y * v[j].y) + (v[j].z * v[j].z + v[j].w * v[j].w); }
        const float rstd = 1.f / sqrtf(wave_sum_l(s, lane) * (1.f / DM) + EPS);
        const GAS f32x4* gp = (const GAS f32x4*)((const float*)(ws + WS_TAB + TB_VEC) + TV_FINALG) + lane; GAS f32x4* o = (GAS f32x4*)(F.out + (size_t)m * DM) + lane;
#pragma unroll
        for (int j = 0; j < 8; ++j) o[64 * j] = v[j] * rstd * gp[64 * j];
    }
}
template <int MODE> __device__ __forceinline__ void naive_kprep(int gw, int lane, const bf16* Z, bf16* KO, const float* gk, const float* rope) {
    if (MODE == 0) {
        if (gw >= MR * 2) return;
        const int m = gw >> 1, kvh = gw & 1; const bf16* zr = Z + (size_t)m * ZLD + ZA_K + kvh * 128;
        float x1 = bf2f(zr[lane]), x2 = bf2f(zr[64 + lane]);
        const float rstd = 1.f / sqrtf(wave_sum_l(x1 * x1 + x2 * x2, lane) * (1.f / 128.f) + EPS);
        x1 *= rstd * gk[lane]; x2 *= rstd * gk[64 + lane];
        if (m < NB * TT) { const int t = m & (TT - 1), pos = lane < 32 ? (t >> 6) : (t & 63), f = lane & 31; const float c = rope[2 * (pos * 32 + f)], s = rope[2 * (pos * 32 + f) + 1];
            const float o1 = x1 * c - x2 * s, o2 = x2 * c + x1 * s; x1 = o1; x2 = o2; }
        KO[(size_t)m * 256 + kvh * 128 + lane] = (bf16)f2bf(x1); KO[(size_t)m * 256 + kvh * 128 + 64 + lane] = (bf16)f2bf(x2);
    } else {
        if (gw >= MR) return;
        const int m = gw, kvh = lane >> 5, j = lane & 31; const bf16* zr = Z + (size_t)m * CD_IN + ZD_K + kvh * 64;
        float x1 = bf2f(zr[j]), x2 = bf2f(zr[32 + j]);
        if (m < NB * TT) { const int t = m & (TT - 1), pos = j < 16 ? (t >> 6) : (t & 63), f = j & 15; const float c = rope[2 * (pos * 16 + f)], s = rope[2 * (pos * 16 + f) + 1];
            const float o1 = x1 * c - x2 * s, o2 = x2 * c + x1 * s; x1 = o1; x2 = o2; }
        KO[(size_t)m * 128 + kvh * 64 + j] = (bf16)f2bf(x1); KO[(size_t)m * 128 + kvh * 64 + 32 + j] = (bf16)f2bf(x2);
    }
}
template <int DH, int MODE> __device__ __forceinline__ void naive_attn(int vb, int vtid, const bf16* Z, const bf16* KB, bf16* CAT, const float* gq, const float* rope, const float* sink) {
    constexpr int H4 = DH / 4, NF = DH / 4, NH = (MODE == 2) ? 16 : 8, QPB = 128;
    constexpr int NQ = (MODE == 1) ? CT : TT, LDZ = (MODE == 2) ? CD_IN : ZLD, LDK = (MODE == 2) ? 128 : 256;
    constexpr int QCOL = (MODE == 2) ? ZD_Q : ZA_Q, VCOL = (MODE == 2) ? ZD_V : ZA_V, OCOL = (MODE == 2) ? 1024 : 0;
    const int nchunk = NQ / QPB; int bid = vb; const int qc = bid % nchunk; bid /= nchunk; const int head = bid % NH, b = bid / NH;
    const int kvh = head / (NH / 2), part = vtid & 3, r = vtid >> 2, qi = qc * QPB + r;
    const int m = (MODE == 1) ? (NB * TT + b * CT + qi) : (b * TT + qi);
    float q[H4], acc[H4];
    const bf16* qp = Z + (size_t)m * LDZ + QCOL + head * DH + part * H4;
#pragma unroll
    for (int i = 0; i < H4; ++i) { q[i] = bf2f(qp[i]); acc[i] = 0.f; }
    if (MODE != 2) { float ss = 0.f;
#pragma unroll
        for (int i = 0; i < H4; ++i) ss += q[i] * q[i];
        ss += __shfl_xor(ss, 1); ss += __shfl_xor(ss, 2); const float rstd = 1.f / sqrtf(ss * (1.f / DH) + EPS);
#pragma unroll
        for (int i = 0; i < H4; ++i) q[i] *= rstd * gq[part * H4 + i]; }
    if (MODE != 1) { const int t = qi;
#pragma unroll
        for (int i = 0; i < H4; ++i) { const int j = (part & 1) * H4 + i;
            const int pos = j < NF ? (t >> 6) : (t & 63), f = j % NF; const float c = rope[2 * (pos * NF + f)], s = rope[2 * (pos * NF + f) + 1];
            const float other = __shfl_xor(q[i], 2); q[i] = part < 2 ? (q[i] * c - other * s) : (q[i] * c + other * s); } }
    const float scale = (DH == 128) ? 0.08838834764831845f : 0.125f;
#pragma unroll
    for (int i = 0; i < H4; ++i) q[i] *= scale;
    float mx = (MODE == 2) ? sink[head] : -1e30f, l = (MODE == 2) ? 1.f : 0.f;
    const int lat_lo = (MODE == 0) ? 0 : (MODE == 2 ? max(0, qc * QPB - 128) : 0), lat_hi = (MODE == 0) ? TT : (MODE == 2 ? min(TT, qc * QPB + QPB + 128) : 0);
    const int nkeys = CT + (lat_hi - lat_lo);
#pragma unroll 2
    for (int kk = 0; kk < nkeys; ++kk) {
        const int kpos = kk - CT + lat_lo;
        const int km = kk < CT ? (NB * TT + b * CT + kk) : (b * TT + kpos);
        const bf16* kp = KB + (size_t)km * LDK + kvh * DH + part * H4;
        float s = 0.f;
#pragma unroll
        for (int i = 0; i < H4; ++i) s += q[i] * bf2f(kp[i]);
        s += __shfl_xor(s, 1); s += __shfl_xor(s, 2);
        if (MODE == 2 && kk >= CT && abs(kpos - qi) > 128) continue;
        const float mn = fmaxf(mx, s), al = expf(mx - mn), p = expf(s - mn);
        l = l * al + p; mx = mn;
        const bf16* vp = Z + (size_t)km * LDZ + VCOL + kvh * DH + part * H4;
#pragma unroll
        for (int i = 0; i < H4; ++i) acc[i] = acc[i] * al + p * bf2f(vp[i]);
    }
    const float il = 1.f / l;
    bf16* op = CAT + (size_t)m * DM + OCOL + head * DH + part * H4;
#pragma unroll
    for (int i = 0; i < H4; ++i) op[i] = (bf16)f2bf(acc[i] * il);
}
__device__ __forceinline__ void naive_mlstm(int seq, int tid, LAS float* sq, const bf16* Z, const float* GATES, const float* bgate, float* HF, float* HB) {
    const int b = seq >> 3, h = (seq >> 1) & 3, dir = seq & 1;
    LAS float* sk = sq + 128; LAS float* sred = sq + 256;
    const int v = tid >> 1, half = tid & 1, lane = tid & 63, wave = tid >> 6;
    float C[64];
#pragma unroll
    for (int j = 0; j < 64; ++j) C[j] = 0.f;
    float nreg = 0.f, mstate = 0.f;
    const float bi = bgate[(2 * dir) * 4 + h], bfg = bgate[(2 * dir + 1) * 4 + h];
    float* HO = dir ? HB : HF;
    for (int p = 0; p < SB; ++p) {
        const int s = dir == 0 ? p : (p < CT ? CT - 1 - p : CT + (SB - 1 - p));
        const int m = s < CT ? (NB * TT + b * CT + s) : (b * TT + s - CT);
        const bf16* zr = Z + (size_t)m * ZLD;
        if (tid < 128) sq[tid] = bf2f(zr[ZB_Q + h * 128 + tid]) * 0.08838834764831845f; else if (tid < 256) sk[tid - 128] = bf2f(zr[ZB_K + h * 128 + tid - 128]);
        const float vv = bf2f(zr[ZB_V + h * 256 + v]);
        const float ig = GATES[(size_t)m * 16 + (2 * dir) * 4 + h] + bi, lf = logsigmoid_acc(GATES[(size_t)m * 16 + (2 * dir + 1) * 4 + h] + bfg);
        const float mn = fmaxf(lf + mstate, ig), ip = expf(ig - mn), fp = expf(lf + mstate - mn); mstate = mn;
        __syncthreads();
        float dpart = 0.f; if (tid < 128) { nreg = fp * nreg + ip * sk[tid]; dpart = nreg * sq[tid]; }
        if (wave < 2) { dpart = wave_sum_l(dpart, lane); if (lane == 0) sred[wave] = dpart; }
        float np = 0.f; const float iv = ip * vv;
#pragma unroll
        for (int j = 0; j < 64; ++j) { C[j] = fp * C[j] + iv * sk[64 * half + j]; np += C[j] * sq[64 * half + j]; }
        np += __shfl_xor(np, 1);
        __syncthreads();
        const float den = sred[0] + sred[1];
        if (half == 0) HO[(size_t)m * 1024 + h * 256 + v] = np / fmaxf(fabsf(den), expf(-mn));
        __syncthreads();
    }
}
__device__ __forceinline__ void naive_mlstm_finish(int gw, int lane, const bf16* Z, const float* HF, const float* HB, const float* headg, bf16* CAT) {
    const int m = gw >> 2, h = gw & 3; const size_t o = (size_t)m * 1024 + h * 256 + lane * 4;
    const f32x4 a = *(const f32x4*)(HF + o), bb = *(const f32x4*)(HB + o); const f32x4 hh = a + bb;
    const float rstd = 1.f / sqrtf(wave_sum_l((hh.x * hh.x + hh.y * hh.y) + (hh.z * hh.z + hh.w * hh.w), lane) * (1.f / 256.f) + EPS);
    const bf16* og = Z + (size_t)m * ZLD + ZB_O + h * 256 + lane * 4; bf16* cp = CAT + (size_t)m * DM + 1024 + h * 256 + lane * 4;
#pragma unroll
    for (int j = 0; j < 4; ++j) { const float sg = 1.f / (1.f + expf(-bf2f(og[j]))); cp[j] = (bf16)f2bf(sg * hh[j] * rstd * headg[h * 256 + lane * 4 + j]); }
}
__device__ __forceinline__ void naive_s5(int id, int lane, const bf16* Z, const float* s5ab, const float* s5bb, const float* cre_in, const float* cim_in, float* YF, float* YB) {
    const int b = id >> 7, g = (id >> 1) & 63, dir = id & 1;
    const int i = (dir * 64 + g) * 64 + lane;
    const float ar = s5ab[2 * i], ai = s5ab[2 * i + 1];
    float Br[16], Bi[16], cr[16], ci[16];
#pragma unroll
    for (int q = 0; q < 16; ++q) { Br[q] = s5bb[((size_t)i * 16 + q) * 2]; Bi[q] = s5bb[((size_t)i * 16 + q) * 2 + 1];
        cr[q] = cre_in[((size_t)(dir * 64 + g) * 16 + q) * 64 + lane]; ci[q] = cim_in[((size_t)(dir * 64 + g) * 16 + q) * 64 + lane]; }
    float xr = 0.f, xi = 0.f; float* Y = dir ? YB : YF;
    for (int p = 0; p < SB; ++p) {
        const int s = dir == 0 ? p : (p < CT ? CT - 1 - p : CT + (SB - 1 - p));
        const int m = s < CT ? (NB * TT + b * CT + s) : (b * TT + s - CT);
        const bf16* up = Z + (size_t)m * CD_IN + ZC_U + g * 16;
        float bur = 0.f, bui = 0.f;
#pragma unroll
        for (int q = 0; q < 16; ++q) { const float u = bf2f(up[q]); bur += Br[q] * u; bui += Bi[q] * u; }
        const float nxr = ar * xr - ai * xi + bur, nxi = ar * xi + ai * xr + bui; xr = nxr; xi = nxi;
        if (s >= CT) { float yo = 0.f;
#pragma unroll
            for (int q = 0; q < 16; ++q) { const float val = wave_sum_l(cr[q] * xr - ci[q] * xi, lane); if (lane == q) yo = val; }
            if (lane < 16) Y[(size_t)m * 1024 + g * 16 + lane] = yo; }
    }
}
__device__ __forceinline__ void naive_s5_finish(size_t i, const bf16* Z, const float* YF, const float* YB, const float* dskip, bf16* G) {
    const int m = (int)(i >> 10), c = (int)(i & 1023);
    const float y = YF[i] + YB[i] + dskip[c] * bf2f(Z[(size_t)m * CD_IN + ZC_U + c]);
    G[i] = (bf16)f2bf(gelu_tanh(y));
}
struct Args { const float* in[30]; float* out; unsigned char* ws; int ph_lo, ph_hi, li, pad; };
constexpr int PH_P0 = 0, PH_P1 = 1, PH_L0 = 2, PH_PER_LAYER = 13, PH_FINAL = 28, N_PHASES = 29;
enum { O_F1N = 0, O_F1U, O_F1D, O_MN, O_MI, O_MP, O_MA, O_MF, O_MG, O_MO, O_F2N, O_F2U, O_F2D };
#define OPAQUE_S(p) asm volatile("" : "+s"(p))
#define GEMM_PHASE(EPI, A_, B_, M_, N_, K_, ...) do { pg8::Gemm g{(const bf16*)(A_), (const bf16*)(B_), (M_), (N_), (K_)}; pg8::StaticOrder S; S.init((M_), (N_), F.G, (int)blockIdx.x); \
    pg8::EPI E{__VA_ARGS__}; pg8::gemm_phase<pg8::EPI, pg8::StaticOrder, true, true>(F.lds + RING_OFF, g, S, E); } while (0)

__global__ void __launch_bounds__(NWAVES * 64, 2) fwd(Args args) {
    extern __shared__ __attribute__((aligned(16))) unsigned char lds[];
    Frame F;
    F.lds = (LAS unsigned char*)lds;
    F.MISC = (volatile LAS unsigned*)(F.lds + MISC_OFF);
    F.tid = threadIdx.x; F.lane = F.tid & 63; F.wave = __builtin_amdgcn_readfirstlane(F.tid >> 6);
    F.G = gridDim.x;
    F.ws = args.ws; F.out = args.out;
    F.ctl = (gu32*)(args.ws + WS_CTL);
    for (int u = F.tid; u < (LDS_BYTES - LDSCTL_OFF) / 4; u += NWAVES * 64) ((LAS unsigned*)(F.lds + LDSCTL_OFF))[u] = 0u;
    __syncthreads();
    const int lo = args.ph_lo, hi = args.ph_hi;
    XcdBarrier bar; bar.bar = (unsigned*)(F.ctl + CW_BAR) + args.li * XCD_BAR_WORDS; bar.x = 0; bar.st = nullptr;
    if (hi - lo > 1) bar = xcd_barrier_post((unsigned*)(F.ctl + CW_BAR) + args.li * XCD_BAR_WORDS, F.MISC + 8);
#define IN(k) (lo <= (k) && (k) < hi)
#define SEAM(k) do { if (IN(k) && IN((k) + 1)) xcd_barrier(bar); } while (0)

    if (IN(PH_P0)) { p0_prologue(F, args.in); } SEAM(PH_P0);
    if (IN(PH_P1)) { p1_modreduce(F, args.in[5], args.in[6]); } SEAM(PH_P1);
    if (IN(PH_L0 + O_F1N)) { norm_phase(F, F.ws, args.in[0], args.in[2], 0, 0, true, MR); }
#pragma unroll 1
    for (int l = 0; l < 2; ++l) {
        const int pb = PH_L0 + PH_PER_LAYER * l;
        const int MLAT = NB * TT;
        const int m_post = (l == 1) ? MLAT : MR;
        if (IN(pb + O_F1N) && l > 0) { unsigned char* ws = F.ws; OPAQUE_S(ws); norm_phase(F, ws, nullptr, nullptr, l, 0, false, MR); } SEAM(pb + O_F1N);
        if (IN(pb + O_F1U)) { unsigned char* ws = F.ws; OPAQUE_S(ws);
            GEMM_PHASE(EpiSwiglu, ws + WS_HN, ws + WS_WUP + (size_t)(l * 2) * 44 * MiB, MR, 2 * FF, DM, (bf16*)(ws + WS_HID), FF); } SEAM(pb + O_F1U);
        if (IN(pb + O_F1D)) { unsigned char* ws = F.ws; OPAQUE_S(ws);
            GEMM_PHASE(EpiResid, ws + WS_HID, ws + WS_WDN + (size_t)(l * 2) * 22 * MiB, MR, DM, FF, (float*)(ws + WS_H), (const float*)(ws + WS_MODV) + (size_t)l * 5 * MODN + 2 * DM, MODN, 0.5f); } SEAM(pb + O_F1D);
        if (IN(pb + O_MN)) { unsigned char* ws = F.ws; OPAQUE_S(ws); norm_phase(F, ws, nullptr, nullptr, l, 1, false, MR); } SEAM(pb + O_MN);
        if (IN(pb + O_MI)) { unsigned char* ws = F.ws; OPAQUE_S(ws);
            if (l == 0) GEMM_PHASE(EpiPlain, ws + WS_HN, ws + WS_WABIN, MR, ZLD, DM, (bf16*)(ws + WS_Z), ZLD, (float*)(ws + WS_GATES), ZB_G / 256);
            else GEMM_PHASE(EpiPlain, ws + WS_HN, ws + WS_WCDIN, MR, CD_IN, DM, (bf16*)(ws + WS_Z), CD_IN, nullptr, -1);
        } SEAM(pb + O_MI);
        if (IN(pb + O_MP)) { unsigned char* ws = F.ws; OPAQUE_S(ws);
            int lane = F.lane; OPAQUE(lane); const int gw = blockIdx.x * NWAVES + F.wave, NGW = F.G * NWAVES;
            const bf16* Z = (const bf16*)(ws + WS_Z); bf16* KA = (bf16*)(ws + WS_KA); const float* tv = (const float*)(ws + WS_TAB + TB_VEC);
            if (l == 0) { for (int it = gw; it < MR * 2; it += NGW) naive_kprep<0>(it, lane, Z, KA, tv + TV_GK, (const float*)(ws + WS_TAB + TB_ROPEA)); }
            else { for (int it = gw; it < MR; it += NGW) naive_kprep<1>(it, lane, Z, KA, nullptr, (const float*)(ws + WS_TAB + TB_ROPED)); }
        } SEAM(pb + O_MP);
        if (IN(pb + O_MA)) { unsigned char* ws = F.ws; OPAQUE_S(ws);
            int tid = F.tid; OPAQUE(tid);
            const bf16* Z = (const bf16*)(ws + WS_Z); const bf16* KA = (const bf16*)(ws + WS_KA); bf16* CAT = (bf16*)(ws + WS_CAT); const float* tv = (const float*)(ws + WS_TAB + TB_VEC);
            float* SC1 = (float*)(ws + WS_SC1); float* SC2 = (float*)(ws + WS_SC2);
            if (l == 0) { const float* ropeA = (const float*)(ws + WS_TAB + TB_ROPEA);
                if (blockIdx.x < 32) naive_mlstm((int)blockIdx.x, tid, (LAS float*)(F.lds + RING_OFF), Z, (const float*)(ws + WS_GATES), tv + TV_BGATE, SC1, SC2);
                else { const int nv = F.G - 32, v0 = (int)blockIdx.x - 32, vtid = tid;
                    for (int vb = v0; vb < NB * 8 * (TT / 128); vb += nv) naive_attn<128, 0>(vb, vtid, Z, KA, CAT, tv + TV_GQ, ropeA, nullptr);
                    for (int vb = v0; vb < NB * 8 * (CT / 128); vb += nv) naive_attn<128, 1>(vb, vtid, Z, KA, CAT, tv + TV_GQ, ropeA, nullptr); }
            } else { const float* ropeD = (const float*)(ws + WS_TAB + TB_ROPED);
                if (blockIdx.x < 64) naive_s5((int)blockIdx.x * NWAVES + F.wave, tid & 63, Z, (const float*)(ws + WS_TAB + TB_S5AB), (const float*)(ws + WS_TAB + TB_S5BB), (const float*)(ws + WS_TAB + TB_S5C), (const float*)(ws + WS_TAB + TB_S5C) + 131072, SC1, SC2);
                else { const int nv = F.G - 64, v0 = (int)blockIdx.x - 64, vtid = tid;
                    for (int vb = v0; vb < NB * 16 * (TT / 128); vb += nv) naive_attn<64, 2>(vb, vtid, Z, KA, CAT, nullptr, ropeD, tv + TV_SINK); }
            }
        } SEAM(pb + O_MA);
        if (IN(pb + O_MF)) { unsigned char* ws = F.ws; OPAQUE_S(ws);
            int tid = F.tid; OPAQUE(tid); const int lane = tid & 63, gw = blockIdx.x * NWAVES + F.wave, NGW = F.G * NWAVES;
            const bf16* Z = (const bf16*)(ws + WS_Z); const float* tv = (const float*)(ws + WS_TAB + TB_VEC);
            const float* SC1 = (const float*)(ws + WS_SC1); const float* SC2 = (const float*)(ws + WS_SC2);
            if (l == 0) { for (int it = gw; it < MR * 4; it += NGW) naive_mlstm_finish(it, lane, Z, SC1, SC2, tv + TV_HEADG, (bf16*)(ws + WS_CAT)); }
            else { for (size_t i = (size_t)blockIdx.x * (NWAVES * 64) + tid; i < (size_t)NB * TT * 1024; i += (size_t)F.G * NWAVES * 64) naive_s5_finish(i, Z, SC1, SC2, tv + TV_DSKIP, (bf16*)(ws + WS_G)); }
        } SEAM(pb + O_MF);
        if (IN(pb + O_MG)) { unsigned char* ws = F.ws; OPAQUE_S(ws);
            if (l == 1) GEMM_PHASE(EpiGlu, ws + WS_G, ws + WS_WGLU, MLAT, 1024, 1024, (bf16*)(ws + WS_CAT), DM, (const bf16*)(ws + WS_G), (const float*)(ws + WS_TAB + TB_VEC) + TV_GLUB);
        } SEAM(pb + O_MG);
        if (IN(pb + O_MO)) { unsigned char* ws = F.ws; OPAQUE_S(ws);
            GEMM_PHASE(EpiResid, ws + WS_CAT, ws + (l == 0 ? WS_WABOUT : WS_WCDOUT), m_post, DM, DM, (float*)(ws + WS_H), (const float*)(ws + WS_MODV) + (size_t)l * 5 * MODN + 5 * DM, MODN, 1.0f); } SEAM(pb + O_MO);
        if (IN(pb + O_F2N)) { unsigned char* ws = F.ws; OPAQUE_S(ws); norm_phase(F, ws, nullptr, nullptr, l, 2, false, m_post); } SEAM(pb + O_F2N);
        if (IN(pb + O_F2U)) { unsigned char* ws = F.ws; OPAQUE_S(ws);
            GEMM_PHASE(EpiSwiglu, ws + WS_HN, ws + WS_WUP + (size_t)(l * 2 + 1) * 44 * MiB, m_post, 2 * FF, DM, (bf16*)(ws + WS_HID), FF); } SEAM(pb + O_F2U);
        if (IN(pb + O_F2D)) { unsigned char* ws = F.ws; OPAQUE_S(ws);
            GEMM_PHASE(EpiResid, ws + WS_HID, ws + WS_WDN + (size_t)(l * 2 + 1) * 22 * MiB, m_post, DM, FF, (float*)(ws + WS_H), (const float*)(ws + WS_MODV) + (size_t)l * 5 * MODN + 8 * DM, MODN, 0.5f); } SEAM(pb + O_F2D);
    }
    if (IN(PH_FINAL)) { unsigned char* ws = F.ws; OPAQUE_S(ws); final_norm_phase(F, ws); }
#undef IN
#undef SEAM
}
extern "C" void kernel_launch(void* const* d_in, const int* in_sizes, int n_in, void* d_out, int out_size, void* d_ws, size_t ws_size, hipStream_t stream) {
    static int grid = 0;
    if (grid == 0) {
        if (n_in != 30 || out_size != NB * TT * DM || ws_size < WS_END) { fprintf(stderr, "kernel_launch: unexpected shapes: n_in %d out %d ws %zu (need %zu)\n", n_in, out_size, ws_size, (size_t)WS_END); grid = -1; return; }
        int dev = 0, cus = 0;
        if (hipGetDevice(&dev) != hipSuccess || hipDeviceGetAttribute(&cus, hipDeviceAttributeMultiprocessorCount, dev) != hipSuccess) { grid = -1; return; }
        if (hipFuncSetAttribute((const void*)fwd, hipFuncAttributeMaxDynamicSharedMemorySize, LDS_BYTES) != hipSuccess) { fprintf(stderr, "kernel_launch: hipFuncSetAttribute failed\n"); grid = -1; return; }
        int per_cu = 0; (void)hipOccupancyMaxActiveBlocksPerMultiprocessor(&per_cu, (const void*)fwd, NWAVES * 64, LDS_BYTES); (void)hipGetLastError();
        if (per_cu < 1) fprintf(stderr, "kernel_launch: occupancy query says %d\n", per_cu);
        grid = cus;
    }
    if (grid < 0) return;
    (void)hipMemsetAsync((char*)d_ws + WS_CTL, 0, CTL_ZERO_BYTES, stream);
    Args a{};
    for (int i = 0; i < 30; ++i) a.in[i] = (const float*)d_in[i];
    a.out = (float*)d_out; a.ws = (unsigned char*)d_ws;
    int li = 0;
    auto run = [&](int lo, int hi) { a.ph_lo = lo; a.ph_hi = hi; a.li = li++; a.pad = 0; hipLaunchKernelGGL(fwd, dim3(grid), dim3(NWAVES * 64), LDS_BYTES, stream, a); };
#ifndef MK_CUTS
#define MK_CUTS 0
#endif
    if (MK_CUTS == 0) run(0, N_PHASES);
    else if (MK_CUTS == 1) { for (int ph = 0; ph < N_PHASES; ++ph) run(ph, ph + 1); }
    else { run(0, PH_L0 + O_MP); run(PH_L0 + O_MP, PH_L0 + O_MO); run(PH_L0 + O_MO, PH_L0 + PH_PER_LAYER + O_MP); run(PH_L0 + PH_PER_LAYER + O_MP, PH_L0 + PH_PER_LAYER + O_MO); run(PH_L0 + PH_PER_LAYER + O_MO, N_PHASES); }
    const hipError_t le = hipPeekAtLastError();
    if (le != hipSuccess) fprintf(stderr, "kernel_launch: launch failed: %s\n", hipGetErrorName(le));
}
```

```cpp
#include <hip/hip_runtime.h>
#include <cstdio>
#include <cstdint>
#include <cmath>
__device__ __forceinline__ int fresh_lane() { int l; asm volatile("v_mbcnt_lo_u32_b32 %0, -1, 0\n\tv_mbcnt_hi_u32_b32 %0, -1, %0" : "=v"(l)); return l; }
__device__ __forceinline__ int fresh_tid(int wave) { return wave * 64 + fresh_lane(); }
namespace pg8 {
#define PG8_LAS __attribute__((address_space(3)))
typedef unsigned short bf16_t;
typedef short bf16x8 __attribute__((ext_vector_type(8)));
typedef float f32x4 __attribute__((ext_vector_type(4)));
typedef unsigned u32x4 __attribute__((ext_vector_type(4)));
constexpr int BM = 256, BK = 64, HALF = 128, HTB = HALF * BK * 2  , STAGE_BYTES = 8 * HTB, NXCD = 8, WGM = 8;

__host__ __device__ __forceinline__ int lds_byte(int r, int c) { const int st = (r >> 4) * 2 + (c >> 5), rr = r & 15, cc = c & 31, ob = rr * 64 + cc * 2; return st * 1024 + (ob ^ (((ob >> 9) & 1) << 5)); }
__host__ __device__ __forceinline__ void stage_rc(int b, int& R, int& C) { const int st = b / 1024, sb = b % 1024, swz = sb ^ (((sb >> 9) & 1) << 5); R = (st >> 1) * 16 + swz / 64; C = (st & 1) * 32 + (swz % 64) / 2; }
__host__ __device__ __forceinline__ int perm32(int rho) { const int n = rho >> 4, i = rho & 15; return 8 * (i >> 2) + 4 * n + (i & 3); }

struct Unit { int pm, pn; };
struct Gemm { const bf16_t* A; const bf16_t* Bt; int M, N, K; };

struct StaticOrder {
    int nM, nN, nwg, G, c;
    __host__ __device__ void init(int M, int N, int G_, int c_) { nM = M / BM; nN = N / BM; nwg = nM * nN; G = G_; c = c_; }
    __host__ __device__ bool next(int i, Unit& u) const {
        const long L = (long)i * G + c; if (L >= nwg) return false;
        int wgid = (int)L; { const int q = nwg / NXCD, r = nwg % NXCD, xcd = wgid % NXCD, off = wgid / NXCD; wgid = (xcd < r ? xcd * (q + 1) : r * (q + 1) + (xcd - r) * q) + off; }
        const int nig = WGM * nN, gid = wgid / nig, fm = gid * WGM, gsz = (nM - fm) < WGM ? (nM - fm) : WGM;
        u.pm = fm + ((wgid % nig) % gsz); u.pn = (wgid % nig) / gsz; return true;
    }
    __device__ __forceinline__ void a_ready(const Unit&) const {}
    __device__ __forceinline__ void done(const Unit&) const {}
};

__device__ __forceinline__ unsigned cvt_pk_bf16(float lo, float hi) { unsigned r; asm volatile("v_cvt_pk_bf16_f32 %0, %1, %2" : "=v"(r) : "v"(lo), "v"(hi)); return r; }
typedef float f32x2 __attribute__((ext_vector_type(2)));
__device__ __forceinline__ float fast_sigmoid(float a) { return __builtin_amdgcn_rcpf(1.f + __builtin_amdgcn_exp2f(-1.4426950408889634f * a)); }
struct EpiPlain {
    static constexpr bool PERM = true, AFTER_DRAIN = false;
    bf16_t* O; int ldc; float* gates; int gate_pn;
    __device__ __forceinline__ void operator()(const f32x4 (&acc)[2][2][4][2], const Unit& u, int wr, int wc, int fr, int fq) const {
        const int row0 = u.pm * BM + wr * 64 + fr, col0 = u.pn * BM + wc * 32 + 8 * fq;
#pragma unroll
        for (int ai = 0; ai < 2; ++ai)
#pragma unroll
            for (int m = 0; m < 4; ++m) { const int row = row0 + ai * HALF + m * 16; bf16_t* rowp = O + (size_t)row * ldc + col0;
#pragma unroll
                for (int bj = 0; bj < 2; ++bj) { const f32x4 v0 = acc[ai][bj][m][0], v1 = acc[ai][bj][m][1];
                    u32x4 w; w.x = cvt_pk_bf16(v0[0], v0[1]); w.y = cvt_pk_bf16(v0[2], v0[3]); w.z = cvt_pk_bf16(v1[0], v1[1]); w.w = cvt_pk_bf16(v1[2], v1[3]);
                    *(u32x4*)(rowp + bj * HALF) = w;
                    if (bj == 0 && u.pn == gate_pn && wc == 0 && fq < 2) { float* gp = gates + (size_t)row * 16 + 8 * fq; *(f32x4*)gp = v0; *(f32x4*)(gp + 4) = v1; } } }
    }
};
struct EpiSwiglu {
    static constexpr bool PERM = true, AFTER_DRAIN = false;
    bf16_t* O; int ldc;
    __device__ __forceinline__ void operator()(const f32x4 (&acc)[2][2][4][2], const Unit& u, int wr, int wc, int fr, int fq) const {
        const int row0 = u.pm * BM + wr * 64 + fr, col0 = u.pn * HALF + wc * 32 + 8 * fq;
#pragma unroll
        for (int ai = 0; ai < 2; ++ai)
#pragma unroll
            for (int m = 0; m < 4; ++m) { bf16_t* rowp = O + (size_t)(row0 + ai * HALF + m * 16) * ldc + col0;
                float r[8];
#pragma unroll
                for (int n = 0; n < 2; ++n)
#pragma unroll
                    for (int j = 0; j < 4; ++j) { const float a = acc[ai][0][m][n][j], b = acc[ai][1][m][n][j]; r[4 * n + j] = a * fast_sigmoid(a) * b; }
                u32x4 w; w.x = cvt_pk_bf16(r[0], r[1]); w.y = cvt_pk_bf16(r[2], r[3]); w.z = cvt_pk_bf16(r[4], r[5]); w.w = cvt_pk_bf16(r[6], r[7]);
                *(u32x4*)rowp = w; }
    }
};
struct EpiResid {
    static constexpr bool PERM = true, AFTER_DRAIN = false;
    float* H; const float* gate; int gstride; float coef;
    __device__ __forceinline__ void operator()(const f32x4 (&acc)[2][2][4][2], const Unit& u, int wr, int wc, int fr, int fq) const {
        const int row0 = u.pm * BM + wr * 64 + fr, col0 = u.pn * BM + wc * 32 + 8 * fq;
        const int sel = u.pm < 64 ? (u.pm >> 4) : 4;
        const float* gp = gate + (size_t)sel * gstride + col0;
        f32x4 gv[2][2];
#pragma unroll
        for (int bj = 0; bj < 2; ++bj)
#pragma unroll
            for (int n = 0; n < 2; ++n) gv[bj][n] = *(const f32x4*)(gp + bj * HALF + 4 * n) * coef;
#pragma unroll
        for (int ai = 0; ai < 2; ++ai)
#pragma unroll
            for (int m = 0; m < 4; ++m) { float* rowp = H + (size_t)(row0 + ai * HALF + m * 16) * 2048 + col0;
#pragma unroll
                for (int bj = 0; bj < 2; ++bj)
#pragma unroll
                    for (int n = 0; n < 2; ++n) { f32x4* p = (f32x4*)(rowp + bj * HALF + 4 * n); *p = *p + gv[bj][n] * acc[ai][bj][m][n]; } }
    }
};
struct EpiGlu {
    static constexpr bool PERM = true, AFTER_DRAIN = false;
    bf16_t* O; int ldc; const bf16_t* G; const float* bias;
    __device__ __forceinline__ void operator()(const f32x4 (&acc)[2][2][4][2], const Unit& u, int wr, int wc, int fr, int fq) const {
        const int row0 = u.pm * BM + wr * 64 + fr, col0 = u.pn * BM + wc * 32 + 8 * fq;
#pragma unroll
        for (int ai = 0; ai < 2; ++ai)
#pragma unroll
            for (int m = 0; m < 4; ++m) { const int row = row0 + ai * HALF + m * 16;
#pragma unroll
                for (int bj = 0; bj < 2; ++bj) { const int col = col0 + bj * HALF;
                    const u32x4 gw = *(const u32x4*)(G + (size_t)row * 1024 + col);
                    const f32x4 b0 = *(const f32x4*)(bias + col), b1 = *(const f32x4*)(bias + col + 4);
                    float r[8];
#pragma unroll
                    for (int j = 0; j < 4; ++j) { r[j] = fast_sigmoid(acc[ai][bj][m][0][j] + b0[j]); r[4 + j] = fast_sigmoid(acc[ai][bj][m][1][j] + b1[j]); }
                    const unsigned gws[4] = {gw.x, gw.y, gw.z, gw.w};
#pragma unroll
                    for (int q = 0; q < 4; ++q) { r[2 * q] *= __builtin_bit_cast(float, gws[q] << 16); r[2 * q + 1] *= __builtin_bit_cast(float, gws[q] & 0xffff0000u); }
                    u32x4 w; w.x = cvt_pk_bf16(r[0], r[1]); w.y = cvt_pk_bf16(r[2], r[3]); w.z = cvt_pk_bf16(r[4], r[5]); w.w = cvt_pk_bf16(r[6], r[7]);
                    *(u32x4*)(O + (size_t)row * ldc + col) = w; } }
    }
};
template <class Epi, class Sched, bool ALIGN_EPI = false, bool SP2 = false>
__device__ __forceinline__ void gemm_phase(PG8_LAS unsigned char* lds, const Gemm g, const Sched& S, const Epi& E, int wave_s) {
    const int tid = fresh_tid(wave_s);
    const int wid = __builtin_amdgcn_readfirstlane(tid >> 6), lane = tid & 63, wr = wid >> 2, wc = wid & 3, fr = lane & 15, fq = lane >> 4;
    const int K = g.K, nt = K / BK;
    unsigned voffA[2], voffB[2];
#pragma unroll
    for (int i = 0; i < 2; ++i) { int R, C; stage_rc(tid * 16 + i * 8192, R, C); const int Rb = Epi::PERM ? ((R & ~31) + perm32(R & 31)) : R;
        voffA[i] = (unsigned)(R * K + C) * 2u; voffB[i] = (unsigned)(Rb * K + C) * 2u; }
    const size_t kstep = (size_t)(BK * 2);
    const size_t hstep = (size_t)HALF * K * 2;
    const size_t tstep = 2 * hstep;
    const unsigned ldsw = (unsigned)wid * 1024u;
    const int aoff = lds_byte(wr * 64 + fr, fq * 8), boff = lds_byte(wc * 32 + fr, fq * 8);
#define PG8_SA(b, h) (((b) * 2 + (h)) * HTB)
#define PG8_SB(b, h) ((4 + (b) * 2 + (h)) * HTB)
#define PG8_STAGE(bufoff, gbase, voff) do { _Pragma("unroll") for (int _i = 0; _i < 2; ++_i) \
        __builtin_amdgcn_global_load_lds((const unsigned*)((const char*)(gbase) + (voff)[_i]), (PG8_LAS unsigned*)(lds + (bufoff) + ldsw + _i * 8192), 16, 0, 0); } while (0)
#define PG8_LDA(dst, b, h) do { _Pragma("unroll") for (int m = 0; m < 4; ++m) _Pragma("unroll") for (int k = 0; k < 2; ++k) dst[m][k] = *(const PG8_LAS bf16x8*)(lds + PG8_SA(b, h) + aoff + m * 2048 + k * 1024); } while (0)
#define PG8_LDB(dst, b, h) do { _Pragma("unroll") for (int n = 0; n < 2; ++n) _Pragma("unroll") for (int k = 0; k < 2; ++k) dst[n][k] = *(const PG8_LAS bf16x8*)(lds + PG8_SB(b, h) + boff + n * 2048 + k * 1024); } while (0)
#define PG8_MMA(ai, bj, At, Bt) do { __builtin_amdgcn_s_setprio(1); _Pragma("unroll") for (int m = 0; m < 4; ++m) _Pragma("unroll") for (int n = 0; n < 2; ++n) _Pragma("unroll") for (int k = 0; k < 2; ++k) \
        acc[ai][bj][m][n] = __builtin_amdgcn_mfma_f32_16x16x32_bf16(Bt[n][k], At[m][k], acc[ai][bj][m][n], 0, 0, 0); __builtin_amdgcn_s_setprio(0); } while (0)
#define PG8_WAIT_V(n) asm volatile("s_waitcnt vmcnt(" #n ")" ::: "memory")
#define PG8_WAIT_L(n) asm volatile("s_waitcnt lgkmcnt(" #n ")" ::: "memory")
#define PG8_BAR __builtin_amdgcn_s_barrier()
#define PG8_SCHED __builtin_amdgcn_sched_barrier(0)
    Unit cur, nxt; int ui = 0;
    if (!S.next(0, cur)) return;
    f32x4 acc[2][2][4][2];
#pragma unroll
    for (int a = 0; a < 2; ++a)
#pragma unroll
        for (int b = 0; b < 2; ++b)
#pragma unroll
            for (int m = 0; m < 4; ++m)
#pragma unroll
                for (int n = 0; n < 2; ++n) acc[a][b][m][n] = (f32x4){0.f, 0.f, 0.f, 0.f};
    bf16x8 At[4][2], B0[2][2], B1[2][2];
    const char* cA = (const char*)g.A + (size_t)cur.pm * tstep; const char* cB = (const char*)g.Bt + (size_t)cur.pn * tstep;
    S.a_ready(cur);
    if constexpr (SP2) {
        PG8_STAGE(PG8_SB(0, 0), cB, voffB); PG8_STAGE(PG8_SB(0, 1), cB + hstep, voffB); PG8_STAGE(PG8_SA(0, 0), cA, voffA); PG8_STAGE(PG8_SA(0, 1), cA + hstep, voffA);
        if (wr == 1) PG8_BAR;
        PG8_WAIT_V(2); PG8_BAR;
        PG8_STAGE(PG8_SB(1, 0), cB + kstep, voffB); PG8_STAGE(PG8_SA(1, 0), cA + kstep, voffA); PG8_STAGE(PG8_SB(1, 1), cB + hstep + kstep, voffB);
        PG8_WAIT_V(6); PG8_BAR;
    } else {
        PG8_STAGE(PG8_SB(0, 0), cB, voffB); PG8_STAGE(PG8_SA(0, 0), cA, voffA); PG8_STAGE(PG8_SB(0, 1), cB + hstep, voffB); PG8_STAGE(PG8_SA(0, 1), cA + hstep, voffA);
        if (wr == 1) PG8_BAR;
        PG8_WAIT_V(4); PG8_BAR;
        PG8_STAGE(PG8_SB(1, 0), cB + kstep, voffB); PG8_STAGE(PG8_SA(1, 0), cA + kstep, voffA); PG8_STAGE(PG8_SB(1, 1), cB + hstep + kstep, voffB);
        PG8_WAIT_V(6); PG8_BAR;
    }
    for (;;) {
        const bool has_next = S.next(ui + 1, nxt);
        const char* nA = has_next ? (const char*)g.A + (size_t)nxt.pm * tstep : cA; const char* nB = has_next ? (const char*)g.Bt + (size_t)nxt.pn * tstep : cB;
        for (int t = 0; t < nt; t += 2) {
            const bool last = (t == nt - 2);
            const char* a1 = cA + (size_t)(t + 1) * kstep;
            const char* a2 = last ? nA : cA + (size_t)(t + 2) * kstep; const char* b2 = last ? nB : cB + (size_t)(t + 2) * kstep;
            const char* a3 = a2 + kstep; const char* b3 = b2 + kstep;
            if (last && has_next) S.a_ready(nxt);
            if constexpr (SP2) {
            PG8_LDB(B0, 0, 0); PG8_LDB(B1, 0, 1); PG8_SCHED; PG8_LDA(At, 0, 0); PG8_STAGE(PG8_SA(1, 1), a1 + hstep, voffA);
            PG8_WAIT_V(8); PG8_WAIT_L(0); PG8_BAR; PG8_MMA(0, 0, At, B0); PG8_MMA(0, 1, At, B1); PG8_BAR; PG8_SCHED;
            PG8_LDA(At, 0, 1); PG8_STAGE(PG8_SB(0, 0), b2, voffB); PG8_STAGE(PG8_SB(0, 1), b2 + hstep, voffB); PG8_STAGE(PG8_SA(0, 0), a2, voffA);
            PG8_WAIT_V(8); PG8_WAIT_L(0); PG8_BAR; PG8_MMA(1, 0, At, B0); PG8_MMA(1, 1, At, B1); PG8_BAR; PG8_SCHED;
            PG8_LDB(B0, 1, 0); PG8_LDB(B1, 1, 1); PG8_SCHED; PG8_LDA(At, 1, 0); PG8_STAGE(PG8_SA(0, 1), a2 + hstep, voffA);
            PG8_WAIT_V(8); PG8_WAIT_L(0); PG8_BAR; PG8_MMA(0, 0, At, B0); PG8_MMA(0, 1, At, B1); PG8_BAR; PG8_SCHED;
            PG8_LDA(At, 1, 1); PG8_STAGE(PG8_SB(1, 0), b3, voffB); PG8_STAGE(PG8_SB(1, 1), b3 + hstep, voffB); PG8_STAGE(PG8_SA(1, 0), a3, voffA);
            PG8_WAIT_V(8); PG8_WAIT_L(0); PG8_BAR; PG8_MMA(1, 0, At, B0); PG8_MMA(1, 1, At, B1); PG8_BAR; PG8_SCHED;
            } else {
            PG8_LDB(B0, 0, 0); PG8_SCHED; PG8_LDA(At, 0, 0); PG8_STAGE(PG8_SA(1, 1), a1 + hstep, voffA);
            PG8_WAIT_L(8); PG8_BAR; PG8_WAIT_L(0); PG8_MMA(0, 0, At, B0); PG8_BAR; PG8_SCHED;
            PG8_LDB(B1, 0, 1); PG8_STAGE(PG8_SB(0, 0), b2, voffB);
            PG8_BAR; PG8_WAIT_L(0); PG8_MMA(0, 1, At, B1); PG8_BAR;
            PG8_LDA(At, 0, 1); PG8_STAGE(PG8_SA(0, 0), a2, voffA);
            PG8_BAR; PG8_WAIT_L(0); PG8_MMA(1, 0, At, B0); PG8_BAR; PG8_SCHED;
            PG8_STAGE(PG8_SB(0, 1), b2 + hstep, voffB);
            PG8_WAIT_V(6); PG8_BAR; PG8_MMA(1, 1, At, B1); PG8_BAR;
            PG8_LDB(B0, 1, 0); PG8_SCHED; PG8_LDA(At, 1, 0); PG8_STAGE(PG8_SA(0, 1), a2 + hstep, voffA);
            PG8_WAIT_L(8); PG8_BAR; PG8_WAIT_L(0); PG8_MMA(0, 0, At, B0); PG8_BAR; PG8_SCHED;
            PG8_LDB(B1, 1, 1); PG8_STAGE(PG8_SB(1, 0), b3, voffB);
            PG8_BAR; PG8_WAIT_L(0); PG8_MMA(0, 1, At, B1); PG8_BAR;
            PG8_LDA(At, 1, 1); PG8_STAGE(PG8_SA(1, 0), a3, voffA);
            PG8_BAR; PG8_WAIT_L(0); PG8_MMA(1, 0, At, B0); PG8_BAR; PG8_SCHED;
            PG8_STAGE(PG8_SB(1, 1), b3 + hstep, voffB);
            PG8_WAIT_V(6); PG8_BAR; PG8_MMA(1, 1, At, B1); PG8_BAR;
            }
        }
        if constexpr (ALIGN_EPI) { if (wr == 0) PG8_BAR; }
        if constexpr (!Epi::AFTER_DRAIN) { E(acc, cur, wr, wc, fr, fq); S.done(cur); }
        if (!has_next) break;
#pragma unroll
        for (int a = 0; a < 2; ++a)
#pragma unroll
            for (int b = 0; b < 2; ++b)
#pragma unroll
                for (int m = 0; m < 4; ++m)
#pragma unroll
                    for (int n = 0; n < 2; ++n) acc[a][b][m][n] = (f32x4){0.f, 0.f, 0.f, 0.f};
        cur = nxt; cA = nA; cB = nB; ++ui;
        if constexpr (ALIGN_EPI) { if (wr == 1) PG8_BAR; }
    }
    PG8_WAIT_V(0);
    if constexpr (!ALIGN_EPI) { if (wr == 0) PG8_BAR; }
    PG8_BAR;
    if constexpr (Epi::AFTER_DRAIN) { E.fused(acc, cur, wr, wc, fr, fq, lds, wid, lane); S.done(cur); }
#undef PG8_SA
#undef PG8_SB
#undef PG8_STAGE
#undef PG8_LDA
#undef PG8_LDB
#undef PG8_MMA
#undef PG8_WAIT_V
#undef PG8_WAIT_L
#undef PG8_BAR
#undef PG8_SCHED
}
}
#define GAS __attribute__((address_space(1)))
#define LAS __attribute__((address_space(3)))
typedef unsigned short bf16;
typedef unsigned v4u __attribute__((ext_vector_type(4)));
typedef float f32x4 __attribute__((ext_vector_type(4)));
typedef short bf16x8 __attribute__((ext_vector_type(8)));
typedef GAS unsigned gu32;
typedef GAS unsigned long long gu64;
#define RLX_AGENT __ATOMIC_RELAXED, __HIP_MEMORY_SCOPE_AGENT
#define LDS_WAIT() asm volatile("s_waitcnt lgkmcnt(0)" ::: "memory")
#define VM_WAIT() asm volatile("s_waitcnt vmcnt(0)" ::: "memory")
__device__ __forceinline__ unsigned long long rt() { return __builtin_amdgcn_s_memrealtime(); }
__device__ __forceinline__ unsigned f2bf(float f) { unsigned u = __builtin_bit_cast(unsigned, f); return (u + 0x7fffu + ((u >> 16) & 1u)) >> 16; }
__device__ __forceinline__ unsigned pk2(float lo, float hi) { return f2bf(lo) | (f2bf(hi) << 16); }

#define XB_TMO      128
#define XB_XCNT(j)  (256  + 64 * (j))
#define XB_XSUB(j)  (1280 + 64 * (j))
#define XB_XGEN(j)  (2304 + 64 * (j))
#define XB_TOP      3328
#define XB_TOPGEN   3392
#define XCD_BAR_WORDS 3456
#define XB_SPIN_CAP (1u << 18)

__device__ __forceinline__ unsigned xb_ld(unsigned* p)              { return __hip_atomic_load(p, __ATOMIC_RELAXED, __HIP_MEMORY_SCOPE_AGENT); }
__device__ __forceinline__ unsigned xb_add(unsigned* p, unsigned v) { return __hip_atomic_fetch_add(p, v, __ATOMIC_RELAXED, __HIP_MEMORY_SCOPE_AGENT); }
__device__ __forceinline__ unsigned xb_xcc_id() { return (unsigned)__builtin_amdgcn_s_getreg((3 << 11) | 20) & 0xFu; }
#define XB_SPIN(cond, bar) do { unsigned _sp = 0; while (cond) { __builtin_amdgcn_s_sleep(1); \
    if ((++_sp & 255u) == 0u) { if (xb_ld(&(bar)[XB_TMO])) break; if (_sp > XB_SPIN_CAP) { atomicAdd(&(bar)[XB_TMO], 1u); break; } } } } while (0)

struct XcdBarrier {
    unsigned* bar; unsigned x;
    volatile LAS unsigned* st;
};

__device__ __forceinline__ XcdBarrier xcd_barrier_post(unsigned* bar, volatile LAS unsigned* st) {
    XcdBarrier b; b.bar = bar; b.x = xb_xcc_id(); b.st = st;
    if (threadIdx.x == 0) (void)xb_add(&bar[XB_XCNT(b.x)], 1u);
    return b;
}
__device__ __forceinline__ void xcd_barrier_complete(unsigned* bar, unsigned x, unsigned& nloc, unsigned& nx) {
    const unsigned G = gridDim.x * gridDim.y * gridDim.z;
    unsigned sum, cnt, mine, sp = 0u;
    for (;;) {
        sum = 0u; cnt = 0u; mine = 0u;
#pragma unroll
        for (unsigned j = 0; j < 16; ++j) { const unsigned c = xb_ld(&bar[XB_XCNT(j)]); sum += c; cnt += (c > 0u) ? 1u : 0u; mine = (j == x) ? c : mine; }
        if (sum == G) break;
        __builtin_amdgcn_s_sleep(1);
        if ((++sp & 255u) == 0u) { if (xb_ld(&bar[XB_TMO])) break; if (sp > XB_SPIN_CAP) { atomicAdd(&bar[XB_TMO], 1u); break; } }
    }
    nloc = mine > 0u ? mine : 1u; nx = cnt > 0u ? cnt : 1u;
}

__device__ __forceinline__ void xcd_barrier(const XcdBarrier& b, int wave_s) {
    asm volatile("s_waitcnt vmcnt(0)" ::: "memory");
    __syncthreads();
    if (wave_s == 0 && fresh_lane() == 0) {
        unsigned* bar = b.bar;
        __builtin_amdgcn_s_waitcnt(0);
        unsigned nloc = b.st[0], nx = b.st[1];
        if (nloc == 0u) { xcd_barrier_complete(bar, b.x, nloc, nx); b.st[0] = nloc; b.st[1] = nx; }
        const unsigned old = xb_add(&bar[XB_XSUB(b.x)], 1u);
        const unsigned gen = old / nloc;
        if (old + 1u == (gen + 1u) * nloc) {
            __builtin_amdgcn_fence(__ATOMIC_RELEASE, "agent");
            asm volatile("s_waitcnt vmcnt(0)" ::: "memory");
            const unsigned og = xb_add(&bar[XB_TOP], 1u);
            const unsigned tg = og / nx;
            if (og + 1u == (tg + 1u) * nx) xb_add(&bar[XB_TOPGEN], 1u);
            else XB_SPIN(xb_ld(&bar[XB_TOPGEN]) == tg, bar);
            __builtin_amdgcn_fence(__ATOMIC_ACQUIRE, "agent");
            xb_add(&bar[XB_XGEN(b.x)], 1u);
            asm volatile("s_waitcnt vmcnt(0)" ::: "memory");
        } else {
            XB_SPIN(xb_ld(&bar[XB_XGEN(b.x)]) == gen, bar);
            __builtin_amdgcn_fence(__ATOMIC_ACQUIRE, "agent");
            asm volatile("s_waitcnt vmcnt(0)" ::: "memory");
        }
    }
    __syncthreads();
}
constexpr int NWAVES = 8;
constexpr int DM = 2048, NB = 4, TT = 4096, CT = 256, SB = 4352, MR = NB * SB  , FF = 5632;
constexpr int AB_IN = 4624, ZLD = 4864, CD_IN = 2304, NMOD = 9, MODN = NMOD * DM  ;
constexpr float EPS = 1e-6f;
constexpr int ZA_Q = 0, ZA_K = 1024, ZA_V = 1280, ZB_Q = 1536, ZB_K = 2048, ZB_V = 2560, ZB_O = 3584, ZB_G = 4608;
constexpr int ZC_U = 0, ZD_Q = 1024, ZD_K = 2048, ZD_V = 2176;
constexpr int KSPLIT = 32;
constexpr size_t MiB = 1u << 20;
constexpr size_t WS_CTL = 0, CTL_ZERO_BYTES = 1 * MiB;
constexpr size_t WS_WUP = 1 * MiB;
constexpr size_t WS_WDN = WS_WUP + 4 * 44 * MiB;
constexpr size_t WS_WABIN = WS_WDN + 4 * 22 * MiB;
constexpr size_t WS_WABOUT = WS_WABIN + 19 * MiB;
constexpr size_t WS_WCDIN = WS_WABOUT + 8 * MiB;
constexpr size_t WS_WCDOUT = WS_WCDIN + 9 * MiB;
constexpr size_t WS_WGLU = WS_WCDOUT + 8 * MiB;
constexpr size_t WS_MODP = WS_WGLU + 2 * MiB;
constexpr size_t WS_MODV = WS_MODP + 23 * MiB;
constexpr size_t WS_NRM = WS_MODV + 1 * MiB;
constexpr size_t WS_TAB = WS_NRM + 1 * MiB;
constexpr size_t WS_H = WS_TAB + 4 * MiB;
constexpr size_t WS_HN = WS_H + 136 * MiB;
constexpr size_t WS_X = WS_HN + 68 * MiB;
constexpr size_t WS_Z = WS_X, WS_ZT = WS_X + 163 * MiB, WS_HID = WS_X;
constexpr size_t WS_CAT = WS_X + 216 * MiB;
constexpr size_t WS_GATES = WS_CAT + 68 * MiB;
constexpr size_t WS_KA = WS_GATES + 2 * MiB;
constexpr size_t WS_G = WS_KA + 10 * MiB;
constexpr size_t WS_SC1 = WS_G + 34 * MiB;
constexpr size_t WS_SC2 = WS_SC1 + 68 * MiB;
constexpr size_t WS_END = WS_SC2 + 68 * MiB;
static_assert((size_t)MR * ZLD * 2 <= 163 * MiB && (size_t)1536 * MR * 2 <= 53 * MiB && (size_t)MR * FF * 2 <= 216 * MiB, "overlay");
constexpr size_t TB_ROPEA = 0;
constexpr size_t TB_ROPED = 16384;
constexpr size_t TB_S5AB = 32768;
constexpr size_t TB_S5BB = TB_S5AB + 65536;
constexpr size_t TB_VEC = TB_S5BB + 1048576;
constexpr int TV_GK = 0, TV_GQ = 128, TV_BGATE = 256, TV_SINK = 272, TV_HEADG = 512, TV_DSKIP = 1536, TV_GLUB = 2560, TV_FINALG = 3584, TV_N = 5632;
constexpr size_t TB_S5C = TB_VEC + 32768;
constexpr size_t TB_S5BT = TB_S5C + 1048576;
constexpr size_t TB_S5CT = TB_S5BT + 524288;
constexpr size_t TB_END = TB_S5CT + 524288;
static_assert(TB_END <= 4 * MiB, "tables");
constexpr int CW_TMO = 0, CW_BAR = 4096;
constexpr int RING_OFF = 0, RING_BYTES = 131072;
constexpr int LDSCTL_OFF = RING_BYTES, MISC_OFF = LDSCTL_OFF + 320;
constexpr int LDS_BYTES = 147456;
static_assert(MISC_OFF + 128 <= LDS_BYTES, "LDS map");
__device__ __forceinline__ float bf2f(bf16 v) { return __builtin_bit_cast(float, (unsigned)v << 16); }
__device__ __forceinline__ float wave_sum(float v) {
#pragma unroll
    for (int o = 1; o < 64; o <<= 1) v += __shfl_xor(v, o);
    return v;
}
__device__ __forceinline__ float wave_sum_l(float v, int lane) {
#pragma unroll
    for (int o = 1; o < 64; o <<= 1) v += __builtin_bit_cast(float, __builtin_amdgcn_ds_bpermute((lane ^ o) << 2, __builtin_bit_cast(int, v)));
    return v;
}
#define OPAQUE(x) asm volatile("" : "+v"(x))
__device__ __forceinline__ float silu_acc(float x) { return x / (1.f + expf(-x)); }
__device__ __forceinline__ float logsigmoid_acc(float x) { return x >= 0.f ? -log1pf(expf(-x)) : x - log1pf(expf(x)); }
__device__ __forceinline__ float gelu_tanh(float x) { const float u = 0.7978845608028654f * (x + 0.044715f * x * x * x); return 0.5f * x * (1.f + tanhf(u)); }
__device__ __forceinline__ int row_sel(int m) { return m < NB * TT ? (m >> 12) : 4; }

struct Frame {
    LAS unsigned char* lds;
    volatile LAS unsigned* MISC;
    gu32* ctl;
    int wave, G;
    float* out; unsigned char* ws;
};

__device__ __forceinline__ void p0_transpose_item(const float* W, int K, int N, int Nvalid, bf16* WT, int drow0, int k0, int n0, LAS float* scr, int lane) {
    const int nn = n0 + (lane & 31); const bool ok = nn < Nvalid;
#pragma unroll 8
    for (int i = 0; i < 32; ++i) { const int kk = 2 * i + (lane >> 5); scr[kk * 33 + (lane & 31)] = ok ? W[(size_t)(k0 + kk) * N + nn] : 0.f; }
    LDS_WAIT(); asm volatile("" ::: "memory");
    const int c = lane & 7;
#pragma unroll
    for (int j = 0; j < 4; ++j) { const int n = (lane >> 3) + 8 * j; const LAS float* s = scr + (8 * c) * 33 + n;
        v4u o; o.x = pk2(s[0 * 33], s[1 * 33]); o.y = pk2(s[2 * 33], s[3 * 33]); o.z = pk2(s[4 * 33], s[5 * 33]); o.w = pk2(s[6 * 33], s[7 * 33]);
        *(GAS v4u*)(WT + (size_t)(drow0 + n) * K + k0 + 8 * c) = o; }
    LDS_WAIT(); asm volatile("" ::: "memory");
}
__device__ __forceinline__ bool p0_mat(int& r, const float* W, int K, int N, int Npad, bf16* WT, int mode  , LAS float* scr, int lane) {
    const int nblk = Npad / 32, items = (K / 64) * nblk;
    if (r >= items) { r -= items; return false; }
    const int kb = r / nblk, nb = r % nblk, n0 = 32 * nb;
    int drow0 = n0; if (mode) drow0 = (n0 >> 7) * 256 + (n0 & 127) + (mode == 2 ? 128 : 0);
    p0_transpose_item(W, K, N, N, WT, drow0, 64 * kb, n0, scr, lane);
    return true;
}
__device__ __forceinline__ void p0_prologue(Frame& F, const float* const (&in)[30]) {
    LAS float* scr = (LAS float*)(F.lds + RING_OFF + F.wave * 16384);
    const int lane = fresh_lane();
    const int gw = blockIdx.x * NWAVES + F.wave, NGW = F.G * NWAVES;
    unsigned char* ws = F.ws;
    {
        constexpr int NCH = MODN / 256, NIT = 2 * KSPLIT * NCH, KPER = DM / KSPLIT;
        for (int it = gw; it < NIT; it += NGW) {
            const int cc = it % NCH, ks = (it / NCH) % KSPLIT, l = it / (NCH * KSPLIT);
            const float* W = in[4] + (size_t)l * DM * MODN + (size_t)(ks * KPER) * MODN + cc * 256 + lane * 4;
            f32x4 a0 = {0, 0, 0, 0}, a1 = a0, a2 = a0, a3 = a0, a4 = a0;
#pragma unroll 4
            for (int k = 0; k < KPER; ++k) {
                const f32x4 w = *(const f32x4*)(W + (size_t)k * MODN); const int kk = ks * KPER + k;
                const float s0 = silu_acc(in[1][kk]), s1 = silu_acc(in[1][DM + kk]), s2 = silu_acc(in[1][2 * DM + kk]), s3 = silu_acc(in[1][3 * DM + kk]), s4 = silu_acc(in[3][kk]);
                a0 += w * s0; a1 += w * s1; a2 += w * s2; a3 += w * s3; a4 += w * s4;
            }
            float* P = (float*)(ws + WS_MODP) + ((size_t)(l * KSPLIT + ks) * 5) * MODN + cc * 256 + lane * 4;
            *(f32x4*)(P) = a0; *(f32x4*)(P + MODN) = a1; *(f32x4*)(P + 2 * MODN) = a2; *(f32x4*)(P + 3 * MODN) = a3; *(f32x4*)(P + 4 * MODN) = a4;
        }
    }
    {
        constexpr int I_UP = (DM / 64) * (FF / 32), I_DN = (FF / 64) * (DM / 32);
        constexpr int NIT = 8 * I_UP + 4 * I_DN + (DM / 64) * (ZLD / 32) + 2 * (DM / 64) * (DM / 32) + (DM / 64) * (CD_IN / 32) + (1024 / 64) * (1024 / 32);
        for (int it = gw; it < NIT; it += NGW) {
            int r = it; bool done = false;
#pragma unroll 1
            for (int lh = 0; lh < 4 && !done; ++lh) {
                bf16* up = (bf16*)(ws + WS_WUP + (size_t)lh * 44 * MiB);
                done = p0_mat(r, in[7] + (size_t)lh * DM * FF, DM, FF, FF, up, 1, scr, lane); if (done) break;
                done = p0_mat(r, in[8] + (size_t)lh * DM * FF, DM, FF, FF, up, 2, scr, lane); if (done) break;
                done = p0_mat(r, in[9] + (size_t)lh * FF * DM, FF, DM, DM, (bf16*)(ws + WS_WDN + (size_t)lh * 22 * MiB), 0, scr, lane);
            }
            if (done) continue;
            {
                const int nblk = ZLD / 32, items = (DM / 64) * nblk;
                if (r < items) { const int kb = r / nblk, nb = r % nblk; p0_transpose_item(in[10], DM, AB_IN, AB_IN, (bf16*)(ws + WS_WABIN), 32 * nb, 64 * kb, 32 * nb, scr, lane); continue; }
                r -= items;
            }
            if (p0_mat(r, in[12], DM, DM, DM, (bf16*)(ws + WS_WABOUT), 0, scr, lane)) continue;
            if (p0_mat(r, in[16], DM, CD_IN, CD_IN, (bf16*)(ws + WS_WCDIN), 0, scr, lane)) continue;
            if (p0_mat(r, in[17], DM, DM, DM, (bf16*)(ws + WS_WCDOUT), 0, scr, lane)) continue;
            p0_mat(r, in[26], 1024, 1024, 1024, (bf16*)(ws + WS_WGLU), 0, scr, lane);
        }
    }
    {
        const int tid_ = fresh_tid(F.wave); const int gt = blockIdx.x * (NWAVES * 64) + tid_, NT = F.G * NWAVES * 64;
        float* ropeA = (float*)(ws + WS_TAB + TB_ROPEA); float* ropeD = (float*)(ws + WS_TAB + TB_ROPED);
        for (int i = gt; i < 64 * 32; i += NT) { const int pos = i >> 5, f = i & 31; const float inv = powf(10000.f, -(float)f / 32.f), a = (float)pos * inv; ropeA[2 * i] = cosf(a); ropeA[2 * i + 1] = sinf(a); }
        for (int i = gt; i < 64 * 16; i += NT) { const int pos = i >> 4, f = i & 15; const float inv = powf(10000.f, -(float)f / 16.f), a = (float)pos * inv; ropeD[2 * i] = cosf(a); ropeD[2 * i + 1] = sinf(a); }
        float* s5ab = (float*)(ws + WS_TAB + TB_S5AB); float* s5bb = (float*)(ws + WS_TAB + TB_S5BB); bf16* s5bt = (bf16*)(ws + WS_TAB + TB_S5BT); bf16* s5ct = (bf16*)(ws + WS_TAB + TB_S5CT);
        for (int i = gt; i < 2 * 64 * 64; i += NT) {
            const int dg = i >> 6;
            const float are = in[18][i], aim = in[19][i], dt = expf(in[20][dg]);
            const float mag = expf(are * dt), abr = mag * cosf(aim * dt), abi = mag * sinf(aim * dt);
            const float den = are * are + aim * aim, nr = abr - 1.f, ni = abi;
            const float kre = (nr * are + ni * aim) / den, kim = (ni * are - nr * aim) / den;
            s5ab[2 * i] = abr; s5ab[2 * i + 1] = abi;
            for (int q = 0; q < 16; ++q) { const float br = in[21][(size_t)i * 16 + q], bi = in[22][(size_t)i * 16 + q];
                const float bbr = kre * br - kim * bi, bbi = kre * bi + kim * br;
                s5bb[((size_t)i * 16 + q) * 2] = bbr; s5bb[((size_t)i * 16 + q) * 2 + 1] = bbi;
                s5bt[((size_t)dg * 128 + (i & 63)) * 16 + q] = (bf16)f2bf(bbr); s5bt[((size_t)dg * 128 + 64 + (i & 63)) * 16 + q] = (bf16)f2bf(bbi); }
        }
        for (int i = gt; i < 2 * 64 * 16 * 128; i += NT) { const int pp = i & 127, dgo = i >> 7;
            s5ct[i] = (bf16)f2bf(pp < 64 ? in[23][(size_t)dgo * 64 + pp] : -in[24][(size_t)dgo * 64 + pp - 64]); }
        float* tv = (float*)(ws + WS_TAB + TB_VEC);
        for (int i = gt; i < TV_N; i += NT) { float v = 0.f;
            if (i < TV_GQ) v = in[14][i]; else if (i < TV_BGATE) v = in[13][i - TV_GQ]; else if (i < TV_SINK) v = in[11][i - TV_BGATE]; else if (i < TV_SINK + 16) v = in[28][i - TV_SINK];
            else if (i >= TV_HEADG && i < TV_DSKIP) v = in[15][i - TV_HEADG]; else if (i >= TV_DSKIP && i < TV_GLUB) v = in[25][i - TV_DSKIP];
            else if (i >= TV_GLUB && i < TV_FINALG) v = in[27][i - TV_GLUB]; else if (i >= TV_FINALG) v = in[29][i - TV_FINALG];
            tv[i] = v; }
        float* s5c = (float*)(ws + WS_TAB + TB_S5C);
        for (int i = gt; i < 2 * 131072; i += NT) s5c[i] = i < 131072 ? in[23][i] : in[24][i - 131072];
    }
}
__device__ __forceinline__ void p1_modreduce(Frame& F, const float* modb, const float* normg) {
    const int tid_ = fresh_tid(F.wave); const int gt = blockIdx.x * (NWAVES * 64) + tid_, NT = F.G * NWAVES * 64;
    const float* P = (const float*)(F.ws + WS_MODP); float* MV = (float*)(F.ws + WS_MODV); float* NR = (float*)(F.ws + WS_NRM);
    for (int i = gt; i < 2 * 5 * DM; i += NT) {
        const int c = i % DM, sel = (i / DM) % 5, l = i / (5 * DM);
        float mv[9];
#pragma unroll
        for (int idx = 0; idx < 9; ++idx) { float s = 0.f;
            for (int ks = 0; ks < KSPLIT; ++ks) s += P[((size_t)(l * KSPLIT + ks) * 5 + sel) * MODN + idx * DM + c];
            s += modb[l * MODN + idx * DM + c]; mv[idx] = s; MV[((size_t)(l * 5 + sel) * 9 + idx) * DM + c] = s; }
#pragma unroll
        for (int w = 0; w < 3; ++w) { const float g = normg[(l * 3 + w) * DM + c];
            NR[(((size_t)(l * 5 + sel) * 3 + w) * 2) * DM + c] = g * (1.f + mv[3 * w + 1]);
            NR[(((size_t)(l * 5 + sel) * 3 + w) * 2 + 1) * DM + c] = mv[3 * w]; }
    }
}
__device__ __forceinline__ void norm_phase(Frame& F, unsigned char* ws, const float* xin, const float* cin, int l, int which, bool first, int nrows) {
    const int lane = fresh_lane();
    const int gw = blockIdx.x * NWAVES + F.wave, NGW = F.G * NWAVES;
    float* H = (float*)(ws + WS_H); bf16* HN = (bf16*)(ws + WS_HN); const float* NR = (const float*)(ws + WS_NRM);
    for (int m = gw; m < nrows; m += NGW) {
        const float* src = first ? (m < NB * TT ? xin + (size_t)m * DM : cin + (size_t)(m - NB * TT) * DM) : H + (size_t)m * DM;
        const GAS f32x4* xr = (const GAS f32x4*)src + lane;
        f32x4 v[8]; float s = 0.f;
#pragma unroll
        for (int j = 0; j < 8; ++j) { v[j] = xr[64 * j]; s += (v[j].x * v[j].x + v[j].y * v[j].y) + (v[j].z * v[j].z + v[j].w * v[j].w); }
        const float rstd = 1.f / sqrtf(wave_sum_l(s, lane) * (1.f / DM) + EPS);
        if (first) { GAS f32x4* hw = (GAS f32x4*)(H + (size_t)m * DM) + lane;
#pragma unroll
            for (int j = 0; j < 8; ++j) hw[64 * j] = v[j]; }
        const int sel = row_sel(m);
        const GAS f32x4* Ap = (const GAS f32x4*)(NR + (((size_t)(l * 5 + sel) * 3 + which) * 2) * DM) + lane; const GAS f32x4* Bp = Ap + DM / 4;
        GAS unsigned long long* o8 = (GAS unsigned long long*)(HN + (size_t)m * DM) + lane;
#pragma unroll
        for (int j = 0; j < 8; ++j) { const f32x4 a = Ap[64 * j], b = Bp[64 * j]; const f32x4 y = v[j] * rstd * a + b;
            o8[64 * j] = (unsigned long long)pk2(y.x, y.y) | ((unsigned long long)pk2(y.z, y.w) << 32); }
    }
}
__device__ __forceinline__ void final_norm_phase(Frame& F, unsigned char* ws) {
    const int lane = fresh_lane();
    const int gw = blockIdx.x * NWAVES + F.wave, NGW = F.G * NWAVES;
    const float* H = (const float*)(ws + WS_H);
    for (int m = gw; m < NB * TT; m += NGW) {
        const GAS f32x4* xr = (const GAS f32x4*)(H + (size_t)m * DM) + lane;
        f32x4 v[8]; float s = 0.f;
#pragma unroll
        for (int j = 0; j < 8; ++j) { v[j] = xr[64 * j]; s += (v[j].x * v[j].x + v[j].y * v[j].y) + (v[j].z * v[j].z + v[j].w * v[j].w); }
        const float rstd = 1.f / sqrtf(wave_sum_l(s, lane) * (1.f / DM) + EPS);
        const GAS f32x4* gp = (const GAS f32x4*)((const float*)(ws + WS_TAB + TB_VEC) + TV_FINALG) + lane; GAS f32x4* o = (GAS f32x4*)(F.out + (size_t)m * DM) + lane;
#pragma unroll
        for (int j = 0; j < 8; ++j) o[64 * j] = v[j] * rstd * gp[64 * j];
    }
}
template <int MODE> __device__ __forceinline__ void naive_kprep(int gw, int lane, const bf16* Z, bf16* KO, const float* gk, const float* rope) {
    if (MODE == 0) {
        if (gw >= MR * 2) return;
        const int m = gw >> 1, kvh = gw & 1; const bf16* zr = Z + (size_t)m * ZLD + ZA_K + kvh * 128;
        float x1 = bf2f(zr[lane]), x2 = bf2f(zr[64 + lane]);
        const float rstd = 1.f / sqrtf(wave_sum_l(x1 * x1 + x2 * x2, lane) * (1.f / 128.f) + EPS);
        x1 *= rstd * gk[lane]; x2 *= rstd * gk[64 + lane];
        if (m < NB * TT) { const int t = m & (TT - 1), pos = lane < 32 ? (t >> 6) : (t & 63), f = lane & 31; const float c = rope[2 * (pos * 32 + f)], s = rope[2 * (pos * 32 + f) + 1];
            const float o1 = x1 * c - x2 * s, o2 = x2 * c + x1 * s; x1 = o1; x2 = o2; }
        KO[(size_t)m * 256 + kvh * 128 + lane] = (bf16)f2bf(x1); KO[(size_t)m * 256 + kvh * 128 + 64 + lane] = (bf16)f2bf(x2);
    } else {
        if (gw >= MR) return;
        const int m = gw, kvh = lane >> 5, j = lane & 31; const bf16* zr = Z + (size_t)m * CD_IN + ZD_K + kvh * 64;
        float x1 = bf2f(zr[j]), x2 = bf2f(zr[32 + j]);
        if (m < NB * TT) { const int t = m & (TT - 1), pos = j < 16 ? (t >> 6) : (t & 63), f = j & 15; const float c = rope[2 * (pos * 16 + f)], s = rope[2 * (pos * 16 + f) + 1];
            const float o1 = x1 * c - x2 * s, o2 = x2 * c + x1 * s; x1 = o1; x2 = o2; }
        KO[(size_t)m * 128 + kvh * 64 + j] = (bf16)f2bf(x1); KO[(size_t)m * 128 + kvh * 64 + 32 + j] = (bf16)f2bf(x2);
    }
}
template <int DH, int MODE> __device__ __forceinline__ void naive_attn(int vb, int vtid, const bf16* Z, const bf16* KB, bf16* CAT, const float* gq, const float* rope, const float* sink) {
    constexpr int H4 = DH / 4, NF = DH / 4, NH = (MODE == 2) ? 16 : 8, QPB = 128;
    constexpr int NQ = (MODE == 1) ? CT : TT, LDZ = (MODE == 2) ? CD_IN : ZLD, LDK = (MODE == 2) ? 128 : 256;
    constexpr int QCOL = (MODE == 2) ? ZD_Q : ZA_Q, VCOL = (MODE == 2) ? ZD_V : ZA_V, OCOL = (MODE == 2) ? 1024 : 0;
    const int nchunk = NQ / QPB; int bid = vb; const int qc = bid % nchunk; bid /= nchunk; const int head = bid % NH, b = bid / NH;
    const int kvh = head / (NH / 2), part = vtid & 3, r = vtid >> 2, qi = qc * QPB + r;
    const int m = (MODE == 1) ? (NB * TT + b * CT + qi) : (b * TT + qi);
    float q[H4], acc[H4];
    const bf16* qp = Z + (size_t)m * LDZ + QCOL + head * DH + part * H4;
#pragma unroll
    for (int i = 0; i < H4; ++i) { q[i] = bf2f(qp[i]); acc[i] = 0.f; }
    if (MODE != 2) { float ss = 0.f;
#pragma unroll
        for (int i = 0; i < H4; ++i) ss += q[i] * q[i];
        ss += __shfl_xor(ss, 1); ss += __shfl_xor(ss, 2); const float rstd = 1.f / sqrtf(ss * (1.f / DH) + EPS);
#pragma unroll
        for (int i = 0; i < H4; ++i) q[i] *= rstd * gq[part * H4 + i]; }
    if (MODE != 1) { const int t = qi;
#pragma unroll
        for (int i = 0; i < H4; ++i) { const int j = (part & 1) * H4 + i;
            const int pos = j < NF ? (t >> 6) : (t & 63), f = j % NF; const float c = rope[2 * (pos * NF + f)], s = rope[2 * (pos * NF + f) + 1];
            const float other = __shfl_xor(q[i], 2); q[i] = part < 2 ? (q[i] * c - other * s) : (q[i] * c + other * s); } }
    const float scale = (DH == 128) ? 0.08838834764831845f : 0.125f;
#pragma unroll
    for (int i = 0; i < H4; ++i) q[i] *= scale;
    float mx = (MODE == 2) ? sink[head] : -1e30f, l = (MODE == 2) ? 1.f : 0.f;
    const int lat_lo = (MODE == 0) ? 0 : (MODE == 2 ? max(0, qc * QPB - 128) : 0), lat_hi = (MODE == 0) ? TT : (MODE == 2 ? min(TT, qc * QPB + QPB + 128) : 0);
    const int nkeys = CT + (lat_hi - lat_lo);
#pragma unroll 2
    for (int kk = 0; kk < nkeys; ++kk) {
        const int kpos = kk - CT + lat_lo;
        const int km = kk < CT ? (NB * TT + b * CT + kk) : (b * TT + kpos);
        const bf16* kp = KB + (size_t)km * LDK + kvh * DH + part * H4;
        float s = 0.f;
#pragma unroll
        for (int i = 0; i < H4; ++i) s += q[i] * bf2f(kp[i]);
        s += __shfl_xor(s, 1); s += __shfl_xor(s, 2);
        if (MODE == 2 && kk >= CT && abs(kpos - qi) > 128) continue;
        const float mn = fmaxf(mx, s), al = expf(mx - mn), p = expf(s - mn);
        l = l * al + p; mx = mn;
        const bf16* vp = Z + (size_t)km * LDZ + VCOL + kvh * DH + part * H4;
#pragma unroll
        for (int i = 0; i < H4; ++i) acc[i] = acc[i] * al + p * bf2f(vp[i]);
    }
    const float il = 1.f / l;
    bf16* op = CAT + (size_t)m * DM + OCOL + head * DH + part * H4;
#pragma unroll
    for (int i = 0; i < H4; ++i) op[i] = (bf16)f2bf(acc[i] * il);
}
__device__ __forceinline__ void naive_mlstm(int seq, int tid, LAS float* sq, const bf16* Z, const float* GATES, const float* bgate, float* HF, float* HB) {
    const int b = seq >> 3, h = (seq >> 1) & 3, dir = seq & 1;
    LAS float* sk = sq + 128; LAS float* sred = sq + 256;
    const int v = tid >> 1, half = tid & 1, lane = tid & 63, wave = tid >> 6;
    float C[64];
#pragma unroll
    for (int j = 0; j < 64; ++j) C[j] = 0.f;
    float nreg = 0.f, mstate = 0.f;
    const float bi = bgate[(2 * dir) * 4 + h], bfg = bgate[(2 * dir + 1) * 4 + h];
    float* HO = dir ? HB : HF;
    for (int p = 0; p < SB; ++p) {
        const int s = dir == 0 ? p : (p < CT ? CT - 1 - p : CT + (SB - 1 - p));
        const int m = s < CT ? (NB * TT + b * CT + s) : (b * TT + s - CT);
        const bf16* zr = Z + (size_t)m * ZLD;
        if (tid < 128) sq[tid] = bf2f(zr[ZB_Q + h * 128 + tid]) * 0.08838834764831845f; else if (tid < 256) sk[tid - 128] = bf2f(zr[ZB_K + h * 128 + tid - 128]);
        const float vv = bf2f(zr[ZB_V + h * 256 + v]);
        const float ig = GATES[(size_t)m * 16 + (2 * dir) * 4 + h] + bi, lf = logsigmoid_acc(GATES[(size_t)m * 16 + (2 * dir + 1) * 4 + h] + bfg);
        const float mn = fmaxf(lf + mstate, ig), ip = expf(ig - mn), fp = expf(lf + mstate - mn); mstate = mn;
        __syncthreads();
        float dpart = 0.f; if (tid < 128) { nreg = fp * nreg + ip * sk[tid]; dpart = nreg * sq[tid]; }
        if (wave < 2) { dpart = wave_sum_l(dpart, lane); if (lane == 0) sred[wave] = dpart; }
        float np = 0.f; const float iv = ip * vv;
#pragma unroll
        for (int j = 0; j < 64; ++j) { C[j] = fp * C[j] + iv * sk[64 * half + j]; np += C[j] * sq[64 * half + j]; }
        np += __builtin_bit_cast(float, __builtin_amdgcn_ds_bpermute((lane ^ 1) << 2, __builtin_bit_cast(int, np)));
        __syncthreads();
        const float den = sred[0] + sred[1];
        if (half == 0) HO[(size_t)m * 1024 + h * 256 + v] = np / fmaxf(fabsf(den), expf(-mn));
        __syncthreads();
    }
}
__device__ __forceinline__ void naive_mlstm_finish(int gw, int lane, const bf16* Z, const float* HF, const float* HB, const float* headg, bf16* CAT) {
    const int m = gw >> 2, h = gw & 3; const size_t o = (size_t)m * 1024 + h * 256 + lane * 4;
    const f32x4 a = *(const f32x4*)(HF + o), bb = *(const f32x4*)(HB + o); const f32x4 hh = a + bb;
    const float rstd = 1.f / sqrtf(wave_sum_l((hh.x * hh.x + hh.y * hh.y) + (hh.z * hh.z + hh.w * hh.w), lane) * (1.f / 256.f) + EPS);
    const bf16* og = Z + (size_t)m * ZLD + ZB_O + h * 256 + lane * 4; bf16* cp = CAT + (size_t)m * DM + 1024 + h * 256 + lane * 4;
#pragma unroll
    for (int j = 0; j < 4; ++j) { const float sg = 1.f / (1.f + expf(-bf2f(og[j]))); cp[j] = (bf16)f2bf(sg * hh[j] * rstd * headg[h * 256 + lane * 4 + j]); }
}
__device__ __forceinline__ void naive_s5(int id, int lane, const bf16* Z, const float* s5ab, const float* s5bb, const float* cre_in, const float* cim_in, float* YF, float* YB) {
    const int b = id >> 7, g = (id >> 1) & 63, dir = id & 1;
    const int i = (dir * 64 + g) * 64 + lane;
    const float ar = s5ab[2 * i], ai = s5ab[2 * i + 1];
    float Br[16], Bi[16], cr[16], ci[16];
#pragma unroll
    for (int q = 0; q < 16; ++q) { Br[q] = s5bb[((size_t)i * 16 + q) * 2]; Bi[q] = s5bb[((size_t)i * 16 + q) * 2 + 1];
        cr[q] = cre_in[((size_t)(dir * 64 + g) * 16 + q) * 64 + lane]; ci[q] = cim_in[((size_t)(dir * 64 + g) * 16 + q) * 64 + lane]; }
    float xr = 0.f, xi = 0.f; float* Y = dir ? YB : YF;
    for (int p = 0; p < SB; ++p) {
        const int s = dir == 0 ? p : (p < CT ? CT - 1 - p : CT + (SB - 1 - p));
        const int m = s < CT ? (NB * TT + b * CT + s) : (b * TT + s - CT);
        const bf16* up = Z + (size_t)m * CD_IN + ZC_U + g * 16;
        float bur = 0.f, bui = 0.f;
#pragma unroll
        for (int q = 0; q < 16; ++q) { const float u = bf2f(up[q]); bur += Br[q] * u; bui += Bi[q] * u; }
        const float nxr = ar * xr - ai * xi + bur, nxi = ar * xi + ai * xr + bui; xr = nxr; xi = nxi;
        if (s >= CT) { float yo = 0.f;
#pragma unroll
            for (int q = 0; q < 16; ++q) { const float val = wave_sum_l(cr[q] * xr - ci[q] * xi, lane); if (lane == q) yo = val; }
            if (lane < 16) Y[(size_t)m * 1024 + g * 16 + lane] = yo; }
    }
}
__device__ __forceinline__ void naive_s5_finish(size_t i, const bf16* Z, const float* YF, const float* YB, const float* dskip, bf16* G) {
    const int m = (int)(i >> 10), c = (int)(i & 1023);
    const float y = YF[i] + YB[i] + dskip[c] * bf2f(Z[(size_t)m * CD_IN + ZC_U + c]);
    G[i] = (bf16)f2bf(gelu_tanh(y));
}
namespace att {
using bf16x8 = __attribute__((ext_vector_type(8))) short;
using s16x4  = __attribute__((ext_vector_type(4))) short;
using f32x16 = __attribute__((ext_vector_type(16))) float;
using u32x4  = __attribute__((ext_vector_type(4))) unsigned;
constexpr int NW = 8, QBLK = 32, KVBLK = 64;
constexpr size_t SHM_V = KVBLK * 128 * 2, SHM_K = KVBLK * 128 * 2, SHM_ATTN = 2 * SHM_V + 2 * SHM_K + NW * 64 * 4;
#define KSWZ(row, colB) ((row) * 256 + ((colB) ^ (((row) & 7) << 4)))
#define SBAR() __builtin_amdgcn_sched_barrier(0)
__device__ __forceinline__ int crow(int r, int hi) { return (r & 3) + 8 * (r >> 2) + 4 * hi; }
__device__ __forceinline__ unsigned cvtpk(float lo, float hi) { unsigned r; asm volatile("v_cvt_pk_bf16_f32 %0, %1, %2" : "=v"(r) : "v"(lo), "v"(hi)); return r; }
template <int DH> struct Cst { static constexpr float SCALE = (DH == 128) ? 0.088388347648318440f : 0.125f; };
constexpr float THR = 8.f;
#ifndef ATT_SDEPTH
#define ATT_SDEPTH 2
#endif
constexpr int SDEPTH = ATT_SDEPTH;
template <int DH> __device__ __forceinline__ void partialSM(f32x16& p0, f32x16& p1, float& m_reg, float& mn, float& alpha) {
  constexpr float SCALE = Cst<DH>::SCALE, C = SCALE * 1.4426950408889634f;
  float pmax = p0[0]; for (int r = 1; r < 16; ++r) pmax = fmaxf(pmax, p0[r]); for (int r = 0; r < 16; ++r) pmax = fmaxf(pmax, p1[r]);
  { auto rr = __builtin_amdgcn_permlane32_swap(__float_as_uint(pmax), __float_as_uint(pmax), false, false);
    pmax = fmaxf(__uint_as_float(rr[0]), __uint_as_float(rr[1])); }
  if (__builtin_expect(__all(pmax - m_reg <= THR / SCALE), 1)) { mn = m_reg; alpha = 1.f; }
  else { mn = fmaxf(m_reg, pmax); alpha = __builtin_amdgcn_exp2f((m_reg - mn) * C); m_reg = mn; }
  float mnC = -mn * C;
  for (int r = 0; r < 16; ++r) p0[r] = fmaf(p0[r], C, mnC); for (int r = 0; r < 16; ++r) p1[r] = fmaf(p1[r], C, mnC);
  for (int r = 0; r < 16; ++r) p0[r] = __builtin_amdgcn_exp2f(p0[r]);
}
__device__ __forceinline__ void finishSM(f32x16& p0, f32x16& p1, float alpha, float& l_reg, bf16x8& pa0, bf16x8& pa1, bf16x8& pa2, bf16x8& pa3) {
  for (int r = 0; r < 16; ++r) p1[r] = __builtin_amdgcn_exp2f(p1[r]);
  float ps = 0; for (int r = 0; r < 16; ++r) ps += p0[r]; for (int r = 0; r < 16; ++r) ps += p1[r];
  { auto rr = __builtin_amdgcn_permlane32_swap(__float_as_uint(ps), __float_as_uint(ps), false, false);
    ps = __uint_as_float(rr[0]) + __uint_as_float(rr[1]); }
  l_reg = l_reg * alpha + ps;
#define PK4(P, BASE, OUT) do { unsigned a0 = cvtpk(P[BASE + 0], P[BASE + 1]), a1 = cvtpk(P[BASE + 2], P[BASE + 3]);   \
    unsigned b0 = cvtpk(P[BASE + 4], P[BASE + 5]), b1 = cvtpk(P[BASE + 6], P[BASE + 7]);                              \
    auto r0 = __builtin_amdgcn_permlane32_swap(a0, b0, false, false); auto r1 = __builtin_amdgcn_permlane32_swap(a1, b1, false, false); \
    u32x4 w = {r0[0], r1[0], r0[1], r1[1]}; OUT = *reinterpret_cast<bf16x8*>(&w); } while (0)
  PK4(p0, 0, pa0); PK4(p0, 8, pa1); PK4(p1, 0, pa2); PK4(p1, 8, pa3);
#undef PK4
}
template <int DH> __device__ __forceinline__ void qkt(f32x16& p0, f32x16& p1, const bf16* Ks, const bf16x8* qr, int r32, int hi) {
  p0 = f32x16{}; p1 = f32x16{};
#pragma unroll
  for (int d0 = 0; d0 < DH / 16; ++d0) { int cb = (d0 * 16 + hi * 8) * 2;
    bf16x8 b0 = *reinterpret_cast<const bf16x8*>((const char*)Ks + KSWZ(r32, cb));
    bf16x8 b1 = *reinterpret_cast<const bf16x8*>((const char*)Ks + KSWZ(32 + r32, cb));
    p0 = __builtin_amdgcn_mfma_f32_32x32x16_bf16(b0, qr[d0], p0, 0, 0, 0);
    p1 = __builtin_amdgcn_mfma_f32_32x32x16_bf16(b1, qr[d0], p1, 0, 0, 0); }
}
__device__ __forceinline__ void wmask(f32x16& p0, f32x16& p1, int kp0, int qpos, int hi) {
#pragma unroll
  for (int r = 0; r < 16; ++r) { const int k = kp0 + crow(r, hi); const int d0 = k - qpos, d1 = k + 32 - qpos;
    if (d0 > 128 || d0 < -128) p0[r] = -1e30f; if (d1 > 128 || d1 < -128) p1[r] = -1e30f; }
}
__device__ __forceinline__ int v_st(int k, int c) { const int kk = (k & ~0xC) | ((k & 4) << 1) | ((k & 8) >> 1); return ((kk >> 3) * 4 + (c >> 5)) * 512 + ((kk & 7) * 32 + (c & 31)) * 2; }
__device__ __forceinline__ int v_rd_base(int lane) { return ((lane & 3) << 3) | (((lane >> 2) & 3) << 6) | (((lane >> 4) & 1) << 5) | (((lane >> 5) & 1) << 8); }
constexpr int v_rd_off(int d0, int ks, int half) { return d0 * 512 + ks * 4096 + half * 2048; }
template <int OFF> __device__ __forceinline__ s16x4 tr_read(int vb) {
  s16x4 r; asm volatile("ds_read_b64_tr_b16 %0, %1 offset:%2" : "=&v"(r) : "v"(vb), "i"(OFF) : "memory"); return r;
}
template <int D0> __device__ __forceinline__ void pv_one(f32x16& od, int vb, bf16x8 pa0, bf16x8 pa1, bf16x8 pa2, bf16x8 pa3) {
  const s16x4 l0 = tr_read<v_rd_off(D0, 0, 0)>(vb), h0 = tr_read<v_rd_off(D0, 0, 1)>(vb), l1 = tr_read<v_rd_off(D0, 1, 0)>(vb), h1 = tr_read<v_rd_off(D0, 1, 1)>(vb);
  const s16x4 l2 = tr_read<v_rd_off(D0, 2, 0)>(vb), h2 = tr_read<v_rd_off(D0, 2, 1)>(vb), l3 = tr_read<v_rd_off(D0, 3, 0)>(vb), h3 = tr_read<v_rd_off(D0, 3, 1)>(vb);
  asm volatile("s_waitcnt lgkmcnt(0)" ::: "memory"); SBAR();
#define PK(L, H) (bf16x8){L[0], L[1], L[2], L[3], H[0], H[1], H[2], H[3]}
  od = __builtin_amdgcn_mfma_f32_32x32x16_bf16(pa0, PK(l0, h0), od, 0, 0, 0);
  od = __builtin_amdgcn_mfma_f32_32x32x16_bf16(pa1, PK(l1, h1), od, 0, 0, 0);
  od = __builtin_amdgcn_mfma_f32_32x32x16_bf16(pa2, PK(l2, h2), od, 0, 0, 0);
  od = __builtin_amdgcn_mfma_f32_32x32x16_bf16(pa3, PK(l3, h3), od, 0, 0, 0);
#undef PK
}
template <int DH> __device__ __forceinline__ void pv_d0(f32x16* o, int vb, bf16x8 pa0, bf16x8 pa1, bf16x8 pa2, bf16x8 pa3) {
  pv_one<0>(o[0], vb, pa0, pa1, pa2, pa3); pv_one<1>(o[1], vb, pa0, pa1, pa2, pa3);
  if (DH == 128) { pv_one<2>(o[2], vb, pa0, pa1, pa2, pa3); pv_one<3>(o[3], vb, pa0, pa1, pa2, pa3); }
}
template <int DH, int MODE>
__device__ __forceinline__ void attn_unit(const bf16* __restrict__ Qb, int LDQ, const bf16* __restrict__ Kb, int LDKK, const bf16* __restrict__ Vb, int LDKV, bf16* __restrict__ Ob,
                                          int b, int i0  , const float* __restrict__ gq, const float* __restrict__ rope, float sinkv, char* lds, int wave_s) {
  const int tid = fresh_tid(wave_s);
  constexpr float SCALE = Cst<DH>::SCALE;
  const int wid = tid >> 6, lane = tid & 63, r32 = lane & 31, hi = lane >> 5;
  bf16* V_lds = (bf16*)lds; bf16* K_lds = (bf16*)(lds + 2 * SHM_V);
  float* ws = (float*)(lds + 2 * SHM_V + 2 * SHM_K) + wid * 64; float* li_l = ws; float* al_l = ws + 32;
  float m_reg = (MODE == 2) ? sinkv / SCALE : -1e30f, l_reg = (MODE == 2) ? 1.f : 0.f; f32x16 o[DH / 32] = {}; bf16x8 qr[DH / 16];
  const int qpos = i0 + wid * QBLK + r32;
  {
    const bf16* Qw = Qb + (long)(wid * QBLK + r32) * LDQ + hi * 8;
    float qf[DH / 16][8];
#pragma unroll
    for (int d0 = 0; d0 < DH / 16; ++d0) { const u32x4 w = *reinterpret_cast<const u32x4*>(Qw + d0 * 16);
#pragma unroll
      for (int e = 0; e < 4; ++e) { qf[d0][2 * e] = __uint_as_float(w[e] << 16); qf[d0][2 * e + 1] = __uint_as_float(w[e] & 0xffff0000u); } }
    if (MODE != 2) { float ss = 0.f;
#pragma unroll
      for (int d0 = 0; d0 < DH / 16; ++d0)
#pragma unroll
        for (int e = 0; e < 8; ++e) ss += qf[d0][e] * qf[d0][e];
      { auto rr = __builtin_amdgcn_permlane32_swap(__float_as_uint(ss), __float_as_uint(ss), false, false); ss = __uint_as_float(rr[0]) + __uint_as_float(rr[1]); }
      const float rstd = 1.f / sqrtf(ss * (1.f / DH) + EPS);
#pragma unroll
      for (int d0 = 0; d0 < DH / 16; ++d0)
#pragma unroll
        for (int e = 0; e < 8; ++e) qf[d0][e] *= rstd * ((const GAS float*)gq)[d0 * 16 + hi * 8 + e]; }
    if (MODE != 1) { constexpr int NF = DH / 4;
#pragma unroll
      for (int d0 = 0; d0 < DH / 32; ++d0)
#pragma unroll
        for (int e = 0; e < 8; ++e) { const int j = d0 * 16 + hi * 8 + e, pos = j < NF ? (qpos >> 6) : (qpos & 63), f = j % NF;
          const float c = ((const GAS float*)rope)[2 * (pos * NF + f)], s = ((const GAS float*)rope)[2 * (pos * NF + f) + 1], x1 = qf[d0][e], x2 = qf[d0 + DH / 32][e];
          qf[d0][e] = x1 * c - x2 * s; qf[d0 + DH / 32][e] = x2 * c + x1 * s; } }
#pragma unroll
    for (int d0 = 0; d0 < DH / 16; ++d0) { u32x4 w = {cvtpk(qf[d0][0], qf[d0][1]), cvtpk(qf[d0][2], qf[d0][3]), cvtpk(qf[d0][4], qf[d0][5]), cvtpk(qf[d0][6], qf[d0][7])}; qr[d0] = *reinterpret_cast<bf16x8*>(&w); }
  }
  const int kl0 = (MODE == 2) ? (i0 - 128 < 0 ? 0 : i0 - 128) : 0;
  const int kl1 = (MODE == 0) ? TT : (MODE == 2 ? (i0 + 384 > TT ? TT : i0 + 384) : 0);
  const int NT = 4 + (kl1 - kl0) / KVBLK;
  const long ctx0 = (long)NB * TT + (long)b * CT, lat0 = (long)b * TT + kl0;
#define TROW(j) ((j) < 4 ? ctx0 + (j) * KVBLK : lat0 + ((j) - 4) * KVBLK)
  const int sr = tid >> 4, sc = (tid & 15) * 8, vst0 = v_st(sr, sc), vst1 = v_st(32 + sr, sc);
  const bool ldok = (DH == 128) || sc < 64;
  const int vb0 = (int)(uintptr_t)V_lds + v_rd_base(lane);
  struct { bf16x8 vs0, vs1, ks0, ks1; } sr_[SDEPTH];
#pragma unroll
  for (int i_ = 0; i_ < SDEPTH; ++i_) sr_[i_].vs0 = sr_[i_].vs1 = sr_[i_].ks0 = sr_[i_].ks1 = bf16x8{};
#define SLOAD(i, j) do { if (ldok) { const long _r = TROW(j); sr_[i].vs0 = *reinterpret_cast<const bf16x8*>(&Vb[(_r + sr) * LDKV + sc]); sr_[i].vs1 = *reinterpret_cast<const bf16x8*>(&Vb[(_r + 32 + sr) * LDKV + sc]); \
    sr_[i].ks0 = *reinterpret_cast<const bf16x8*>(&Kb[(_r + sr) * LDKK + sc]); sr_[i].ks1 = *reinterpret_cast<const bf16x8*>(&Kb[(_r + 32 + sr) * LDKK + sc]); } } while (0)
#define SWRITE(bb, i) do { *(bf16x8*)((char*)V_lds + (bb) * SHM_V + vst0) = sr_[i].vs0;          \
    *(bf16x8*)((char*)V_lds + (bb) * SHM_V + vst1) = sr_[i].vs1; int kc = sc * 2;               \
    *(bf16x8*)((char*)K_lds + (bb) * SHM_K + KSWZ(sr, kc)) = sr_[i].ks0;                       \
    *(bf16x8*)((char*)K_lds + (bb) * SHM_K + KSWZ(32 + sr, kc)) = sr_[i].ks1; } while (0)
#define SWAIT() do { if (SDEPTH == 2) asm volatile("s_waitcnt vmcnt(4)" ::: "memory"); else asm volatile("s_waitcnt vmcnt(0)" ::: "memory"); } while (0)
#define RESC(a) do { if (__any((a) < 1.f)) { if (hi == 0) al_l[r32] = (a); asm volatile("s_waitcnt lgkmcnt(0)" ::: "memory"); \
    for (int d = 0; d < DH / 32; ++d) for (int r = 0; r < 16; ++r) o[d][r] *= al_l[crow(r, hi)]; } } while (0)
#define WMASK(P0, P1, j) do { if (MODE == 2 && (j) >= 4) wmask(P0, P1, kl0 + ((j) - 4) * KVBLK, qpos, hi); } while (0)
  f32x16 pA0, pA1, pB0, pB1; float mnA, mnB, alA, alB; bf16x8 pa0, pa1, pa2, pa3;
  constexpr int SE = 0, SO = SDEPTH - 1;
  SLOAD(SE, 0); asm volatile("s_waitcnt vmcnt(0)" ::: "memory"); SWRITE(0, SE); __syncthreads();
  qkt<DH>(pA0, pA1, K_lds, qr, r32, hi); WMASK(pA0, pA1, 0); partialSM<DH>(pA0, pA1, m_reg, mnA, alA);
  SLOAD(SO, 1); if (SDEPTH == 2) { if (2 < NT) SLOAD(SE, 2); }
  SWAIT(); SWRITE(1, SO); __syncthreads();
  for (int j = 1; j + 1 < NT; j += 2) {
    SBAR(); qkt<DH>(pB0, pB1, (bf16*)((char*)K_lds + SHM_K), qr, r32, hi); WMASK(pB0, pB1, j);
    finishSM(pA0, pA1, alA, l_reg, pa0, pa1, pa2, pa3); SBAR();
    SLOAD(SO, j + SDEPTH < NT ? j + SDEPTH : j); SBAR();
    pv_d0<DH>(o, vb0, pa0, pa1, pa2, pa3); partialSM<DH>(pB0, pB1, m_reg, mnB, alB);
    __syncthreads(); SWAIT(); SWRITE(0, SE);
    RESC(alB); __syncthreads();
    SBAR(); qkt<DH>(pA0, pA1, K_lds, qr, r32, hi); WMASK(pA0, pA1, j + 1);
    finishSM(pB0, pB1, alB, l_reg, pa0, pa1, pa2, pa3); SBAR();
    SLOAD(SE, j + 1 + SDEPTH < NT ? j + 1 + SDEPTH : j + 1); SBAR();
    pv_d0<DH>(o, vb0 + (int)SHM_V, pa0, pa1, pa2, pa3); partialSM<DH>(pA0, pA1, m_reg, mnA, alA);
    __syncthreads(); SWAIT(); SWRITE(1, SO);
    RESC(alA); __syncthreads();
  }
  SBAR(); qkt<DH>(pB0, pB1, (bf16*)((char*)K_lds + SHM_K), qr, r32, hi); WMASK(pB0, pB1, NT - 1);
  finishSM(pA0, pA1, alA, l_reg, pa0, pa1, pa2, pa3); SBAR();
  pv_d0<DH>(o, vb0, pa0, pa1, pa2, pa3); partialSM<DH>(pB0, pB1, m_reg, mnB, alB);
  __syncthreads(); RESC(alB);
  finishSM(pB0, pB1, alB, l_reg, pa0, pa1, pa2, pa3); SBAR();
  pv_d0<DH>(o, vb0 + (int)SHM_V, pa0, pa1, pa2, pa3);
  if (hi == 0) li_l[r32] = l_reg; asm volatile("s_waitcnt lgkmcnt(0)" ::: "memory");
  float rli[16];
#pragma unroll
  for (int r = 0; r < 16; ++r) rli[r] = __builtin_amdgcn_rcpf(li_l[crow(r, hi)]);
  bf16* Ow = Ob + (long)(wid * QBLK) * DM;
#pragma unroll
  for (int r = 0; r < 16; ++r) { int orow = crow(r, hi);
#pragma unroll
    for (int d0 = 0; d0 < DH / 32; ++d0) Ow[(long)orow * DM + d0 * 32 + r32] = (bf16)(cvtpk(o[d0][r] * rli[r], 0.f) & 0xffffu); }
  asm volatile("s_waitcnt vmcnt(0)" ::: "memory"); __syncthreads();
#undef SLOAD
#undef SWRITE
#undef SWAIT
#undef RESC
#undef WMASK
#undef TROW
}
}
namespace s5 {
using bf16x8 = __attribute__((ext_vector_type(8))) short;
using f32x16 = __attribute__((ext_vector_type(16))) float;
using f32x4v = __attribute__((ext_vector_type(4))) float;
using u32x4 = __attribute__((ext_vector_type(4))) unsigned;
using u32x2 = __attribute__((ext_vector_type(2))) unsigned;
constexpr int XROWB = 272;
constexpr int WAVE_LDS = 32 * XROWB;
__device__ __forceinline__ float bperm(float v, int srclane) { return __builtin_bit_cast(float, __builtin_amdgcn_ds_bpermute(srclane << 2, __builtin_bit_cast(int, v))); }
__device__ __forceinline__ void cmul(float& r, float& i, float ar, float ai) { const float nr = ar * r - ai * i, ni = ar * i + ai * r; r = nr; i = ni; }
__device__ __forceinline__ size_t seg_row0(int b, int seg) { return seg < 16 ? (size_t)b * TT + seg * 256 : (size_t)NB * TT + b * CT; }
template <int PASS>
__device__ __forceinline__ void s5_unit(int b, int g, int seg, const bf16* __restrict__ Z2, const float* __restrict__ s5ab, const bf16* __restrict__ BT, const bf16* __restrict__ CTb,
                                        float* __restrict__ SEND, const float* __restrict__ dskip, bf16* __restrict__ G, LAS unsigned char* xl) {
  const int lane = fresh_lane();
  const int r32 = lane & 31, hi = lane >> 5;
  const size_t row0 = seg_row0(b, seg);
  const int tau = 16 * ((r32 >> 2) & 1) + 4 * (r32 >> 3) + (r32 & 3);
  f32x4v accy[8][2];
  if (PASS == 2) {
#pragma unroll
    for (int q = 0; q < 8; ++q) { accy[q][0] = (f32x4v){0.f, 0.f, 0.f, 0.f}; accy[q][1] = accy[q][0]; }
  }
#pragma unroll
  for (int dir = 0; dir < 2; ++dir) {
    const int dg = dir * 64 + g;
    float ar[2], ai[2], a16r[2], a16i[2];
#pragma unroll
    for (int s = 0; s < 2; ++s) { typedef float f32x2s __attribute__((ext_vector_type(2))); const f32x2s v = *(const GAS f32x2s*)(s5ab + 2 * (dg * 64 + r32 + 32 * s)); ar[s] = v.x; ai[s] = v.y; a16r[s] = v.x; a16i[s] = v.y;
#pragma unroll
      for (int k = 0; k < 4; ++k) cmul(a16r[s], a16i[s], a16r[s], a16i[s]); }
    bf16x8 bfr[4];
#pragma unroll
    for (int k = 0; k < 4; ++k) bfr[k] = *(const GAS bf16x8*)(BT + ((size_t)dg * 128 + 32 * k + r32) * 16 + hi * 8);
    float cr[2] = {0.f, 0.f}, ci[2] = {0.f, 0.f};
    if (PASS == 2) {
      float a256r[2], a256i[2];
#pragma unroll
      for (int s = 0; s < 2; ++s) { a256r[s] = a16r[s]; a256i[s] = a16i[s];
#pragma unroll
        for (int k = 0; k < 4; ++k) cmul(a256r[s], a256i[s], a256r[s], a256i[s]); }
      const float* Sb = SEND + ((size_t)(dir * NB + b) * 64 + g) * 17 * 128;
      { const float* p = Sb + 16 * 128;
#pragma unroll
        for (int s = 0; s < 2; ++s) { cr[s] = p[r32 + 32 * s]; ci[s] = p[64 + r32 + 32 * s]; } }
      const int nprev = dir == 0 ? seg : 15 - seg;
      for (int k = 0; k < nprev; ++k) { const float* p = Sb + (dir == 0 ? k : 15 - k) * 128;
#pragma unroll
        for (int s = 0; s < 2; ++s) { cmul(cr[s], ci[s], a256r[s], a256i[s]); cr[s] += p[r32 + 32 * s]; ci[s] += p[64 + r32 + 32 * s]; } }
    }
    const bf16* CT_dg = CTb + (size_t)dg * 16 * 128;
#pragma unroll
    for (int qq = 0; qq < 8; ++qq) {
      const int q = dir == 0 ? qq : 7 - qq;
      const int rloc = dir == 0 ? tau : 31 - tau;
      const bf16x8 ufr = *(const GAS bf16x8*)(Z2 + (row0 + 32 * q + rloc) * CD_IN + ZC_U + g * 16 + hi * 8);
      f32x16 bu[4];
#pragma unroll
      for (int k = 0; k < 4; ++k) { bu[k] = f32x16{}; bu[k] = __builtin_amdgcn_mfma_f32_32x32x16_bf16(ufr, bfr[k], bu[k], 0, 0, 0); }
#pragma unroll
      for (int s = 0; s < 2; ++s) { float xr = 0.f, xi = 0.f;
#pragma unroll
        for (int r = 0; r < 16; ++r) { const float nr = ar[s] * xr - ai[s] * xi + bu[s][r], ni = ar[s] * xi + ai[s] * xr + bu[2 + s][r]; xr = nr; xi = ni; bu[s][r] = xr; bu[2 + s][r] = xi; } }
#pragma unroll
      for (int s = 0; s < 2; ++s) {
        const float per = bperm(bu[s][15], lane ^ 32), pei = bperm(bu[2 + s][15], lane ^ 32);
        float c1r = cr[s], c1i = ci[s]; cmul(c1r, c1i, a16r[s], a16i[s]); c1r += per; c1i += pei;
        float cxr = hi ? c1r : cr[s], cxi = hi ? c1i : ci[s];
#pragma unroll
        for (int r = 0; r < 16; ++r) { cmul(cxr, cxi, ar[s], ai[s]); bu[s][r] += cxr; bu[2 + s][r] += cxi; }
        const float ner = bperm(bu[s][15], lane ^ 32), nei = bperm(bu[2 + s][15], lane ^ 32);
        cr[s] = hi ? bu[s][15] : ner; ci[s] = hi ? bu[2 + s][15] : nei;
      }
      if (PASS == 2) {
#pragma unroll
        for (int k = 0; k < 4; ++k)
#pragma unroll
          for (int r = 0; r < 16; ++r) { const int st = 16 * hi + r, rl = dir == 0 ? st : 31 - st;
            *(LAS unsigned short*)(xl + rl * XROWB + (32 * k + r32) * 2) = (unsigned short)f2bf(bu[k][r]); }
        asm volatile("s_waitcnt lgkmcnt(0)" ::: "memory");
        const int fr = lane & 15, fq = lane >> 4;
#pragma unroll
        for (int ks = 0; ks < 4; ++ks) { const bf16x8 cf = *(const GAS bf16x8*)(CT_dg + fr * 128 + 32 * ks + 8 * fq);
#pragma unroll
          for (int mb = 0; mb < 2; ++mb) { const bf16x8 xf = *(const LAS bf16x8*)(xl + (16 * mb + fr) * XROWB + (32 * ks + 8 * fq) * 2);
            accy[q][mb] = __builtin_amdgcn_mfma_f32_16x16x32_bf16(cf, xf, accy[q][mb], 0, 0, 0); } }
        asm volatile("s_waitcnt lgkmcnt(0)" ::: "memory");
      }
    }
    if (PASS == 1) { float* p = SEND + (((size_t)(dir * NB + b) * 64 + g) * 17 + seg) * 128;
      if (hi == 0) {
#pragma unroll
        for (int s = 0; s < 2; ++s) { p[r32 + 32 * s] = cr[s]; p[64 + r32 + 32 * s] = ci[s]; } } }
  }
  if (PASS == 2) {
    const int fr = lane & 15, fq = lane >> 4;
    const f32x4v dk = *(const GAS f32x4v*)(dskip + g * 16 + 4 * fq);
#pragma unroll
    for (int q = 0; q < 8; ++q)
#pragma unroll
      for (int mb = 0; mb < 2; ++mb) { const size_t row = row0 + 32 * q + 16 * mb + fr;
        const u32x2 uw = *(const GAS u32x2*)(Z2 + row * CD_IN + ZC_U + g * 16 + 4 * fq);
        const float u0 = __builtin_bit_cast(float, uw.x << 16), u1 = __builtin_bit_cast(float, uw.x & 0xffff0000u), u2 = __builtin_bit_cast(float, uw.y << 16), u3 = __builtin_bit_cast(float, uw.y & 0xffff0000u);
        const float y0 = gelu_tanh(accy[q][mb][0] + dk[0] * u0), y1 = gelu_tanh(accy[q][mb][1] + dk[1] * u1), y2 = gelu_tanh(accy[q][mb][2] + dk[2] * u2), y3 = gelu_tanh(accy[q][mb][3] + dk[3] * u3);
        u32x2 w; w.x = pk2(y0, y1); w.y = pk2(y2, y3);
        *(GAS u32x2*)(G + row * 1024 + g * 16 + 4 * fq) = w; }
  }
}
}
namespace ml {
using bf16x8 = __attribute__((ext_vector_type(8))) short;
using f32x16 = __attribute__((ext_vector_type(16))) float;
using f32x4v = __attribute__((ext_vector_type(4))) float;
using u32x4 = __attribute__((ext_vector_type(4))) unsigned;
using u32x2 = __attribute__((ext_vector_type(2))) unsigned;
constexpr int NSEQ = NB * 4 * 2, NBLK = 17;
constexpr size_t CST_BYTES = (size_t)NSEQ * NBLK * 256 * 128 * 2;
constexpr size_t NST_OFF = CST_BYTES, MST_OFF = NST_OFF + (size_t)NSEQ * NBLK * 128 * 4, ST_END = MST_OFF + (size_t)NSEQ * NBLK * 4;
__device__ __forceinline__ float bperm(float v, int srclane) { return __builtin_bit_cast(float, __builtin_amdgcn_ds_bpermute(srclane << 2, __builtin_bit_cast(int, v))); }
__device__ __forceinline__ float swap_add(float v) { auto rr = __builtin_amdgcn_permlane32_swap(__float_as_uint(v), __float_as_uint(v), false, false); return __uint_as_float(rr[0]) + __uint_as_float(rr[1]); }
__device__ __forceinline__ float wmax(float v, int lane) {
#pragma unroll
  for (int o = 1; o < 64; o <<= 1) v = fmaxf(v, bperm(v, lane ^ o));
  return v;
}
__device__ __forceinline__ size_t blk_row0(int b, int blkid) { return blkid == 0 ? (size_t)NB * TT + b * CT : (size_t)b * TT + (blkid - 1) * 256; }
__device__ __forceinline__ int seq_blk(int dir, int j) { return j == 0 ? 0 : (dir == 0 ? j : 17 - j); }
__device__ __forceinline__ int blk_seq(int dir, int blkid) { return blkid == 0 ? 0 : (dir == 0 ? blkid : 17 - blkid); }
__device__ __forceinline__ void gate_scan(const float* __restrict__ GATES, const float* __restrict__ bg, size_t row0, int h, int dir, int lane, float (&F)[4], float (&Bt)[4], float (&ML)[4], float& b_last, float& bmax) {
  const float bi = ((const GAS float*)bg)[(2 * dir) * 4 + h], bf_ = ((const GAS float*)bg)[(2 * dir + 1) * 4 + h];
  float ig[4], c = 0.f;
#pragma unroll
  for (int i = 0; i < 4; ++i) { const int p = 4 * lane + i, r = dir ? 255 - p : p; const GAS float* gp = (const GAS float*)GATES + (row0 + r) * 16;
    ig[i] = gp[(2 * dir) * 4 + h] + bi; c += logsigmoid_acc(gp[(2 * dir + 1) * 4 + h] + bf_); F[i] = c; }
  float inc = c;
#pragma unroll
  for (int o = 1; o < 64; o <<= 1) { const float t = bperm(inc, lane - o); if (lane >= o) inc += t; }
  const float exc = inc - c;
  b_last = bperm(inc, 63);
  float mx = -3.0e38f;
#pragma unroll
  for (int i = 0; i < 4; ++i) { F[i] += exc; Bt[i] = ig[i] - F[i]; mx = fmaxf(mx, Bt[i]); ML[i] = mx; }
  float imx = mx;
#pragma unroll
  for (int o = 1; o < 64; o <<= 1) { const float t = bperm(imx, lane - o); if (lane >= o) imx = fmaxf(imx, t); }
  const float emx = bperm(imx, lane - 1);
  if (lane > 0) {
#pragma unroll
    for (int i = 0; i < 4; ++i) ML[i] = fmaxf(ML[i], emx); }
  bmax = bperm(imx, 63);
}
__device__ __forceinline__ void l1_unit(int seq, int vblk, int dblk, const bf16* __restrict__ ZT, const float* __restrict__ GATES, const float* __restrict__ bg, unsigned char* __restrict__ ST, LAS float* wt  ) {
  const int lane = fresh_lane();
  const int b = seq >> 3, h = (seq >> 1) & 3, dir = seq & 1, r32 = lane & 31, hi = lane >> 5;
  f32x16 acc = f32x16{}; float npart = 0.f, m = 0.f;
  const bf16* kT = ZT + (size_t)(h * 128 + 32 * dblk + r32) * MR;
  const bf16* vT = ZT + (size_t)(512 + h * 256 + 32 * vblk + r32) * MR;
  bf16* CS = (bf16*)ST; float* NS = (float*)(ST + NST_OFF); float* MS = (float*)(ST + MST_OFF);
#pragma unroll 1
  for (int j = 0; j < NBLK; ++j) {
    { bf16* cp = CS + ((size_t)(seq * NBLK + j) * 256 + 32 * vblk) * 128 + 32 * dblk + r32;
#pragma unroll
      for (int r = 0; r < 16; ++r) cp[(size_t)att::crow(r, hi) * 128] = (bf16)f2bf(acc[r]);
      if (vblk == 0) { const float nt = npart + bperm(npart, lane ^ 32); if (hi == 0) NS[(size_t)(seq * NBLK + j) * 128 + 32 * dblk + r32] = nt; if (dblk == 0 && lane == 0) MS[seq * NBLK + j] = m; } }
    if (j == NBLK - 1) break;
    const size_t row0 = blk_row0(b, seq_blk(dir, j));
    float F[4], Bt[4], ML[4], b_last, bmax;
    gate_scan(GATES, bg, row0, h, dir, lane, F, Bt, ML, b_last, bmax);
    const float Mf = fmaxf(m, bmax), decay = expf(m - Mf);
#pragma unroll
    for (int i = 0; i < 4; ++i) { const int p = 4 * lane + i, r = dir ? 255 - p : p; wt[r] = expf(Bt[i] - Mf); }
    asm volatile("s_waitcnt lgkmcnt(0)" ::: "memory");
    acc = acc * decay; npart *= decay; m = b_last + Mf;
#pragma unroll 4
    for (int ks = 0; ks < 16; ++ks) { const int tok = 16 * ks + 8 * hi;
      const bf16x8 af = *(const GAS bf16x8*)(vT + row0 + tok); const u32x4 kw = *(const GAS u32x4*)(kT + row0 + tok);
      const f32x4v w0 = *(const LAS f32x4v*)(wt + tok), w1 = *(const LAS f32x4v*)(wt + tok + 4);
      float kf[8];
#pragma unroll
      for (int e = 0; e < 4; ++e) { kf[2 * e] = __uint_as_float(kw[e] << 16); kf[2 * e + 1] = __uint_as_float(kw[e] & 0xffff0000u); }
      kf[0] *= w0[0]; kf[1] *= w0[1]; kf[2] *= w0[2]; kf[3] *= w0[3]; kf[4] *= w1[0]; kf[5] *= w1[1]; kf[6] *= w1[2]; kf[7] *= w1[3];
      npart += ((kf[0] + kf[1]) + (kf[2] + kf[3])) + ((kf[4] + kf[5]) + (kf[6] + kf[7]));
      u32x4 kb = {att::cvtpk(kf[0], kf[1]), att::cvtpk(kf[2], kf[3]), att::cvtpk(kf[4], kf[5]), att::cvtpk(kf[6], kf[7])};
      acc = __builtin_amdgcn_mfma_f32_32x32x16_bf16(af, *reinterpret_cast<bf16x8*>(&kb), acc, 0, 0, 0); }
  }
}
__device__ __forceinline__ void l2_unit(int b, int h, int blkid, int half, const bf16* __restrict__ Z, const bf16* __restrict__ ZT, const float* __restrict__ GATES, const float* __restrict__ bg,
                                        const unsigned char* __restrict__ ST, const float* __restrict__ headg, bf16* __restrict__ CAT, LAS float* tab, LAS float* exch, int wave) {
  const int lane = fresh_lane();
  const int r32 = lane & 31, hi = lane >> 5, rgrp = wave & 3, dvh = wave >> 2;
  const size_t row0 = blk_row0(b, blkid);
  const int t0 = half * 128 + rgrp * 32, t = t0 + r32;
  const bf16* CS = (const bf16*)ST; const float* NS = (const float*)(ST + NST_OFF); const float* MS = (const float*)(ST + MST_OFF);
  bf16x8 qf[8];
  { const bf16* qp = Z + (row0 + t) * ZLD + ZB_Q + h * 128 + hi * 8;
#pragma unroll
    for (int d0 = 0; d0 < 8; ++d0) { const u32x4 w = *(const GAS u32x4*)(qp + 16 * d0); u32x4 o;
#pragma unroll
      for (int e = 0; e < 4; ++e) o[e] = att::cvtpk(__uint_as_float(w[e] << 16) * 0.08838834764831845f, __uint_as_float(w[e] & 0xffff0000u) * 0.08838834764831845f);
      qf[d0] = *reinterpret_cast<bf16x8*>(&o); } }
  f32x16 hh[4];
#pragma unroll
  for (int mb = 0; mb < 4; ++mb) hh[mb] = f32x16{};
  LAS float* beta_t = tab; LAS float* M_t = tab + 256; LAS float* F_t = tab + 512;
#define ML_STILE(kt) f32x16 p0 = f32x16{}, p1 = f32x16{}; { const bf16* kp = Z + (row0 + 64 * (kt) + r32) * ZLD + ZB_K + h * 128 + hi * 8; \
      _Pragma("unroll") for (int d0 = 0; d0 < 8; ++d0) { const bf16x8 k0 = *(const GAS bf16x8*)(kp + 16 * d0), k1 = *(const GAS bf16x8*)(kp + (size_t)32 * ZLD + 16 * d0); \
        p0 = __builtin_amdgcn_mfma_f32_32x32x16_bf16(k0, qf[d0], p0, 0, 0, 0); p1 = __builtin_amdgcn_mfma_f32_32x32x16_bf16(k1, qf[d0], p1, 0, 0, 0); if ((d0 & 3) == 3) __builtin_amdgcn_sched_barrier(0); } \
      _Pragma("unroll") for (int r = 0; r < 16; ++r) { const int k0i = 64 * (kt) + att::crow(r, hi), k1i = k0i + 32; \
        const bool v0 = dir == 0 ? (k0i <= t) : (k0i >= t), v1 = dir == 0 ? (k1i <= t) : (k1i >= t); \
        p0[r] = v0 ? p0[r] * __expf(beta_t[k0i] - Mt) : 0.f; p1[r] = v1 ? p1[r] * __expf(beta_t[k1i] - Mt) : 0.f; } }
#pragma unroll
  for (int dir = 0; dir < 2; ++dir) {
    const int seq = (b * 4 + h) * 2 + dir, j = blk_seq(dir, blkid);
    const float m_prev = ((const GAS float*)MS)[seq * NBLK + j];
    { float F[4], Bt[4], ML[4], b_last, bmax;
      gate_scan(GATES, bg, row0, h, dir, lane, F, Bt, ML, b_last, bmax);
#pragma unroll
      for (int i = 0; i < 4; ++i) { const int p = 4 * lane + i, r = dir ? 255 - p : p; beta_t[r] = Bt[i]; M_t[r] = fmaxf(m_prev, ML[i]); F_t[r] = F[i]; } }
    asm volatile("s_waitcnt lgkmcnt(0)" ::: "memory");
    const float Mt = M_t[t], Ft = F_t[t];
    const float w_inter = expf(m_prev - Mt), floorv = expf(-Ft - Mt);
    float den;
    { const GAS float* np = (const GAS float*)NS + (size_t)(seq * NBLK + j) * 128 + hi * 8; float dot = 0.f;
#pragma unroll
      for (int d0 = 0; d0 < 8; ++d0) { const u32x4 w = *reinterpret_cast<const u32x4*>(&qf[d0]); const f32x4v n0 = *(const GAS f32x4v*)(np + 16 * d0), n1 = *(const GAS f32x4v*)(np + 16 * d0 + 4);
        dot += __uint_as_float(w[0] << 16) * n0[0] + __uint_as_float(w[0] & 0xffff0000u) * n0[1] + __uint_as_float(w[1] << 16) * n0[2] + __uint_as_float(w[1] & 0xffff0000u) * n0[3]
             + __uint_as_float(w[2] << 16) * n1[0] + __uint_as_float(w[2] & 0xffff0000u) * n1[1] + __uint_as_float(w[3] << 16) * n1[2] + __uint_as_float(w[3] & 0xffff0000u) * n1[3]; }
      den = w_inter * swap_add(dot); }
    { float rsum = 0.f;
#pragma unroll 1
      for (int kt = 0; kt < 4; ++kt) {
        if (dir == 0 ? (64 * kt > t0 + 31) : (64 * kt + 63 < t0)) continue;
        ML_STILE(kt);
#pragma unroll
        for (int r = 0; r < 16; ++r) rsum += p0[r] + p1[r]; }
      den += swap_add(rsum); }
    const float inv = 1.f / fmaxf(fabsf(den), floorv);
    { const float sc = w_inter * inv;
      const bf16* cb = CS + ((size_t)(seq * NBLK + j) * 256 + dvh * 128 + r32) * 128 + hi * 8;
#pragma unroll
      for (int d0 = 0; d0 < 8; ++d0) { const u32x4 w = *reinterpret_cast<const u32x4*>(&qf[d0]); u32x4 qs;
#pragma unroll
        for (int e = 0; e < 4; ++e) qs[e] = att::cvtpk(__uint_as_float(w[e] << 16) * sc, __uint_as_float(w[e] & 0xffff0000u) * sc);
#pragma unroll
        for (int mb = 0; mb < 4; ++mb) { const bf16x8 cf = *(const GAS bf16x8*)(cb + (size_t)(32 * mb) * 128 + 16 * d0); hh[mb] = __builtin_amdgcn_mfma_f32_32x32x16_bf16(cf, *reinterpret_cast<bf16x8*>(&qs), hh[mb], 0, 0, 0); } if (d0 & 1) __builtin_amdgcn_sched_barrier(0); } }
#pragma unroll 1
    for (int kt = 0; kt < 4; ++kt) {
      if (dir == 0 ? (64 * kt > t0 + 31) : (64 * kt + 63 < t0)) continue;
      ML_STILE(kt);
#pragma unroll
      for (int r = 0; r < 16; ++r) { p0[r] *= inv; p1[r] *= inv; }
      bf16x8 pa[4];
#define PK4(P, BASE, OUT) do { unsigned a0 = att::cvtpk(P[BASE + 0], P[BASE + 1]), a1 = att::cvtpk(P[BASE + 2], P[BASE + 3]);   \
    unsigned b0 = att::cvtpk(P[BASE + 4], P[BASE + 5]), b1 = att::cvtpk(P[BASE + 6], P[BASE + 7]);                              \
    auto r0 = __builtin_amdgcn_permlane32_swap(a0, b0, false, false); auto r1 = __builtin_amdgcn_permlane32_swap(a1, b1, false, false); \
    u32x4 w = {r0[0], r1[0], r0[1], r1[1]}; OUT = *reinterpret_cast<bf16x8*>(&w); } while (0)
      PK4(p0, 0, pa[0]); PK4(p0, 8, pa[1]); PK4(p1, 0, pa[2]); PK4(p1, 8, pa[3]);
#undef PK4
      const bf16* vp = ZT + (size_t)(512 + h * 256 + dvh * 128 + r32) * MR + row0 + 64 * kt + hi * 8;
#pragma unroll
      for (int mb = 0; mb < 4; ++mb)
#pragma unroll
        for (int ks = 0; ks < 4; ++ks) { const bf16x8 vf = *(const GAS bf16x8*)(vp + (size_t)(32 * mb) * MR + 16 * ks); hh[mb] = __builtin_amdgcn_mfma_f32_32x32x16_bf16(vf, pa[ks], hh[mb], 0, 0, 0); if ((mb & 1) && ks == 3) __builtin_amdgcn_sched_barrier(0); }
    }
  }
#undef ML_STILE
  float ss = 0.f;
#pragma unroll
  for (int mb = 0; mb < 4; ++mb)
#pragma unroll
    for (int r = 0; r < 16; ++r) ss += hh[mb][r] * hh[mb][r];
  ss = swap_add(ss);
  if (hi == 0) exch[wave * 32 + r32] = ss;
  __syncthreads();
  const float tot = exch[(wave & 3) * 32 + r32] + exch[((wave & 3) + 4) * 32 + r32];
  const float rstd = 1.f / sqrtf(tot * (1.f / 256.f) + EPS);
  { const int l2_ = fresh_lane(); const int hi = l2_ >> 5; const size_t row = blk_row0(b, blkid) + t0 + (l2_ & 31);
    const bf16* og = Z + row * ZLD + ZB_O + h * 256 + dvh * 128; bf16* cp = CAT + row * DM + 1024 + h * 256 + dvh * 128; const GAS float* hg = (const GAS float*)headg + h * 256 + dvh * 128;
#pragma unroll
    for (int mb = 0; mb < 4; ++mb)
#pragma unroll
      for (int a = 0; a < 4; ++a) { const int v = 32 * mb + 8 * a + 4 * hi;
        const u32x2 ow = *(const GAS u32x2*)(og + v); const f32x4v g4 = *(const GAS f32x4v*)(hg + v);
        const float o0 = __uint_as_float(ow.x << 16), o1 = __uint_as_float(ow.x & 0xffff0000u), o2 = __uint_as_float(ow.y << 16), o3 = __uint_as_float(ow.y & 0xffff0000u);
        const float y0 = hh[mb][4 * a] * rstd * g4[0] / (1.f + __expf(-o0)), y1 = hh[mb][4 * a + 1] * rstd * g4[1] / (1.f + __expf(-o1));
        const float y2 = hh[mb][4 * a + 2] * rstd * g4[2] / (1.f + __expf(-o2)), y3 = hh[mb][4 * a + 3] * rstd * g4[3] / (1.f + __expf(-o3));
        u32x2 w; w.x = pk2(y0, y1); w.y = pk2(y2, y3); *(GAS u32x2*)(cp + v) = w; } }
  __syncthreads();
}
}
struct Args { const float* in[30]; float* out; unsigned char* ws; int ph_lo, ph_hi, li, pad; };
constexpr int PH_P0 = 0, PH_P1 = 1, PH_L0 = 2, PH_PER_LAYER = 13, PH_FINAL = 28, N_PHASES = 29;
enum { O_F1N = 0, O_F1U, O_F1D, O_MN, O_MI, O_MP, O_MA, O_MF, O_MG, O_MO, O_F2N, O_F2U, O_F2D };
#define OPAQUE_S(p) asm volatile("" : "+s"(p))
__device__ __forceinline__ int opq(int v) { asm volatile("" : "+s"(v)); return v; }
#define GEMM_PHASE(EPI, A_, B_, M_, N_, K_, ...) do { pg8::Gemm g{(const bf16*)(A_), (const bf16*)(B_), (M_), (N_), (K_)}; pg8::StaticOrder S; S.init((M_), (N_), F.G, (int)blockIdx.x); \
    pg8::EPI E{__VA_ARGS__}; pg8::gemm_phase<pg8::EPI, pg8::StaticOrder, true, true>(F.lds + RING_OFF, g, S, E, F.wave); } while (0)

__global__ void __launch_bounds__(NWAVES * 64, 2) fwd(Args args) {
    extern __shared__ __attribute__((aligned(16))) unsigned char lds[];
    Frame F;
    F.lds = (LAS unsigned char*)lds;
    F.MISC = (volatile LAS unsigned*)(F.lds + MISC_OFF);
    F.wave = __builtin_amdgcn_readfirstlane((int)threadIdx.x >> 6);
    F.G = gridDim.x;
    F.ws = args.ws; F.out = args.out;
    F.ctl = (gu32*)(args.ws + WS_CTL);
    for (int u = threadIdx.x; u < (LDS_BYTES - LDSCTL_OFF) / 4; u += NWAVES * 64) ((LAS unsigned*)(F.lds + LDSCTL_OFF))[u] = 0u;
    __syncthreads();
    const int lo = args.ph_lo, hi = args.ph_hi;
    XcdBarrier bar; bar.bar = (unsigned*)(F.ctl + CW_BAR) + args.li * XCD_BAR_WORDS; bar.x = 0; bar.st = nullptr;
    if (hi - lo > 1) bar = xcd_barrier_post((unsigned*)(F.ctl + CW_BAR) + args.li * XCD_BAR_WORDS, F.MISC + 8);
#define IN(k) (opq(lo) <= (k) && (k) < opq(hi))
#define SEAM(k) do { if (IN(k) && IN((k) + 1)) xcd_barrier(bar, F.wave); } while (0)

    if (IN(PH_P0)) { p0_prologue(F, args.in); } SEAM(PH_P0);
    if (IN(PH_P1)) { p1_modreduce(F, args.in[5], args.in[6]); } SEAM(PH_P1);
    if (IN(PH_L0 + O_F1N)) { norm_phase(F, F.ws, args.in[0], args.in[2], 0, 0, true, MR); }
#pragma unroll 1
    for (int l = 0; l < 2; ++l) {
        const int pb = PH_L0 + PH_PER_LAYER * l;
        const int MLAT = NB * TT;
        const int m_post = (l == 1) ? MLAT : MR;
        if (IN(pb + O_F1N) && l > 0) { unsigned char* ws = F.ws; OPAQUE_S(ws); norm_phase(F, ws, nullptr, nullptr, l, 0, false, MR); } SEAM(pb + O_F1N);
        if (IN(pb + O_F1U)) { unsigned char* ws = F.ws; OPAQUE_S(ws);
            GEMM_PHASE(EpiSwiglu, ws + WS_HN, ws + WS_WUP + (size_t)(l * 2) * 44 * MiB, MR, 2 * FF, DM, (bf16*)(ws + WS_HID), FF); } SEAM(pb + O_F1U);
        if (IN(pb + O_F1D)) { unsigned char* ws = F.ws; OPAQUE_S(ws);
            GEMM_PHASE(EpiResid, ws + WS_HID, ws + WS_WDN + (size_t)(l * 2) * 22 * MiB, MR, DM, FF, (float*)(ws + WS_H), (const float*)(ws + WS_MODV) + (size_t)l * 5 * MODN + 2 * DM, MODN, 0.5f); } SEAM(pb + O_F1D);
        if (IN(pb + O_MN)) { unsigned char* ws = F.ws; OPAQUE_S(ws); norm_phase(F, ws, nullptr, nullptr, l, 1, false, MR); } SEAM(pb + O_MN);
        if (IN(pb + O_MI)) { unsigned char* ws = F.ws; OPAQUE_S(ws);
            if (l == 0) { GEMM_PHASE(EpiPlain, ws + WS_HN, ws + WS_WABIN, MR, ZLD, DM, (bf16*)(ws + WS_Z), ZLD, (float*)(ws + WS_GATES), ZB_G / 256);
                GEMM_PHASE(EpiPlain, ws + WS_WABIN + (size_t)ZB_K * DM * 2, ws + WS_HN, 1536, MR, DM, (bf16*)(ws + WS_ZT), MR, nullptr, -1); }
            else GEMM_PHASE(EpiPlain, ws + WS_HN, ws + WS_WCDIN, MR, CD_IN, DM, (bf16*)(ws + WS_Z), CD_IN, nullptr, -1);
        } SEAM(pb + O_MI);
        if (IN(pb + O_MP)) { unsigned char* ws = F.ws; OPAQUE_S(ws);
            const int lane = fresh_lane(); const int gw = blockIdx.x * NWAVES + F.wave, NGW = F.G * NWAVES;
            const bf16* Z = (const bf16*)(ws + WS_Z); bf16* KA = (bf16*)(ws + WS_KA); const float* tv = (const float*)(ws + WS_TAB + TB_VEC);
            if (l == 0) { for (int it = gw; it < MR * 2; it += NGW) naive_kprep<0>(it, lane, Z, KA, tv + TV_GK, (const float*)(ws + WS_TAB + TB_ROPEA));
                if (F.wave < 4) for (int u = (int)blockIdx.x * 4 + F.wave; u < ml::NSEQ * 32; u += F.G * 4)
                    ml::l1_unit(u >> 5, (u >> 2) & 7, u & 3, (const bf16*)(ws + WS_ZT), (const float*)(ws + WS_GATES), tv + TV_BGATE, ws + WS_SC1, (LAS float*)(F.lds + RING_OFF) + F.wave * 256); }
            else { for (int it = gw; it < MR; it += NGW) naive_kprep<1>(it, lane, Z, KA, nullptr, (const float*)(ws + WS_TAB + TB_ROPED));
                for (int u = gw; u < NB * 64 * 17; u += NGW) { const int seg = 16 - (u / (NB * 64)), bg = u % (NB * 64);
                    s5::s5_unit<1>(bg >> 6, bg & 63, seg, Z, (const float*)(ws + WS_TAB + TB_S5AB), (const bf16*)(ws + WS_TAB + TB_S5BT), (const bf16*)(ws + WS_TAB + TB_S5CT), (float*)(ws + WS_SC2), nullptr, nullptr, nullptr); } }
        } SEAM(pb + O_MP);
        if (IN(pb + O_MA)) { unsigned char* ws = F.ws; OPAQUE_S(ws);
            const int tid = fresh_tid(F.wave);
            const bf16* Z = (const bf16*)(ws + WS_Z); const bf16* KA = (const bf16*)(ws + WS_KA); bf16* CAT = (bf16*)(ws + WS_CAT); const float* tv = (const float*)(ws + WS_TAB + TB_VEC);
            float* SC1 = (float*)(ws + WS_SC1); float* SC2 = (float*)(ws + WS_SC2);
            if (l == 0) { const float* ropeA = (const float*)(ws + WS_TAB + TB_ROPEA);
                { const int nv = F.G, v0 = (int)blockIdx.x;
                    for (int u = v0; u < 512; u += nv) { const int b = u >> 7, head = (u >> 4) & 7, qb = u & 15, kvh = head >> 2; const size_t row0 = (size_t)b * TT + qb * 256;
                        att::attn_unit<128, 0>(Z + row0 * ZLD + ZA_Q + head * 128, ZLD, KA + kvh * 128, 256, Z + ZA_V + kvh * 128, ZLD, CAT + row0 * DM + head * 128, b, qb * 256, tv + TV_GQ, ropeA, 0.f, (char*)lds + RING_OFF, F.wave); }
                    for (int u = v0; u < 32; u += nv) { const int b = u >> 3, head = u & 7, kvh = head >> 2; const size_t row0 = (size_t)NB * TT + b * CT;
                        att::attn_unit<128, 1>(Z + row0 * ZLD + ZA_Q + head * 128, ZLD, KA + kvh * 128, 256, Z + ZA_V + kvh * 128, ZLD, CAT + row0 * DM + head * 128, b, 0, tv + TV_GQ, ropeA, 0.f, (char*)lds + RING_OFF, F.wave); } }
                for (int u = (int)blockIdx.x; u < NB * 4 * 34; u += F.G) { const int b = u / 136, rem = u % 136, h = rem / 34, bh = rem % 34;
                    ml::l2_unit(b, h, bh >> 1, bh & 1, Z, (const bf16*)(ws + WS_ZT), (const float*)(ws + WS_GATES), tv + TV_BGATE, ws + WS_SC1, tv + TV_HEADG, CAT,
                                (LAS float*)(F.lds + RING_OFF) + F.wave * 768, (LAS float*)(F.lds + RING_OFF) + 8 * 768, F.wave); }
            } else { const float* ropeD = (const float*)(ws + WS_TAB + TB_ROPED);
                { const int nv = F.G, v0 = (int)blockIdx.x;
                    for (int u = v0; u < 1024; u += nv) { const int b = u >> 8, head = (u >> 4) & 15, qb = u & 15, kvh = head >> 3; const size_t row0 = (size_t)b * TT + qb * 256;
                        att::attn_unit<64, 2>(Z + row0 * CD_IN + ZD_Q + head * 64, CD_IN, KA + kvh * 64, 128, Z + ZD_V + kvh * 64, CD_IN, CAT + row0 * DM + 1024 + head * 64, b, qb * 256, nullptr, ropeD, tv[TV_SINK + head], (char*)lds + RING_OFF, F.wave); } }
                { const int gw = blockIdx.x * NWAVES + F.wave, NGW = F.G * NWAVES;
                    for (int u = gw; u < NB * 64 * 16; u += NGW) { const int seg = u / (NB * 64), bg = u % (NB * 64);
                        s5::s5_unit<2>(bg >> 6, bg & 63, seg, Z, (const float*)(ws + WS_TAB + TB_S5AB), (const bf16*)(ws + WS_TAB + TB_S5BT), (const bf16*)(ws + WS_TAB + TB_S5CT), (float*)(ws + WS_SC2), tv + TV_DSKIP, (bf16*)(ws + WS_G),
                                       F.lds + RING_OFF + F.wave * s5::WAVE_LDS); } }
            }
        } SEAM(pb + O_MA);
        if (IN(pb + O_MF)) { unsigned char* ws = F.ws; OPAQUE_S(ws);
            const int tid = fresh_tid(F.wave); const int lane = tid & 63, gw = blockIdx.x * NWAVES + F.wave, NGW = F.G * NWAVES;
            const bf16* Z = (const bf16*)(ws + WS_Z); const float* tv = (const float*)(ws + WS_TAB + TB_VEC);
            const float* SC1 = (const float*)(ws + WS_SC1); const float* SC2 = (const float*)(ws + WS_SC2);

        } SEAM(pb + O_MF);
        if (IN(pb + O_MG)) { unsigned char* ws = F.ws; OPAQUE_S(ws);
            if (l == 1) GEMM_PHASE(EpiGlu, ws + WS_G, ws + WS_WGLU, MLAT, 1024, 1024, (bf16*)(ws + WS_CAT), DM, (const bf16*)(ws + WS_G), (const float*)(ws + WS_TAB + TB_VEC) + TV_GLUB);
        } SEAM(pb + O_MG);
        if (IN(pb + O_MO)) { unsigned char* ws = F.ws; OPAQUE_S(ws);
            GEMM_PHASE(EpiResid, ws + WS_CAT, ws + (l == 0 ? WS_WABOUT : WS_WCDOUT), m_post, DM, DM, (float*)(ws + WS_H), (const float*)(ws + WS_MODV) + (size_t)l * 5 * MODN + 5 * DM, MODN, 1.0f); } SEAM(pb + O_MO);
        if (IN(pb + O_F2N)) { unsigned char* ws = F.ws; OPAQUE_S(ws); norm_phase(F, ws, nullptr, nullptr, l, 2, false, m_post); } SEAM(pb + O_F2N);
        if (IN(pb + O_F2U)) { unsigned char* ws = F.ws; OPAQUE_S(ws);
            GEMM_PHASE(EpiSwiglu, ws + WS_HN, ws + WS_WUP + (size_t)(l * 2 + 1) * 44 * MiB, m_post, 2 * FF, DM, (bf16*)(ws + WS_HID), FF); } SEAM(pb + O_F2U);
        if (IN(pb + O_F2D)) { unsigned char* ws = F.ws; OPAQUE_S(ws);
            GEMM_PHASE(EpiResid, ws + WS_HID, ws + WS_WDN + (size_t)(l * 2 + 1) * 22 * MiB, m_post, DM, FF, (float*)(ws + WS_H), (const float*)(ws + WS_MODV) + (size_t)l * 5 * MODN + 8 * DM, MODN, 0.5f); } SEAM(pb + O_F2D);
    }
    if (IN(PH_FINAL)) { unsigned char* ws = F.ws; OPAQUE_S(ws); final_norm_phase(F, ws); }
#undef IN
#undef SEAM
}
extern "C" void kernel_launch(void* const* d_in, const int* in_sizes, int n_in, void* d_out, int out_size, void* d_ws, size_t ws_size, hipStream_t stream) {
    static int grid = 0;
    if (grid == 0) {
        if (n_in != 30 || out_size != NB * TT * DM || ws_size < WS_END) { fprintf(stderr, "kernel_launch: unexpected shapes: n_in %d out %d ws %zu (need %zu)\n", n_in, out_size, ws_size, (size_t)WS_END); grid = -1; return; }
        int dev = 0, cus = 0;
        if (hipGetDevice(&dev) != hipSuccess || hipDeviceGetAttribute(&cus, hipDeviceAttributeMultiprocessorCount, dev) != hipSuccess) { grid = -1; return; }
        if (hipFuncSetAttribute((const void*)fwd, hipFuncAttributeMaxDynamicSharedMemorySize, LDS_BYTES) != hipSuccess) { fprintf(stderr, "kernel_launch: hipFuncSetAttribute failed\n"); grid = -1; return; }
        int per_cu = 0; (void)hipOccupancyMaxActiveBlocksPerMultiprocessor(&per_cu, (const void*)fwd, NWAVES * 64, LDS_BYTES); (void)hipGetLastError();
        if (per_cu < 1) fprintf(stderr, "kernel_launch: occupancy query says %d\n", per_cu);
        grid = cus;
    }
    if (grid < 0) return;
    (void)hipMemsetAsync((char*)d_ws + WS_CTL, 0, CTL_ZERO_BYTES, stream);
    Args a{};
    for (int i = 0; i < 30; ++i) a.in[i] = (const float*)d_in[i];
    a.out = (float*)d_out; a.ws = (unsigned char*)d_ws;
    int li = 0;
    auto run = [&](int lo, int hi) { a.ph_lo = lo; a.ph_hi = hi; a.li = li++; a.pad = 0; hipLaunchKernelGGL(fwd, dim3(grid), dim3(NWAVES * 64), LDS_BYTES, stream, a); };
#ifndef MK_CUTS
#define MK_CUTS 0
#endif
    if (MK_CUTS == 0) run(0, N_PHASES);
    else if (MK_CUTS == 1) { for (int ph = 0; ph < N_PHASES; ++ph) run(ph, ph + 1); }
    else { run(0, PH_L0 + O_MP); run(PH_L0 + O_MP, PH_L0 + O_MO); run(PH_L0 + O_MO, PH_L0 + PH_PER_LAYER + O_MP); run(PH_L0 + PH_PER_LAYER + O_MP, PH_L0 + PH_PER_LAYER + O_MO); run(PH_L0 + PH_PER_LAYER + O_MO, N_PHASES); }
    const hipError_t le = hipPeekAtLastError();
    if (le != hipSuccess) fprintf(stderr, "kernel_launch: launch failed: %s\n", hipGetErrorName(le));
}
```

```cpp
#include <hip/hip_runtime.h>
#include <cstdio>
#include <cstdint>
#include <cmath>
__device__ __forceinline__ int fresh_lane() { int l; asm volatile("v_mbcnt_lo_u32_b32 %0, -1, 0\n\tv_mbcnt_hi_u32_b32 %0, -1, %0" : "=v"(l)); return l; }
__device__ __forceinline__ int fresh_tid(int wave) { return wave * 64 + fresh_lane(); }
namespace pg8 {
#define PG8_LAS __attribute__((address_space(3)))
typedef unsigned short bf16_t;
typedef short bf16x8 __attribute__((ext_vector_type(8)));
typedef float f32x4 __attribute__((ext_vector_type(4)));
typedef unsigned u32x4 __attribute__((ext_vector_type(4)));
constexpr int BM = 256, BK = 64, HALF = 128, HTB = HALF * BK * 2  , STAGE_BYTES = 8 * HTB, NXCD = 8, WGM = 8;

__host__ __device__ __forceinline__ int lds_byte(int r, int c) { const int st = (r >> 4) * 2 + (c >> 5), rr = r & 15, cc = c & 31, ob = rr * 64 + cc * 2; return st * 1024 + (ob ^ (((ob >> 9) & 1) << 5)); }
__host__ __device__ __forceinline__ void stage_rc(int b, int& R, int& C) { const int st = b / 1024, sb = b % 1024, swz = sb ^ (((sb >> 9) & 1) << 5); R = (st >> 1) * 16 + swz / 64; C = (st & 1) * 32 + (swz % 64) / 2; }
__host__ __device__ __forceinline__ int perm32(int rho) { const int n = rho >> 4, i = rho & 15; return 8 * (i >> 2) + 4 * n + (i & 3); }

struct Unit { int pm, pn, kt0, nkt; };
struct Gemm { const bf16_t* A; const bf16_t* Bt; int M, N, K; };

struct StaticOrder {
    int nM, nN, nwg, G, c, nt, S, mode;
    __host__ __device__ __forceinline__ void init(int M, int N, int G_, int c_, int K = 0, int mode_ = 0) { nM = M / BM; nN = N / BM; nwg = nM * nN; G = G_; c = c_; nt = K / BK; S = 1; mode = mode_;
        if (mode_) { const int r = nwg % G; if (r > 0) { const int s = G / r; for (int cand = (s < 8 ? s : 8); cand >= 2; --cand) if (nt % (2 * cand) == 0) { S = cand; break; } } } }
    __host__ __device__ __forceinline__ bool next(int i, Unit& u) const {
        const int q = nwg / G; long L; int piece = 0; bool tail = false;
        if (mode == 2) { if (S == 1 || i > 0 || c >= S * (nwg - q * G)) return false; L = (long)q * G + c / S; piece = c % S; tail = true; }
        else { L = (long)i * G + c; if (L >= nwg || (mode == 1 && S > 1 && i >= q)) return false; }
        int wgid = (int)L; { const int q8 = nwg / NXCD, r = nwg % NXCD, xcd = wgid % NXCD, off = wgid / NXCD; wgid = (xcd < r ? xcd * (q8 + 1) : r * (q8 + 1) + (xcd - r) * q8) + off; }
        const int nig = WGM * nN, gid = wgid / nig, fm = gid * WGM, gsz = (nM - fm) < WGM ? (nM - fm) : WGM;
        u.pm = fm + ((wgid % nig) % gsz); u.pn = (wgid % nig) / gsz;
        u.nkt = tail ? nt / S : nt; u.kt0 = piece * u.nkt; return true;
    }
    __device__ __forceinline__ void a_ready(const Unit&) const {}
    __device__ __forceinline__ void done(const Unit&) const {}
};

__device__ __forceinline__ unsigned cvt_pk_bf16(float lo, float hi) { unsigned r; asm volatile("v_cvt_pk_bf16_f32 %0, %1, %2" : "=v"(r) : "v"(lo), "v"(hi)); return r; }
typedef float f32x2 __attribute__((ext_vector_type(2)));
__device__ __forceinline__ float fast_sigmoid(float a) { return __builtin_amdgcn_rcpf(1.f + __builtin_amdgcn_exp2f(-1.4426950408889634f * a)); }
struct EpiPlain {
    static constexpr bool PERM = true, AFTER_DRAIN = false;
    bf16_t* O; int ldc; float* gates; int gate_pn;
    __device__ __forceinline__ void operator()(const f32x4 (&acc)[2][2][4][2], const Unit& u, int wr, int wc, int fr, int fq) const {
        const int row0 = u.pm * BM + wr * 64 + fr, col0 = u.pn * BM + wc * 32 + 8 * fq;
#pragma unroll
        for (int ai = 0; ai < 2; ++ai)
#pragma unroll
            for (int m = 0; m < 4; ++m) { const int row = row0 + ai * HALF + m * 16; bf16_t* rowp = O + (size_t)row * ldc + col0;
#pragma unroll
                for (int bj = 0; bj < 2; ++bj) { const f32x4 v0 = acc[ai][bj][m][0], v1 = acc[ai][bj][m][1];
                    u32x4 w; w.x = cvt_pk_bf16(v0[0], v0[1]); w.y = cvt_pk_bf16(v0[2], v0[3]); w.z = cvt_pk_bf16(v1[0], v1[1]); w.w = cvt_pk_bf16(v1[2], v1[3]);
                    *(u32x4*)(rowp + bj * HALF) = w;
                    if (bj == 0 && u.pn == gate_pn && wc == 0 && fq < 2) { float* gp = gates + (size_t)row * 16 + 8 * fq; *(f32x4*)gp = v0; *(f32x4*)(gp + 4) = v1; } } }
    }
};
struct EpiSwiglu {
    static constexpr bool PERM = true, AFTER_DRAIN = false;
    bf16_t* O; int ldc;
    __device__ __forceinline__ void operator()(const f32x4 (&acc)[2][2][4][2], const Unit& u, int wr, int wc, int fr, int fq) const {
        const int row0 = u.pm * BM + wr * 64 + fr, col0 = u.pn * HALF + wc * 32 + 8 * fq;
#pragma unroll
        for (int ai = 0; ai < 2; ++ai)
#pragma unroll
            for (int m = 0; m < 4; ++m) { bf16_t* rowp = O + (size_t)(row0 + ai * HALF + m * 16) * ldc + col0;
                float r[8];
#pragma unroll
                for (int n = 0; n < 2; ++n)
#pragma unroll
                    for (int j = 0; j < 4; ++j) { const float a = acc[ai][0][m][n][j], b = acc[ai][1][m][n][j]; r[4 * n + j] = a * fast_sigmoid(a) * b; }
                u32x4 w; w.x = cvt_pk_bf16(r[0], r[1]); w.y = cvt_pk_bf16(r[2], r[3]); w.z = cvt_pk_bf16(r[4], r[5]); w.w = cvt_pk_bf16(r[6], r[7]);
                *(u32x4*)rowp = w; }
    }
};
template <bool ATOMIC> struct EpiResidT {
    static constexpr bool PERM = true, AFTER_DRAIN = false;
    float* H; const float* gate; int gstride; float coef;
    __device__ __forceinline__ void operator()(const f32x4 (&acc)[2][2][4][2], const Unit& u, int wr, int wc, int fr, int fq) const {
        const int row0 = u.pm * BM + wr * 64 + fr, col0 = u.pn * BM + wc * 32 + 8 * fq;
        const int sel = u.pm < 64 ? (u.pm >> 4) : 4;
        const float* gp = gate + (size_t)sel * gstride + col0;
        f32x4 gv[2][2];
#pragma unroll
        for (int bj = 0; bj < 2; ++bj)
#pragma unroll
            for (int n = 0; n < 2; ++n) gv[bj][n] = *(const f32x4*)(gp + bj * HALF + 4 * n) * coef;
#pragma unroll
        for (int ai = 0; ai < 2; ++ai)
#pragma unroll
            for (int m = 0; m < 4; ++m) { float* rowp = H + (size_t)(row0 + ai * HALF + m * 16) * 2048 + col0;
#pragma unroll
                for (int bj = 0; bj < 2; ++bj)
#pragma unroll
                    for (int n = 0; n < 2; ++n) { f32x4* p = (f32x4*)(rowp + bj * HALF + 4 * n); const f32x4 v = gv[bj][n] * acc[ai][bj][m][n];
                        if (!ATOMIC) *p = *p + v;
                        else { __attribute__((address_space(1))) float* pa = (__attribute__((address_space(1))) float*)p;
                            __builtin_amdgcn_global_atomic_fadd_f32(pa, v[0]); __builtin_amdgcn_global_atomic_fadd_f32(pa + 1, v[1]); __builtin_amdgcn_global_atomic_fadd_f32(pa + 2, v[2]); __builtin_amdgcn_global_atomic_fadd_f32(pa + 3, v[3]); } } }
    }
};
typedef EpiResidT<false> EpiResid; typedef EpiResidT<true> EpiResidA;
struct EpiGlu {
    static constexpr bool PERM = true, AFTER_DRAIN = false;
    bf16_t* O; int ldc; const bf16_t* G; const float* bias;
    __device__ __forceinline__ void operator()(const f32x4 (&acc)[2][2][4][2], const Unit& u, int wr, int wc, int fr, int fq) const {
        const int row0 = u.pm * BM + wr * 64 + fr, col0 = u.pn * BM + wc * 32 + 8 * fq;
#pragma unroll
        for (int ai = 0; ai < 2; ++ai)
#pragma unroll
            for (int m = 0; m < 4; ++m) { const int row = row0 + ai * HALF + m * 16;
#pragma unroll
                for (int bj = 0; bj < 2; ++bj) { const int col = col0 + bj * HALF;
                    const u32x4 gw = *(const u32x4*)(G + (size_t)row * 1024 + col);
                    const f32x4 b0 = *(const f32x4*)(bias + col), b1 = *(const f32x4*)(bias + col + 4);
                    float r[8];
#pragma unroll
                    for (int j = 0; j < 4; ++j) { r[j] = fast_sigmoid(acc[ai][bj][m][0][j] + b0[j]); r[4 + j] = fast_sigmoid(acc[ai][bj][m][1][j] + b1[j]); }
                    const unsigned gws[4] = {gw.x, gw.y, gw.z, gw.w};
#pragma unroll
                    for (int q = 0; q < 4; ++q) { r[2 * q] *= __builtin_bit_cast(float, gws[q] << 16); r[2 * q + 1] *= __builtin_bit_cast(float, gws[q] & 0xffff0000u); }
                    u32x4 w; w.x = cvt_pk_bf16(r[0], r[1]); w.y = cvt_pk_bf16(r[2], r[3]); w.z = cvt_pk_bf16(r[4], r[5]); w.w = cvt_pk_bf16(r[6], r[7]);
                    *(u32x4*)(O + (size_t)row * ldc + col) = w; } }
    }
};
template <class Epi, class Sched, bool ALIGN_EPI = false, bool SP2 = false>
__device__ __forceinline__ void gemm_phase(PG8_LAS unsigned char* lds, const Gemm g, const Sched& S, const Epi& E, int wave_s) {
    const int tid = fresh_tid(wave_s);
    const int wid = __builtin_amdgcn_readfirstlane(tid >> 6), lane = tid & 63, wr = wid >> 2, wc = wid & 3, fr = lane & 15, fq = lane >> 4;
    const int K = g.K, nt = K / BK;
    unsigned voffA[2], voffB[2];
#pragma unroll
    for (int i = 0; i < 2; ++i) { int R, C; stage_rc(tid * 16 + i * 8192, R, C); const int Rb = Epi::PERM ? ((R & ~31) + perm32(R & 31)) : R;
        voffA[i] = (unsigned)(R * K + C) * 2u; voffB[i] = (unsigned)(Rb * K + C) * 2u; }
    const size_t kstep = (size_t)(BK * 2);
    const size_t hstep = (size_t)HALF * K * 2;
    const size_t tstep = 2 * hstep;
    const unsigned ldsw = (unsigned)wid * 1024u;
    const int aoff = lds_byte(wr * 64 + fr, fq * 8), boff = lds_byte(wc * 32 + fr, fq * 8);
#define PG8_SA(b, h) (((b) * 2 + (h)) * HTB)
#define PG8_SB(b, h) ((4 + (b) * 2 + (h)) * HTB)
#define PG8_STAGE(bufoff, gbase, voff) do { _Pragma("unroll") for (int _i = 0; _i < 2; ++_i) \
        __builtin_amdgcn_global_load_lds((const unsigned*)((const char*)(gbase) + (voff)[_i]), (PG8_LAS unsigned*)(lds + (bufoff) + ldsw + _i * 8192), 16, 0, 0); } while (0)
#define PG8_LDA(dst, b, h) do { _Pragma("unroll") for (int m = 0; m < 4; ++m) _Pragma("unroll") for (int k = 0; k < 2; ++k) dst[m][k] = *(const PG8_LAS bf16x8*)(lds + PG8_SA(b, h) + aoff + m * 2048 + k * 1024); } while (0)
#define PG8_LDB(dst, b, h) do { _Pragma("unroll") for (int n = 0; n < 2; ++n) _Pragma("unroll") for (int k = 0; k < 2; ++k) dst[n][k] = *(const PG8_LAS bf16x8*)(lds + PG8_SB(b, h) + boff + n * 2048 + k * 1024); } while (0)
#define PG8_MMA(ai, bj, At, Bt) do { __builtin_amdgcn_s_setprio(1); _Pragma("unroll") for (int m = 0; m < 4; ++m) _Pragma("unroll") for (int n = 0; n < 2; ++n) _Pragma("unroll") for (int k = 0; k < 2; ++k) \
        acc[ai][bj][m][n] = __builtin_amdgcn_mfma_f32_16x16x32_bf16(Bt[n][k], At[m][k], acc[ai][bj][m][n], 0, 0, 0); __builtin_amdgcn_s_setprio(0); } while (0)
#define PG8_WAIT_V(n) asm volatile("s_waitcnt vmcnt(" #n ")" ::: "memory")
#define PG8_WAIT_L(n) asm volatile("s_waitcnt lgkmcnt(" #n ")" ::: "memory")
#define PG8_BAR __builtin_amdgcn_s_barrier()
#define PG8_SCHED __builtin_amdgcn_sched_barrier(0)
    Unit cur, nxt; int ui = 0;
    if (!S.next(0, cur)) return;
    f32x4 acc[2][2][4][2];
#pragma unroll
    for (int a = 0; a < 2; ++a)
#pragma unroll
        for (int b = 0; b < 2; ++b)
#pragma unroll
            for (int m = 0; m < 4; ++m)
#pragma unroll
                for (int n = 0; n < 2; ++n) acc[a][b][m][n] = (f32x4){0.f, 0.f, 0.f, 0.f};
    bf16x8 At[4][2], B0[2][2], B1[2][2];
    const char* cA = (const char*)g.A + (size_t)cur.pm * tstep + (size_t)cur.kt0 * kstep; const char* cB = (const char*)g.Bt + (size_t)cur.pn * tstep + (size_t)cur.kt0 * kstep;
    S.a_ready(cur);
    if constexpr (SP2) {
        PG8_STAGE(PG8_SB(0, 0), cB, voffB); PG8_STAGE(PG8_SB(0, 1), cB + hstep, voffB); PG8_STAGE(PG8_SA(0, 0), cA, voffA); PG8_STAGE(PG8_SA(0, 1), cA + hstep, voffA);
        if (wr == 1) PG8_BAR;
        PG8_WAIT_V(2); PG8_BAR;
        PG8_STAGE(PG8_SB(1, 0), cB + kstep, voffB); PG8_STAGE(PG8_SA(1, 0), cA + kstep, voffA); PG8_STAGE(PG8_SB(1, 1), cB + hstep + kstep, voffB);
        PG8_WAIT_V(6); PG8_BAR;
    } else {
        PG8_STAGE(PG8_SB(0, 0), cB, voffB); PG8_STAGE(PG8_SA(0, 0), cA, voffA); PG8_STAGE(PG8_SB(0, 1), cB + hstep, voffB); PG8_STAGE(PG8_SA(0, 1), cA + hstep, voffA);
        if (wr == 1) PG8_BAR;
        PG8_WAIT_V(4); PG8_BAR;
        PG8_STAGE(PG8_SB(1, 0), cB + kstep, voffB); PG8_STAGE(PG8_SA(1, 0), cA + kstep, voffA); PG8_STAGE(PG8_SB(1, 1), cB + hstep + kstep, voffB);
        PG8_WAIT_V(6); PG8_BAR;
    }
    for (;;) {
        const bool has_next = S.next(ui + 1, nxt);
        const char* nA = has_next ? (const char*)g.A + (size_t)nxt.pm * tstep + (size_t)nxt.kt0 * kstep : cA; const char* nB = has_next ? (const char*)g.Bt + (size_t)nxt.pn * tstep + (size_t)nxt.kt0 * kstep : cB;
        const int ntc = cur.nkt;
        for (int t = 0; t < ntc; t += 2) {
            const bool last = (t == ntc - 2);
            const char* a1 = cA + (size_t)(t + 1) * kstep;
            const char* a2 = last ? nA : cA + (size_t)(t + 2) * kstep; const char* b2 = last ? nB : cB + (size_t)(t + 2) * kstep;
            const char* a3 = a2 + kstep; const char* b3 = b2 + kstep;
            if (last && has_next) S.a_ready(nxt);
            if constexpr (SP2) {
            PG8_LDB(B0, 0, 0); PG8_LDB(B1, 0, 1); PG8_SCHED; PG8_LDA(At, 0, 0); PG8_STAGE(PG8_SA(1, 1), a1 + hstep, voffA);
            PG8_WAIT_V(8); PG8_WAIT_L(0); PG8_BAR; PG8_MMA(0, 0, At, B0); PG8_MMA(0, 1, At, B1); PG8_BAR; PG8_SCHED;
            PG8_LDA(At, 0, 1); PG8_STAGE(PG8_SB(0, 0), b2, voffB); PG8_STAGE(PG8_SB(0, 1), b2 + hstep, voffB); PG8_STAGE(PG8_SA(0, 0), a2, voffA);
            PG8_WAIT_V(8); PG8_WAIT_L(0); PG8_BAR; PG8_MMA(1, 0, At, B0); PG8_MMA(1, 1, At, B1); PG8_BAR; PG8_SCHED;
            PG8_LDB(B0, 1, 0); PG8_LDB(B1, 1, 1); PG8_SCHED; PG8_LDA(At, 1, 0); PG8_STAGE(PG8_SA(0, 1), a2 + hstep, voffA);
            PG8_WAIT_V(8); PG8_WAIT_L(0); PG8_BAR; PG8_MMA(0, 0, At, B0); PG8_MMA(0, 1, At, B1); PG8_BAR; PG8_SCHED;
            PG8_LDA(At, 1, 1); PG8_STAGE(PG8_SB(1, 0), b3, voffB); PG8_STAGE(PG8_SB(1, 1), b3 + hstep, voffB); PG8_STAGE(PG8_SA(1, 0), a3, voffA);
            PG8_WAIT_V(8); PG8_WAIT_L(0); PG8_BAR; PG8_MMA(1, 0, At, B0); PG8_MMA(1, 1, At, B1); PG8_BAR; PG8_SCHED;
            } else {
            PG8_LDB(B0, 0, 0); PG8_SCHED; PG8_LDA(At, 0, 0); PG8_STAGE(PG8_SA(1, 1), a1 + hstep, voffA);
            PG8_WAIT_L(8); PG8_BAR; PG8_WAIT_L(0); PG8_MMA(0, 0, At, B0); PG8_BAR; PG8_SCHED;
            PG8_LDB(B1, 0, 1); PG8_STAGE(PG8_SB(0, 0), b2, voffB);
            PG8_BAR; PG8_WAIT_L(0); PG8_MMA(0, 1, At, B1); PG8_BAR;
            PG8_LDA(At, 0, 1); PG8_STAGE(PG8_SA(0, 0), a2, voffA);
            PG8_BAR; PG8_WAIT_L(0); PG8_MMA(1, 0, At, B0); PG8_BAR; PG8_SCHED;
            PG8_STAGE(PG8_SB(0, 1), b2 + hstep, voffB);
            PG8_WAIT_V(6); PG8_BAR; PG8_MMA(1, 1, At, B1); PG8_BAR;
            PG8_LDB(B0, 1, 0); PG8_SCHED; PG8_LDA(At, 1, 0); PG8_STAGE(PG8_SA(0, 1), a2 + hstep, voffA);
            PG8_WAIT_L(8); PG8_BAR; PG8_WAIT_L(0); PG8_MMA(0, 0, At, B0); PG8_BAR; PG8_SCHED;
            PG8_LDB(B1, 1, 1); PG8_STAGE(PG8_SB(1, 0), b3, voffB);
            PG8_BAR; PG8_WAIT_L(0); PG8_MMA(0, 1, At, B1); PG8_BAR;
            PG8_LDA(At, 1, 1); PG8_STAGE(PG8_SA(1, 0), a3, voffA);
            PG8_BAR; PG8_WAIT_L(0); PG8_MMA(1, 0, At, B0); PG8_BAR; PG8_SCHED;
            PG8_STAGE(PG8_SB(1, 1), b3 + hstep, voffB);
            PG8_WAIT_V(6); PG8_BAR; PG8_MMA(1, 1, At, B1); PG8_BAR;
            }
        }
        if constexpr (ALIGN_EPI) { if (wr == 0) PG8_BAR; }
        if constexpr (!Epi::AFTER_DRAIN) { E(acc, cur, wr, wc, fr, fq); S.done(cur); }
        if (!has_next) break;
#pragma unroll
        for (int a = 0; a < 2; ++a)
#pragma unroll
            for (int b = 0; b < 2; ++b)
#pragma unroll
                for (int m = 0; m < 4; ++m)
#pragma unroll
                    for (int n = 0; n < 2; ++n) acc[a][b][m][n] = (f32x4){0.f, 0.f, 0.f, 0.f};
        cur = nxt; cA = nA; cB = nB; ++ui;
        if constexpr (ALIGN_EPI) { if (wr == 1) PG8_BAR; }
    }
    PG8_WAIT_V(0);
    if constexpr (!ALIGN_EPI) { if (wr == 0) PG8_BAR; }
    PG8_BAR;
    if constexpr (Epi::AFTER_DRAIN) { E.fused(acc, cur, wr, wc, fr, fq, lds, wid, lane); S.done(cur); }
#undef PG8_SA
#undef PG8_SB
#undef PG8_STAGE
#undef PG8_LDA
#undef PG8_LDB
#undef PG8_MMA
#undef PG8_WAIT_V
#undef PG8_WAIT_L
#undef PG8_BAR
#undef PG8_SCHED
}
}
#define GAS __attribute__((address_space(1)))
#define LAS __attribute__((address_space(3)))
typedef unsigned short bf16;
typedef unsigned v4u __attribute__((ext_vector_type(4)));
typedef float f32x4 __attribute__((ext_vector_type(4)));
typedef short bf16x8 __attribute__((ext_vector_type(8)));
typedef GAS unsigned gu32;
typedef GAS unsigned long long gu64;
#define RLX_AGENT __ATOMIC_RELAXED, __HIP_MEMORY_SCOPE_AGENT
#define LDS_WAIT() asm volatile("s_waitcnt lgkmcnt(0)" ::: "memory")
#define VM_WAIT() asm volatile("s_waitcnt vmcnt(0)" ::: "memory")
__device__ __forceinline__ unsigned long long rt() { return __builtin_amdgcn_s_memrealtime(); }
__device__ __forceinline__ unsigned f2bf(float f) { unsigned u = __builtin_bit_cast(unsigned, f); return (u + 0x7fffu + ((u >> 16) & 1u)) >> 16; }
__device__ __forceinline__ unsigned pk2(float lo, float hi) { return f2bf(lo) | (f2bf(hi) << 16); }

#define XB_TMO      128
#define XB_XCNT(j)  (256  + 64 * (j))
#define XB_XSUB(j)  (1280 + 64 * (j))
#define XB_XGEN(j)  (2304 + 64 * (j))
#define XB_TOP      3328
#define XB_TOPGEN   3392
#define XCD_BAR_WORDS 3456
#define XB_SPIN_CAP (1u << 18)

__device__ __forceinline__ unsigned xb_ld(unsigned* p)              { return __hip_atomic_load(p, __ATOMIC_RELAXED, __HIP_MEMORY_SCOPE_AGENT); }
__device__ __forceinline__ unsigned xb_add(unsigned* p, unsigned v) { return __hip_atomic_fetch_add(p, v, __ATOMIC_RELAXED, __HIP_MEMORY_SCOPE_AGENT); }
__device__ __forceinline__ unsigned xb_xcc_id() { return (unsigned)__builtin_amdgcn_s_getreg((3 << 11) | 20) & 0xFu; }
#define XB_SPIN(cond, bar) do { unsigned _sp = 0; while (cond) { __builtin_amdgcn_s_sleep(1); \
    if ((++_sp & 255u) == 0u) { if (xb_ld(&(bar)[XB_TMO])) break; if (_sp > XB_SPIN_CAP) { atomicAdd(&(bar)[XB_TMO], 1u); break; } } } } while (0)

struct XcdBarrier {
    unsigned* bar; unsigned x;
    volatile LAS unsigned* st;
};

__device__ __forceinline__ XcdBarrier xcd_barrier_post(unsigned* bar, volatile LAS unsigned* st) {
    XcdBarrier b; b.bar = bar; b.x = xb_xcc_id(); b.st = st;
    if (threadIdx.x == 0) (void)xb_add(&bar[XB_XCNT(b.x)], 1u);
    return b;
}
__device__ __forceinline__ void xcd_barrier_complete(unsigned* bar, unsigned x, unsigned& nloc, unsigned& nx) {
    const unsigned G = gridDim.x * gridDim.y * gridDim.z;
    unsigned sum, cnt, mine, sp = 0u;
    for (;;) {
        sum = 0u; cnt = 0u; mine = 0u;
#pragma unroll
        for (unsigned j = 0; j < 16; ++j) { const unsigned c = xb_ld(&bar[XB_XCNT(j)]); sum += c; cnt += (c > 0u) ? 1u : 0u; mine = (j == x) ? c : mine; }
        if (sum == G) break;
        __builtin_amdgcn_s_sleep(1);
        if ((++sp & 255u) == 0u) { if (xb_ld(&bar[XB_TMO])) break; if (sp > XB_SPIN_CAP) { atomicAdd(&bar[XB_TMO], 1u); break; } }
    }
    nloc = mine > 0u ? mine : 1u; nx = cnt > 0u ? cnt : 1u;
}

__device__ __forceinline__ void xcd_barrier(const XcdBarrier& b, int wave_s) {
    asm volatile("s_waitcnt vmcnt(0)" ::: "memory");
    __syncthreads();
    if (wave_s == 0 && fresh_lane() == 0) {
        unsigned* bar = b.bar;
        __builtin_amdgcn_s_waitcnt(0);
        unsigned nloc = b.st[0], nx = b.st[1];
        if (nloc == 0u) { xcd_barrier_complete(bar, b.x, nloc, nx); b.st[0] = nloc; b.st[1] = nx; }
        const unsigned old = xb_add(&bar[XB_XSUB(b.x)], 1u);
        const unsigned gen = old / nloc;
        if (old + 1u == (gen + 1u) * nloc) {
            __builtin_amdgcn_fence(__ATOMIC_RELEASE, "agent");
            asm volatile("s_waitcnt vmcnt(0)" ::: "memory");
            const unsigned og = xb_add(&bar[XB_TOP], 1u);
            const unsigned tg = og / nx;
            if (og + 1u == (tg + 1u) * nx) xb_add(&bar[XB_TOPGEN], 1u);
            else XB_SPIN(xb_ld(&bar[XB_TOPGEN]) == tg, bar);
            __builtin_amdgcn_fence(__ATOMIC_ACQUIRE, "agent");
            xb_add(&bar[XB_XGEN(b.x)], 1u);
            asm volatile("s_waitcnt vmcnt(0)" ::: "memory");
        } else {
            XB_SPIN(xb_ld(&bar[XB_XGEN(b.x)]) == gen, bar);
            __builtin_amdgcn_fence(__ATOMIC_ACQUIRE, "agent");
            asm volatile("s_waitcnt vmcnt(0)" ::: "memory");
        }
    }
    __syncthreads();
}
constexpr int NWAVES = 8;
constexpr int DM = 2048, NB = 4, TT = 4096, CT = 256, SB = 4352, MR = NB * SB  , FF = 5632;
constexpr int AB_IN = 4624, ZLD = 4864, CD_IN = 2304, NMOD = 9, MODN = NMOD * DM  ;
constexpr float EPS = 1e-6f;
constexpr int ZA_Q = 0, ZA_K = 1024, ZA_V = 1280, ZB_Q = 1536, ZB_K = 2048, ZB_V = 2560, ZB_O = 3584, ZB_G = 4608;
constexpr int ZC_U = 0, ZD_Q = 1024, ZD_K = 2048, ZD_V = 2176;
constexpr int KSPLIT = 32;
constexpr size_t MiB = 1u << 20;
constexpr size_t WS_CTL = 0, CTL_ZERO_BYTES = 1 * MiB;
constexpr size_t WS_WUP = 1 * MiB;
constexpr size_t WS_WDN = WS_WUP + 4 * 44 * MiB;
constexpr size_t WS_WABIN = WS_WDN + 4 * 22 * MiB;
constexpr size_t WS_WABOUT = WS_WABIN + 19 * MiB;
constexpr size_t WS_WCDIN = WS_WABOUT + 8 * MiB;
constexpr size_t WS_WCDOUT = WS_WCDIN + 9 * MiB;
constexpr size_t WS_WGLU = WS_WCDOUT + 8 * MiB;
constexpr size_t WS_MODP = WS_WGLU + 2 * MiB;
constexpr size_t WS_MODV = WS_MODP + 23 * MiB;
constexpr size_t WS_NRM = WS_MODV + 1 * MiB;
constexpr size_t WS_TAB = WS_NRM + 1 * MiB;
constexpr size_t WS_H = WS_TAB + 4 * MiB;
constexpr size_t WS_HN = WS_H + 136 * MiB;
constexpr size_t WS_X = WS_HN + 68 * MiB;
constexpr size_t WS_Z = WS_X, WS_ZT = WS_X + 163 * MiB, WS_HID = WS_X;
constexpr size_t WS_CAT = WS_X + 216 * MiB;
constexpr size_t WS_GATES = WS_CAT + 68 * MiB;
constexpr size_t WS_KA = WS_GATES + 2 * MiB;
constexpr size_t WS_G = WS_KA + 10 * MiB;
constexpr size_t WS_SC1 = WS_G + 34 * MiB;
constexpr size_t WS_SC2 = WS_SC1 + 68 * MiB;
constexpr size_t WS_END = WS_SC2 + 68 * MiB;
static_assert((size_t)MR * ZLD * 2 <= 163 * MiB && (size_t)1536 * MR * 2 <= 53 * MiB && (size_t)MR * FF * 2 <= 216 * MiB, "overlay");
constexpr size_t TB_ROPEA = 0;
constexpr size_t TB_ROPED = 16384;
constexpr size_t TB_S5AB = 32768;
constexpr size_t TB_S5BB = TB_S5AB + 65536;
constexpr size_t TB_VEC = TB_S5BB + 1048576;
constexpr int TV_GK = 0, TV_GQ = 128, TV_BGATE = 256, TV_SINK = 272, TV_HEADG = 512, TV_DSKIP = 1536, TV_GLUB = 2560, TV_FINALG = 3584, TV_N = 5632;
constexpr size_t TB_S5C = TB_VEC + 32768;
constexpr size_t TB_S5BT = TB_S5C + 1048576;
constexpr size_t TB_S5CT = TB_S5BT + 524288;
constexpr size_t TB_END = TB_S5CT + 524288;
static_assert(TB_END <= 4 * MiB, "tables");
constexpr int CW_TMO = 0, CW_BAR = 4096;
constexpr int RING_OFF = 0, RING_BYTES = 131072;
constexpr int LDSCTL_OFF = RING_BYTES, MISC_OFF = LDSCTL_OFF + 320;
constexpr int LDS_BYTES = 147456;
static_assert(MISC_OFF + 128 <= LDSCTL_OFF + 512 && LDSCTL_OFF + 512 + 8 * 1024 <= LDS_BYTES, "LDS map");
__device__ __forceinline__ float bf2f(bf16 v) { return __builtin_bit_cast(float, (unsigned)v << 16); }
__device__ __forceinline__ float wave_sum(float v) {
#pragma unroll
    for (int o = 1; o < 64; o <<= 1) v += __shfl_xor(v, o);
    return v;
}
__device__ __forceinline__ float wave_sum_l(float v, int lane) {
#pragma unroll
    for (int o = 1; o < 64; o <<= 1) v += __builtin_bit_cast(float, __builtin_amdgcn_ds_bpermute((lane ^ o) << 2, __builtin_bit_cast(int, v)));
    return v;
}
#define OPAQUE(x) asm volatile("" : "+v"(x))
__device__ __forceinline__ float silu_acc(float x) { return x / (1.f + expf(-x)); }
__device__ __forceinline__ float logsigmoid_acc(float x) { return x >= 0.f ? -log1pf(expf(-x)) : x - log1pf(expf(x)); }
__device__ __forceinline__ float gelu_tanh(float x) { const float u = 0.7978845608028654f * (x + 0.044715f * x * x * x); return 0.5f * x * (1.f + tanhf(u)); }
__device__ __forceinline__ int row_sel(int m) { return m < NB * TT ? (m >> 12) : 4; }

struct Frame {
    LAS unsigned char* lds;
    volatile LAS unsigned* MISC;
    gu32* ctl;
    int wave, G;
    float* out; unsigned char* ws;
};

__device__ __forceinline__ void p0_transpose_item(const float* W, int K, int N, int Nvalid, bf16* WT, int drow0, int k0, int n0, LAS float* scr, int lane) {
    const int nn = n0 + (lane & 31); const bool ok = nn < Nvalid;
#pragma unroll
    for (int i = 0; i < 32; ++i) { const int kk = 2 * i + (lane >> 5); scr[kk * 33 + (lane & 31)] = ok ? W[(size_t)(k0 + kk) * N + nn] : 0.f; }
    LDS_WAIT(); asm volatile("" ::: "memory");
    const int c = lane & 7;
#pragma unroll
    for (int j = 0; j < 4; ++j) { const int n = (lane >> 3) + 8 * j; const LAS float* s = scr + (8 * c) * 33 + n;
        v4u o; o.x = pk2(s[0 * 33], s[1 * 33]); o.y = pk2(s[2 * 33], s[3 * 33]); o.z = pk2(s[4 * 33], s[5 * 33]); o.w = pk2(s[6 * 33], s[7 * 33]);
        *(GAS v4u*)(WT + (size_t)(drow0 + n) * K + k0 + 8 * c) = o; }
    LDS_WAIT(); asm volatile("" ::: "memory");
}
__device__ __forceinline__ bool p0_mat(int& r, const float* W, int K, int N, int Npad, bf16* WT, int mode  , LAS float* scr, int lane) {
    const int nblk = Npad / 32, items = (K / 64) * nblk;
    if (r >= items) { r -= items; return false; }
    const int kb = r / nblk, nb = r % nblk, n0 = 32 * nb;
    int drow0 = n0; if (mode) drow0 = (n0 >> 7) * 256 + (n0 & 127) + (mode == 2 ? 128 : 0);
    p0_transpose_item(W, K, N, N, WT, drow0, 64 * kb, n0, scr, lane);
    return true;
}
__device__ __forceinline__ void p0_prologue(Frame& F, const float* const (&in)[30]) {
    LAS float* scr = (LAS float*)(F.lds + RING_OFF + F.wave * 16384);
    const int lane = fresh_lane();
    const int gw = blockIdx.x * NWAVES + F.wave, NGW = F.G * NWAVES;
    unsigned char* ws = F.ws;
    {
        constexpr int NCH = MODN / 256, NIT = 2 * KSPLIT * NCH, KPER = DM / KSPLIT;
        for (int it = gw; it < NIT; it += NGW) {
            const int cc = it % NCH, ks = (it / NCH) % KSPLIT, l = it / (NCH * KSPLIT);
            const float* W = in[4] + (size_t)l * DM * MODN + (size_t)(ks * KPER) * MODN + cc * 256 + lane * 4;
            f32x4 a0 = {0, 0, 0, 0}, a1 = a0, a2 = a0, a3 = a0, a4 = a0;
#pragma unroll 16
            for (int k = 0; k < KPER; ++k) {
                const f32x4 w = *(const f32x4*)(W + (size_t)k * MODN); const int kk = ks * KPER + k;
                const float s0 = silu_acc(in[1][kk]), s1 = silu_acc(in[1][DM + kk]), s2 = silu_acc(in[1][2 * DM + kk]), s3 = silu_acc(in[1][3 * DM + kk]), s4 = silu_acc(in[3][kk]);
                a0 += w * s0; a1 += w * s1; a2 += w * s2; a3 += w * s3; a4 += w * s4;
            }
            float* P = (float*)(ws + WS_MODP) + ((size_t)(l * KSPLIT + ks) * 5) * MODN + cc * 256 + lane * 4;
            *(f32x4*)(P) = a0; *(f32x4*)(P + MODN) = a1; *(f32x4*)(P + 2 * MODN) = a2; *(f32x4*)(P + 3 * MODN) = a3; *(f32x4*)(P + 4 * MODN) = a4;
        }
    }
    {
        constexpr int I_UP = (DM / 64) * (FF / 32), I_DN = (FF / 64) * (DM / 32);
        constexpr int NIT = 8 * I_UP + 4 * I_DN + (DM / 64) * (ZLD / 32) + 2 * (DM / 64) * (DM / 32) + (DM / 64) * (CD_IN / 32) + (1024 / 64) * (1024 / 32);
        for (int it = gw; it < NIT; it += NGW) {
            int r = it; bool done = false;
#pragma unroll 1
            for (int lh = 0; lh < 4 && !done; ++lh) {
                bf16* up = (bf16*)(ws + WS_WUP + (size_t)lh * 44 * MiB);
                done = p0_mat(r, in[7] + (size_t)lh * DM * FF, DM, FF, FF, up, 1, scr, lane); if (done) break;
                done = p0_mat(r, in[8] + (size_t)lh * DM * FF, DM, FF, FF, up, 2, scr, lane); if (done) break;
                done = p0_mat(r, in[9] + (size_t)lh * FF * DM, FF, DM, DM, (bf16*)(ws + WS_WDN + (size_t)lh * 22 * MiB), 0, scr, lane);
            }
            if (done) continue;
            {
                const int nblk = ZLD / 32, items = (DM / 64) * nblk;
                if (r < items) { const int kb = r / nblk, nb = r % nblk; p0_transpose_item(in[10], DM, AB_IN, AB_IN, (bf16*)(ws + WS_WABIN), 32 * nb, 64 * kb, 32 * nb, scr, lane); continue; }
                r -= items;
            }
            if (p0_mat(r, in[12], DM, DM, DM, (bf16*)(ws + WS_WABOUT), 0, scr, lane)) continue;
            if (p0_mat(r, in[16], DM, CD_IN, CD_IN, (bf16*)(ws + WS_WCDIN), 0, scr, lane)) continue;
            if (p0_mat(r, in[17], DM, DM, DM, (bf16*)(ws + WS_WCDOUT), 0, scr, lane)) continue;
            p0_mat(r, in[26], 1024, 1024, 1024, (bf16*)(ws + WS_WGLU), 0, scr, lane);
        }
    }
    {
        const int tid_ = fresh_tid(F.wave); const int gt = blockIdx.x * (NWAVES * 64) + tid_, NT = F.G * NWAVES * 64;
        float* ropeA = (float*)(ws + WS_TAB + TB_ROPEA); float* ropeD = (float*)(ws + WS_TAB + TB_ROPED);
        for (int i = gt; i < 64 * 32; i += NT) { const int pos = i >> 5, f = i & 31; const float inv = powf(10000.f, -(float)f / 32.f), a = (float)pos * inv; ropeA[2 * i] = cosf(a); ropeA[2 * i + 1] = sinf(a); }
        for (int i = gt; i < 64 * 16; i += NT) { const int pos = i >> 4, f = i & 15; const float inv = powf(10000.f, -(float)f / 16.f), a = (float)pos * inv; ropeD[2 * i] = cosf(a); ropeD[2 * i + 1] = sinf(a); }
        float* s5ab = (float*)(ws + WS_TAB + TB_S5AB); float* s5bb = (float*)(ws + WS_TAB + TB_S5BB); bf16* s5bt = (bf16*)(ws + WS_TAB + TB_S5BT); bf16* s5ct = (bf16*)(ws + WS_TAB + TB_S5CT);
        for (int i = gt; i < 2 * 64 * 64; i += NT) {
            const int dg = i >> 6;
            const float are = in[18][i], aim = in[19][i], dt = expf(in[20][dg]);
            const float mag = expf(are * dt), abr = mag * cosf(aim * dt), abi = mag * sinf(aim * dt);
            const float den = are * are + aim * aim, nr = abr - 1.f, ni = abi;
            const float kre = (nr * are + ni * aim) / den, kim = (ni * are - nr * aim) / den;
            s5ab[2 * i] = abr; s5ab[2 * i + 1] = abi;
            for (int q = 0; q < 16; ++q) { const float br = in[21][(size_t)i * 16 + q], bi = in[22][(size_t)i * 16 + q];
                const float bbr = kre * br - kim * bi, bbi = kre * bi + kim * br;
                s5bb[((size_t)i * 16 + q) * 2] = bbr; s5bb[((size_t)i * 16 + q) * 2 + 1] = bbi;
                s5bt[((size_t)dg * 128 + (i & 63)) * 16 + q] = (bf16)f2bf(bbr); s5bt[((size_t)dg * 128 + 64 + (i & 63)) * 16 + q] = (bf16)f2bf(bbi); }
        }
        for (int i = gt; i < 2 * 64 * 16 * 128; i += NT) { const int pp = i & 127, dgo = i >> 7;
            s5ct[i] = (bf16)f2bf(pp < 64 ? in[23][(size_t)dgo * 64 + pp] : -in[24][(size_t)dgo * 64 + pp - 64]); }
        float* tv = (float*)(ws + WS_TAB + TB_VEC);
        for (int i = gt; i < TV_N; i += NT) { float v = 0.f;
            if (i < TV_GQ) v = in[14][i]; else if (i < TV_BGATE) v = in[13][i - TV_GQ]; else if (i < TV_SINK) v = in[11][i - TV_BGATE]; else if (i < TV_SINK + 16) v = in[28][i - TV_SINK];
            else if (i >= TV_HEADG && i < TV_DSKIP) v = in[15][i - TV_HEADG]; else if (i >= TV_DSKIP && i < TV_GLUB) v = in[25][i - TV_DSKIP];
            else if (i >= TV_GLUB && i < TV_FINALG) v = in[27][i - TV_GLUB]; else if (i >= TV_FINALG) v = in[29][i - TV_FINALG];
            tv[i] = v; }
        float* s5c = (float*)(ws + WS_TAB + TB_S5C);
        for (int i = gt; i < 2 * 131072; i += NT) s5c[i] = i < 131072 ? in[23][i] : in[24][i - 131072];
    }
}
__device__ __forceinline__ void p1_modreduce(Frame& F, const float* modb, const float* normg) {
    const int tid_ = fresh_tid(F.wave); const int gt = blockIdx.x * (NWAVES * 64) + tid_, NT = F.G * NWAVES * 64;
    const float* P = (const float*)(F.ws + WS_MODP); float* MV = (float*)(F.ws + WS_MODV); float* NR = (float*)(F.ws + WS_NRM);
    for (int i = gt; i < 2 * 5 * DM; i += NT) {
        const int c = i % DM, sel = (i / DM) % 5, l = i / (5 * DM);
        float mv[9];
#pragma unroll
        for (int idx = 0; idx < 9; ++idx) { float s = 0.f;
            for (int ks = 0; ks < KSPLIT; ++ks) s += P[((size_t)(l * KSPLIT + ks) * 5 + sel) * MODN + idx * DM + c];
            s += modb[l * MODN + idx * DM + c]; mv[idx] = s; MV[((size_t)(l * 5 + sel) * 9 + idx) * DM + c] = s; }
#pragma unroll
        for (int w = 0; w < 3; ++w) { const float g = normg[(l * 3 + w) * DM + c];
            NR[(((size_t)(l * 5 + sel) * 3 + w) * 2) * DM + c] = g * (1.f + mv[3 * w + 1]);
            NR[(((size_t)(l * 5 + sel) * 3 + w) * 2 + 1) * DM + c] = mv[3 * w]; }
    }
}
__device__ __forceinline__ void norm_phase(Frame& F, unsigned char* ws, const float* xin, const float* cin, int l, int which, bool first, int nrows) {
    const int lane = fresh_lane();
    const int gw = blockIdx.x * NWAVES + F.wave, NGW = F.G * NWAVES;
    float* H = (float*)(ws + WS_H); bf16* HN = (bf16*)(ws + WS_HN); const float* NR = (const float*)(ws + WS_NRM);
    for (int m = gw; m < nrows; m += NGW) {
        const float* src = first ? (m < NB * TT ? xin + (size_t)m * DM : cin + (size_t)(m - NB * TT) * DM) : H + (size_t)m * DM;
        const GAS f32x4* xr = (const GAS f32x4*)src + lane;
        f32x4 v[8]; float s = 0.f;
#pragma unroll
        for (int j = 0; j < 8; ++j) { v[j] = xr[64 * j]; s += (v[j].x * v[j].x + v[j].y * v[j].y) + (v[j].z * v[j].z + v[j].w * v[j].w); }
        const float rstd = 1.f / sqrtf(wave_sum_l(s, lane) * (1.f / DM) + EPS);
        if (first) { GAS f32x4* hw = (GAS f32x4*)(H + (size_t)m * DM) + lane;
#pragma unroll
            for (int j = 0; j < 8; ++j) hw[64 * j] = v[j]; }
        const int sel = row_sel(m);
        const GAS f32x4* Ap = (const GAS f32x4*)(NR + (((size_t)(l * 5 + sel) * 3 + which) * 2) * DM) + lane; const GAS f32x4* Bp = Ap + DM / 4;
        GAS unsigned long long* o8 = (GAS unsigned long long*)(HN + (size_t)m * DM) + lane;
#pragma unroll
        for (int j = 0; j < 8; ++j) { const f32x4 a = Ap[64 * j], b = Bp[64 * j]; const f32x4 y = v[j] * rstd * a + b;
            o8[64 * j] = (unsigned long long)pk2(y.x, y.y) | ((unsigned long long)pk2(y.z, y.w) << 32); }
    }
}
__device__ __forceinline__ void final_norm_phase(Frame& F, unsigned char* ws) {
    const int lane = fresh_lane();
    const int gw = blockIdx.x * NWAVES + F.wave, NGW = F.G * NWAVES;
    const float* H = (const float*)(ws + WS_H);
    for (int m = gw; m < NB * TT; m += NGW) {
        const GAS f32x4* xr = (const GAS f32x4*)(H + (size_t)m * DM) + lane;
        f32x4 v[8]; float s = 0.f;
#pragma unroll
        for (int j = 0; j < 8; ++j) { v[j] = xr[64 * j]; s += (v[j].x * v[j].x + v[j].y * v[j].y) + (v[j].z * v[j].z + v[j].w * v[j].w); }
        const float rstd = 1.f / sqrtf(wave_sum_l(s, lane) * (1.f / DM) + EPS);
        const GAS f32x4* gp = (const GAS f32x4*)((const float*)(ws + WS_TAB + TB_VEC) + TV_FINALG) + lane; GAS f32x4* o = (GAS f32x4*)(F.out + (size_t)m * DM) + lane;
#pragma unroll
        for (int j = 0; j < 8; ++j) o[64 * j] = v[j] * rstd * gp[64 * j];
    }
}
template <int MODE> __device__ __forceinline__ void naive_kprep(int gw, int lane, const bf16* Z, bf16* KO, const float* gk, const float* rope) {
    if (MODE == 0) {
        if (gw >= MR * 2) return;
        const int m = gw >> 1, kvh = gw & 1; const bf16* zr = Z + (size_t)m * ZLD + ZA_K + kvh * 128;
        float x1 = bf2f(zr[lane]), x2 = bf2f(zr[64 + lane]);
        const float rstd = 1.f / sqrtf(wave_sum_l(x1 * x1 + x2 * x2, lane) * (1.f / 128.f) + EPS);
        x1 *= rstd * gk[lane]; x2 *= rstd * gk[64 + lane];
        if (m < NB * TT) { const int t = m & (TT - 1), pos = lane < 32 ? (t >> 6) : (t & 63), f = lane & 31; const float c = rope[2 * (pos * 32 + f)], s = rope[2 * (pos * 32 + f) + 1];
            const float o1 = x1 * c - x2 * s, o2 = x2 * c + x1 * s; x1 = o1; x2 = o2; }
        KO[(size_t)m * 256 + kvh * 128 + lane] = (bf16)f2bf(x1); KO[(size_t)m * 256 + kvh * 128 + 64 + lane] = (bf16)f2bf(x2);
    } else {
        if (gw >= MR) return;
        const int m = gw, kvh = lane >> 5, j = lane & 31; const bf16* zr = Z + (size_t)m * CD_IN + ZD_K + kvh * 64;
        float x1 = bf2f(zr[j]), x2 = bf2f(zr[32 + j]);
        if (m < NB * TT) { const int t = m & (TT - 1), pos = j < 16 ? (t >> 6) : (t & 63), f = j & 15; const float c = rope[2 * (pos * 16 + f)], s = rope[2 * (pos * 16 + f) + 1];
            const float o1 = x1 * c - x2 * s, o2 = x2 * c + x1 * s; x1 = o1; x2 = o2; }
        KO[(size_t)m * 128 + kvh * 64 + j] = (bf16)f2bf(x1); KO[(size_t)m * 128 + kvh * 64 + 32 + j] = (bf16)f2bf(x2);
    }
}
template <int DH, int MODE> __device__ __forceinline__ void naive_attn(int vb, int vtid, const bf16* Z, const bf16* KB, bf16* CAT, const float* gq, const float* rope, const float* sink) {
    constexpr int H4 = DH / 4, NF = DH / 4, NH = (MODE == 2) ? 16 : 8, QPB = 128;
    constexpr int NQ = (MODE == 1) ? CT : TT, LDZ = (MODE == 2) ? CD_IN : ZLD, LDK = (MODE == 2) ? 128 : 256;
    constexpr int QCOL = (MODE == 2) ? ZD_Q : ZA_Q, VCOL = (MODE == 2) ? ZD_V : ZA_V, OCOL = (MODE == 2) ? 1024 : 0;
    const int nchunk = NQ / QPB; int bid = vb; const int qc = bid % nchunk; bid /= nchunk; const int head = bid % NH, b = bid / NH;
    const int kvh = head / (NH / 2), part = vtid & 3, r = vtid >> 2, qi = qc * QPB + r;
    const int m = (MODE == 1) ? (NB * TT + b * CT + qi) : (b * TT + qi);
    float q[H4], acc[H4];
    const bf16* qp = Z + (size_t)m * LDZ + QCOL + head * DH + part * H4;
#pragma unroll
    for (int i = 0; i < H4; ++i) { q[i] = bf2f(qp[i]); acc[i] = 0.f; }
    if (MODE != 2) { float ss = 0.f;
#pragma unroll
        for (int i = 0; i < H4; ++i) ss += q[i] * q[i];
        ss += __shfl_xor(ss, 1); ss += __shfl_xor(ss, 2); const float rstd = 1.f / sqrtf(ss * (1.f / DH) + EPS);
#pragma unroll
        for (int i = 0; i < H4; ++i) q[i] *= rstd * gq[part * H4 + i]; }
    if (MODE != 1) { const int t = qi;
#pragma unroll
        for (int i = 0; i < H4; ++i) { const int j = (part & 1) * H4 + i;
            const int pos = j < NF ? (t >> 6) : (t & 63), f = j % NF; const float c = rope[2 * (pos * NF + f)], s = rope[2 * (pos * NF + f) + 1];
            const float other = __shfl_xor(q[i], 2); q[i] = part < 2 ? (q[i] * c - other * s) : (q[i] * c + other * s); } }
    const float scale = (DH == 128) ? 0.08838834764831845f : 0.125f;
#pragma unroll
    for (int i = 0; i < H4; ++i) q[i] *= scale;
    float mx = (MODE == 2) ? sink[head] : -1e30f, l = (MODE == 2) ? 1.f : 0.f;
    const int lat_lo = (MODE == 0) ? 0 : (MODE == 2 ? max(0, qc * QPB - 128) : 0), lat_hi = (MODE == 0) ? TT : (MODE == 2 ? min(TT, qc * QPB + QPB + 128) : 0);
    const int nkeys = CT + (lat_hi - lat_lo);
#pragma unroll 2
    for (int kk = 0; kk < nkeys; ++kk) {
        const int kpos = kk - CT + lat_lo;
        const int km = kk < CT ? (NB * TT + b * CT + kk) : (b * TT + kpos);
        const bf16* kp = KB + (size_t)km * LDK + kvh * DH + part * H4;
        float s = 0.f;
#pragma unroll
        for (int i = 0; i < H4; ++i) s += q[i] * bf2f(kp[i]);
        s += __shfl_xor(s, 1); s += __shfl_xor(s, 2);
        if (MODE == 2 && kk >= CT && abs(kpos - qi) > 128) continue;
        const float mn = fmaxf(mx, s), al = expf(mx - mn), p = expf(s - mn);
        l = l * al + p; mx = mn;
        const bf16* vp = Z + (size_t)km * LDZ + VCOL + kvh * DH + part * H4;
#pragma unroll
        for (int i = 0; i < H4; ++i) acc[i] = acc[i] * al + p * bf2f(vp[i]);
    }
    const float il = 1.f / l;
    bf16* op = CAT + (size_t)m * DM + OCOL + head * DH + part * H4;
#pragma unroll
    for (int i = 0; i < H4; ++i) op[i] = (bf16)f2bf(acc[i] * il);
}
__device__ __forceinline__ void naive_mlstm(int seq, int tid, LAS float* sq, const bf16* Z, const float* GATES, const float* bgate, float* HF, float* HB) {
    const int b = seq >> 3, h = (seq >> 1) & 3, dir = seq & 1;
    LAS float* sk = sq + 128; LAS float* sred = sq + 256;
    const int v = tid >> 1, half = tid & 1, lane = tid & 63, wave = tid >> 6;
    float C[64];
#pragma unroll
    for (int j = 0; j < 64; ++j) C[j] = 0.f;
    float nreg = 0.f, mstate = 0.f;
    const float bi = bgate[(2 * dir) * 4 + h], bfg = bgate[(2 * dir + 1) * 4 + h];
    float* HO = dir ? HB : HF;
    for (int p = 0; p < SB; ++p) {
        const int s = dir == 0 ? p : (p < CT ? CT - 1 - p : CT + (SB - 1 - p));
        const int m = s < CT ? (NB * TT + b * CT + s) : (b * TT + s - CT);
        const bf16* zr = Z + (size_t)m * ZLD;
        if (tid < 128) sq[tid] = bf2f(zr[ZB_Q + h * 128 + tid]) * 0.08838834764831845f; else if (tid < 256) sk[tid - 128] = bf2f(zr[ZB_K + h * 128 + tid - 128]);
        const float vv = bf2f(zr[ZB_V + h * 256 + v]);
        const float ig = GATES[(size_t)m * 16 + (2 * dir) * 4 + h] + bi, lf = logsigmoid_acc(GATES[(size_t)m * 16 + (2 * dir + 1) * 4 + h] + bfg);
        const float mn = fmaxf(lf + mstate, ig), ip = expf(ig - mn), fp = expf(lf + mstate - mn); mstate = mn;
        __syncthreads();
        float dpart = 0.f; if (tid < 128) { nreg = fp * nreg + ip * sk[tid]; dpart = nreg * sq[tid]; }
        if (wave < 2) { dpart = wave_sum_l(dpart, lane); if (lane == 0) sred[wave] = dpart; }
        float np = 0.f; const float iv = ip * vv;
#pragma unroll
        for (int j = 0; j < 64; ++j) { C[j] = fp * C[j] + iv * sk[64 * half + j]; np += C[j] * sq[64 * half + j]; }
        np += __builtin_bit_cast(float, __builtin_amdgcn_ds_bpermute((lane ^ 1) << 2, __builtin_bit_cast(int, np)));
        __syncthreads();
        const float den = sred[0] + sred[1];
        if (half == 0) HO[(size_t)m * 1024 + h * 256 + v] = np / fmaxf(fabsf(den), expf(-mn));
        __syncthreads();
    }
}
__device__ __forceinline__ void naive_mlstm_finish(int gw, int lane, const bf16* Z, const float* HF, const float* HB, const float* headg, bf16* CAT) {
    const int m = gw >> 2, h = gw & 3; const size_t o = (size_t)m * 1024 + h * 256 + lane * 4;
    const f32x4 a = *(const f32x4*)(HF + o), bb = *(const f32x4*)(HB + o); const f32x4 hh = a + bb;
    const float rstd = 1.f / sqrtf(wave_sum_l((hh.x * hh.x + hh.y * hh.y) + (hh.z * hh.z + hh.w * hh.w), lane) * (1.f / 256.f) + EPS);
    const bf16* og = Z + (size_t)m * ZLD + ZB_O + h * 256 + lane * 4; bf16* cp = CAT + (size_t)m * DM + 1024 + h * 256 + lane * 4;
#pragma unroll
    for (int j = 0; j < 4; ++j) { const float sg = 1.f / (1.f + expf(-bf2f(og[j]))); cp[j] = (bf16)f2bf(sg * hh[j] * rstd * headg[h * 256 + lane * 4 + j]); }
}
__device__ __forceinline__ void naive_s5(int id, int lane, const bf16* Z, const float* s5ab, const float* s5bb, const float* cre_in, const float* cim_in, float* YF, float* YB) {
    const int b = id >> 7, g = (id >> 1) & 63, dir = id & 1;
    const int i = (dir * 64 + g) * 64 + lane;
    const float ar = s5ab[2 * i], ai = s5ab[2 * i + 1];
    float Br[16], Bi[16], cr[16], ci[16];
#pragma unroll
    for (int q = 0; q < 16; ++q) { Br[q] = s5bb[((size_t)i * 16 + q) * 2]; Bi[q] = s5bb[((size_t)i * 16 + q) * 2 + 1];
        cr[q] = cre_in[((size_t)(dir * 64 + g) * 16 + q) * 64 + lane]; ci[q] = cim_in[((size_t)(dir * 64 + g) * 16 + q) * 64 + lane]; }
    float xr = 0.f, xi = 0.f; float* Y = dir ? YB : YF;
    for (int p = 0; p < SB; ++p) {
        const int s = dir == 0 ? p : (p < CT ? CT - 1 - p : CT + (SB - 1 - p));
        const int m = s < CT ? (NB * TT + b * CT + s) : (b * TT + s - CT);
        const bf16* up = Z + (size_t)m * CD_IN + ZC_U + g * 16;
        float bur = 0.f, bui = 0.f;
#pragma unroll
        for (int q = 0; q < 16; ++q) { const float u = bf2f(up[q]); bur += Br[q] * u; bui += Bi[q] * u; }
        const float nxr = ar * xr - ai * xi + bur, nxi = ar * xi + ai * xr + bui; xr = nxr; xi = nxi;
        if (s >= CT) { float yo = 0.f;
#pragma unroll
            for (int q = 0; q < 16; ++q) { const float val = wave_sum_l(cr[q] * xr - ci[q] * xi, lane); if (lane == q) yo = val; }
            if (lane < 16) Y[(size_t)m * 1024 + g * 16 + lane] = yo; }
    }
}
__device__ __forceinline__ void naive_s5_finish(size_t i, const bf16* Z, const float* YF, const float* YB, const float* dskip, bf16* G) {
    const int m = (int)(i >> 10), c = (int)(i & 1023);
    const float y = YF[i] + YB[i] + dskip[c] * bf2f(Z[(size_t)m * CD_IN + ZC_U + c]);
    G[i] = (bf16)f2bf(gelu_tanh(y));
}
namespace att {
using bf16x8 = __attribute__((ext_vector_type(8))) short;
using s16x4  = __attribute__((ext_vector_type(4))) short;
using f32x16 = __attribute__((ext_vector_type(16))) float;
using u32x4  = __attribute__((ext_vector_type(4))) unsigned;
constexpr int NW = 8, QBLK = 32, KVBLK = 64;
constexpr size_t SHM_V = KVBLK * 128 * 2, SHM_K = KVBLK * 128 * 2, SHM_ATTN = 2 * SHM_V + 2 * SHM_K + NW * 64 * 4;
#define KSWZ(row, colB) ((row) * 256 + ((colB) ^ (((row) & 7) << 4)))
#define SBAR() __builtin_amdgcn_sched_barrier(0)
__device__ __forceinline__ int crow(int r, int hi) { return (r & 3) + 8 * (r >> 2) + 4 * hi; }
__device__ __forceinline__ unsigned cvtpk(float lo, float hi) { unsigned r; asm volatile("v_cvt_pk_bf16_f32 %0, %1, %2" : "=v"(r) : "v"(lo), "v"(hi)); return r; }
template <int DH> struct Cst { static constexpr float SCALE = (DH == 128) ? 0.088388347648318440f : 0.125f; };
constexpr float THR = 8.f;
#ifndef ATT_SDEPTH
#define ATT_SDEPTH 2
#endif
constexpr int SDEPTH = ATT_SDEPTH;
template <int DH> __device__ __forceinline__ void partialSM(f32x16& p0, f32x16& p1, float& m_reg, float& mn, float& alpha) {
  constexpr float SCALE = Cst<DH>::SCALE, C = SCALE * 1.4426950408889634f;
  float pmax = p0[0]; for (int r = 1; r < 16; ++r) pmax = fmaxf(pmax, p0[r]); for (int r = 0; r < 16; ++r) pmax = fmaxf(pmax, p1[r]);
  { auto rr = __builtin_amdgcn_permlane32_swap(__float_as_uint(pmax), __float_as_uint(pmax), false, false);
    pmax = fmaxf(__uint_as_float(rr[0]), __uint_as_float(rr[1])); }
  if (__builtin_expect(__all(pmax - m_reg <= THR / SCALE), 1)) { mn = m_reg; alpha = 1.f; }
  else { mn = fmaxf(m_reg, pmax); alpha = __builtin_amdgcn_exp2f((m_reg - mn) * C); m_reg = mn; }
  float mnC = -mn * C;
  for (int r = 0; r < 16; ++r) p0[r] = fmaf(p0[r], C, mnC); for (int r = 0; r < 16; ++r) p1[r] = fmaf(p1[r], C, mnC);
  for (int r = 0; r < 16; ++r) p0[r] = __builtin_amdgcn_exp2f(p0[r]);
}
__device__ __forceinline__ void finishSM(f32x16& p0, f32x16& p1, float alpha, float& l_reg, bf16x8& pa0, bf16x8& pa1, bf16x8& pa2, bf16x8& pa3) {
  for (int r = 0; r < 16; ++r) p1[r] = __builtin_amdgcn_exp2f(p1[r]);
  float ps = 0; for (int r = 0; r < 16; ++r) ps += p0[r]; for (int r = 0; r < 16; ++r) ps += p1[r];
  { auto rr = __builtin_amdgcn_permlane32_swap(__float_as_uint(ps), __float_as_uint(ps), false, false);
    ps = __uint_as_float(rr[0]) + __uint_as_float(rr[1]); }
  l_reg = l_reg * alpha + ps;
#define PK4(P, BASE, OUT) do { unsigned a0 = cvtpk(P[BASE + 0], P[BASE + 1]), a1 = cvtpk(P[BASE + 2], P[BASE + 3]);   \
    unsigned b0 = cvtpk(P[BASE + 4], P[BASE + 5]), b1 = cvtpk(P[BASE + 6], P[BASE + 7]);                              \
    auto r0 = __builtin_amdgcn_permlane32_swap(a0, b0, false, false); auto r1 = __builtin_amdgcn_permlane32_swap(a1, b1, false, false); \
    u32x4 w = {r0[0], r1[0], r0[1], r1[1]}; OUT = *reinterpret_cast<bf16x8*>(&w); } while (0)
  PK4(p0, 0, pa0); PK4(p0, 8, pa1); PK4(p1, 0, pa2); PK4(p1, 8, pa3);
#undef PK4
}
template <int DH> __device__ __forceinline__ void qkt(f32x16& p0, f32x16& p1, const bf16* Ks, const bf16x8* qr, int r32, int hi) {
  p0 = f32x16{}; p1 = f32x16{};
#pragma unroll
  for (int d0 = 0; d0 < DH / 16; ++d0) { int cb = (d0 * 16 + hi * 8) * 2;
    bf16x8 b0 = *reinterpret_cast<const bf16x8*>((const char*)Ks + KSWZ(r32, cb));
    bf16x8 b1 = *reinterpret_cast<const bf16x8*>((const char*)Ks + KSWZ(32 + r32, cb));
    p0 = __builtin_amdgcn_mfma_f32_32x32x16_bf16(b0, qr[d0], p0, 0, 0, 0);
    p1 = __builtin_amdgcn_mfma_f32_32x32x16_bf16(b1, qr[d0], p1, 0, 0, 0); }
}
__device__ __forceinline__ void wmask(f32x16& p0, f32x16& p1, int kp0, int qpos, int hi) {
#pragma unroll
  for (int r = 0; r < 16; ++r) { const int k = kp0 + crow(r, hi); const int d0 = k - qpos, d1 = k + 32 - qpos;
    if (d0 > 128 || d0 < -128) p0[r] = -1e30f; if (d1 > 128 || d1 < -128) p1[r] = -1e30f; }
}
__device__ __forceinline__ int v_st(int k, int c) { const int kk = (k & ~0xC) | ((k & 4) << 1) | ((k & 8) >> 1); return ((kk >> 3) * 4 + (c >> 5)) * 512 + ((kk & 7) * 32 + (c & 31)) * 2; }
__device__ __forceinline__ int v_rd_base(int lane) { return ((lane & 3) << 3) | (((lane >> 2) & 3) << 6) | (((lane >> 4) & 1) << 5) | (((lane >> 5) & 1) << 8); }
constexpr int v_rd_off(int d0, int ks, int half) { return d0 * 512 + ks * 4096 + half * 2048; }
template <int OFF> __device__ __forceinline__ s16x4 tr_read(int vb) {
  s16x4 r; asm volatile("ds_read_b64_tr_b16 %0, %1 offset:%2" : "=&v"(r) : "v"(vb), "i"(OFF) : "memory"); return r;
}
template <int D0> __device__ __forceinline__ void pv_one(f32x16& od, int vb, bf16x8 pa0, bf16x8 pa1, bf16x8 pa2, bf16x8 pa3) {
  const s16x4 l0 = tr_read<v_rd_off(D0, 0, 0)>(vb), h0 = tr_read<v_rd_off(D0, 0, 1)>(vb), l1 = tr_read<v_rd_off(D0, 1, 0)>(vb), h1 = tr_read<v_rd_off(D0, 1, 1)>(vb);
  const s16x4 l2 = tr_read<v_rd_off(D0, 2, 0)>(vb), h2 = tr_read<v_rd_off(D0, 2, 1)>(vb), l3 = tr_read<v_rd_off(D0, 3, 0)>(vb), h3 = tr_read<v_rd_off(D0, 3, 1)>(vb);
  asm volatile("s_waitcnt lgkmcnt(0)" ::: "memory"); SBAR();
#define PK(L, H) (bf16x8){L[0], L[1], L[2], L[3], H[0], H[1], H[2], H[3]}
  od = __builtin_amdgcn_mfma_f32_32x32x16_bf16(pa0, PK(l0, h0), od, 0, 0, 0);
  od = __builtin_amdgcn_mfma_f32_32x32x16_bf16(pa1, PK(l1, h1), od, 0, 0, 0);
  od = __builtin_amdgcn_mfma_f32_32x32x16_bf16(pa2, PK(l2, h2), od, 0, 0, 0);
  od = __builtin_amdgcn_mfma_f32_32x32x16_bf16(pa3, PK(l3, h3), od, 0, 0, 0);
#undef PK
}
template <int DH> __device__ __forceinline__ void pv_d0(f32x16* o, int vb, bf16x8 pa0, bf16x8 pa1, bf16x8 pa2, bf16x8 pa3) {
  pv_one<0>(o[0], vb, pa0, pa1, pa2, pa3); pv_one<1>(o[1], vb, pa0, pa1, pa2, pa3);
  if (DH == 128) { pv_one<2>(o[2], vb, pa0, pa1, pa2, pa3); pv_one<3>(o[3], vb, pa0, pa1, pa2, pa3); }
}
template <int DH, int MODE>
__device__ __forceinline__ void attn_unit(const bf16* __restrict__ Qb, int LDQ, const bf16* __restrict__ Kb, int LDKK, const bf16* __restrict__ Vb, int LDKV, bf16* __restrict__ Ob,
                                          int b, int i0  , const float* __restrict__ gq, const float* __restrict__ rope, float sinkv, char* lds, int wave_s) {
  const int tid = fresh_tid(wave_s);
  constexpr float SCALE = Cst<DH>::SCALE;
  const int wid = tid >> 6, lane = tid & 63, r32 = lane & 31, hi = lane >> 5;
  bf16* V_lds = (bf16*)lds; bf16* K_lds = (bf16*)(lds + 2 * SHM_V);
  float* ws = (float*)(lds + 2 * SHM_V + 2 * SHM_K) + wid * 64; float* li_l = ws; float* al_l = ws + 32;
  float m_reg = (MODE == 2) ? sinkv / SCALE : -1e30f, l_reg = (MODE == 2) ? 1.f : 0.f; f32x16 o[DH / 32] = {}; bf16x8 qr[DH / 16];
  const int qpos = i0 + wid * QBLK + r32;
  {
    const bf16* Qw = Qb + (long)(wid * QBLK + r32) * LDQ + hi * 8;
    float qf[DH / 16][8];
#pragma unroll
    for (int d0 = 0; d0 < DH / 16; ++d0) { const u32x4 w = *reinterpret_cast<const u32x4*>(Qw + d0 * 16);
#pragma unroll
      for (int e = 0; e < 4; ++e) { qf[d0][2 * e] = __uint_as_float(w[e] << 16); qf[d0][2 * e + 1] = __uint_as_float(w[e] & 0xffff0000u); } }
    if (MODE != 2) { float ss = 0.f;
#pragma unroll
      for (int d0 = 0; d0 < DH / 16; ++d0)
#pragma unroll
        for (int e = 0; e < 8; ++e) ss += qf[d0][e] * qf[d0][e];
      { auto rr = __builtin_amdgcn_permlane32_swap(__float_as_uint(ss), __float_as_uint(ss), false, false); ss = __uint_as_float(rr[0]) + __uint_as_float(rr[1]); }
      const float rstd = 1.f / sqrtf(ss * (1.f / DH) + EPS);
#pragma unroll
      for (int d0 = 0; d0 < DH / 16; ++d0)
#pragma unroll
        for (int e = 0; e < 8; ++e) qf[d0][e] *= rstd * ((const GAS float*)gq)[d0 * 16 + hi * 8 + e]; }
    if (MODE != 1) { constexpr int NF = DH / 4;
#pragma unroll
      for (int d0 = 0; d0 < DH / 32; ++d0)
#pragma unroll
        for (int e = 0; e < 8; ++e) { const int j = d0 * 16 + hi * 8 + e, pos = j < NF ? (qpos >> 6) : (qpos & 63), f = j % NF;
          const float c = ((const GAS float*)rope)[2 * (pos * NF + f)], s = ((const GAS float*)rope)[2 * (pos * NF + f) + 1], x1 = qf[d0][e], x2 = qf[d0 + DH / 32][e];
          qf[d0][e] = x1 * c - x2 * s; qf[d0 + DH / 32][e] = x2 * c + x1 * s; } }
#pragma unroll
    for (int d0 = 0; d0 < DH / 16; ++d0) { u32x4 w = {cvtpk(qf[d0][0], qf[d0][1]), cvtpk(qf[d0][2], qf[d0][3]), cvtpk(qf[d0][4], qf[d0][5]), cvtpk(qf[d0][6], qf[d0][7])}; qr[d0] = *reinterpret_cast<bf16x8*>(&w); }
  }
  const int kl0 = (MODE == 2) ? (i0 - 128 < 0 ? 0 : i0 - 128) : 0;
  const int kl1 = (MODE == 0) ? TT : (MODE == 2 ? (i0 + 384 > TT ? TT : i0 + 384) : 0);
  const int NT = 4 + (kl1 - kl0) / KVBLK;
  const long ctx0 = (long)NB * TT + (long)b * CT, lat0 = (long)b * TT + kl0;
#define TROW(j) ((j) < 4 ? ctx0 + (j) * KVBLK : lat0 + ((j) - 4) * KVBLK)
  const int sr = tid >> 4, sc = (tid & 15) * 8, vst0 = v_st(sr, sc), vst1 = v_st(32 + sr, sc);
  const bool ldok = (DH == 128) || sc < 64;
  const int vb0 = (int)(uintptr_t)V_lds + v_rd_base(lane);
  struct { bf16x8 vs0, vs1, ks0, ks1; } sr_[SDEPTH];
#pragma unroll
  for (int i_ = 0; i_ < SDEPTH; ++i_) sr_[i_].vs0 = sr_[i_].vs1 = sr_[i_].ks0 = sr_[i_].ks1 = bf16x8{};
#define SLOAD(i, j) do { if (ldok) { const long _r = TROW(j); sr_[i].vs0 = *reinterpret_cast<const bf16x8*>(&Vb[(_r + sr) * LDKV + sc]); sr_[i].vs1 = *reinterpret_cast<const bf16x8*>(&Vb[(_r + 32 + sr) * LDKV + sc]); \
    sr_[i].ks0 = *reinterpret_cast<const bf16x8*>(&Kb[(_r + sr) * LDKK + sc]); sr_[i].ks1 = *reinterpret_cast<const bf16x8*>(&Kb[(_r + 32 + sr) * LDKK + sc]); } } while (0)
#define SWRITE(bb, i) do { *(bf16x8*)((char*)V_lds + (bb) * SHM_V + vst0) = sr_[i].vs0;          \
    *(bf16x8*)((char*)V_lds + (bb) * SHM_V + vst1) = sr_[i].vs1; int kc = sc * 2;               \
    *(bf16x8*)((char*)K_lds + (bb) * SHM_K + KSWZ(sr, kc)) = sr_[i].ks0;                       \
    *(bf16x8*)((char*)K_lds + (bb) * SHM_K + KSWZ(32 + sr, kc)) = sr_[i].ks1; } while (0)
#define SWAIT() do { if (SDEPTH == 2) asm volatile("s_waitcnt vmcnt(4)" ::: "memory"); else asm volatile("s_waitcnt vmcnt(0)" ::: "memory"); } while (0)
#define RESC(a) do { if (__any((a) < 1.f)) { if (hi == 0) al_l[r32] = (a); asm volatile("s_waitcnt lgkmcnt(0)" ::: "memory"); \
    for (int d = 0; d < DH / 32; ++d) for (int r = 0; r < 16; ++r) o[d][r] *= al_l[crow(r, hi)]; } } while (0)
#define WMASK(P0, P1, j) do { if (MODE == 2 && (j) >= 4) wmask(P0, P1, kl0 + ((j) - 4) * KVBLK, qpos, hi); } while (0)
  f32x16 pA0, pA1, pB0, pB1; float mnA, mnB, alA, alB; bf16x8 pa0, pa1, pa2, pa3;
  constexpr int SE = 0, SO = SDEPTH - 1;
  SLOAD(SE, 0); asm volatile("s_waitcnt vmcnt(0)" ::: "memory"); SWRITE(0, SE); __syncthreads();
  qkt<DH>(pA0, pA1, K_lds, qr, r32, hi); WMASK(pA0, pA1, 0); partialSM<DH>(pA0, pA1, m_reg, mnA, alA);
  SLOAD(SO, 1); if (SDEPTH == 2) { if (2 < NT) SLOAD(SE, 2); }
  SWAIT(); SWRITE(1, SO); __syncthreads();
  for (int j = 1; j + 1 < NT; j += 2) {
    SBAR(); qkt<DH>(pB0, pB1, (bf16*)((char*)K_lds + SHM_K), qr, r32, hi); WMASK(pB0, pB1, j);
    finishSM(pA0, pA1, alA, l_reg, pa0, pa1, pa2, pa3); SBAR();
    SLOAD(SO, j + SDEPTH < NT ? j + SDEPTH : j); SBAR();
    pv_d0<DH>(o, vb0, pa0, pa1, pa2, pa3); partialSM<DH>(pB0, pB1, m_reg, mnB, alB);
    __syncthreads(); SWAIT(); SWRITE(0, SE);
    RESC(alB); __syncthreads();
    SBAR(); qkt<DH>(pA0, pA1, K_lds, qr, r32, hi); WMASK(pA0, pA1, j + 1);
    finishSM(pB0, pB1, alB, l_reg, pa0, pa1, pa2, pa3); SBAR();
    SLOAD(SE, j + 1 + SDEPTH < NT ? j + 1 + SDEPTH : j + 1); SBAR();
    pv_d0<DH>(o, vb0 + (int)SHM_V, pa0, pa1, pa2, pa3); partialSM<DH>(pA0, pA1, m_reg, mnA, alA);
    __syncthreads(); SWAIT(); SWRITE(1, SO);
    RESC(alA); __syncthreads();
  }
  SBAR(); qkt<DH>(pB0, pB1, (bf16*)((char*)K_lds + SHM_K), qr, r32, hi); WMASK(pB0, pB1, NT - 1);
  finishSM(pA0, pA1, alA, l_reg, pa0, pa1, pa2, pa3); SBAR();
  pv_d0<DH>(o, vb0, pa0, pa1, pa2, pa3); partialSM<DH>(pB0, pB1, m_reg, mnB, alB);
  __syncthreads(); RESC(alB);
  finishSM(pB0, pB1, alB, l_reg, pa0, pa1, pa2, pa3); SBAR();
  pv_d0<DH>(o, vb0 + (int)SHM_V, pa0, pa1, pa2, pa3);
  if (hi == 0) li_l[r32] = l_reg; asm volatile("s_waitcnt lgkmcnt(0)" ::: "memory");
  float rli[16];
#pragma unroll
  for (int r = 0; r < 16; ++r) rli[r] = __builtin_amdgcn_rcpf(li_l[crow(r, hi)]);
  bf16* Ow = Ob + (long)(wid * QBLK) * DM;
#pragma unroll
  for (int r = 0; r < 16; ++r) { int orow = crow(r, hi);
#pragma unroll
    for (int d0 = 0; d0 < DH / 32; ++d0) Ow[(long)orow * DM + d0 * 32 + r32] = (bf16)(cvtpk(o[d0][r] * rli[r], 0.f) & 0xffffu); }
  asm volatile("s_waitcnt vmcnt(0)" ::: "memory"); __syncthreads();
#undef SLOAD
#undef SWRITE
#undef SWAIT
#undef RESC
#undef WMASK
#undef TROW
}
}
namespace s5 {
using bf16x8 = __attribute__((ext_vector_type(8))) short;
using f32x16 = __attribute__((ext_vector_type(16))) float;
using f32x4v = __attribute__((ext_vector_type(4))) float;
using u32x4 = __attribute__((ext_vector_type(4))) unsigned;
using u32x2 = __attribute__((ext_vector_type(2))) unsigned;
constexpr int XROWB = 272;
constexpr int WAVE_LDS = 32 * XROWB;
__device__ __forceinline__ float bperm(float v, int srclane) { return __builtin_bit_cast(float, __builtin_amdgcn_ds_bpermute(srclane << 2, __builtin_bit_cast(int, v))); }
__device__ __forceinline__ void cmul(float& r, float& i, float ar, float ai) { const float nr = ar * r - ai * i, ni = ar * i + ai * r; r = nr; i = ni; }
__device__ __forceinline__ size_t seg_row0(int b, int seg) { return seg < 16 ? (size_t)b * TT + seg * 256 : (size_t)NB * TT + b * CT; }
template <int PASS>
__device__ __forceinline__ void s5_unit(int b, int g, int seg, const bf16* __restrict__ Z2, const float* __restrict__ s5ab, const bf16* __restrict__ BT, const bf16* __restrict__ CTb,
                                        float* __restrict__ SEND, const float* __restrict__ dskip, bf16* __restrict__ G, LAS unsigned char* xl) {
  const int lane = fresh_lane();
  const int r32 = lane & 31, hi = lane >> 5;
  const size_t row0 = seg_row0(b, seg);
  const int tau = 16 * ((r32 >> 2) & 1) + 4 * (r32 >> 3) + (r32 & 3);
  f32x4v accy[8][2];
  if (PASS == 2) {
#pragma unroll
    for (int q = 0; q < 8; ++q) { accy[q][0] = (f32x4v){0.f, 0.f, 0.f, 0.f}; accy[q][1] = accy[q][0]; }
  }
#pragma unroll
  for (int dir = 0; dir < 2; ++dir) {
    const int dg = dir * 64 + g;
    float ar[2], ai[2], a16r[2], a16i[2];
#pragma unroll
    for (int s = 0; s < 2; ++s) { typedef float f32x2s __attribute__((ext_vector_type(2))); const f32x2s v = *(const GAS f32x2s*)(s5ab + 2 * (dg * 64 + r32 + 32 * s)); ar[s] = v.x; ai[s] = v.y; a16r[s] = v.x; a16i[s] = v.y;
#pragma unroll
      for (int k = 0; k < 4; ++k) cmul(a16r[s], a16i[s], a16r[s], a16i[s]); }
    bf16x8 bfr[4];
#pragma unroll
    for (int k = 0; k < 4; ++k) bfr[k] = *(const GAS bf16x8*)(BT + ((size_t)dg * 128 + 32 * k + r32) * 16 + hi * 8);
    float cr[2] = {0.f, 0.f}, ci[2] = {0.f, 0.f};
    if (PASS == 2) {
      float a256r[2], a256i[2];
#pragma unroll
      for (int s = 0; s < 2; ++s) { a256r[s] = a16r[s]; a256i[s] = a16i[s];
#pragma unroll
        for (int k = 0; k < 4; ++k) cmul(a256r[s], a256i[s], a256r[s], a256i[s]); }
      const float* Sb = SEND + ((size_t)(dir * NB + b) * 64 + g) * 17 * 128;
      { const float* p = Sb + 16 * 128;
#pragma unroll
        for (int s = 0; s < 2; ++s) { cr[s] = p[r32 + 32 * s]; ci[s] = p[64 + r32 + 32 * s]; } }
      const int nprev = dir == 0 ? seg : 15 - seg;
      for (int k = 0; k < nprev; ++k) { const float* p = Sb + (dir == 0 ? k : 15 - k) * 128;
#pragma unroll
        for (int s = 0; s < 2; ++s) { cmul(cr[s], ci[s], a256r[s], a256i[s]); cr[s] += p[r32 + 32 * s]; ci[s] += p[64 + r32 + 32 * s]; } }
    }
    const bf16* CT_dg = CTb + (size_t)dg * 16 * 128;
#pragma unroll
    for (int qq = 0; qq < 8; ++qq) {
      const int q = dir == 0 ? qq : 7 - qq;
      const int rloc = dir == 0 ? tau : 31 - tau;
      const bf16x8 ufr = *(const GAS bf16x8*)(Z2 + (row0 + 32 * q + rloc) * CD_IN + ZC_U + g * 16 + hi * 8);
      f32x16 bu[4];
#pragma unroll
      for (int k = 0; k < 4; ++k) { bu[k] = f32x16{}; bu[k] = __builtin_amdgcn_mfma_f32_32x32x16_bf16(ufr, bfr[k], bu[k], 0, 0, 0); }
#pragma unroll
      for (int s = 0; s < 2; ++s) { float xr = 0.f, xi = 0.f;
#pragma unroll
        for (int r = 0; r < 16; ++r) { const float nr = ar[s] * xr - ai[s] * xi + bu[s][r], ni = ar[s] * xi + ai[s] * xr + bu[2 + s][r]; xr = nr; xi = ni; bu[s][r] = xr; bu[2 + s][r] = xi; } }
#pragma unroll
      for (int s = 0; s < 2; ++s) {
        const float per = bperm(bu[s][15], lane ^ 32), pei = bperm(bu[2 + s][15], lane ^ 32);
        float c1r = cr[s], c1i = ci[s]; cmul(c1r, c1i, a16r[s], a16i[s]); c1r += per; c1i += pei;
        float cxr = hi ? c1r : cr[s], cxi = hi ? c1i : ci[s];
#pragma unroll
        for (int r = 0; r < 16; ++r) { cmul(cxr, cxi, ar[s], ai[s]); bu[s][r] += cxr; bu[2 + s][r] += cxi; }
        const float ner = bperm(bu[s][15], lane ^ 32), nei = bperm(bu[2 + s][15], lane ^ 32);
        cr[s] = hi ? bu[s][15] : ner; ci[s] = hi ? bu[2 + s][15] : nei;
      }
      if (PASS == 2) {
#pragma unroll
        for (int k = 0; k < 4; ++k)
#pragma unroll
          for (int r = 0; r < 16; ++r) { const int st = 16 * hi + r, rl = dir == 0 ? st : 31 - st;
            *(LAS unsigned short*)(xl + rl * XROWB + (32 * k + r32) * 2) = (unsigned short)f2bf(bu[k][r]); }
        asm volatile("s_waitcnt lgkmcnt(0)" ::: "memory");
        const int fr = lane & 15, fq = lane >> 4;
#pragma unroll
        for (int ks = 0; ks < 4; ++ks) { const bf16x8 cf = *(const GAS bf16x8*)(CT_dg + fr * 128 + 32 * ks + 8 * fq);
#pragma unroll
          for (int mb = 0; mb < 2; ++mb) { const bf16x8 xf = *(const LAS bf16x8*)(xl + (16 * mb + fr) * XROWB + (32 * ks + 8 * fq) * 2);
            accy[q][mb] = __builtin_amdgcn_mfma_f32_16x16x32_bf16(cf, xf, accy[q][mb], 0, 0, 0); } }
        asm volatile("s_waitcnt lgkmcnt(0)" ::: "memory");
      }
    }
    if (PASS == 1) { float* p = SEND + (((size_t)(dir * NB + b) * 64 + g) * 17 + seg) * 128;
      if (hi == 0) {
#pragma unroll
        for (int s = 0; s < 2; ++s) { p[r32 + 32 * s] = cr[s]; p[64 + r32 + 32 * s] = ci[s]; } } }
  }
  if (PASS == 2) {
    const int fr = lane & 15, fq = lane >> 4;
    const f32x4v dk = *(const GAS f32x4v*)(dskip + g * 16 + 4 * fq);
#pragma unroll
    for (int q = 0; q < 8; ++q)
#pragma unroll
      for (int mb = 0; mb < 2; ++mb) { const size_t row = row0 + 32 * q + 16 * mb + fr;
        const u32x2 uw = *(const GAS u32x2*)(Z2 + row * CD_IN + ZC_U + g * 16 + 4 * fq);
        const float u0 = __builtin_bit_cast(float, uw.x << 16), u1 = __builtin_bit_cast(float, uw.x & 0xffff0000u), u2 = __builtin_bit_cast(float, uw.y << 16), u3 = __builtin_bit_cast(float, uw.y & 0xffff0000u);
        const float y0 = gelu_tanh(accy[q][mb][0] + dk[0] * u0), y1 = gelu_tanh(accy[q][mb][1] + dk[1] * u1), y2 = gelu_tanh(accy[q][mb][2] + dk[2] * u2), y3 = gelu_tanh(accy[q][mb][3] + dk[3] * u3);
        u32x2 w; w.x = pk2(y0, y1); w.y = pk2(y2, y3);
        *(GAS u32x2*)(G + row * 1024 + g * 16 + 4 * fq) = w; }
  }
}
}
namespace ml {
using bf16x8 = __attribute__((ext_vector_type(8))) short;
using f32x16 = __attribute__((ext_vector_type(16))) float;
using f32x4v = __attribute__((ext_vector_type(4))) float;
using u32x4 = __attribute__((ext_vector_type(4))) unsigned;
using u32x2 = __attribute__((ext_vector_type(2))) unsigned;
constexpr int NSEQ = NB * 4 * 2, NBLK = 17;
constexpr size_t CST_BYTES = (size_t)NSEQ * NBLK * 256 * 128 * 2;
constexpr size_t NST_OFF = CST_BYTES, MST_OFF = NST_OFF + (size_t)NSEQ * NBLK * 128 * 4, ST_END = MST_OFF + (size_t)NSEQ * NBLK * 4;
__device__ __forceinline__ float bperm(float v, int srclane) { return __builtin_bit_cast(float, __builtin_amdgcn_ds_bpermute(srclane << 2, __builtin_bit_cast(int, v))); }
__device__ __forceinline__ float swap_add(float v) { auto rr = __builtin_amdgcn_permlane32_swap(__float_as_uint(v), __float_as_uint(v), false, false); return __uint_as_float(rr[0]) + __uint_as_float(rr[1]); }
__device__ __forceinline__ float wmax(float v, int lane) {
#pragma unroll
  for (int o = 1; o < 64; o <<= 1) v = fmaxf(v, bperm(v, lane ^ o));
  return v;
}
__device__ __forceinline__ size_t blk_row0(int b, int blkid) { return blkid == 0 ? (size_t)NB * TT + b * CT : (size_t)b * TT + (blkid - 1) * 256; }
__device__ __forceinline__ int seq_blk(int dir, int j) { return j == 0 ? 0 : (dir == 0 ? j : 17 - j); }
__device__ __forceinline__ int blk_seq(int dir, int blkid) { return blkid == 0 ? 0 : (dir == 0 ? blkid : 17 - blkid); }
__device__ __forceinline__ void gate_scan(const float* __restrict__ GATES, const float* __restrict__ bg, size_t row0, int h, int dir, int lane, float (&F)[4], float (&Bt)[4], float (&ML)[4], float& b_last, float& bmax) {
  const float bi = ((const GAS float*)bg)[(2 * dir) * 4 + h], bf_ = ((const GAS float*)bg)[(2 * dir + 1) * 4 + h];
  float ig[4], c = 0.f;
#pragma unroll
  for (int i = 0; i < 4; ++i) { const int p = 4 * lane + i, r = dir ? 255 - p : p; const GAS float* gp = (const GAS float*)GATES + (row0 + r) * 16;
    ig[i] = gp[(2 * dir) * 4 + h] + bi; c += logsigmoid_acc(gp[(2 * dir + 1) * 4 + h] + bf_); F[i] = c; }
  float inc = c;
#pragma unroll
  for (int o = 1; o < 64; o <<= 1) { const float t = bperm(inc, lane - o); if (lane >= o) inc += t; }
  const float exc = inc - c;
  b_last = bperm(inc, 63);
  float mx = -3.0e38f;
#pragma unroll
  for (int i = 0; i < 4; ++i) { F[i] += exc; Bt[i] = ig[i] - F[i]; mx = fmaxf(mx, Bt[i]); ML[i] = mx; }
  float imx = mx;
#pragma unroll
  for (int o = 1; o < 64; o <<= 1) { const float t = bperm(imx, lane - o); if (lane >= o) imx = fmaxf(imx, t); }
  const float emx = bperm(imx, lane - 1);
  if (lane > 0) {
#pragma unroll
    for (int i = 0; i < 4; ++i) ML[i] = fmaxf(ML[i], emx); }
  bmax = bperm(imx, 63);
}
__device__ __forceinline__ void l1_unit(int seq, int vblk, int dblk, const bf16* __restrict__ ZT, const float* __restrict__ GATES, const float* __restrict__ bg, unsigned char* __restrict__ ST, LAS float* wt  ) {
  const int lane = fresh_lane();
  const int b = seq >> 3, h = (seq >> 1) & 3, dir = seq & 1, r32 = lane & 31, hi = lane >> 5;
  f32x16 acc = f32x16{}; float npart = 0.f, m = 0.f;
  const bf16* kT = ZT + (size_t)(h * 128 + 32 * dblk + r32) * MR;
  const bf16* vT = ZT + (size_t)(512 + h * 256 + 32 * vblk + r32) * MR;
  bf16* CS = (bf16*)ST; float* NS = (float*)(ST + NST_OFF); float* MS = (float*)(ST + MST_OFF);
#pragma unroll 1
  for (int j = 0; j < NBLK; ++j) {
    { bf16* cp = CS + ((size_t)(seq * NBLK + j) * 256 + 32 * vblk) * 128 + 32 * dblk + r32;
#pragma unroll
      for (int r = 0; r < 16; ++r) cp[(size_t)att::crow(r, hi) * 128] = (bf16)f2bf(acc[r]);
      if (vblk == 0) { const float nt = npart + bperm(npart, lane ^ 32); if (hi == 0) NS[(size_t)(seq * NBLK + j) * 128 + 32 * dblk + r32] = nt; if (dblk == 0 && lane == 0) MS[seq * NBLK + j] = m; } }
    if (j == NBLK - 1) break;
    const size_t row0 = blk_row0(b, seq_blk(dir, j));
    float F[4], Bt[4], ML[4], b_last, bmax;
    gate_scan(GATES, bg, row0, h, dir, lane, F, Bt, ML, b_last, bmax);
    const float Mf = fmaxf(m, bmax), decay = expf(m - Mf);
#pragma unroll
    for (int i = 0; i < 4; ++i) { const int p = 4 * lane + i, r = dir ? 255 - p : p; wt[r] = expf(Bt[i] - Mf); }
    asm volatile("s_waitcnt lgkmcnt(0)" ::: "memory");
    acc = acc * decay; npart *= decay; m = b_last + Mf;
#pragma unroll 4
    for (int ks = 0; ks < 16; ++ks) { const int tok = 16 * ks + 8 * hi;
      const bf16x8 af = *(const GAS bf16x8*)(vT + row0 + tok); const u32x4 kw = *(const GAS u32x4*)(kT + row0 + tok);
      const f32x4v w0 = *(const LAS f32x4v*)(wt + tok), w1 = *(const LAS f32x4v*)(wt + tok + 4);
      float kf[8];
#pragma unroll
      for (int e = 0; e < 4; ++e) { kf[2 * e] = __uint_as_float(kw[e] << 16); kf[2 * e + 1] = __uint_as_float(kw[e] & 0xffff0000u); }
      kf[0] *= w0[0]; kf[1] *= w0[1]; kf[2] *= w0[2]; kf[3] *= w0[3]; kf[4] *= w1[0]; kf[5] *= w1[1]; kf[6] *= w1[2]; kf[7] *= w1[3];
      npart += ((kf[0] + kf[1]) + (kf[2] + kf[3])) + ((kf[4] + kf[5]) + (kf[6] + kf[7]));
      u32x4 kb = {att::cvtpk(kf[0], kf[1]), att::cvtpk(kf[2], kf[3]), att::cvtpk(kf[4], kf[5]), att::cvtpk(kf[6], kf[7])};
      acc = __builtin_amdgcn_mfma_f32_32x32x16_bf16(af, *reinterpret_cast<bf16x8*>(&kb), acc, 0, 0, 0); }
  }
}
__device__ __forceinline__ void l2_unit(int b, int h, int blkid, int dvh, const bf16* __restrict__ Z, const float* __restrict__ GATES, const float* __restrict__ bg,
                                        const unsigned char* __restrict__ ST, float* __restrict__ HH, char* lds, LAS float* btab, int wave_s) {
  const int tid = fresh_tid(wave_s), wid = tid >> 6, lane = tid & 63, r32 = lane & 31, hi = lane >> 5;
  const size_t row0 = blk_row0(b, blkid);
  const int t0 = wid * 32, t = t0 + r32;
  const bf16* CS = (const bf16*)ST; const float* NS = (const float*)(ST + NST_OFF); const float* MS = (const float*)(ST + MST_OFF);
  { const int sr = tid >> 4, sc = (tid & 15) * 8, vst0 = att::v_st(sr, sc), vst1 = att::v_st(32 + sr, sc), kc = sc * 2;
    const bf16* kb = Z + (row0 + sr) * ZLD + ZB_K + h * 128 + sc; const bf16* vb = Z + (row0 + sr) * ZLD + ZB_V + h * 256 + dvh * 128 + sc;
#pragma unroll
    for (int kt = 0; kt < 4; ++kt) {
      const bf16x8 k0 = *(const GAS bf16x8*)(kb + (size_t)(64 * kt) * ZLD), k1 = *(const GAS bf16x8*)(kb + (size_t)(64 * kt + 32) * ZLD);
      const bf16x8 v0 = *(const GAS bf16x8*)(vb + (size_t)(64 * kt) * ZLD), v1 = *(const GAS bf16x8*)(vb + (size_t)(64 * kt + 32) * ZLD);
      *(bf16x8*)(lds + kt * 16384 + KSWZ(sr, kc)) = k0; *(bf16x8*)(lds + kt * 16384 + KSWZ(32 + sr, kc)) = k1;
      *(bf16x8*)(lds + 65536 + kt * 16384 + vst0) = v0; *(bf16x8*)(lds + 65536 + kt * 16384 + vst1) = v1; } }
  bf16x8 qf[8];
  { const bf16* qp = Z + (row0 + t) * ZLD + ZB_Q + h * 128 + hi * 8;
#pragma unroll
    for (int d0 = 0; d0 < 8; ++d0) { const u32x4 w = *(const GAS u32x4*)(qp + 16 * d0); u32x4 o;
#pragma unroll
      for (int e = 0; e < 4; ++e) o[e] = att::cvtpk(__uint_as_float(w[e] << 16) * 0.08838834764831845f, __uint_as_float(w[e] & 0xffff0000u) * 0.08838834764831845f);
      qf[d0] = *reinterpret_cast<bf16x8*>(&o); } }
  __syncthreads();
  f32x16 o[4];
#pragma unroll
  for (int nb = 0; nb < 4; ++nb) o[nb] = f32x16{};
  const int vbase = (int)(uintptr_t)(lds + 65536) + att::v_rd_base(lane);
#define ML_STILE(kt) f32x16 p0, p1; att::qkt<128>(p0, p1, (const bf16*)(lds + (kt) * 16384), qf, r32, hi); \
      _Pragma("unroll") for (int r = 0; r < 16; ++r) { const int k0i = 64 * (kt) + att::crow(r, hi), k1i = k0i + 32; \
        const bool v0 = dir == 0 ? (k0i <= t) : (k0i >= t), v1 = dir == 0 ? (k1i <= t) : (k1i >= t); \
        p0[r] = v0 ? p0[r] * __expf(btab[k0i] - Mt) : 0.f; p1[r] = v1 ? p1[r] * __expf(btab[k1i] - Mt) : 0.f; }
#pragma unroll
  for (int dir = 0; dir < 2; ++dir) {
    const int seq = (b * 4 + h) * 2 + dir, j = blk_seq(dir, blkid);
    const float m_prev = ((const GAS float*)MS)[seq * NBLK + j];
    float Mt, Ft;
    { float F[4], Bt[4], ML[4], b_last, bmax;
      gate_scan(GATES, bg, row0, h, dir, lane, F, Bt, ML, b_last, bmax);
#pragma unroll
      for (int i = 0; i < 4; ++i) { const int p = 4 * lane + i, r = dir ? 255 - p : p; btab[r] = Bt[i]; }
      const int pp = dir ? 255 - t : t, src = pp >> 2, e = pp & 3;
      const float m0 = bperm(fmaxf(m_prev, ML[0]), src), m1 = bperm(fmaxf(m_prev, ML[1]), src), m2 = bperm(fmaxf(m_prev, ML[2]), src), m3 = bperm(fmaxf(m_prev, ML[3]), src);
      const float f0 = bperm(F[0], src), f1 = bperm(F[1], src), f2 = bperm(F[2], src), f3 = bperm(F[3], src);
      Mt = e == 0 ? m0 : (e == 1 ? m1 : (e == 2 ? m2 : m3)); Ft = e == 0 ? f0 : (e == 1 ? f1 : (e == 2 ? f2 : f3)); }
    asm volatile("s_waitcnt lgkmcnt(0)" ::: "memory");
    const float w_inter = expf(m_prev - Mt), floorv = expf(-Ft - Mt);
    float den;
    { const GAS float* np = (const GAS float*)NS + (size_t)(seq * NBLK + j) * 128 + hi * 8; float dot = 0.f;
#pragma unroll
      for (int d0 = 0; d0 < 8; ++d0) { const u32x4 w = *reinterpret_cast<const u32x4*>(&qf[d0]); const f32x4v n0 = *(const GAS f32x4v*)(np + 16 * d0), n1 = *(const GAS f32x4v*)(np + 16 * d0 + 4);
        dot += __uint_as_float(w[0] << 16) * n0[0] + __uint_as_float(w[0] & 0xffff0000u) * n0[1] + __uint_as_float(w[1] << 16) * n0[2] + __uint_as_float(w[1] & 0xffff0000u) * n0[3]
             + __uint_as_float(w[2] << 16) * n1[0] + __uint_as_float(w[2] & 0xffff0000u) * n1[1] + __uint_as_float(w[3] << 16) * n1[2] + __uint_as_float(w[3] & 0xffff0000u) * n1[3]; }
      den = w_inter * swap_add(dot); }
    { float rsum = 0.f;
#pragma unroll 1
      for (int kt = 0; kt < 4; ++kt) {
        if (dir == 0 ? (64 * kt > t0 + 31) : (64 * kt + 63 < t0)) continue;
        ML_STILE(kt);
#pragma unroll
        for (int r = 0; r < 16; ++r) rsum += p0[r] + p1[r]; }
      den += swap_add(rsum); }
    const float inv = 1.f / fmaxf(fabsf(den), floorv);
    { const float sc = w_inter * inv;
      const bf16* cb = CS + ((size_t)(seq * NBLK + j) * 256 + dvh * 128 + r32) * 128 + hi * 8;
#pragma unroll
      for (int d0 = 0; d0 < 8; ++d0) { const u32x4 w = *reinterpret_cast<const u32x4*>(&qf[d0]); u32x4 qs;
#pragma unroll
        for (int e = 0; e < 4; ++e) qs[e] = att::cvtpk(__uint_as_float(w[e] << 16) * sc, __uint_as_float(w[e] & 0xffff0000u) * sc);
#pragma unroll
        for (int nb = 0; nb < 4; ++nb) { const bf16x8 cf = *(const GAS bf16x8*)(cb + (size_t)(32 * nb) * 128 + 16 * d0); o[nb] = __builtin_amdgcn_mfma_f32_32x32x16_bf16(*reinterpret_cast<bf16x8*>(&qs), cf, o[nb], 0, 0, 0); } } }
#pragma unroll 1
    for (int kt = 0; kt < 4; ++kt) {
      if (dir == 0 ? (64 * kt > t0 + 31) : (64 * kt + 63 < t0)) continue;
      ML_STILE(kt);
#pragma unroll
      for (int r = 0; r < 16; ++r) { p0[r] *= inv; p1[r] *= inv; }
      bf16x8 pa0, pa1, pa2, pa3;
#define PK4(P, BASE, OUT) do { unsigned a0 = att::cvtpk(P[BASE + 0], P[BASE + 1]), a1 = att::cvtpk(P[BASE + 2], P[BASE + 3]);   \
    unsigned b0 = att::cvtpk(P[BASE + 4], P[BASE + 5]), b1 = att::cvtpk(P[BASE + 6], P[BASE + 7]);                              \
    auto r0 = __builtin_amdgcn_permlane32_swap(a0, b0, false, false); auto r1 = __builtin_amdgcn_permlane32_swap(a1, b1, false, false); \
    u32x4 w = {r0[0], r1[0], r0[1], r1[1]}; OUT = *reinterpret_cast<bf16x8*>(&w); } while (0)
      PK4(p0, 0, pa0); PK4(p0, 8, pa1); PK4(p1, 0, pa2); PK4(p1, 8, pa3);
#undef PK4
      att::pv_d0<128>(o, vbase + kt * 16384, pa0, pa1, pa2, pa3);
    }
  }
#undef ML_STILE
  { const int l2_ = fresh_lane(), hi2 = l2_ >> 5; float* Ow = HH + (blk_row0(b, blkid) + wid * 32) * 1024 + h * 256 + dvh * 128 + (l2_ & 31);
#pragma unroll
    for (int r = 0; r < 16; ++r)
#pragma unroll
      for (int nb = 0; nb < 4; ++nb) Ow[(size_t)att::crow(r, hi2) * 1024 + nb * 32] = o[nb][r]; }
  asm volatile("s_waitcnt vmcnt(0)" ::: "memory"); __syncthreads();
}
__device__ __forceinline__ void finish_item(int gw, int lane, const bf16* Z, const float* HH, const float* headg, bf16* CAT) {
  const int m = gw >> 2, h = gw & 3; const size_t o = (size_t)m * 1024 + h * 256 + lane * 4;
  const f32x4v hh = *(const GAS f32x4v*)(HH + o);
  const float rstd = 1.f / sqrtf(wave_sum_l((hh[0] * hh[0] + hh[1] * hh[1]) + (hh[2] * hh[2] + hh[3] * hh[3]), lane) * (1.f / 256.f) + EPS);
  const u32x2 ow = *(const GAS u32x2*)(Z + (size_t)m * ZLD + ZB_O + h * 256 + lane * 4); const f32x4v g4 = *(const GAS f32x4v*)(headg + h * 256 + lane * 4);
  const float o0 = __uint_as_float(ow.x << 16), o1 = __uint_as_float(ow.x & 0xffff0000u), o2 = __uint_as_float(ow.y << 16), o3 = __uint_as_float(ow.y & 0xffff0000u);
  u32x2 w; w.x = pk2(hh[0] * rstd * g4[0] / (1.f + __expf(-o0)), hh[1] * rstd * g4[1] / (1.f + __expf(-o1))); w.y = pk2(hh[2] * rstd * g4[2] / (1.f + __expf(-o2)), hh[3] * rstd * g4[3] / (1.f + __expf(-o3)));
  *(GAS u32x2*)(CAT + (size_t)m * DM + 1024 + h * 256 + lane * 4) = w;
}
}
struct Args { const float* in[30]; float* out; unsigned char* ws; int ph_lo, ph_hi, li, pad; };
constexpr int PH_P0 = 0, PH_P1 = 1, PH_L0 = 2, PH_PER_LAYER = 13, PH_FINAL = 28, N_PHASES = 29;
enum { O_F1N = 0, O_F1U, O_F1D, O_MN, O_MI, O_MP, O_MA, O_MF, O_MG, O_MO, O_F2N, O_F2U, O_F2D };
#ifndef DUP_MASK
#define DUP_MASK 0
#endif
#define REP(bit) for (int rep_ = 0; rep_ < (((DUP_MASK) & (bit)) ? 2 : 1); ++rep_)
#define OPAQUE_S(p) asm volatile("" : "+s"(p))
__device__ __forceinline__ int opq(int v) { asm volatile("" : "+s"(v)); return v; }
#define GEMM_PHASE(EPI, A_, B_, M_, N_, K_, ...) GEMM_PHASE_S(0, EPI, A_, B_, M_, N_, K_, __VA_ARGS__)
#define GEMM_RESID(A_, B_, M_, N_, K_, ...) GEMM_PHASE_S(0, EpiResid, A_, B_, M_, N_, K_, __VA_ARGS__)
#define GEMM_PHASE_S(MODE, EPI, A_, B_, M_, N_, K_, ...) do { pg8::Gemm g{(const bf16*)(A_), (const bf16*)(B_), (M_), (N_), (K_)}; pg8::StaticOrder S; S.init((M_), (N_), F.G, (int)blockIdx.x, (K_), (MODE)); \
    pg8::EPI E{__VA_ARGS__}; pg8::gemm_phase<pg8::EPI, pg8::StaticOrder, true, true>(F.lds + RING_OFF, g, S, E, F.wave); } while (0)

__global__ void __launch_bounds__(NWAVES * 64, 2) fwd(Args args) {
    extern __shared__ __attribute__((aligned(16))) unsigned char lds[];
    Frame F;
    F.lds = (LAS unsigned char*)lds;
    F.MISC = (volatile LAS unsigned*)(F.lds + MISC_OFF);
    F.wave = __builtin_amdgcn_readfirstlane((int)threadIdx.x >> 6);
    F.G = gridDim.x;
    F.ws = args.ws; F.out = args.out;
    F.ctl = (gu32*)(args.ws + WS_CTL);
    for (int u = threadIdx.x; u < (LDS_BYTES - LDSCTL_OFF) / 4; u += NWAVES * 64) ((LAS unsigned*)(F.lds + LDSCTL_OFF))[u] = 0u;
    __syncthreads();
    const int lo = args.ph_lo, hi = args.ph_hi;
    XcdBarrier bar; bar.bar = (unsigned*)(F.ctl + CW_BAR) + args.li * XCD_BAR_WORDS; bar.x = 0; bar.st = nullptr;
    if (hi - lo > 1) bar = xcd_barrier_post((unsigned*)(F.ctl + CW_BAR) + args.li * XCD_BAR_WORDS, F.MISC + 8);
#define IN(k) (opq(lo) <= (k) && (k) < opq(hi))
#define SEAM(k) do { if (IN(k) && IN((k) + 1)) { xcd_barrier(bar, F.wave); if ((DUP_MASK) & 4096) xcd_barrier(bar, F.wave); } } while (0)

    if (IN(PH_P0)) REP(8) { p0_prologue(F, args.in); } SEAM(PH_P0);
    if (IN(PH_P1)) REP(8) { p1_modreduce(F, args.in[5], args.in[6]); } SEAM(PH_P1);
    if (IN(PH_L0 + O_F1N)) REP(4) { norm_phase(F, F.ws, args.in[0], args.in[2], 0, 0, true, MR); }
#pragma unroll 1
    for (int l = 0; l < 2; ++l) {
        const int pb = PH_L0 + PH_PER_LAYER * l;
        const int MLAT = NB * TT;
        const int m_post = (l == 1) ? MLAT : MR;
        if (IN(pb + O_F1N) && l > 0) REP(4) { unsigned char* ws = F.ws; OPAQUE_S(ws); norm_phase(F, ws, nullptr, nullptr, l, 0, false, MR); } SEAM(pb + O_F1N);
        if (IN(pb + O_F1U)) REP(1) { unsigned char* ws = F.ws; OPAQUE_S(ws);
            GEMM_PHASE(EpiSwiglu, ws + WS_HN, ws + WS_WUP + (size_t)(l * 2) * 44 * MiB, MR, 2 * FF, DM, (bf16*)(ws + WS_HID), FF); } SEAM(pb + O_F1U);
        if (IN(pb + O_F1D)) REP(2) { unsigned char* ws = F.ws; OPAQUE_S(ws);
            GEMM_RESID(ws + WS_HID, ws + WS_WDN + (size_t)(l * 2) * 22 * MiB, MR, DM, FF, (float*)(ws + WS_H), (const float*)(ws + WS_MODV) + (size_t)l * 5 * MODN + 2 * DM, MODN, rep_ ? 0.f : 0.5f); } SEAM(pb + O_F1D);
        if (IN(pb + O_MN)) REP(4) { unsigned char* ws = F.ws; OPAQUE_S(ws); norm_phase(F, ws, nullptr, nullptr, l, 1, false, MR); } SEAM(pb + O_MN);
        if (IN(pb + O_MI)) REP(16) { unsigned char* ws = F.ws; OPAQUE_S(ws);
            if (l == 0) { GEMM_PHASE(EpiPlain, ws + WS_HN, ws + WS_WABIN, MR, ZLD, DM, (bf16*)(ws + WS_Z), ZLD, (float*)(ws + WS_GATES), ZB_G / 256);
                GEMM_PHASE(EpiPlain, ws + WS_WABIN + (size_t)ZB_K * DM * 2, ws + WS_HN, 1536, MR, DM, (bf16*)(ws + WS_ZT), MR, nullptr, -1); }
            else GEMM_PHASE(EpiPlain, ws + WS_HN, ws + WS_WCDIN, MR, CD_IN, DM, (bf16*)(ws + WS_Z), CD_IN, nullptr, -1);
        } SEAM(pb + O_MI);
        if (IN(pb + O_MP)) REP(32) { unsigned char* ws = F.ws; OPAQUE_S(ws);
            const int lane = fresh_lane(); const int gw = blockIdx.x * NWAVES + F.wave, NGW = F.G * NWAVES;
            const bf16* Z = (const bf16*)(ws + WS_Z); bf16* KA = (bf16*)(ws + WS_KA); const float* tv = (const float*)(ws + WS_TAB + TB_VEC);
            if (l == 0) { for (int it = gw; it < MR * 2; it += NGW) naive_kprep<0>(it, lane, Z, KA, tv + TV_GK, (const float*)(ws + WS_TAB + TB_ROPEA));
                if (F.wave < 4) for (int u = (int)blockIdx.x * 4 + F.wave; u < ml::NSEQ * 32; u += F.G * 4)
                    ml::l1_unit(u >> 5, (u >> 2) & 7, u & 3, (const bf16*)(ws + WS_ZT), (const float*)(ws + WS_GATES), tv + TV_BGATE, ws + WS_SC1, (LAS float*)(F.lds + RING_OFF) + F.wave * 256); }
            else { for (int it = gw; it < MR; it += NGW) naive_kprep<1>(it, lane, Z, KA, nullptr, (const float*)(ws + WS_TAB + TB_ROPED));
                for (int u = gw; u < NB * 64 * 17; u += NGW) { const int seg = 16 - (u / (NB * 64)), bg = u % (NB * 64);
                    s5::s5_unit<1>(bg >> 6, bg & 63, seg, Z, (const float*)(ws + WS_TAB + TB_S5AB), (const bf16*)(ws + WS_TAB + TB_S5BT), (const bf16*)(ws + WS_TAB + TB_S5CT), (float*)(ws + WS_SC2), nullptr, nullptr, nullptr); } }
        } SEAM(pb + O_MP);
        if (IN(pb + O_MA)) REP(64) { unsigned char* ws = F.ws; OPAQUE_S(ws);
            const int tid = fresh_tid(F.wave);
            const bf16* Z = (const bf16*)(ws + WS_Z); const bf16* KA = (const bf16*)(ws + WS_KA); bf16* CAT = (bf16*)(ws + WS_CAT); const float* tv = (const float*)(ws + WS_TAB + TB_VEC);
            float* SC1 = (float*)(ws + WS_SC1); float* SC2 = (float*)(ws + WS_SC2);
            if (l == 0) { const float* ropeA = (const float*)(ws + WS_TAB + TB_ROPEA);
                REP(256) { const int nv = F.G, v0 = (int)blockIdx.x;
                    for (int u = v0; u < 512; u += nv) { const int b = u >> 7, head = (u >> 4) & 7, qb = u & 15, kvh = head >> 2; const size_t row0 = (size_t)b * TT + qb * 256;
                        att::attn_unit<128, 0>(Z + row0 * ZLD + ZA_Q + head * 128, ZLD, KA + kvh * 128, 256, Z + ZA_V + kvh * 128, ZLD, CAT + row0 * DM + head * 128, b, qb * 256, tv + TV_GQ, ropeA, 0.f, (char*)lds + RING_OFF, F.wave); }
                    for (int u = v0; u < 32; u += nv) { const int b = u >> 3, head = u & 7, kvh = head >> 2; const size_t row0 = (size_t)NB * TT + b * CT;
                        att::attn_unit<128, 1>(Z + row0 * ZLD + ZA_Q + head * 128, ZLD, KA + kvh * 128, 256, Z + ZA_V + kvh * 128, ZLD, CAT + row0 * DM + head * 128, b, 0, tv + TV_GQ, ropeA, 0.f, (char*)lds + RING_OFF, F.wave); } }
                REP(512) for (int u = (int)blockIdx.x; u < NB * 4 * 34; u += F.G) { const int b = u / 136, rem = u % 136, h = rem / 34, bh = rem % 34;
                    ml::l2_unit(b, h, bh >> 1, bh & 1, Z, (const float*)(ws + WS_GATES), tv + TV_BGATE, ws + WS_SC1, SC2, (char*)lds + RING_OFF, (LAS float*)(F.lds + LDSCTL_OFF + 512) + F.wave * 256, F.wave); }
            } else { const float* ropeD = (const float*)(ws + WS_TAB + TB_ROPED);
                REP(1024) { const int nv = F.G, v0 = (int)blockIdx.x;
                    for (int u = v0; u < 1024; u += nv) { const int b = u >> 8, head = (u >> 4) & 15, qb = u & 15, kvh = head >> 3; const size_t row0 = (size_t)b * TT + qb * 256;
                        att::attn_unit<64, 2>(Z + row0 * CD_IN + ZD_Q + head * 64, CD_IN, KA + kvh * 64, 128, Z + ZD_V + kvh * 64, CD_IN, CAT + row0 * DM + 1024 + head * 64, b, qb * 256, nullptr, ropeD, tv[TV_SINK + head], (char*)lds + RING_OFF, F.wave); } }
                REP(2048) { const int gw = blockIdx.x * NWAVES + F.wave, NGW = F.G * NWAVES;
                    for (int u = gw; u < NB * 64 * 16; u += NGW) { const int seg = u / (NB * 64), bg = u % (NB * 64);
                        s5::s5_unit<2>(bg >> 6, bg & 63, seg, Z, (const float*)(ws + WS_TAB + TB_S5AB), (const bf16*)(ws + WS_TAB + TB_S5BT), (const bf16*)(ws + WS_TAB + TB_S5CT), (float*)(ws + WS_SC2), tv + TV_DSKIP, (bf16*)(ws + WS_G),
                                       F.lds + RING_OFF + F.wave * s5::WAVE_LDS); } }
            }
        } SEAM(pb + O_MA);
        if (IN(pb + O_MF)) { unsigned char* ws = F.ws; OPAQUE_S(ws);
            const int lane = fresh_lane(), gw = blockIdx.x * NWAVES + F.wave, NGW = F.G * NWAVES;
            if (l == 0) { for (int it = gw; it < MR * 4; it += NGW) ml::finish_item(it, lane, (const bf16*)(ws + WS_Z), (const float*)(ws + WS_SC2), (const float*)(ws + WS_TAB + TB_VEC) + TV_HEADG, (bf16*)(ws + WS_CAT)); }
        } SEAM(pb + O_MF);
        if (IN(pb + O_MG)) REP(128) { unsigned char* ws = F.ws; OPAQUE_S(ws);
            if (l == 1) GEMM_PHASE(EpiGlu, ws + WS_G, ws + WS_WGLU, MLAT, 1024, 1024, (bf16*)(ws + WS_CAT), DM, (const bf16*)(ws + WS_G), (const float*)(ws + WS_TAB + TB_VEC) + TV_GLUB);
        } SEAM(pb + O_MG);
        if (IN(pb + O_MO)) REP(128) { unsigned char* ws = F.ws; OPAQUE_S(ws);
            GEMM_RESID(ws + WS_CAT, ws + (l == 0 ? WS_WABOUT : WS_WCDOUT), m_post, DM, DM, (float*)(ws + WS_H), (const float*)(ws + WS_MODV) + (size_t)l * 5 * MODN + 5 * DM, MODN, rep_ ? 0.f : 1.0f); } SEAM(pb + O_MO);
        if (IN(pb + O_F2N)) REP(4) { unsigned char* ws = F.ws; OPAQUE_S(ws); norm_phase(F, ws, nullptr, nullptr, l, 2, false, m_post); } SEAM(pb + O_F2N);
        if (IN(pb + O_F2U)) REP(1) { unsigned char* ws = F.ws; OPAQUE_S(ws);
            GEMM_PHASE(EpiSwiglu, ws + WS_HN, ws + WS_WUP + (size_t)(l * 2 + 1) * 44 * MiB, m_post, 2 * FF, DM, (bf16*)(ws + WS_HID), FF); } SEAM(pb + O_F2U);
        if (IN(pb + O_F2D)) REP(2) { unsigned char* ws = F.ws; OPAQUE_S(ws);
            GEMM_RESID(ws + WS_HID, ws + WS_WDN + (size_t)(l * 2 + 1) * 22 * MiB, m_post, DM, FF, (float*)(ws + WS_H), (const float*)(ws + WS_MODV) + (size_t)l * 5 * MODN + 8 * DM, MODN, rep_ ? 0.f : 0.5f); } SEAM(pb + O_F2D);
    }
    if (IN(PH_FINAL)) REP(4) { unsigned char* ws = F.ws; OPAQUE_S(ws); final_norm_phase(F, ws); }
#undef IN
#undef SEAM
}
extern "C" void kernel_launch(void* const* d_in, const int* in_sizes, int n_in, void* d_out, int out_size, void* d_ws, size_t ws_size, hipStream_t stream) {
    static int grid = 0;
    if (grid == 0) {
        if (n_in != 30 || out_size != NB * TT * DM || ws_size < WS_END) { fprintf(stderr, "kernel_launch: unexpected shapes: n_in %d out %d ws %zu (need %zu)\n", n_in, out_size, ws_size, (size_t)WS_END); grid = -1; return; }
        int dev = 0, cus = 0;
        if (hipGetDevice(&dev) != hipSuccess || hipDeviceGetAttribute(&cus, hipDeviceAttributeMultiprocessorCount, dev) != hipSuccess) { grid = -1; return; }
        if (hipFuncSetAttribute((const void*)fwd, hipFuncAttributeMaxDynamicSharedMemorySize, LDS_BYTES) != hipSuccess) { fprintf(stderr, "kernel_launch: hipFuncSetAttribute failed\n"); grid = -1; return; }
        int per_cu = 0; (void)hipOccupancyMaxActiveBlocksPerMultiprocessor(&per_cu, (const void*)fwd, NWAVES * 64, LDS_BYTES); (void)hipGetLastError();
        if (per_cu < 1) fprintf(stderr, "kernel_launch: occupancy query says %d\n", per_cu);
        grid = cus;
    }
    if (grid < 0) return;
    (void)hipMemsetAsync((char*)d_ws + WS_CTL, 0, CTL_ZERO_BYTES, stream);
    Args a{};
    for (int i = 0; i < 30; ++i) a.in[i] = (const float*)d_in[i];
    a.out = (float*)d_out; a.ws = (unsigned char*)d_ws;
    int li = 0;
    auto run = [&](int lo, int hi) { a.ph_lo = lo; a.ph_hi = hi; a.li = li++; a.pad = 0; hipLaunchKernelGGL(fwd, dim3(grid), dim3(NWAVES * 64), LDS_BYTES, stream, a); };
#ifndef MK_CUTS
#define MK_CUTS 0
#endif
    if (MK_CUTS == 0) run(0, N_PHASES);
    else if (MK_CUTS == 1) { for (int ph = 0; ph < N_PHASES; ++ph) run(ph, ph + 1); }
    else { run(0, PH_L0 + O_MP); run(PH_L0 + O_MP, PH_L0 + O_MO); run(PH_L0 + O_MO, PH_L0 + PH_PER_LAYER + O_MP); run(PH_L0 + PH_PER_LAYER + O_MP, PH_L0 + PH_PER_LAYER + O_MO); run(PH_L0 + PH_PER_LAYER + O_MO, N_PHASES); }
    const hipError_t le = hipPeekAtLastError();
    if (le != hipSuccess) fprintf(stderr, "kernel_launch: launch failed: %s\n", hipGetErrorName(le));
}
```

```cpp
#include <hip/hip_runtime.h>
#include <cstdio>
#include <cstdint>
#include <cmath>
__device__ __forceinline__ int fresh_lane() { int l; asm volatile("v_mbcnt_lo_u32_b32 %0, -1, 0\n\tv_mbcnt_hi_u32_b32 %0, -1, %0" : "=v"(l)); return l; }
__device__ __forceinline__ int fresh_tid(int wave) { return wave * 64 + fresh_lane(); }
namespace pg8 {
#define PG8_LAS __attribute__((address_space(3)))
typedef unsigned short bf16_t;
typedef short bf16x8 __attribute__((ext_vector_type(8)));
typedef float f32x4 __attribute__((ext_vector_type(4)));
typedef unsigned u32x4 __attribute__((ext_vector_type(4)));
constexpr int BM = 256, BK = 64, HALF = 128, HTB = HALF * BK * 2  , STAGE_BYTES = 8 * HTB, NXCD = 8, WGM = 8;

__host__ __device__ __forceinline__ int lds_byte(int r, int c) { const int st = (r >> 4) * 2 + (c >> 5), rr = r & 15, cc = c & 31, ob = rr * 64 + cc * 2; return st * 1024 + (ob ^ (((ob >> 9) & 1) << 5)); }
__host__ __device__ __forceinline__ void stage_rc(int b, int& R, int& C) { const int st = b / 1024, sb = b % 1024, swz = sb ^ (((sb >> 9) & 1) << 5); R = (st >> 1) * 16 + swz / 64; C = (st & 1) * 32 + (swz % 64) / 2; }
__host__ __device__ __forceinline__ int perm32(int rho) { const int n = rho >> 4, i = rho & 15; return 8 * (i >> 2) + 4 * n + (i & 3); }

struct Unit { int pm, pn, kt0, nkt, piece; };
struct Gemm { const bf16_t* A; const bf16_t* Bt; int M, N, K; };

template <int S = 1, int NXM = 1> struct StaticOrderT {
    int nM, nN, nwg, G, c, nt; bool xr;
    __host__ __device__ __forceinline__ void init(int M, int N, int G_, int c_, int K = 0, bool xr_ = false) { nM = M / BM; nN = N / BM; nwg = nM * nN; G = G_; c = c_; nt = K / BK; xr = xr_; }
    __host__ __device__ __forceinline__ bool next(int i, Unit& u) const {
        const int rounds = (nwg + G - 1) / G;
        if (xr && i == rounds) { if (c >= S * NXM * nN) return false; const int x = c / S, piece = c % S;
            u.pm = nM + x % NXM; u.pn = x / NXM; u.piece = piece; u.kt0 = 2 * ((piece * nt) / (2 * S)); u.nkt = 2 * (((piece + 1) * nt) / (2 * S)) - u.kt0; return true; }
        const long L = (long)i * G + c; if (L >= nwg) return false;
        int wgid = (int)L; { const int q8 = nwg / NXCD, r = nwg % NXCD, xcd = wgid % NXCD, off = wgid / NXCD; wgid = (xcd < r ? xcd * (q8 + 1) : r * (q8 + 1) + (xcd - r) * q8) + off; }
        const int nig = WGM * nN, gid = wgid / nig, fm = gid * WGM, gsz = (nM - fm) < WGM ? (nM - fm) : WGM;
        u.pm = fm + ((wgid % nig) % gsz); u.pn = (wgid % nig) / gsz; u.piece = -1; u.kt0 = 0; u.nkt = nt; return true;
    }
    __device__ __forceinline__ void a_ready(const Unit&) const {}
    __device__ __forceinline__ void done(const Unit&) const {}
};
typedef StaticOrderT<1, 1> StaticOrder;

__device__ __forceinline__ unsigned cvt_pk_bf16(float lo, float hi) { unsigned r; asm volatile("v_cvt_pk_bf16_f32 %0, %1, %2" : "=v"(r) : "v"(lo), "v"(hi)); return r; }
typedef float f32x2 __attribute__((ext_vector_type(2)));
__device__ __forceinline__ float fast_sigmoid(float a) { return __builtin_amdgcn_rcpf(1.f + __builtin_amdgcn_exp2f(-1.4426950408889634f * a)); }
struct EpiPlain {
    static constexpr bool PERM = true, AFTER_DRAIN = false;
    bf16_t* O; int ldc; float* gates; int gate_pn;
    __device__ __forceinline__ void operator()(const f32x4 (&acc)[2][2][4][2], const Unit& u, int wr, int wc, int fr, int fq) const {
        const int row0 = u.pm * BM + wr * 64 + fr, col0 = u.pn * BM + wc * 32 + 8 * fq;
#pragma unroll
        for (int ai = 0; ai < 2; ++ai)
#pragma unroll
            for (int m = 0; m < 4; ++m) { const int row = row0 + ai * HALF + m * 16; bf16_t* rowp = O + (size_t)row * ldc + col0;
#pragma unroll
                for (int bj = 0; bj < 2; ++bj) { const f32x4 v0 = acc[ai][bj][m][0], v1 = acc[ai][bj][m][1];
                    u32x4 w; w.x = cvt_pk_bf16(v0[0], v0[1]); w.y = cvt_pk_bf16(v0[2], v0[3]); w.z = cvt_pk_bf16(v1[0], v1[1]); w.w = cvt_pk_bf16(v1[2], v1[3]);
                    *(u32x4*)(rowp + bj * HALF) = w;
                    if (bj == 0 && u.pn == gate_pn && wc == 0 && fq < 2) { float* gp = gates + (size_t)row * 16 + 8 * fq; *(f32x4*)gp = v0; *(f32x4*)(gp + 4) = v1; } } }
    }
};
struct EpiSwiglu {
    static constexpr bool PERM = true, AFTER_DRAIN = false;
    bf16_t* O; int ldc;
    __device__ __forceinline__ void operator()(const f32x4 (&acc)[2][2][4][2], const Unit& u, int wr, int wc, int fr, int fq) const {
        const int row0 = u.pm * BM + wr * 64 + fr, col0 = u.pn * HALF + wc * 32 + 8 * fq;
#pragma unroll
        for (int ai = 0; ai < 2; ++ai)
#pragma unroll
            for (int m = 0; m < 4; ++m) { bf16_t* rowp = O + (size_t)(row0 + ai * HALF + m * 16) * ldc + col0;
                float r[8];
#pragma unroll
                for (int n = 0; n < 2; ++n)
#pragma unroll
                    for (int j = 0; j < 4; ++j) { const float a = acc[ai][0][m][n][j], b = acc[ai][1][m][n][j]; r[4 * n + j] = a * fast_sigmoid(a) * b; }
                u32x4 w; w.x = cvt_pk_bf16(r[0], r[1]); w.y = cvt_pk_bf16(r[2], r[3]); w.z = cvt_pk_bf16(r[4], r[5]); w.w = cvt_pk_bf16(r[6], r[7]);
                *(u32x4*)rowp = w; }
    }
};
struct EpiResid {
    static constexpr bool PERM = true, AFTER_DRAIN = false;
    float* H; const float* gate; int gstride; float coef;
    __device__ __forceinline__ void operator()(const f32x4 (&acc)[2][2][4][2], const Unit& u, int wr, int wc, int fr, int fq) const {
        const int row0 = u.pm * BM + wr * 64 + fr, col0 = u.pn * BM + wc * 32 + 8 * fq;
        const int sel = u.pm < 64 ? (u.pm >> 4) : 4;
        const float* gp = gate + (size_t)sel * gstride + col0;
        f32x4 gv[2][2];
#pragma unroll
        for (int bj = 0; bj < 2; ++bj)
#pragma unroll
            for (int n = 0; n < 2; ++n) gv[bj][n] = *(const f32x4*)(gp + bj * HALF + 4 * n) * coef;
#pragma unroll
        for (int ai = 0; ai < 2; ++ai)
#pragma unroll
            for (int m = 0; m < 4; ++m) { float* rowp = H + (size_t)(row0 + ai * HALF + m * 16) * 2048 + col0;
#pragma unroll
                for (int bj = 0; bj < 2; ++bj)
#pragma unroll
                    for (int n = 0; n < 2; ++n) { f32x4* p = (f32x4*)(rowp + bj * HALF + 4 * n); *p = *p + gv[bj][n] * acc[ai][bj][m][n]; } }
    }
};
struct EpiPart {
    static constexpr bool PERM = true, AFTER_DRAIN = false;
    float* P;
    __device__ __forceinline__ void operator()(const f32x4 (&acc)[2][2][4][2], const Unit& u, int wr, int wc, int fr, int fq) const {
        const int row0 = u.pm * BM + wr * 64 + fr, col0 = u.pn * BM + wc * 32 + 8 * fq;
        float* base = P + (size_t)u.piece * (1024 * 2048);
#pragma unroll
        for (int ai = 0; ai < 2; ++ai)
#pragma unroll
            for (int m = 0; m < 4; ++m) { float* rowp = base + (size_t)(row0 + ai * HALF + m * 16) * 2048 + col0;
#pragma unroll
                for (int bj = 0; bj < 2; ++bj)
#pragma unroll
                    for (int n = 0; n < 2; ++n) *(f32x4*)(rowp + bj * HALF + 4 * n) = acc[ai][bj][m][n]; }
    }
};
struct EpiResidPart {
    static constexpr bool PERM = true, AFTER_DRAIN = false;
    float* H; const float* gate; int gstride; float coef; float* P;
    __device__ __forceinline__ void operator()(const f32x4 (&acc)[2][2][4][2], const Unit& u, int wr, int wc, int fr, int fq) const {
        const bool res = u.piece < 0;
        const int row0 = (res ? u.pm : u.pm - 64) * BM + wr * 64 + fr, col0 = u.pn * BM + wc * 32 + 8 * fq;
        float* base = res ? H : P + (size_t)u.piece * (1024 * 2048);
        const int sel = u.pm < 64 ? (u.pm >> 4) : 4;
        const float* gp = gate + (size_t)sel * gstride + col0;
        f32x4 gv[2][2];
#pragma unroll
        for (int bj = 0; bj < 2; ++bj)
#pragma unroll
            for (int n = 0; n < 2; ++n) gv[bj][n] = res ? *(const f32x4*)(gp + bj * HALF + 4 * n) * coef : (f32x4){1.f, 1.f, 1.f, 1.f};
#pragma unroll
        for (int ai = 0; ai < 2; ++ai)
#pragma unroll
            for (int m = 0; m < 4; ++m) { float* rowp = base + (size_t)(row0 + ai * HALF + m * 16) * 2048 + col0;
#pragma unroll
                for (int bj = 0; bj < 2; ++bj)
#pragma unroll
                    for (int n = 0; n < 2; ++n) { f32x4* p = (f32x4*)(rowp + bj * HALF + 4 * n); f32x4 old = {0.f, 0.f, 0.f, 0.f}; if (res) old = *p; *p = old + gv[bj][n] * acc[ai][bj][m][n]; } }
    }
};
struct EpiGlu {
    static constexpr bool PERM = true, AFTER_DRAIN = false;
    bf16_t* O; int ldc; const bf16_t* G; const float* bias;
    __device__ __forceinline__ void operator()(const f32x4 (&acc)[2][2][4][2], const Unit& u, int wr, int wc, int fr, int fq) const {
        const int row0 = u.pm * BM + wr * 64 + fr, col0 = u.pn * BM + wc * 32 + 8 * fq;
#pragma unroll
        for (int ai = 0; ai < 2; ++ai)
#pragma unroll
            for (int m = 0; m < 4; ++m) { const int row = row0 + ai * HALF + m * 16;
#pragma unroll
                for (int bj = 0; bj < 2; ++bj) { const int col = col0 + bj * HALF;
                    const u32x4 gw = *(const u32x4*)(G + (size_t)row * 1024 + col);
                    const f32x4 b0 = *(const f32x4*)(bias + col), b1 = *(const f32x4*)(bias + col + 4);
                    float r[8];
#pragma unroll
                    for (int j = 0; j < 4; ++j) { r[j] = fast_sigmoid(acc[ai][bj][m][0][j] + b0[j]); r[4 + j] = fast_sigmoid(acc[ai][bj][m][1][j] + b1[j]); }
                    const unsigned gws[4] = {gw.x, gw.y, gw.z, gw.w};
#pragma unroll
                    for (int q = 0; q < 4; ++q) { r[2 * q] *= __builtin_bit_cast(float, gws[q] << 16); r[2 * q + 1] *= __builtin_bit_cast(float, gws[q] & 0xffff0000u); }
                    u32x4 w; w.x = cvt_pk_bf16(r[0], r[1]); w.y = cvt_pk_bf16(r[2], r[3]); w.z = cvt_pk_bf16(r[4], r[5]); w.w = cvt_pk_bf16(r[6], r[7]);
                    *(u32x4*)(O + (size_t)row * ldc + col) = w; } }
    }
};
template <class Epi, class Sched, bool ALIGN_EPI = false, bool SP2 = false>
__device__ __forceinline__ void gemm_phase(PG8_LAS unsigned char* lds, const Gemm g, const Sched& S, const Epi& E, int wave_s) {
    const int tid = fresh_tid(wave_s);
    const int wid = __builtin_amdgcn_readfirstlane(tid >> 6), lane = tid & 63, wr = wid >> 2, wc = wid & 3, fr = lane & 15, fq = lane >> 4;
    const int K = g.K, nt = K / BK;
    unsigned voffA[2], voffB[2];
#pragma unroll
    for (int i = 0; i < 2; ++i) { int R, C; stage_rc(tid * 16 + i * 8192, R, C); const int Rb = Epi::PERM ? ((R & ~31) + perm32(R & 31)) : R;
        voffA[i] = (unsigned)(R * K + C) * 2u; voffB[i] = (unsigned)(Rb * K + C) * 2u; }
    const size_t kstep = (size_t)(BK * 2);
    const size_t hstep = (size_t)HALF * K * 2;
    const size_t tstep = 2 * hstep;
    const unsigned ldsw = (unsigned)wid * 1024u;
    const int aoff = lds_byte(wr * 64 + fr, fq * 8), boff = lds_byte(wc * 32 + fr, fq * 8);
#define PG8_SA(b, h) (((b) * 2 + (h)) * HTB)
#define PG8_SB(b, h) ((4 + (b) * 2 + (h)) * HTB)
#define PG8_STAGE(bufoff, gbase, voff) do { _Pragma("unroll") for (int _i = 0; _i < 2; ++_i) \
        __builtin_amdgcn_global_load_lds((const unsigned*)((const char*)(gbase) + (voff)[_i]), (PG8_LAS unsigned*)(lds + (bufoff) + ldsw + _i * 8192), 16, 0, 0); } while (0)
#define PG8_LDA(dst, b, h) do { _Pragma("unroll") for (int m = 0; m < 4; ++m) _Pragma("unroll") for (int k = 0; k < 2; ++k) dst[m][k] = *(const PG8_LAS bf16x8*)(lds + PG8_SA(b, h) + aoff + m * 2048 + k * 1024); } while (0)
#define PG8_LDB(dst, b, h) do { _Pragma("unroll") for (int n = 0; n < 2; ++n) _Pragma("unroll") for (int k = 0; k < 2; ++k) dst[n][k] = *(const PG8_LAS bf16x8*)(lds + PG8_SB(b, h) + boff + n * 2048 + k * 1024); } while (0)
#define PG8_MMA(ai, bj, At, Bt) do { __builtin_amdgcn_s_setprio(1); _Pragma("unroll") for (int m = 0; m < 4; ++m) _Pragma("unroll") for (int n = 0; n < 2; ++n) _Pragma("unroll") for (int k = 0; k < 2; ++k) \
        acc[ai][bj][m][n] = __builtin_amdgcn_mfma_f32_16x16x32_bf16(Bt[n][k], At[m][k], acc[ai][bj][m][n], 0, 0, 0); __builtin_amdgcn_s_setprio(0); } while (0)
#define PG8_WAIT_V(n) asm volatile("s_waitcnt vmcnt(" #n ")" ::: "memory")
#define PG8_WAIT_L(n) asm volatile("s_waitcnt lgkmcnt(" #n ")" ::: "memory")
#define PG8_BAR __builtin_amdgcn_s_barrier()
#define PG8_SCHED __builtin_amdgcn_sched_barrier(0)
    Unit cur, nxt; int ui = 0;
    if (!S.next(0, cur)) return;
    f32x4 acc[2][2][4][2];
#pragma unroll
    for (int a = 0; a < 2; ++a)
#pragma unroll
        for (int b = 0; b < 2; ++b)
#pragma unroll
            for (int m = 0; m < 4; ++m)
#pragma unroll
                for (int n = 0; n < 2; ++n) acc[a][b][m][n] = (f32x4){0.f, 0.f, 0.f, 0.f};
    bf16x8 At[4][2], B0[2][2], B1[2][2];
    const char* cA = (const char*)g.A + (size_t)cur.pm * tstep + (size_t)cur.kt0 * kstep; const char* cB = (const char*)g.Bt + (size_t)cur.pn * tstep + (size_t)cur.kt0 * kstep;
    S.a_ready(cur);
    if constexpr (SP2) {
        PG8_STAGE(PG8_SB(0, 0), cB, voffB); PG8_STAGE(PG8_SB(0, 1), cB + hstep, voffB); PG8_STAGE(PG8_SA(0, 0), cA, voffA); PG8_STAGE(PG8_SA(0, 1), cA + hstep, voffA);
        if (wr == 1) PG8_BAR;
        PG8_WAIT_V(2); PG8_BAR;
        PG8_STAGE(PG8_SB(1, 0), cB + kstep, voffB); PG8_STAGE(PG8_SA(1, 0), cA + kstep, voffA); PG8_STAGE(PG8_SB(1, 1), cB + hstep + kstep, voffB);
        PG8_WAIT_V(6); PG8_BAR;
    } else {
        PG8_STAGE(PG8_SB(0, 0), cB, voffB); PG8_STAGE(PG8_SA(0, 0), cA, voffA); PG8_STAGE(PG8_SB(0, 1), cB + hstep, voffB); PG8_STAGE(PG8_SA(0, 1), cA + hstep, voffA);
        if (wr == 1) PG8_BAR;
        PG8_WAIT_V(4); PG8_BAR;
        PG8_STAGE(PG8_SB(1, 0), cB + kstep, voffB); PG8_STAGE(PG8_SA(1, 0), cA + kstep, voffA); PG8_STAGE(PG8_SB(1, 1), cB + hstep + kstep, voffB);
        PG8_WAIT_V(6); PG8_BAR;
    }
    for (;;) {
        const bool has_next = S.next(ui + 1, nxt);
        const char* nA = has_next ? (const char*)g.A + (size_t)nxt.pm * tstep + (size_t)nxt.kt0 * kstep : cA; const char* nB = has_next ? (const char*)g.Bt + (size_t)nxt.pn * tstep + (size_t)nxt.kt0 * kstep : cB;
        const int ntc = cur.nkt;
        for (int t = 0; t < ntc; t += 2) {
            const bool last = (t == ntc - 2);
            const char* a1 = cA + (size_t)(t + 1) * kstep;
            const char* a2 = last ? nA : cA + (size_t)(t + 2) * kstep; const char* b2 = last ? nB : cB + (size_t)(t + 2) * kstep;
            const char* a3 = a2 + kstep; const char* b3 = b2 + kstep;
            if (last && has_next) S.a_ready(nxt);
            if constexpr (SP2) {
            PG8_LDB(B0, 0, 0); PG8_LDB(B1, 0, 1); PG8_SCHED; PG8_LDA(At, 0, 0); PG8_STAGE(PG8_SA(1, 1), a1 + hstep, voffA);
            PG8_WAIT_V(8); PG8_WAIT_L(0); PG8_BAR; PG8_MMA(0, 0, At, B0); PG8_MMA(0, 1, At, B1); PG8_BAR; PG8_SCHED;
            PG8_LDA(At, 0, 1); PG8_STAGE(PG8_SB(0, 0), b2, voffB); PG8_STAGE(PG8_SB(0, 1), b2 + hstep, voffB); PG8_STAGE(PG8_SA(0, 0), a2, voffA);
            PG8_WAIT_V(8); PG8_WAIT_L(0); PG8_BAR; PG8_MMA(1, 0, At, B0); PG8_MMA(1, 1, At, B1); PG8_BAR; PG8_SCHED;
            PG8_LDB(B0, 1, 0); PG8_LDB(B1, 1, 1); PG8_SCHED; PG8_LDA(At, 1, 0); PG8_STAGE(PG8_SA(0, 1), a2 + hstep, voffA);
            PG8_WAIT_V(8); PG8_WAIT_L(0); PG8_BAR; PG8_MMA(0, 0, At, B0); PG8_MMA(0, 1, At, B1); PG8_BAR; PG8_SCHED;
            PG8_LDA(At, 1, 1); PG8_STAGE(PG8_SB(1, 0), b3, voffB); PG8_STAGE(PG8_SB(1, 1), b3 + hstep, voffB); PG8_STAGE(PG8_SA(1, 0), a3, voffA);
            PG8_WAIT_V(8); PG8_WAIT_L(0); PG8_BAR; PG8_MMA(1, 0, At, B0); PG8_MMA(1, 1, At, B1); PG8_BAR; PG8_SCHED;
            } else {
            PG8_LDB(B0, 0, 0); PG8_SCHED; PG8_LDA(At, 0, 0); PG8_STAGE(PG8_SA(1, 1), a1 + hstep, voffA);
            PG8_WAIT_L(8); PG8_BAR; PG8_WAIT_L(0); PG8_MMA(0, 0, At, B0); PG8_BAR; PG8_SCHED;
            PG8_LDB(B1, 0, 1); PG8_STAGE(PG8_SB(0, 0), b2, voffB);
            PG8_BAR; PG8_WAIT_L(0); PG8_MMA(0, 1, At, B1); PG8_BAR;
            PG8_LDA(At, 0, 1); PG8_STAGE(PG8_SA(0, 0), a2, voffA);
            PG8_BAR; PG8_WAIT_L(0); PG8_MMA(1, 0, At, B0); PG8_BAR; PG8_SCHED;
            PG8_STAGE(PG8_SB(0, 1), b2 + hstep, voffB);
            PG8_WAIT_V(6); PG8_BAR; PG8_MMA(1, 1, At, B1); PG8_BAR;
            PG8_LDB(B0, 1, 0); PG8_SCHED; PG8_LDA(At, 1, 0); PG8_STAGE(PG8_SA(0, 1), a2 + hstep, voffA);
            PG8_WAIT_L(8); PG8_BAR; PG8_WAIT_L(0); PG8_MMA(0, 0, At, B0); PG8_BAR; PG8_SCHED;
            PG8_LDB(B1, 1, 1); PG8_STAGE(PG8_SB(1, 0), b3, voffB);
            PG8_BAR; PG8_WAIT_L(0); PG8_MMA(0, 1, At, B1); PG8_BAR;
            PG8_LDA(At, 1, 1); PG8_STAGE(PG8_SA(1, 0), a3, voffA);
            PG8_BAR; PG8_WAIT_L(0); PG8_MMA(1, 0, At, B0); PG8_BAR; PG8_SCHED;
            PG8_STAGE(PG8_SB(1, 1), b3 + hstep, voffB);
            PG8_WAIT_V(6); PG8_BAR; PG8_MMA(1, 1, At, B1); PG8_BAR;
            }
        }
        if constexpr (ALIGN_EPI) { if (wr == 0) PG8_BAR; }
        if constexpr (!Epi::AFTER_DRAIN) { E(acc, cur, wr, wc, fr, fq); S.done(cur); }
        if (!has_next) break;
#pragma unroll
        for (int a = 0; a < 2; ++a)
#pragma unroll
            for (int b = 0; b < 2; ++b)
#pragma unroll
                for (int m = 0; m < 4; ++m)
#pragma unroll
                    for (int n = 0; n < 2; ++n) acc[a][b][m][n] = (f32x4){0.f, 0.f, 0.f, 0.f};
        cur = nxt; cA = nA; cB = nB; ++ui;
        if constexpr (ALIGN_EPI) { if (wr == 1) PG8_BAR; }
    }
    PG8_WAIT_V(0);
    if constexpr (!ALIGN_EPI) { if (wr == 0) PG8_BAR; }
    PG8_BAR;
    if constexpr (Epi::AFTER_DRAIN) { E.fused(acc, cur, wr, wc, fr, fq, lds, wid, lane); S.done(cur); }
#undef PG8_SA
#undef PG8_SB
#undef PG8_STAGE
#undef PG8_LDA
#undef PG8_LDB
#undef PG8_MMA
#undef PG8_WAIT_V
#undef PG8_WAIT_L
#undef PG8_BAR
#undef PG8_SCHED
}
}
#define GAS __attribute__((address_space(1)))
#define LAS __attribute__((address_space(3)))
typedef unsigned short bf16;
typedef unsigned v4u __attribute__((ext_vector_type(4)));
typedef float f32x4 __attribute__((ext_vector_type(4)));
typedef short bf16x8 __attribute__((ext_vector_type(8)));
typedef GAS unsigned gu32;
typedef GAS unsigned long long gu64;
#define RLX_AGENT __ATOMIC_RELAXED, __HIP_MEMORY_SCOPE_AGENT
#define LDS_WAIT() asm volatile("s_waitcnt lgkmcnt(0)" ::: "memory")
#define VM_WAIT() asm volatile("s_waitcnt vmcnt(0)" ::: "memory")
__device__ __forceinline__ unsigned long long rt() { return __builtin_amdgcn_s_memrealtime(); }
__device__ __forceinline__ unsigned f2bf(float f) { unsigned u = __builtin_bit_cast(unsigned, f); return (u + 0x7fffu + ((u >> 16) & 1u)) >> 16; }
__device__ __forceinline__ unsigned pk2(float lo, float hi) { return f2bf(lo) | (f2bf(hi) << 16); }

#define XB_TMO      128
#define XB_XCNT(j)  (256  + 64 * (j))
#define XB_XSUB(j)  (1280 + 64 * (j))
#define XB_XGEN(j)  (2304 + 64 * (j))
#define XB_TOP      3328
#define XB_TOPGEN   3392
#define XCD_BAR_WORDS 3456
#define XB_SPIN_CAP (1u << 18)

__device__ __forceinline__ unsigned xb_ld(unsigned* p)              { return __hip_atomic_load(p, __ATOMIC_RELAXED, __HIP_MEMORY_SCOPE_AGENT); }
__device__ __forceinline__ unsigned xb_add(unsigned* p, unsigned v) { return __hip_atomic_fetch_add(p, v, __ATOMIC_RELAXED, __HIP_MEMORY_SCOPE_AGENT); }
__device__ __forceinline__ unsigned xb_xcc_id() { return (unsigned)__builtin_amdgcn_s_getreg((3 << 11) | 20) & 0xFu; }
#define XB_SPIN(cond, bar) do { unsigned _sp = 0; while (cond) { __builtin_amdgcn_s_sleep(1); \
    if ((++_sp & 255u) == 0u) { if (xb_ld(&(bar)[XB_TMO])) break; if (_sp > XB_SPIN_CAP) { atomicAdd(&(bar)[XB_TMO], 1u); break; } } } } while (0)

struct XcdBarrier {
    unsigned* bar; unsigned x;
    volatile LAS unsigned* st;
};

__device__ __forceinline__ XcdBarrier xcd_barrier_post(unsigned* bar, volatile LAS unsigned* st) {
    XcdBarrier b; b.bar = bar; b.x = xb_xcc_id(); b.st = st;
    if (threadIdx.x == 0) (void)xb_add(&bar[XB_XCNT(b.x)], 1u);
    return b;
}
__device__ __forceinline__ void xcd_barrier_complete(unsigned* bar, unsigned x, unsigned& nloc, unsigned& nx) {
    const unsigned G = gridDim.x * gridDim.y * gridDim.z;
    unsigned sum, cnt, mine, sp = 0u;
    for (;;) {
        sum = 0u; cnt = 0u; mine = 0u;
#pragma unroll
        for (unsigned j = 0; j < 16; ++j) { const unsigned c = xb_ld(&bar[XB_XCNT(j)]); sum += c; cnt += (c > 0u) ? 1u : 0u; mine = (j == x) ? c : mine; }
        if (sum == G) break;
        __builtin_amdgcn_s_sleep(1);
        if ((++sp & 255u) == 0u) { if (xb_ld(&bar[XB_TMO])) break; if (sp > XB_SPIN_CAP) { atomicAdd(&bar[XB_TMO], 1u); break; } }
    }
    nloc = mine > 0u ? mine : 1u; nx = cnt > 0u ? cnt : 1u;
}

__device__ __forceinline__ void xcd_barrier(const XcdBarrier& b, int wave_s) {
    asm volatile("s_waitcnt vmcnt(0)" ::: "memory");
    __syncthreads();
    if (wave_s == 0 && fresh_lane() == 0) {
        unsigned* bar = b.bar;
        __builtin_amdgcn_s_waitcnt(0);
        unsigned nloc = b.st[0], nx = b.st[1];
        if (nloc == 0u) { xcd_barrier_complete(bar, b.x, nloc, nx); b.st[0] = nloc; b.st[1] = nx; }
        const unsigned old = xb_add(&bar[XB_XSUB(b.x)], 1u);
        const unsigned gen = old / nloc;
        if (old + 1u == (gen + 1u) * nloc) {
            __builtin_amdgcn_fence(__ATOMIC_RELEASE, "agent");
            asm volatile("s_waitcnt vmcnt(0)" ::: "memory");
            const unsigned og = xb_add(&bar[XB_TOP], 1u);
            const unsigned tg = og / nx;
            if (og + 1u == (tg + 1u) * nx) xb_add(&bar[XB_TOPGEN], 1u);
            else XB_SPIN(xb_ld(&bar[XB_TOPGEN]) == tg, bar);
            __builtin_amdgcn_fence(__ATOMIC_ACQUIRE, "agent");
            xb_add(&bar[XB_XGEN(b.x)], 1u);
            asm volatile("s_waitcnt vmcnt(0)" ::: "memory");
        } else {
            XB_SPIN(xb_ld(&bar[XB_XGEN(b.x)]) == gen, bar);
            __builtin_amdgcn_fence(__ATOMIC_ACQUIRE, "agent");
            asm volatile("s_waitcnt vmcnt(0)" ::: "memory");
        }
    }
    __syncthreads();
}
constexpr int NWAVES = 8;
constexpr int DM = 2048, NB = 4, TT = 4096, CT = 256, SB = 4352, MR = NB * SB  , FF = 5632;
constexpr int AB_IN = 4624, ZLD = 4864, CD_IN = 2304, NMOD = 9, MODN = NMOD * DM  ;
constexpr float EPS = 1e-6f;
constexpr int ZA_Q = 0, ZA_K = 1024, ZA_V = 1280, ZB_Q = 1536, ZB_K = 2048, ZB_V = 2560, ZB_O = 3584, ZB_G = 4608;
constexpr int ZC_U = 0, ZD_Q = 1024, ZD_K = 2048, ZD_V = 2176;
constexpr int KSPLIT = 32;
constexpr size_t MiB = 1u << 20;
constexpr size_t WS_CTL = 0, CTL_ZERO_BYTES = 1 * MiB;
constexpr size_t WS_WUP = 1 * MiB;
constexpr size_t WS_WDN = WS_WUP + 4 * 44 * MiB;
constexpr size_t WS_WABIN = WS_WDN + 4 * 22 * MiB;
constexpr size_t WS_WABOUT = WS_WABIN + 19 * MiB;
constexpr size_t WS_WCDIN = WS_WABOUT + 8 * MiB;
constexpr size_t WS_WCDOUT = WS_WCDIN + 9 * MiB;
constexpr size_t WS_WGLU = WS_WCDOUT + 8 * MiB;
constexpr size_t WS_MODP = WS_WGLU + 2 * MiB;
constexpr size_t WS_MODV = WS_MODP + 23 * MiB;
constexpr size_t WS_NRM = WS_MODV + 1 * MiB;
constexpr size_t WS_TAB = WS_NRM + 1 * MiB;
constexpr size_t WS_H = WS_TAB + 4 * MiB;
constexpr size_t WS_HN = WS_H + 136 * MiB;
constexpr size_t WS_X = WS_HN + 68 * MiB;
constexpr size_t WS_Z = WS_X, WS_ZT = WS_X + 163 * MiB, WS_HID = WS_X;
constexpr size_t WS_CAT = WS_X + 216 * MiB;
constexpr size_t WS_GATES = WS_CAT + 68 * MiB;
constexpr size_t WS_KA = WS_GATES + 2 * MiB;
constexpr size_t WS_G = WS_KA + 10 * MiB;
constexpr size_t WS_SC1 = WS_G + 34 * MiB;
constexpr size_t WS_SC2 = WS_SC1 + 68 * MiB;
constexpr size_t WS_END = WS_SC2 + 68 * MiB;
static_assert((size_t)MR * ZLD * 2 <= 163 * MiB && (size_t)1536 * MR * 2 <= 53 * MiB && (size_t)MR * FF * 2 <= 216 * MiB, "overlay");
constexpr size_t TB_ROPEA = 0;
constexpr size_t TB_ROPED = 16384;
constexpr size_t TB_S5AB = 32768;
constexpr size_t TB_S5BB = TB_S5AB + 65536;
constexpr size_t TB_VEC = TB_S5BB + 1048576;
constexpr int TV_GK = 0, TV_GQ = 128, TV_BGATE = 256, TV_SINK = 272, TV_HEADG = 512, TV_DSKIP = 1536, TV_GLUB = 2560, TV_FINALG = 3584, TV_N = 5632;
constexpr size_t TB_S5C = TB_VEC + 32768;
constexpr size_t TB_S5BT = TB_S5C + 1048576;
constexpr size_t TB_S5CT = TB_S5BT + 524288;
constexpr size_t TB_END = TB_S5CT + 524288;
static_assert(TB_END <= 4 * MiB, "tables");
constexpr int CW_TMO = 0, CW_BAR = 4096;
constexpr int RING_OFF = 0, RING_BYTES = 131072;
constexpr int LDSCTL_OFF = RING_BYTES, MISC_OFF = LDSCTL_OFF + 320;
constexpr int LDS_BYTES = 147456;
static_assert(MISC_OFF + 128 <= LDSCTL_OFF + 512 && LDSCTL_OFF + 512 + 8 * 1024 <= LDS_BYTES, "LDS map");
__device__ __forceinline__ float bf2f(bf16 v) { return __builtin_bit_cast(float, (unsigned)v << 16); }
__device__ __forceinline__ float wave_sum(float v) {
#pragma unroll
    for (int o = 1; o < 64; o <<= 1) v += __shfl_xor(v, o);
    return v;
}
__device__ __forceinline__ float wave_sum_l(float v, int lane) {
#pragma unroll
    for (int o = 1; o < 64; o <<= 1) v += __builtin_bit_cast(float, __builtin_amdgcn_ds_bpermute((lane ^ o) << 2, __builtin_bit_cast(int, v)));
    return v;
}
#define OPAQUE(x) asm volatile("" : "+v"(x))
__device__ __forceinline__ float silu_acc(float x) { return x / (1.f + expf(-x)); }
__device__ __forceinline__ float logsigmoid_acc(float x) { return x >= 0.f ? -log1pf(expf(-x)) : x - log1pf(expf(x)); }
__device__ __forceinline__ float gelu_tanh(float x) { const float u = 0.7978845608028654f * (x + 0.044715f * x * x * x); return 0.5f * x * (1.f + tanhf(u)); }
__device__ __forceinline__ int row_sel(int m) { return m < NB * TT ? (m >> 12) : 4; }

struct Frame {
    LAS unsigned char* lds;
    volatile LAS unsigned* MISC;
    gu32* ctl;
    int wave, G;
    float* out; unsigned char* ws;
};

__device__ __forceinline__ void p0_transpose_item(const float* W, int K, int N, int Nvalid, bf16* WT, int drow0, int k0, int n0, LAS float* scr, int lane) {
    const int nn = n0 + (lane & 31); const bool ok = nn < Nvalid;
#pragma unroll
    for (int i = 0; i < 32; ++i) { const int kk = 2 * i + (lane >> 5); scr[kk * 33 + (lane & 31)] = ok ? W[(size_t)(k0 + kk) * N + nn] : 0.f; }
    LDS_WAIT(); asm volatile("" ::: "memory");
    const int c = lane & 7;
#pragma unroll
    for (int j = 0; j < 4; ++j) { const int n = (lane >> 3) + 8 * j; const LAS float* s = scr + (8 * c) * 33 + n;
        v4u o; o.x = pk2(s[0 * 33], s[1 * 33]); o.y = pk2(s[2 * 33], s[3 * 33]); o.z = pk2(s[4 * 33], s[5 * 33]); o.w = pk2(s[6 * 33], s[7 * 33]);
        *(GAS v4u*)(WT + (size_t)(drow0 + n) * K + k0 + 8 * c) = o; }
    LDS_WAIT(); asm volatile("" ::: "memory");
}
__device__ __forceinline__ bool p0_mat(int& r, const float* W, int K, int N, int Npad, bf16* WT, int mode  , LAS float* scr, int lane) {
    const int nblk = Npad / 32, items = (K / 64) * nblk;
    if (r >= items) { r -= items; return false; }
    const int kb = r / nblk, nb = r % nblk, n0 = 32 * nb;
    int drow0 = n0; if (mode) drow0 = (n0 >> 7) * 256 + (n0 & 127) + (mode == 2 ? 128 : 0);
    p0_transpose_item(W, K, N, N, WT, drow0, 64 * kb, n0, scr, lane);
    return true;
}
__device__ __forceinline__ void p0_prologue(Frame& F, const float* const (&in)[30]) {
    LAS float* scr = (LAS float*)(F.lds + RING_OFF + F.wave * 16384);
    const int lane = fresh_lane();
    const int gw = blockIdx.x * NWAVES + F.wave, NGW = F.G * NWAVES;
    unsigned char* ws = F.ws;
    {
        constexpr int NCH = MODN / 256, NIT = 2 * KSPLIT * NCH, KPER = DM / KSPLIT;
        for (int it = gw; it < NIT; it += NGW) {
            const int cc = it % NCH, ks = (it / NCH) % KSPLIT, l = it / (NCH * KSPLIT);
            const float* W = in[4] + (size_t)l * DM * MODN + (size_t)(ks * KPER) * MODN + cc * 256 + lane * 4;
            f32x4 a0 = {0, 0, 0, 0}, a1 = a0, a2 = a0, a3 = a0, a4 = a0;
#pragma unroll 16
            for (int k = 0; k < KPER; ++k) {
                const f32x4 w = *(const f32x4*)(W + (size_t)k * MODN); const int kk = ks * KPER + k;
                const float s0 = silu_acc(in[1][kk]), s1 = silu_acc(in[1][DM + kk]), s2 = silu_acc(in[1][2 * DM + kk]), s3 = silu_acc(in[1][3 * DM + kk]), s4 = silu_acc(in[3][kk]);
                a0 += w * s0; a1 += w * s1; a2 += w * s2; a3 += w * s3; a4 += w * s4;
            }
            float* P = (float*)(ws + WS_MODP) + ((size_t)(l * KSPLIT + ks) * 5) * MODN + cc * 256 + lane * 4;
            *(f32x4*)(P) = a0; *(f32x4*)(P + MODN) = a1; *(f32x4*)(P + 2 * MODN) = a2; *(f32x4*)(P + 3 * MODN) = a3; *(f32x4*)(P + 4 * MODN) = a4;
        }
    }
    {
        constexpr int I_UP = (DM / 64) * (FF / 32), I_DN = (FF / 64) * (DM / 32);
        constexpr int NIT = 8 * I_UP + 4 * I_DN + (DM / 64) * (ZLD / 32) + 2 * (DM / 64) * (DM / 32) + (DM / 64) * (CD_IN / 32) + (1024 / 64) * (1024 / 32);
        for (int it = gw; it < NIT; it += NGW) {
            int r = it; bool done = false;
#pragma unroll 1
            for (int lh = 0; lh < 4 && !done; ++lh) {
                bf16* up = (bf16*)(ws + WS_WUP + (size_t)lh * 44 * MiB);
                done = p0_mat(r, in[7] + (size_t)lh * DM * FF, DM, FF, FF, up, 1, scr, lane); if (done) break;
                done = p0_mat(r, in[8] + (size_t)lh * DM * FF, DM, FF, FF, up, 2, scr, lane); if (done) break;
                done = p0_mat(r, in[9] + (size_t)lh * FF * DM, FF, DM, DM, (bf16*)(ws + WS_WDN + (size_t)lh * 22 * MiB), 0, scr, lane);
            }
            if (done) continue;
            {
                const int nblk = ZLD / 32, items = (DM / 64) * nblk;
                if (r < items) { const int kb = r / nblk, nb = r % nblk; p0_transpose_item(in[10], DM, AB_IN, AB_IN, (bf16*)(ws + WS_WABIN), 32 * nb, 64 * kb, 32 * nb, scr, lane); continue; }
                r -= items;
            }
            if (p0_mat(r, in[12], DM, DM, DM, (bf16*)(ws + WS_WABOUT), 0, scr, lane)) continue;
            if (p0_mat(r, in[16], DM, CD_IN, CD_IN, (bf16*)(ws + WS_WCDIN), 0, scr, lane)) continue;
            if (p0_mat(r, in[17], DM, DM, DM, (bf16*)(ws + WS_WCDOUT), 0, scr, lane)) continue;
            p0_mat(r, in[26], 1024, 1024, 1024, (bf16*)(ws + WS_WGLU), 0, scr, lane);
        }
    }
    {
        const int tid_ = fresh_tid(F.wave); const int gt = blockIdx.x * (NWAVES * 64) + tid_, NT = F.G * NWAVES * 64;
        float* ropeA = (float*)(ws + WS_TAB + TB_ROPEA); float* ropeD = (float*)(ws + WS_TAB + TB_ROPED);
        for (int i = gt; i < 64 * 32; i += NT) { const int pos = i >> 5, f = i & 31; const float inv = powf(10000.f, -(float)f / 32.f), a = (float)pos * inv; ropeA[2 * i] = cosf(a); ropeA[2 * i + 1] = sinf(a); }
        for (int i = gt; i < 64 * 16; i += NT) { const int pos = i >> 4, f = i & 15; const float inv = powf(10000.f, -(float)f / 16.f), a = (float)pos * inv; ropeD[2 * i] = cosf(a); ropeD[2 * i + 1] = sinf(a); }
        float* s5ab = (float*)(ws + WS_TAB + TB_S5AB); float* s5bb = (float*)(ws + WS_TAB + TB_S5BB); bf16* s5bt = (bf16*)(ws + WS_TAB + TB_S5BT); bf16* s5ct = (bf16*)(ws + WS_TAB + TB_S5CT);
        for (int i = gt; i < 2 * 64 * 64; i += NT) {
            const int dg = i >> 6;
            const float are = in[18][i], aim = in[19][i], dt = expf(in[20][dg]);
            const float mag = expf(are * dt), abr = mag * cosf(aim * dt), abi = mag * sinf(aim * dt);
            const float den = are * are + aim * aim, nr = abr - 1.f, ni = abi;
            const float kre = (nr * are + ni * aim) / den, kim = (ni * are - nr * aim) / den;
            s5ab[2 * i] = abr; s5ab[2 * i + 1] = abi;
            for (int q = 0; q < 16; ++q) { const float br = in[21][(size_t)i * 16 + q], bi = in[22][(size_t)i * 16 + q];
                const float bbr = kre * br - kim * bi, bbi = kre * bi + kim * br;
                s5bb[((size_t)i * 16 + q) * 2] = bbr; s5bb[((size_t)i * 16 + q) * 2 + 1] = bbi;
                s5bt[((size_t)dg * 128 + (i & 63)) * 16 + q] = (bf16)f2bf(bbr); s5bt[((size_t)dg * 128 + 64 + (i & 63)) * 16 + q] = (bf16)f2bf(bbi); }
        }
        for (int i = gt; i < 2 * 64 * 16 * 128; i += NT) { const int pp = i & 127, dgo = i >> 7;
            s5ct[i] = (bf16)f2bf(pp < 64 ? in[23][(size_t)dgo * 64 + pp] : -in[24][(size_t)dgo * 64 + pp - 64]); }
        float* tv = (float*)(ws + WS_TAB + TB_VEC);
        for (int i = gt; i < TV_N; i += NT) { float v = 0.f;
            if (i < TV_GQ) v = in[14][i]; else if (i < TV_BGATE) v = in[13][i - TV_GQ]; else if (i < TV_SINK) v = in[11][i - TV_BGATE]; else if (i < TV_SINK + 16) v = in[28][i - TV_SINK];
            else if (i >= TV_HEADG && i < TV_DSKIP) v = in[15][i - TV_HEADG]; else if (i >= TV_DSKIP && i < TV_GLUB) v = in[25][i - TV_DSKIP];
            else if (i >= TV_GLUB && i < TV_FINALG) v = in[27][i - TV_GLUB]; else if (i >= TV_FINALG) v = in[29][i - TV_FINALG];
            tv[i] = v; }
        float* s5c = (float*)(ws + WS_TAB + TB_S5C);
        for (int i = gt; i < 2 * 131072; i += NT) s5c[i] = i < 131072 ? in[23][i] : in[24][i - 131072];
    }
}
__device__ __forceinline__ void p1_modreduce(Frame& F, const float* modb, const float* normg) {
    const int tid_ = fresh_tid(F.wave); const int gt = blockIdx.x * (NWAVES * 64) + tid_, NT = F.G * NWAVES * 64;
    const float* P = (const float*)(F.ws + WS_MODP); float* MV = (float*)(F.ws + WS_MODV); float* NR = (float*)(F.ws + WS_NRM);
    for (int i = gt; i < 2 * 5 * DM; i += NT) {
        const int c = i % DM, sel = (i / DM) % 5, l = i / (5 * DM);
        float mv[9];
#pragma unroll
        for (int idx = 0; idx < 9; ++idx) { float s = 0.f;
            for (int ks = 0; ks < KSPLIT; ++ks) s += P[((size_t)(l * KSPLIT + ks) * 5 + sel) * MODN + idx * DM + c];
            s += modb[l * MODN + idx * DM + c]; mv[idx] = s; MV[((size_t)(l * 5 + sel) * 9 + idx) * DM + c] = s; }
#pragma unroll
        for (int w = 0; w < 3; ++w) { const float g = normg[(l * 3 + w) * DM + c];
            NR[(((size_t)(l * 5 + sel) * 3 + w) * 2) * DM + c] = g * (1.f + mv[3 * w + 1]);
            NR[(((size_t)(l * 5 + sel) * 3 + w) * 2 + 1) * DM + c] = mv[3 * w]; }
    }
}
__device__ __forceinline__ void norm_phase(Frame& F, unsigned char* ws, const float* xin, const float* cin, int l, int which, bool first, int nrows, int part_S = 0, const float* pgate = nullptr, float pcoef = 0.f) {
    const int lane = fresh_lane();
    const int gw = blockIdx.x * NWAVES + F.wave, NGW = F.G * NWAVES;
    float* H = (float*)(ws + WS_H); bf16* HN = (bf16*)(ws + WS_HN); const float* NR = (const float*)(ws + WS_NRM);
    for (int m = gw; m < nrows; m += NGW) {
        const float* src = first ? (m < NB * TT ? xin + (size_t)m * DM : cin + (size_t)(m - NB * TT) * DM) : H + (size_t)m * DM;
        const GAS f32x4* xr = (const GAS f32x4*)src + lane;
        f32x4 v[8]; float s = 0.f;
#pragma unroll
        for (int j = 0; j < 8; ++j) { v[j] = xr[64 * j]; s += (v[j].x * v[j].x + v[j].y * v[j].y) + (v[j].z * v[j].z + v[j].w * v[j].w); }
        const bool merge = part_S > 0 && m >= NB * TT;
        if (merge) { const GAS f32x4* pp = (const GAS f32x4*)((const float*)(ws + WS_SC1) + (size_t)(m - NB * TT) * DM) + lane; const GAS f32x4* gp = (const GAS f32x4*)pgate + lane; s = 0.f;
#pragma unroll
            for (int j = 0; j < 8; ++j) { f32x4 a = pp[64 * j]; for (int q = 1; q < part_S; ++q) a += pp[(size_t)q * (1024 * DM / 4) + 64 * j]; v[j] += gp[64 * j] * pcoef * a;
                s += (v[j].x * v[j].x + v[j].y * v[j].y) + (v[j].z * v[j].z + v[j].w * v[j].w); } }
        const float rstd = 1.f / sqrtf(wave_sum_l(s, lane) * (1.f / DM) + EPS);
        if (first || merge) { GAS f32x4* hw = (GAS f32x4*)(H + (size_t)m * DM) + lane;
#pragma unroll
            for (int j = 0; j < 8; ++j) hw[64 * j] = v[j]; }
        const int sel = row_sel(m);
        const GAS f32x4* Ap = (const GAS f32x4*)(NR + (((size_t)(l * 5 + sel) * 3 + which) * 2) * DM) + lane; const GAS f32x4* Bp = Ap + DM / 4;
        GAS unsigned long long* o8 = (GAS unsigned long long*)(HN + (size_t)m * DM) + lane;
#pragma unroll
        for (int j = 0; j < 8; ++j) { const f32x4 a = Ap[64 * j], b = Bp[64 * j]; const f32x4 y = v[j] * rstd * a + b;
            o8[64 * j] = (unsigned long long)pk2(y.x, y.y) | ((unsigned long long)pk2(y.z, y.w) << 32); }
    }
}
__device__ __forceinline__ void final_norm_phase(Frame& F, unsigned char* ws) {
    const int lane = fresh_lane();
    const int gw = blockIdx.x * NWAVES + F.wave, NGW = F.G * NWAVES;
    const float* H = (const float*)(ws + WS_H);
    for (int m = gw; m < NB * TT; m += NGW) {
        const GAS f32x4* xr = (const GAS f32x4*)(H + (size_t)m * DM) + lane;
        f32x4 v[8]; float s = 0.f;
#pragma unroll
        for (int j = 0; j < 8; ++j) { v[j] = xr[64 * j]; s += (v[j].x * v[j].x + v[j].y * v[j].y) + (v[j].z * v[j].z + v[j].w * v[j].w); }
        const float rstd = 1.f / sqrtf(wave_sum_l(s, lane) * (1.f / DM) + EPS);
        const GAS f32x4* gp = (const GAS f32x4*)((const float*)(ws + WS_TAB + TB_VEC) + TV_FINALG) + lane; GAS f32x4* o = (GAS f32x4*)(F.out + (size_t)m * DM) + lane;
#pragma unroll
        for (int j = 0; j < 8; ++j) o[64 * j] = v[j] * rstd * gp[64 * j];
    }
}
template <int MODE> __device__ __forceinline__ void naive_kprep(int gw, int lane, const bf16* Z, bf16* KO, const float* gk, const float* rope) {
    if (MODE == 0) {
        if (gw >= MR * 2) return;
        const int m = gw >> 1, kvh = gw & 1; const bf16* zr = Z + (size_t)m * ZLD + ZA_K + kvh * 128;
        float x1 = bf2f(zr[lane]), x2 = bf2f(zr[64 + lane]);
        const float rstd = 1.f / sqrtf(wave_sum_l(x1 * x1 + x2 * x2, lane) * (1.f / 128.f) + EPS);
        x1 *= rstd * gk[lane]; x2 *= rstd * gk[64 + lane];
        if (m < NB * TT) { const int t = m & (TT - 1), pos = lane < 32 ? (t >> 6) : (t & 63), f = lane & 31; const float c = rope[2 * (pos * 32 + f)], s = rope[2 * (pos * 32 + f) + 1];
            const float o1 = x1 * c - x2 * s, o2 = x2 * c + x1 * s; x1 = o1; x2 = o2; }
        KO[(size_t)m * 256 + kvh * 128 + lane] = (bf16)f2bf(x1); KO[(size_t)m * 256 + kvh * 128 + 64 + lane] = (bf16)f2bf(x2);
    } else {
        if (gw >= MR) return;
        const int m = gw, kvh = lane >> 5, j = lane & 31; const bf16* zr = Z + (size_t)m * CD_IN + ZD_K + kvh * 64;
        float x1 = bf2f(zr[j]), x2 = bf2f(zr[32 + j]);
        if (m < NB * TT) { const int t = m & (TT - 1), pos = j < 16 ? (t >> 6) : (t & 63), f = j & 15; const float c = rope[2 * (pos * 16 + f)], s = rope[2 * (pos * 16 + f) + 1];
            const float o1 = x1 * c - x2 * s, o2 = x2 * c + x1 * s; x1 = o1; x2 = o2; }
        KO[(size_t)m * 128 + kvh * 64 + j] = (bf16)f2bf(x1); KO[(size_t)m * 128 + kvh * 64 + 32 + j] = (bf16)f2bf(x2);
    }
}
template <int DH, int MODE> __device__ __forceinline__ void naive_attn(int vb, int vtid, const bf16* Z, const bf16* KB, bf16* CAT, const float* gq, const float* rope, const float* sink) {
    constexpr int H4 = DH / 4, NF = DH / 4, NH = (MODE == 2) ? 16 : 8, QPB = 128;
    constexpr int NQ = (MODE == 1) ? CT : TT, LDZ = (MODE == 2) ? CD_IN : ZLD, LDK = (MODE == 2) ? 128 : 256;
    constexpr int QCOL = (MODE == 2) ? ZD_Q : ZA_Q, VCOL = (MODE == 2) ? ZD_V : ZA_V, OCOL = (MODE == 2) ? 1024 : 0;
    const int nchunk = NQ / QPB; int bid = vb; const int qc = bid % nchunk; bid /= nchunk; const int head = bid % NH, b = bid / NH;
    const int kvh = head / (NH / 2), part = vtid & 3, r = vtid >> 2, qi = qc * QPB + r;
    const int m = (MODE == 1) ? (NB * TT + b * CT + qi) : (b * TT + qi);
    float q[H4], acc[H4];
    const bf16* qp = Z + (size_t)m * LDZ + QCOL + head * DH + part * H4;
#pragma unroll
    for (int i = 0; i < H4; ++i) { q[i] = bf2f(qp[i]); acc[i] = 0.f; }
    if (MODE != 2) { float ss = 0.f;
#pragma unroll
        for (int i = 0; i < H4; ++i) ss += q[i] * q[i];
        ss += __shfl_xor(ss, 1); ss += __shfl_xor(ss, 2); const float rstd = 1.f / sqrtf(ss * (1.f / DH) + EPS);
#pragma unroll
        for (int i = 0; i < H4; ++i) q[i] *= rstd * gq[part * H4 + i]; }
    if (MODE != 1) { const int t = qi;
#pragma unroll
        for (int i = 0; i < H4; ++i) { const int j = (part & 1) * H4 + i;
            const int pos = j < NF ? (t >> 6) : (t & 63), f = j % NF; const float c = rope[2 * (pos * NF + f)], s = rope[2 * (pos * NF + f) + 1];
            const float other = __shfl_xor(q[i], 2); q[i] = part < 2 ? (q[i] * c - other * s) : (q[i] * c + other * s); } }
    const float scale = (DH == 128) ? 0.08838834764831845f : 0.125f;
#pragma unroll
    for (int i = 0; i < H4; ++i) q[i] *= scale;
    float mx = (MODE == 2) ? sink[head] : -1e30f, l = (MODE == 2) ? 1.f : 0.f;
    const int lat_lo = (MODE == 0) ? 0 : (MODE == 2 ? max(0, qc * QPB - 128) : 0), lat_hi = (MODE == 0) ? TT : (MODE == 2 ? min(TT, qc * QPB + QPB + 128) : 0);
    const int nkeys = CT + (lat_hi - lat_lo);
#pragma unroll 2
    for (int kk = 0; kk < nkeys; ++kk) {
        const int kpos = kk - CT + lat_lo;
        const int km = kk < CT ? (NB * TT + b * CT + kk) : (b * TT + kpos);
        const bf16* kp = KB + (size_t)km * LDK + kvh * DH + part * H4;
        float s = 0.f;
#pragma unroll
        for (int i = 0; i < H4; ++i) s += q[i] * bf2f(kp[i]);
        s += __shfl_xor(s, 1); s += __shfl_xor(s, 2);
        if (MODE == 2 && kk >= CT && abs(kpos - qi) > 128) continue;
        const float mn = fmaxf(mx, s), al = expf(mx - mn), p = expf(s - mn);
        l = l * al + p; mx = mn;
        const bf16* vp = Z + (size_t)km * LDZ + VCOL + kvh * DH + part * H4;
#pragma unroll
        for (int i = 0; i < H4; ++i) acc[i] = acc[i] * al + p * bf2f(vp[i]);
    }
    const float il = 1.f / l;
    bf16* op = CAT + (size_t)m * DM + OCOL + head * DH + part * H4;
#pragma unroll
    for (int i = 0; i < H4; ++i) op[i] = (bf16)f2bf(acc[i] * il);
}
__device__ __forceinline__ void naive_mlstm(int seq, int tid, LAS float* sq, const bf16* Z, const float* GATES, const float* bgate, float* HF, float* HB) {
    const int b = seq >> 3, h = (seq >> 1) & 3, dir = seq & 1;
    LAS float* sk = sq + 128; LAS float* sred = sq + 256;
    const int v = tid >> 1, half = tid & 1, lane = tid & 63, wave = tid >> 6;
    float C[64];
#pragma unroll
    for (int j = 0; j < 64; ++j) C[j] = 0.f;
    float nreg = 0.f, mstate = 0.f;
    const float bi = bgate[(2 * dir) * 4 + h], bfg = bgate[(2 * dir + 1) * 4 + h];
    float* HO = dir ? HB : HF;
    for (int p = 0; p < SB; ++p) {
        const int s = dir == 0 ? p : (p < CT ? CT - 1 - p : CT + (SB - 1 - p));
        const int m = s < CT ? (NB * TT + b * CT + s) : (b * TT + s - CT);
        const bf16* zr = Z + (size_t)m * ZLD;
        if (tid < 128) sq[tid] = bf2f(zr[ZB_Q + h * 128 + tid]) * 0.08838834764831845f; else if (tid < 256) sk[tid - 128] = bf2f(zr[ZB_K + h * 128 + tid - 128]);
        const float vv = bf2f(zr[ZB_V + h * 256 + v]);
        const float ig = GATES[(size_t)m * 16 + (2 * dir) * 4 + h] + bi, lf = logsigmoid_acc(GATES[(size_t)m * 16 + (2 * dir + 1) * 4 + h] + bfg);
        const float mn = fmaxf(lf + mstate, ig), ip = expf(ig - mn), fp = expf(lf + mstate - mn); mstate = mn;
        __syncthreads();
        float dpart = 0.f; if (tid < 128) { nreg = fp * nreg + ip * sk[tid]; dpart = nreg * sq[tid]; }
        if (wave < 2) { dpart = wave_sum_l(dpart, lane); if (lane == 0) sred[wave] = dpart; }
        float np = 0.f; const float iv = ip * vv;
#pragma unroll
        for (int j = 0; j < 64; ++j) { C[j] = fp * C[j] + iv * sk[64 * half + j]; np += C[j] * sq[64 * half + j]; }
        np += __builtin_bit_cast(float, __builtin_amdgcn_ds_bpermute((lane ^ 1) << 2, __builtin_bit_cast(int, np)));
        __syncthreads();
        const float den = sred[0] + sred[1];
        if (half == 0) HO[(size_t)m * 1024 + h * 256 + v] = np / fmaxf(fabsf(den), expf(-mn));
        __syncthreads();
    }
}
__device__ __forceinline__ void naive_mlstm_finish(int gw, int lane, const bf16* Z, const float* HF, const float* HB, const float* headg, bf16* CAT) {
    const int m = gw >> 2, h = gw & 3; const size_t o = (size_t)m * 1024 + h * 256 + lane * 4;
    const f32x4 a = *(const f32x4*)(HF + o), bb = *(const f32x4*)(HB + o); const f32x4 hh = a + bb;
    const float rstd = 1.f / sqrtf(wave_sum_l((hh.x * hh.x + hh.y * hh.y) + (hh.z * hh.z + hh.w * hh.w), lane) * (1.f / 256.f) + EPS);
    const bf16* og = Z + (size_t)m * ZLD + ZB_O + h * 256 + lane * 4; bf16* cp = CAT + (size_t)m * DM + 1024 + h * 256 + lane * 4;
#pragma unroll
    for (int j = 0; j < 4; ++j) { const float sg = 1.f / (1.f + expf(-bf2f(og[j]))); cp[j] = (bf16)f2bf(sg * hh[j] * rstd * headg[h * 256 + lane * 4 + j]); }
}
__device__ __forceinline__ void naive_s5(int id, int lane, const bf16* Z, const float* s5ab, const float* s5bb, const float* cre_in, const float* cim_in, float* YF, float* YB) {
    const int b = id >> 7, g = (id >> 1) & 63, dir = id & 1;
    const int i = (dir * 64 + g) * 64 + lane;
    const float ar = s5ab[2 * i], ai = s5ab[2 * i + 1];
    float Br[16], Bi[16], cr[16], ci[16];
#pragma unroll
    for (int q = 0; q < 16; ++q) { Br[q] = s5bb[((size_t)i * 16 + q) * 2]; Bi[q] = s5bb[((size_t)i * 16 + q) * 2 + 1];
        cr[q] = cre_in[((size_t)(dir * 64 + g) * 16 + q) * 64 + lane]; ci[q] = cim_in[((size_t)(dir * 64 + g) * 16 + q) * 64 + lane]; }
    float xr = 0.f, xi = 0.f; float* Y = dir ? YB : YF;
    for (int p = 0; p < SB; ++p) {
        const int s = dir == 0 ? p : (p < CT ? CT - 1 - p : CT + (SB - 1 - p));
        const int m = s < CT ? (NB * TT + b * CT + s) : (b * TT + s - CT);
        const bf16* up = Z + (size_t)m * CD_IN + ZC_U + g * 16;
        float bur = 0.f, bui = 0.f;
#pragma unroll
        for (int q = 0; q < 16; ++q) { const float u = bf2f(up[q]); bur += Br[q] * u; bui += Bi[q] * u; }
        const float nxr = ar * xr - ai * xi + bur, nxi = ar * xi + ai * xr + bui; xr = nxr; xi = nxi;
        if (s >= CT) { float yo = 0.f;
#pragma unroll
            for (int q = 0; q < 16; ++q) { const float val = wave_sum_l(cr[q] * xr - ci[q] * xi, lane); if (lane == q) yo = val; }
            if (lane < 16) Y[(size_t)m * 1024 + g * 16 + lane] = yo; }
    }
}
__device__ __forceinline__ void naive_s5_finish(size_t i, const bf16* Z, const float* YF, const float* YB, const float* dskip, bf16* G) {
    const int m = (int)(i >> 10), c = (int)(i & 1023);
    const float y = YF[i] + YB[i] + dskip[c] * bf2f(Z[(size_t)m * CD_IN + ZC_U + c]);
    G[i] = (bf16)f2bf(gelu_tanh(y));
}
namespace att {
using bf16x8 = __attribute__((ext_vector_type(8))) short;
using s16x4  = __attribute__((ext_vector_type(4))) short;
using f32x16 = __attribute__((ext_vector_type(16))) float;
using u32x4  = __attribute__((ext_vector_type(4))) unsigned;
constexpr int NW = 8, QBLK = 32, KVBLK = 64;
constexpr size_t SHM_V = KVBLK * 128 * 2, SHM_K = KVBLK * 128 * 2, SHM_ATTN = 2 * SHM_V + 2 * SHM_K + NW * 64 * 4;
#define KSWZ(row, colB) ((row) * 256 + ((colB) ^ (((row) & 7) << 4)))
#define SBAR() __builtin_amdgcn_sched_barrier(0)
__device__ __forceinline__ int crow(int r, int hi) { return (r & 3) + 8 * (r >> 2) + 4 * hi; }
__device__ __forceinline__ unsigned cvtpk(float lo, float hi) { unsigned r; asm volatile("v_cvt_pk_bf16_f32 %0, %1, %2" : "=v"(r) : "v"(lo), "v"(hi)); return r; }
template <int DH> struct Cst { static constexpr float SCALE = (DH == 128) ? 0.088388347648318440f : 0.125f; };
constexpr float THR = 8.f;
#ifndef ATT_SDEPTH
#define ATT_SDEPTH 2
#endif
constexpr int SDEPTH = ATT_SDEPTH;
template <int DH> __device__ __forceinline__ void partialSM(f32x16& p0, f32x16& p1, float& m_reg, float& mn, float& alpha) {
  constexpr float SCALE = Cst<DH>::SCALE, C = SCALE * 1.4426950408889634f;
  float pmax = p0[0]; for (int r = 1; r < 16; ++r) pmax = fmaxf(pmax, p0[r]); for (int r = 0; r < 16; ++r) pmax = fmaxf(pmax, p1[r]);
  { auto rr = __builtin_amdgcn_permlane32_swap(__float_as_uint(pmax), __float_as_uint(pmax), false, false);
    pmax = fmaxf(__uint_as_float(rr[0]), __uint_as_float(rr[1])); }
  if (__builtin_expect(__all(pmax - m_reg <= THR / SCALE), 1)) { mn = m_reg; alpha = 1.f; }
  else { mn = fmaxf(m_reg, pmax); alpha = __builtin_amdgcn_exp2f((m_reg - mn) * C); m_reg = mn; }
  float mnC = -mn * C;
  for (int r = 0; r < 16; ++r) p0[r] = fmaf(p0[r], C, mnC); for (int r = 0; r < 16; ++r) p1[r] = fmaf(p1[r], C, mnC);
  for (int r = 0; r < 16; ++r) p0[r] = __builtin_amdgcn_exp2f(p0[r]);
}
__device__ __forceinline__ void finishSM(f32x16& p0, f32x16& p1, float alpha, float& l_reg, bf16x8& pa0, bf16x8& pa1, bf16x8& pa2, bf16x8& pa3) {
  for (int r = 0; r < 16; ++r) p1[r] = __builtin_amdgcn_exp2f(p1[r]);
  float ps = 0; for (int r = 0; r < 16; ++r) ps += p0[r]; for (int r = 0; r < 16; ++r) ps += p1[r];
  { auto rr = __builtin_amdgcn_permlane32_swap(__float_as_uint(ps), __float_as_uint(ps), false, false);
    ps = __uint_as_float(rr[0]) + __uint_as_float(rr[1]); }
  l_reg = l_reg * alpha + ps;
#define PK4(P, BASE, OUT) do { unsigned a0 = cvtpk(P[BASE + 0], P[BASE + 1]), a1 = cvtpk(P[BASE + 2], P[BASE + 3]);   \
    unsigned b0 = cvtpk(P[BASE + 4], P[BASE + 5]), b1 = cvtpk(P[BASE + 6], P[BASE + 7]);                              \
    auto r0 = __builtin_amdgcn_permlane32_swap(a0, b0, false, false); auto r1 = __builtin_amdgcn_permlane32_swap(a1, b1, false, false); \
    u32x4 w = {r0[0], r1[0], r0[1], r1[1]}; OUT = *reinterpret_cast<bf16x8*>(&w); } while (0)
  PK4(p0, 0, pa0); PK4(p0, 8, pa1); PK4(p1, 0, pa2); PK4(p1, 8, pa3);
#undef PK4
}
template <int DH> __device__ __forceinline__ void qkt(f32x16& p0, f32x16& p1, const bf16* Ks, const bf16x8* qr, int r32, int hi) {
  p0 = f32x16{}; p1 = f32x16{};
#pragma unroll
  for (int d0 = 0; d0 < DH / 16; ++d0) { int cb = (d0 * 16 + hi * 8) * 2;
    bf16x8 b0 = *reinterpret_cast<const bf16x8*>((const char*)Ks + KSWZ(r32, cb));
    bf16x8 b1 = *reinterpret_cast<const bf16x8*>((const char*)Ks + KSWZ(32 + r32, cb));
    p0 = __builtin_amdgcn_mfma_f32_32x32x16_bf16(b0, qr[d0], p0, 0, 0, 0);
    p1 = __builtin_amdgcn_mfma_f32_32x32x16_bf16(b1, qr[d0], p1, 0, 0, 0); }
}
__device__ __forceinline__ void wmask(f32x16& p0, f32x16& p1, int kp0, int qpos, int hi) {
#pragma unroll
  for (int r = 0; r < 16; ++r) { const int k = kp0 + crow(r, hi); const int d0 = k - qpos, d1 = k + 32 - qpos;
    if (d0 > 128 || d0 < -128) p0[r] = -1e30f; if (d1 > 128 || d1 < -128) p1[r] = -1e30f; }
}
__device__ __forceinline__ int v_st(int k, int c) { const int kk = (k & ~0xC) | ((k & 4) << 1) | ((k & 8) >> 1); return ((kk >> 3) * 4 + (c >> 5)) * 512 + ((kk & 7) * 32 + (c & 31)) * 2; }
__device__ __forceinline__ int v_rd_base(int lane) { return ((lane & 3) << 3) | (((lane >> 2) & 3) << 6) | (((lane >> 4) & 1) << 5) | (((lane >> 5) & 1) << 8); }
constexpr int v_rd_off(int d0, int ks, int half) { return d0 * 512 + ks * 4096 + half * 2048; }
template <int OFF> __device__ __forceinline__ s16x4 tr_read(int vb) {
  s16x4 r; asm volatile("ds_read_b64_tr_b16 %0, %1 offset:%2" : "=&v"(r) : "v"(vb), "i"(OFF) : "memory"); return r;
}
template <int D0> __device__ __forceinline__ void pv_one(f32x16& od, int vb, bf16x8 pa0, bf16x8 pa1, bf16x8 pa2, bf16x8 pa3) {
  const s16x4 l0 = tr_read<v_rd_off(D0, 0, 0)>(vb), h0 = tr_read<v_rd_off(D0, 0, 1)>(vb), l1 = tr_read<v_rd_off(D0, 1, 0)>(vb), h1 = tr_read<v_rd_off(D0, 1, 1)>(vb);
  const s16x4 l2 = tr_read<v_rd_off(D0, 2, 0)>(vb), h2 = tr_read<v_rd_off(D0, 2, 1)>(vb), l3 = tr_read<v_rd_off(D0, 3, 0)>(vb), h3 = tr_read<v_rd_off(D0, 3, 1)>(vb);
  asm volatile("s_waitcnt lgkmcnt(0)" ::: "memory"); SBAR();
#define PK(L, H) (bf16x8){L[0], L[1], L[2], L[3], H[0], H[1], H[2], H[3]}
  od = __builtin_amdgcn_mfma_f32_32x32x16_bf16(pa0, PK(l0, h0), od, 0, 0, 0);
  od = __builtin_amdgcn_mfma_f32_32x32x16_bf16(pa1, PK(l1, h1), od, 0, 0, 0);
  od = __builtin_amdgcn_mfma_f32_32x32x16_bf16(pa2, PK(l2, h2), od, 0, 0, 0);
  od = __builtin_amdgcn_mfma_f32_32x32x16_bf16(pa3, PK(l3, h3), od, 0, 0, 0);
#undef PK
}
template <int DH> __device__ __forceinline__ void pv_d0(f32x16* o, int vb, bf16x8 pa0, bf16x8 pa1, bf16x8 pa2, bf16x8 pa3) {
  pv_one<0>(o[0], vb, pa0, pa1, pa2, pa3); pv_one<1>(o[1], vb, pa0, pa1, pa2, pa3);
  if (DH == 128) { pv_one<2>(o[2], vb, pa0, pa1, pa2, pa3); pv_one<3>(o[3], vb, pa0, pa1, pa2, pa3); }
}
template <int DH, int MODE>
__device__ __forceinline__ void attn_unit(const bf16* __restrict__ Qb, int LDQ, const bf16* __restrict__ Kb, int LDKK, const bf16* __restrict__ Vb, int LDKV, bf16* __restrict__ Ob,
                                          int b, int i0  , const float* __restrict__ gq, const float* __restrict__ rope, float sinkv, char* lds, int wave_s) {
  const int tid = fresh_tid(wave_s);
  constexpr float SCALE = Cst<DH>::SCALE;
  const int wid = tid >> 6, lane = tid & 63, r32 = lane & 31, hi = lane >> 5;
  bf16* V_lds = (bf16*)lds; bf16* K_lds = (bf16*)(lds + 2 * SHM_V);
  float* ws = (float*)(lds + 2 * SHM_V + 2 * SHM_K) + wid * 64; float* li_l = ws; float* al_l = ws + 32;
  float m_reg = (MODE == 2) ? sinkv / SCALE : -1e30f, l_reg = (MODE == 2) ? 1.f : 0.f; f32x16 o[DH / 32] = {}; bf16x8 qr[DH / 16];
  const int qpos = i0 + wid * QBLK + r32;
  {
    const bf16* Qw = Qb + (long)(wid * QBLK + r32) * LDQ + hi * 8;
    float qf[DH / 16][8];
#pragma unroll
    for (int d0 = 0; d0 < DH / 16; ++d0) { const u32x4 w = *reinterpret_cast<const u32x4*>(Qw + d0 * 16);
#pragma unroll
      for (int e = 0; e < 4; ++e) { qf[d0][2 * e] = __uint_as_float(w[e] << 16); qf[d0][2 * e + 1] = __uint_as_float(w[e] & 0xffff0000u); } }
    if (MODE != 2) { float ss = 0.f;
#pragma unroll
      for (int d0 = 0; d0 < DH / 16; ++d0)
#pragma unroll
        for (int e = 0; e < 8; ++e) ss += qf[d0][e] * qf[d0][e];
      { auto rr = __builtin_amdgcn_permlane32_swap(__float_as_uint(ss), __float_as_uint(ss), false, false); ss = __uint_as_float(rr[0]) + __uint_as_float(rr[1]); }
      const float rstd = 1.f / sqrtf(ss * (1.f / DH) + EPS);
#pragma unroll
      for (int d0 = 0; d0 < DH / 16; ++d0)
#pragma unroll
        for (int e = 0; e < 8; ++e) qf[d0][e] *= rstd * ((const GAS float*)gq)[d0 * 16 + hi * 8 + e]; }
    if (MODE != 1) { constexpr int NF = DH / 4;
#pragma unroll
      for (int d0 = 0; d0 < DH / 32; ++d0)
#pragma unroll
        for (int e = 0; e < 8; ++e) { const int j = d0 * 16 + hi * 8 + e, pos = j < NF ? (qpos >> 6) : (qpos & 63), f = j % NF;
          const float c = ((const GAS float*)rope)[2 * (pos * NF + f)], s = ((const GAS float*)rope)[2 * (pos * NF + f) + 1], x1 = qf[d0][e], x2 = qf[d0 + DH / 32][e];
          qf[d0][e] = x1 * c - x2 * s; qf[d0 + DH / 32][e] = x2 * c + x1 * s; } }
#pragma unroll
    for (int d0 = 0; d0 < DH / 16; ++d0) { u32x4 w = {cvtpk(qf[d0][0], qf[d0][1]), cvtpk(qf[d0][2], qf[d0][3]), cvtpk(qf[d0][4], qf[d0][5]), cvtpk(qf[d0][6], qf[d0][7])}; qr[d0] = *reinterpret_cast<bf16x8*>(&w); }
  }
  const int kl0 = (MODE == 2) ? (i0 - 128 < 0 ? 0 : i0 - 128) : 0;
  const int kl1 = (MODE == 0) ? TT : (MODE == 2 ? (i0 + 384 > TT ? TT : i0 + 384) : 0);
  const int NT = 4 + (kl1 - kl0) / KVBLK;
  const long ctx0 = (long)NB * TT + (long)b * CT, lat0 = (long)b * TT + kl0;
#define TROW(j) ((j) < 4 ? ctx0 + (j) * KVBLK : lat0 + ((j) - 4) * KVBLK)
  const int sr = tid >> 4, sc = (tid & 15) * 8, vst0 = v_st(sr, sc), vst1 = v_st(32 + sr, sc);
  const bool ldok = (DH == 128) || sc < 64;
  const int vb0 = (int)(uintptr_t)V_lds + v_rd_base(lane);
  struct { bf16x8 vs0, vs1, ks0, ks1; } sr_[SDEPTH];
#pragma unroll
  for (int i_ = 0; i_ < SDEPTH; ++i_) sr_[i_].vs0 = sr_[i_].vs1 = sr_[i_].ks0 = sr_[i_].ks1 = bf16x8{};
#define SLOAD(i, j) do { if (ldok) { const long _r = TROW(j); sr_[i].vs0 = *reinterpret_cast<const bf16x8*>(&Vb[(_r + sr) * LDKV + sc]); sr_[i].vs1 = *reinterpret_cast<const bf16x8*>(&Vb[(_r + 32 + sr) * LDKV + sc]); \
    sr_[i].ks0 = *reinterpret_cast<const bf16x8*>(&Kb[(_r + sr) * LDKK + sc]); sr_[i].ks1 = *reinterpret_cast<const bf16x8*>(&Kb[(_r + 32 + sr) * LDKK + sc]); } } while (0)
#define SWRITE(bb, i) do { *(bf16x8*)((char*)V_lds + (bb) * SHM_V + vst0) = sr_[i].vs0;          \
    *(bf16x8*)((char*)V_lds + (bb) * SHM_V + vst1) = sr_[i].vs1; int kc = sc * 2;               \
    *(bf16x8*)((char*)K_lds + (bb) * SHM_K + KSWZ(sr, kc)) = sr_[i].ks0;                       \
    *(bf16x8*)((char*)K_lds + (bb) * SHM_K + KSWZ(32 + sr, kc)) = sr_[i].ks1; } while (0)
#define SWAIT() do { if (SDEPTH == 2) asm volatile("s_waitcnt vmcnt(4)" ::: "memory"); else asm volatile("s_waitcnt vmcnt(0)" ::: "memory"); } while (0)
#define RESC(a) do { if (__any((a) < 1.f)) { if (hi == 0) al_l[r32] = (a); asm volatile("s_waitcnt lgkmcnt(0)" ::: "memory"); \
    for (int d = 0; d < DH / 32; ++d) for (int r = 0; r < 16; ++r) o[d][r] *= al_l[crow(r, hi)]; } } while (0)
#define WMASK(P0, P1, j) do { if (MODE == 2 && (j) >= 4) wmask(P0, P1, kl0 + ((j) - 4) * KVBLK, qpos, hi); } while (0)
  f32x16 pA0, pA1, pB0, pB1; float mnA, mnB, alA, alB; bf16x8 pa0, pa1, pa2, pa3;
  constexpr int SE = 0, SO = SDEPTH - 1;
  SLOAD(SE, 0); asm volatile("s_waitcnt vmcnt(0)" ::: "memory"); SWRITE(0, SE); __syncthreads();
  qkt<DH>(pA0, pA1, K_lds, qr, r32, hi); WMASK(pA0, pA1, 0); partialSM<DH>(pA0, pA1, m_reg, mnA, alA);
  SLOAD(SO, 1); if (SDEPTH == 2) { if (2 < NT) SLOAD(SE, 2); }
  SWAIT(); SWRITE(1, SO); __syncthreads();
  for (int j = 1; j + 1 < NT; j += 2) {
    SBAR(); qkt<DH>(pB0, pB1, (bf16*)((char*)K_lds + SHM_K), qr, r32, hi); WMASK(pB0, pB1, j);
    finishSM(pA0, pA1, alA, l_reg, pa0, pa1, pa2, pa3); SBAR();
    SLOAD(SO, j + SDEPTH < NT ? j + SDEPTH : j); SBAR();
    pv_d0<DH>(o, vb0, pa0, pa1, pa2, pa3); partialSM<DH>(pB0, pB1, m_reg, mnB, alB);
    __syncthreads(); SWAIT(); SWRITE(0, SE);
    RESC(alB); __syncthreads();
    SBAR(); qkt<DH>(pA0, pA1, K_lds, qr, r32, hi); WMASK(pA0, pA1, j + 1);
    finishSM(pB0, pB1, alB, l_reg, pa0, pa1, pa2, pa3); SBAR();
    SLOAD(SE, j + 1 + SDEPTH < NT ? j + 1 + SDEPTH : j + 1); SBAR();
    pv_d0<DH>(o, vb0 + (int)SHM_V, pa0, pa1, pa2, pa3); partialSM<DH>(pA0, pA1, m_reg, mnA, alA);
    __syncthreads(); SWAIT(); SWRITE(1, SO);
    RESC(alA); __syncthreads();
  }
  SBAR(); qkt<DH>(pB0, pB1, (bf16*)((char*)K_lds + SHM_K), qr, r32, hi); WMASK(pB0, pB1, NT - 1);
  finishSM(pA0, pA1, alA, l_reg, pa0, pa1, pa2, pa3); SBAR();
  pv_d0<DH>(o, vb0, pa0, pa1, pa2, pa3); partialSM<DH>(pB0, pB1, m_reg, mnB, alB);
  __syncthreads(); RESC(alB);
  finishSM(pB0, pB1, alB, l_reg, pa0, pa1, pa2, pa3); SBAR();
  pv_d0<DH>(o, vb0 + (int)SHM_V, pa0, pa1, pa2, pa3);
  if (hi == 0) li_l[r32] = l_reg; asm volatile("s_waitcnt lgkmcnt(0)" ::: "memory");
  float rli[16];
#pragma unroll
  for (int r = 0; r < 16; ++r) rli[r] = __builtin_amdgcn_rcpf(li_l[crow(r, hi)]);
  bf16* Ow = Ob + (long)(wid * QBLK) * DM;
#pragma unroll
  for (int r = 0; r < 16; ++r) { int orow = crow(r, hi);
#pragma unroll
    for (int d0 = 0; d0 < DH / 32; ++d0) Ow[(long)orow * DM + d0 * 32 + r32] = (bf16)(cvtpk(o[d0][r] * rli[r], 0.f) & 0xffffu); }
  asm volatile("s_waitcnt vmcnt(0)" ::: "memory"); __syncthreads();
#undef SLOAD
#undef SWRITE
#undef SWAIT
#undef RESC
#undef WMASK
#undef TROW
}
}
namespace s5 {
using bf16x8 = __attribute__((ext_vector_type(8))) short;
using f32x16 = __attribute__((ext_vector_type(16))) float;
using f32x4v = __attribute__((ext_vector_type(4))) float;
using u32x4 = __attribute__((ext_vector_type(4))) unsigned;
using u32x2 = __attribute__((ext_vector_type(2))) unsigned;
constexpr int XROWB = 272;
constexpr int WAVE_LDS = 32 * XROWB;
__device__ __forceinline__ float bperm(float v, int srclane) { return __builtin_bit_cast(float, __builtin_amdgcn_ds_bpermute(srclane << 2, __builtin_bit_cast(int, v))); }
__device__ __forceinline__ void cmul(float& r, float& i, float ar, float ai) { const float nr = ar * r - ai * i, ni = ar * i + ai * r; r = nr; i = ni; }
__device__ __forceinline__ size_t seg_row0(int b, int seg) { return seg < 16 ? (size_t)b * TT + seg * 256 : (size_t)NB * TT + b * CT; }
template <int PASS>
__device__ __forceinline__ void s5_unit(int b, int g, int seg, const bf16* __restrict__ Z2, const float* __restrict__ s5ab, const bf16* __restrict__ BT, const bf16* __restrict__ CTb,
                                        float* __restrict__ SEND, const float* __restrict__ dskip, bf16* __restrict__ G, LAS unsigned char* xl) {
  const int lane = fresh_lane();
  const int r32 = lane & 31, hi = lane >> 5;
  const size_t row0 = seg_row0(b, seg);
  const int tau = 16 * ((r32 >> 2) & 1) + 4 * (r32 >> 3) + (r32 & 3);
  f32x4v accy[8][2];
  if (PASS == 2) {
#pragma unroll
    for (int q = 0; q < 8; ++q) { accy[q][0] = (f32x4v){0.f, 0.f, 0.f, 0.f}; accy[q][1] = accy[q][0]; }
  }
#pragma unroll
  for (int dir = 0; dir < 2; ++dir) {
    const int dg = dir * 64 + g;
    float ar[2], ai[2], a16r[2], a16i[2];
#pragma unroll
    for (int s = 0; s < 2; ++s) { typedef float f32x2s __attribute__((ext_vector_type(2))); const f32x2s v = *(const GAS f32x2s*)(s5ab + 2 * (dg * 64 + r32 + 32 * s)); ar[s] = v.x; ai[s] = v.y; a16r[s] = v.x; a16i[s] = v.y;
#pragma unroll
      for (int k = 0; k < 4; ++k) cmul(a16r[s], a16i[s], a16r[s], a16i[s]); }
    bf16x8 bfr[4];
#pragma unroll
    for (int k = 0; k < 4; ++k) bfr[k] = *(const GAS bf16x8*)(BT + ((size_t)dg * 128 + 32 * k + r32) * 16 + hi * 8);
    float cr[2] = {0.f, 0.f}, ci[2] = {0.f, 0.f};
    if (PASS == 2) {
      float a256r[2], a256i[2];
#pragma unroll
      for (int s = 0; s < 2; ++s) { a256r[s] = a16r[s]; a256i[s] = a16i[s];
#pragma unroll
        for (int k = 0; k < 4; ++k) cmul(a256r[s], a256i[s], a256r[s], a256i[s]); }
      const float* Sb = SEND + ((size_t)(dir * NB + b) * 64 + g) * 17 * 128;
      { const float* p = Sb + 16 * 128;
#pragma unroll
        for (int s = 0; s < 2; ++s) { cr[s] = p[r32 + 32 * s]; ci[s] = p[64 + r32 + 32 * s]; } }
      const int nprev = dir == 0 ? seg : 15 - seg;
      for (int k = 0; k < nprev; ++k) { const float* p = Sb + (dir == 0 ? k : 15 - k) * 128;
#pragma unroll
        for (int s = 0; s < 2; ++s) { cmul(cr[s], ci[s], a256r[s], a256i[s]); cr[s] += p[r32 + 32 * s]; ci[s] += p[64 + r32 + 32 * s]; } }
    }
    const bf16* CT_dg = CTb + (size_t)dg * 16 * 128;
#pragma unroll
    for (int qq = 0; qq < 8; ++qq) {
      const int q = dir == 0 ? qq : 7 - qq;
      const int rloc = dir == 0 ? tau : 31 - tau;
      const bf16x8 ufr = *(const GAS bf16x8*)(Z2 + (row0 + 32 * q + rloc) * CD_IN + ZC_U + g * 16 + hi * 8);
      f32x16 bu[4];
#pragma unroll
      for (int k = 0; k < 4; ++k) { bu[k] = f32x16{}; bu[k] = __builtin_amdgcn_mfma_f32_32x32x16_bf16(ufr, bfr[k], bu[k], 0, 0, 0); }
#pragma unroll
      for (int s = 0; s < 2; ++s) { float xr = 0.f, xi = 0.f;
#pragma unroll
        for (int r = 0; r < 16; ++r) { const float nr = ar[s] * xr - ai[s] * xi + bu[s][r], ni = ar[s] * xi + ai[s] * xr + bu[2 + s][r]; xr = nr; xi = ni; bu[s][r] = xr; bu[2 + s][r] = xi; } }
#pragma unroll
      for (int s = 0; s < 2; ++s) {
        const float per = bperm(bu[s][15], lane ^ 32), pei = bperm(bu[2 + s][15], lane ^ 32);
        float c1r = cr[s], c1i = ci[s]; cmul(c1r, c1i, a16r[s], a16i[s]); c1r += per; c1i += pei;
        float cxr = hi ? c1r : cr[s], cxi = hi ? c1i : ci[s];
#pragma unroll
        for (int r = 0; r < 16; ++r) { cmul(cxr, cxi, ar[s], ai[s]); bu[s][r] += cxr; bu[2 + s][r] += cxi; }
        const float ner = bperm(bu[s][15], lane ^ 32), nei = bperm(bu[2 + s][15], lane ^ 32);
        cr[s] = hi ? bu[s][15] : ner; ci[s] = hi ? bu[2 + s][15] : nei;
      }
      if (PASS == 2) {
#pragma unroll
        for (int k = 0; k < 4; ++k)
#pragma unroll
          for (int r = 0; r < 16; ++r) { const int st = 16 * hi + r, rl = dir == 0 ? st : 31 - st;
            *(LAS unsigned short*)(xl + rl * XROWB + (32 * k + r32) * 2) = (unsigned short)f2bf(bu[k][r]); }
        asm volatile("s_waitcnt lgkmcnt(0)" ::: "memory");
        const int fr = lane & 15, fq = lane >> 4;
#pragma unroll
        for (int ks = 0; ks < 4; ++ks) { const bf16x8 cf = *(const GAS bf16x8*)(CT_dg + fr * 128 + 32 * ks + 8 * fq);
#pragma unroll
          for (int mb = 0; mb < 2; ++mb) { const bf16x8 xf = *(const LAS bf16x8*)(xl + (16 * mb + fr) * XROWB + (32 * ks + 8 * fq) * 2);
            accy[q][mb] = __builtin_amdgcn_mfma_f32_16x16x32_bf16(cf, xf, accy[q][mb], 0, 0, 0); } }
        asm volatile("s_waitcnt lgkmcnt(0)" ::: "memory");
      }
    }
    if (PASS == 1) { float* p = SEND + (((size_t)(dir * NB + b) * 64 + g) * 17 + seg) * 128;
      if (hi == 0) {
#pragma unroll
        for (int s = 0; s < 2; ++s) { p[r32 + 32 * s] = cr[s]; p[64 + r32 + 32 * s] = ci[s]; } } }
  }
  if (PASS == 2) {
    const int fr = lane & 15, fq = lane >> 4;
    const f32x4v dk = *(const GAS f32x4v*)(dskip + g * 16 + 4 * fq);
#pragma unroll
    for (int q = 0; q < 8; ++q)
#pragma unroll
      for (int mb = 0; mb < 2; ++mb) { const size_t row = row0 + 32 * q + 16 * mb + fr;
        const u32x2 uw = *(const GAS u32x2*)(Z2 + row * CD_IN + ZC_U + g * 16 + 4 * fq);
        const float u0 = __builtin_bit_cast(float, uw.x << 16), u1 = __builtin_bit_cast(float, uw.x & 0xffff0000u), u2 = __builtin_bit_cast(float, uw.y << 16), u3 = __builtin_bit_cast(float, uw.y & 0xffff0000u);
        const float y0 = gelu_tanh(accy[q][mb][0] + dk[0] * u0), y1 = gelu_tanh(accy[q][mb][1] + dk[1] * u1), y2 = gelu_tanh(accy[q][mb][2] + dk[2] * u2), y3 = gelu_tanh(accy[q][mb][3] + dk[3] * u3);
        u32x2 w; w.x = pk2(y0, y1); w.y = pk2(y2, y3);
        *(GAS u32x2*)(G + row * 1024 + g * 16 + 4 * fq) = w; }
  }
}
}
namespace ml {
using bf16x8 = __attribute__((ext_vector_type(8))) short;
using f32x16 = __attribute__((ext_vector_type(16))) float;
using f32x4v = __attribute__((ext_vector_type(4))) float;
using u32x4 = __attribute__((ext_vector_type(4))) unsigned;
using u32x2 = __attribute__((ext_vector_type(2))) unsigned;
constexpr int NSEQ = NB * 4 * 2, NBLK = 17;
constexpr size_t CST_BYTES = (size_t)NSEQ * NBLK * 256 * 128 * 2;
constexpr size_t NST_OFF = CST_BYTES, MST_OFF = NST_OFF + (size_t)NSEQ * NBLK * 128 * 4, ST_END = MST_OFF + (size_t)NSEQ * NBLK * 4;
__device__ __forceinline__ float bperm(float v, int srclane) { return __builtin_bit_cast(float, __builtin_amdgcn_ds_bpermute(srclane << 2, __builtin_bit_cast(int, v))); }
__device__ __forceinline__ float swap_add(float v) { auto rr = __builtin_amdgcn_permlane32_swap(__float_as_uint(v), __float_as_uint(v), false, false); return __uint_as_float(rr[0]) + __uint_as_float(rr[1]); }
__device__ __forceinline__ float wmax(float v, int lane) {
#pragma unroll
  for (int o = 1; o < 64; o <<= 1) v = fmaxf(v, bperm(v, lane ^ o));
  return v;
}
__device__ __forceinline__ size_t blk_row0(int b, int blkid) { return blkid == 0 ? (size_t)NB * TT + b * CT : (size_t)b * TT + (blkid - 1) * 256; }
__device__ __forceinline__ int seq_blk(int dir, int j) { return j == 0 ? 0 : (dir == 0 ? j : 17 - j); }
__device__ __forceinline__ int blk_seq(int dir, int blkid) { return blkid == 0 ? 0 : (dir == 0 ? blkid : 17 - blkid); }
__device__ __forceinline__ void gate_scan(const float* __restrict__ GATES, const float* __restrict__ bg, size_t row0, int h, int dir, int lane, float (&F)[4], float (&Bt)[4], float (&ML)[4], float& b_last, float& bmax) {
  const float bi = ((const GAS float*)bg)[(2 * dir) * 4 + h], bf_ = ((const GAS float*)bg)[(2 * dir + 1) * 4 + h];
  float ig[4], c = 0.f;
#pragma unroll
  for (int i = 0; i < 4; ++i) { const int p = 4 * lane + i, r = dir ? 255 - p : p; const GAS float* gp = (const GAS float*)GATES + (row0 + r) * 16;
    ig[i] = gp[(2 * dir) * 4 + h] + bi; c += logsigmoid_acc(gp[(2 * dir + 1) * 4 + h] + bf_); F[i] = c; }
  float inc = c;
#pragma unroll
  for (int o = 1; o < 64; o <<= 1) { const float t = bperm(inc, lane - o); if (lane >= o) inc += t; }
  const float exc = inc - c;
  b_last = bperm(inc, 63);
  float mx = -3.0e38f;
#pragma unroll
  for (int i = 0; i < 4; ++i) { F[i] += exc; Bt[i] = ig[i] - F[i]; mx = fmaxf(mx, Bt[i]); ML[i] = mx; }
  float imx = mx;
#pragma unroll
  for (int o = 1; o < 64; o <<= 1) { const float t = bperm(imx, lane - o); if (lane >= o) imx = fmaxf(imx, t); }
  const float emx = bperm(imx, lane - 1);
  if (lane > 0) {
#pragma unroll
    for (int i = 0; i < 4; ++i) ML[i] = fmaxf(ML[i], emx); }
  bmax = bperm(imx, 63);
}
__device__ __forceinline__ void l1_unit(int seq, int vblk, int dblk, const bf16* __restrict__ ZT, const float* __restrict__ GATES, const float* __restrict__ bg, unsigned char* __restrict__ ST, LAS float* wt  ) {
  const int lane = fresh_lane();
  const int b = seq >> 3, h = (seq >> 1) & 3, dir = seq & 1, r32 = lane & 31, hi = lane >> 5;
  f32x16 acc = f32x16{}; float npart = 0.f, m = 0.f;
  const bf16* kT = ZT + (size_t)(h * 128 + 32 * dblk + r32) * MR;
  const bf16* vT = ZT + (size_t)(512 + h * 256 + 32 * vblk + r32) * MR;
  bf16* CS = (bf16*)ST; float* NS = (float*)(ST + NST_OFF); float* MS = (float*)(ST + MST_OFF);
#pragma unroll 1
  for (int j = 0; j < NBLK; ++j) {
    { bf16* cp = CS + ((size_t)(seq * NBLK + j) * 256 + 32 * vblk) * 128 + 32 * dblk + r32;
#pragma unroll
      for (int r = 0; r < 16; ++r) cp[(size_t)att::crow(r, hi) * 128] = (bf16)f2bf(acc[r]);
      if (vblk == 0) { const float nt = npart + bperm(npart, lane ^ 32); if (hi == 0) NS[(size_t)(seq * NBLK + j) * 128 + 32 * dblk + r32] = nt; if (dblk == 0 && lane == 0) MS[seq * NBLK + j] = m; } }
    if (j == NBLK - 1) break;
    const size_t row0 = blk_row0(b, seq_blk(dir, j));
    float F[4], Bt[4], ML[4], b_last, bmax;
    gate_scan(GATES, bg, row0, h, dir, lane, F, Bt, ML, b_last, bmax);
    const float Mf = fmaxf(m, bmax), decay = expf(m - Mf);
#pragma unroll
    for (int i = 0; i < 4; ++i) { const int p = 4 * lane + i, r = dir ? 255 - p : p; wt[r] = expf(Bt[i] - Mf); }
    asm volatile("s_waitcnt lgkmcnt(0)" ::: "memory");
    acc = acc * decay; npart *= decay; m = b_last + Mf;
#pragma unroll 4
    for (int ks = 0; ks < 16; ++ks) { const int tok = 16 * ks + 8 * hi;
      const bf16x8 af = *(const GAS bf16x8*)(vT + row0 + tok); const u32x4 kw = *(const GAS u32x4*)(kT + row0 + tok);
      const f32x4v w0 = *(const LAS f32x4v*)(wt + tok), w1 = *(const LAS f32x4v*)(wt + tok + 4);
      float kf[8];
#pragma unroll
      for (int e = 0; e < 4; ++e) { kf[2 * e] = __uint_as_float(kw[e] << 16); kf[2 * e + 1] = __uint_as_float(kw[e] & 0xffff0000u); }
      kf[0] *= w0[0]; kf[1] *= w0[1]; kf[2] *= w0[2]; kf[3] *= w0[3]; kf[4] *= w1[0]; kf[5] *= w1[1]; kf[6] *= w1[2]; kf[7] *= w1[3];
      npart += ((kf[0] + kf[1]) + (kf[2] + kf[3])) + ((kf[4] + kf[5]) + (kf[6] + kf[7]));
      u32x4 kb = {att::cvtpk(kf[0], kf[1]), att::cvtpk(kf[2], kf[3]), att::cvtpk(kf[4], kf[5]), att::cvtpk(kf[6], kf[7])};
      acc = __builtin_amdgcn_mfma_f32_32x32x16_bf16(af, *reinterpret_cast<bf16x8*>(&kb), acc, 0, 0, 0); }
  }
}
__device__ __forceinline__ void l2_unit(int b, int h, int blkid, int dvh, const bf16* __restrict__ Z, const float* __restrict__ GATES, const float* __restrict__ bg,
                                        const unsigned char* __restrict__ ST, float* __restrict__ HH, char* lds, LAS float* btab, int wave_s) {
  const int tid = fresh_tid(wave_s), wid = tid >> 6, lane = tid & 63, r32 = lane & 31, hi = lane >> 5;
  const size_t row0 = blk_row0(b, blkid);
  const int t0 = wid * 32, t = t0 + r32;
  const bf16* CS = (const bf16*)ST; const float* NS = (const float*)(ST + NST_OFF); const float* MS = (const float*)(ST + MST_OFF);
  { const int sr = tid >> 4, sc = (tid & 15) * 8, vst0 = att::v_st(sr, sc), vst1 = att::v_st(32 + sr, sc), kc = sc * 2;
    const bf16* kb = Z + (row0 + sr) * ZLD + ZB_K + h * 128 + sc; const bf16* vb = Z + (row0 + sr) * ZLD + ZB_V + h * 256 + dvh * 128 + sc;
#pragma unroll
    for (int kt = 0; kt < 4; ++kt) {
      const bf16x8 k0 = *(const GAS bf16x8*)(kb + (size_t)(64 * kt) * ZLD), k1 = *(const GAS bf16x8*)(kb + (size_t)(64 * kt + 32) * ZLD);
      const bf16x8 v0 = *(const GAS bf16x8*)(vb + (size_t)(64 * kt) * ZLD), v1 = *(const GAS bf16x8*)(vb + (size_t)(64 * kt + 32) * ZLD);
      *(bf16x8*)(lds + kt * 16384 + KSWZ(sr, kc)) = k0; *(bf16x8*)(lds + kt * 16384 + KSWZ(32 + sr, kc)) = k1;
      *(bf16x8*)(lds + 65536 + kt * 16384 + vst0) = v0; *(bf16x8*)(lds + 65536 + kt * 16384 + vst1) = v1; } }
  bf16x8 qf[8];
  { const bf16* qp = Z + (row0 + t) * ZLD + ZB_Q + h * 128 + hi * 8;
#pragma unroll
    for (int d0 = 0; d0 < 8; ++d0) { const u32x4 w = *(const GAS u32x4*)(qp + 16 * d0); u32x4 o;
#pragma unroll
      for (int e = 0; e < 4; ++e) o[e] = att::cvtpk(__uint_as_float(w[e] << 16) * 0.08838834764831845f, __uint_as_float(w[e] & 0xffff0000u) * 0.08838834764831845f);
      qf[d0] = *reinterpret_cast<bf16x8*>(&o); } }
  __syncthreads();
  f32x16 o[4];
#pragma unroll
  for (int nb = 0; nb < 4; ++nb) o[nb] = f32x16{};
  const int vbase = (int)(uintptr_t)(lds + 65536) + att::v_rd_base(lane);
#define ML_STILE(kt) f32x16 p0, p1; att::qkt<128>(p0, p1, (const bf16*)(lds + (kt) * 16384), qf, r32, hi); \
      _Pragma("unroll") for (int r = 0; r < 16; ++r) { const int k0i = 64 * (kt) + att::crow(r, hi), k1i = k0i + 32; \
        const bool v0 = dir == 0 ? (k0i <= t) : (k0i >= t), v1 = dir == 0 ? (k1i <= t) : (k1i >= t); \
        p0[r] = v0 ? p0[r] * __expf(btab[k0i] - Mt) : 0.f; p1[r] = v1 ? p1[r] * __expf(btab[k1i] - Mt) : 0.f; }
#pragma unroll
  for (int dir = 0; dir < 2; ++dir) {
    const int seq = (b * 4 + h) * 2 + dir, j = blk_seq(dir, blkid);
    const float m_prev = ((const GAS float*)MS)[seq * NBLK + j];
    float Mt, Ft;
    { float F[4], Bt[4], ML[4], b_last, bmax;
      gate_scan(GATES, bg, row0, h, dir, lane, F, Bt, ML, b_last, bmax);
#pragma unroll
      for (int i = 0; i < 4; ++i) { const int p = 4 * lane + i, r = dir ? 255 - p : p; btab[r] = Bt[i]; }
      const int pp = dir ? 255 - t : t, src = pp >> 2, e = pp & 3;
      const float m0 = bperm(fmaxf(m_prev, ML[0]), src), m1 = bperm(fmaxf(m_prev, ML[1]), src), m2 = bperm(fmaxf(m_prev, ML[2]), src), m3 = bperm(fmaxf(m_prev, ML[3]), src);
      const float f0 = bperm(F[0], src), f1 = bperm(F[1], src), f2 = bperm(F[2], src), f3 = bperm(F[3], src);
      Mt = e == 0 ? m0 : (e == 1 ? m1 : (e == 2 ? m2 : m3)); Ft = e == 0 ? f0 : (e == 1 ? f1 : (e == 2 ? f2 : f3)); }
    asm volatile("s_waitcnt lgkmcnt(0)" ::: "memory");
    const float w_inter = expf(m_prev - Mt), floorv = expf(-Ft - Mt);
    float den;
    { const GAS float* np = (const GAS float*)NS + (size_t)(seq * NBLK + j) * 128 + hi * 8; float dot = 0.f;
#pragma unroll
      for (int d0 = 0; d0 < 8; ++d0) { const u32x4 w = *reinterpret_cast<const u32x4*>(&qf[d0]); const f32x4v n0 = *(const GAS f32x4v*)(np + 16 * d0), n1 = *(const GAS f32x4v*)(np + 16 * d0 + 4);
        dot += __uint_as_float(w[0] << 16) * n0[0] + __uint_as_float(w[0] & 0xffff0000u) * n0[1] + __uint_as_float(w[1] << 16) * n0[2] + __uint_as_float(w[1] & 0xffff0000u) * n0[3]
             + __uint_as_float(w[2] << 16) * n1[0] + __uint_as_float(w[2] & 0xffff0000u) * n1[1] + __uint_as_float(w[3] << 16) * n1[2] + __uint_as_float(w[3] & 0xffff0000u) * n1[3]; }
      den = w_inter * swap_add(dot); }
    { float rsum = 0.f;
#pragma unroll 1
      for (int kt = 0; kt < 4; ++kt) {
        if (dir == 0 ? (64 * kt > t0 + 31) : (64 * kt + 63 < t0)) continue;
        ML_STILE(kt);
#pragma unroll
        for (int r = 0; r < 16; ++r) rsum += p0[r] + p1[r]; }
      den += swap_add(rsum); }
    const float inv = 1.f / fmaxf(fabsf(den), floorv);
    { const float sc = w_inter * inv;
      const bf16* cb = CS + ((size_t)(seq * NBLK + j) * 256 + dvh * 128 + r32) * 128 + hi * 8;
#pragma unroll
      for (int d0 = 0; d0 < 8; ++d0) { const u32x4 w = *reinterpret_cast<const u32x4*>(&qf[d0]); u32x4 qs;
#pragma unroll
        for (int e = 0; e < 4; ++e) qs[e] = att::cvtpk(__uint_as_float(w[e] << 16) * sc, __uint_as_float(w[e] & 0xffff0000u) * sc);
#pragma unroll
        for (int nb = 0; nb < 4; ++nb) { const bf16x8 cf = *(const GAS bf16x8*)(cb + (size_t)(32 * nb) * 128 + 16 * d0); o[nb] = __builtin_amdgcn_mfma_f32_32x32x16_bf16(*reinterpret_cast<bf16x8*>(&qs), cf, o[nb], 0, 0, 0); } } }
#pragma unroll 1
    for (int kt = 0; kt < 4; ++kt) {
      if (dir == 0 ? (64 * kt > t0 + 31) : (64 * kt + 63 < t0)) continue;
      ML_STILE(kt);
#pragma unroll
      for (int r = 0; r < 16; ++r) { p0[r] *= inv; p1[r] *= inv; }
      bf16x8 pa0, pa1, pa2, pa3;
#define PK4(P, BASE, OUT) do { unsigned a0 = att::cvtpk(P[BASE + 0], P[BASE + 1]), a1 = att::cvtpk(P[BASE + 2], P[BASE + 3]);   \
    unsigned b0 = att::cvtpk(P[BASE + 4], P[BASE + 5]), b1 = att::cvtpk(P[BASE + 6], P[BASE + 7]);                              \
    auto r0 = __builtin_amdgcn_permlane32_swap(a0, b0, false, false); auto r1 = __builtin_amdgcn_permlane32_swap(a1, b1, false, false); \
    u32x4 w = {r0[0], r1[0], r0[1], r1[1]}; OUT = *reinterpret_cast<bf16x8*>(&w); } while (0)
      PK4(p0, 0, pa0); PK4(p0, 8, pa1); PK4(p1, 0, pa2); PK4(p1, 8, pa3);
#undef PK4
      att::pv_d0<128>(o, vbase + kt * 16384, pa0, pa1, pa2, pa3);
    }
  }
#undef ML_STILE
  { const int l2_ = fresh_lane(), hi2 = l2_ >> 5; float* Ow = HH + (blk_row0(b, blkid) + wid * 32) * 1024 + h * 256 + dvh * 128 + (l2_ & 31);
#pragma unroll
    for (int r = 0; r < 16; ++r)
#pragma unroll
      for (int nb = 0; nb < 4; ++nb) Ow[(size_t)att::crow(r, hi2) * 1024 + nb * 32] = o[nb][r]; }
  asm volatile("s_waitcnt vmcnt(0)" ::: "memory"); __syncthreads();
}
__device__ __forceinline__ void finish_item(int gw, int lane, const bf16* Z, const float* HH, const float* headg, bf16* CAT) {
  const int m = gw >> 2, h = gw & 3; const size_t o = (size_t)m * 1024 + h * 256 + lane * 4;
  const f32x4v hh = *(const GAS f32x4v*)(HH + o);
  const float rstd = 1.f / sqrtf(wave_sum_l((hh[0] * hh[0] + hh[1] * hh[1]) + (hh[2] * hh[2] + hh[3] * hh[3]), lane) * (1.f / 256.f) + EPS);
  const u32x2 ow = *(const GAS u32x2*)(Z + (size_t)m * ZLD + ZB_O + h * 256 + lane * 4); const f32x4v g4 = *(const GAS f32x4v*)(headg + h * 256 + lane * 4);
  const float o0 = __uint_as_float(ow.x << 16), o1 = __uint_as_float(ow.x & 0xffff0000u), o2 = __uint_as_float(ow.y << 16), o3 = __uint_as_float(ow.y & 0xffff0000u);
  u32x2 w; w.x = pk2(hh[0] * rstd * g4[0] / (1.f + __expf(-o0)), hh[1] * rstd * g4[1] / (1.f + __expf(-o1))); w.y = pk2(hh[2] * rstd * g4[2] / (1.f + __expf(-o2)), hh[3] * rstd * g4[3] / (1.f + __expf(-o3)));
  *(GAS u32x2*)(CAT + (size_t)m * DM + 1024 + h * 256 + lane * 4) = w;
}
}
struct Args { const float* in[30]; float* out; unsigned char* ws; int ph_lo, ph_hi, li, pad; };
constexpr int PH_P0 = 0, PH_P1 = 1, PH_L0 = 2, PH_PER_LAYER = 13, PH_FINAL = 28, N_PHASES = 29;
enum { O_F1N = 0, O_F1U, O_F1D, O_MN, O_MI, O_MP, O_MA, O_MF, O_MG, O_MO, O_F2N, O_F2U, O_F2D };
#ifndef DUP_MASK
#define DUP_MASK 0
#endif
#define REP(bit) for (int rep_ = 0; rep_ < (((DUP_MASK) & (bit)) ? 2 : 1); ++rep_)
#define OPAQUE_S(p) asm volatile("" : "+s"(p))
__device__ __forceinline__ int opq(int v) { asm volatile("" : "+s"(v)); return v; }
#define GEMM_PHASE(EPI, A_, B_, M_, N_, K_, ...) GEMM_PHASE_S(0, EPI, A_, B_, M_, N_, K_, __VA_ARGS__)
#define GEMM_RESID(A_, B_, M_, N_, K_, SPL, ...) do { pg8::Gemm g{(const bf16*)(A_), (const bf16*)(B_), (M_), (N_), (K_)}; pg8::StaticOrderT<SPL, NB * CT / 256> S; S.init(NB * TT, (N_), F.G, (int)blockIdx.x, (K_), (M_) > NB * TT); \
    pg8::EpiResidPart E{__VA_ARGS__, (float*)(ws + WS_SC1)}; pg8::gemm_phase<pg8::EpiResidPart, pg8::StaticOrderT<SPL, NB * CT / 256>, true, true>(F.lds + RING_OFF, g, S, E, F.wave); } while (0)
#define GEMM_PHASE_S(MODE, EPI, A_, B_, M_, N_, K_, ...) do { pg8::Gemm g{(const bf16*)(A_), (const bf16*)(B_), (M_), (N_), (K_)}; pg8::StaticOrder S; S.init((M_), (N_), F.G, (int)blockIdx.x, (K_)); \
    pg8::EPI E{__VA_ARGS__}; pg8::gemm_phase<pg8::EPI, pg8::StaticOrder, true, true>(F.lds + RING_OFF, g, S, E, F.wave); } while (0)

__global__ void __launch_bounds__(NWAVES * 64, 2) fwd(Args args) {
    extern __shared__ __attribute__((aligned(16))) unsigned char lds[];
    Frame F;
    F.lds = (LAS unsigned char*)lds;
    F.MISC = (volatile LAS unsigned*)(F.lds + MISC_OFF);
    F.wave = __builtin_amdgcn_readfirstlane((int)threadIdx.x >> 6);
    F.G = gridDim.x;
    F.ws = args.ws; F.out = args.out;
    F.ctl = (gu32*)(args.ws + WS_CTL);
    for (int u = threadIdx.x; u < (LDS_BYTES - LDSCTL_OFF) / 4; u += NWAVES * 64) ((LAS unsigned*)(F.lds + LDSCTL_OFF))[u] = 0u;
    __syncthreads();
    const int lo = args.ph_lo, hi = args.ph_hi;
    XcdBarrier bar; bar.bar = (unsigned*)(F.ctl + CW_BAR) + args.li * XCD_BAR_WORDS; bar.x = 0; bar.st = nullptr;
    if (hi - lo > 1) bar = xcd_barrier_post((unsigned*)(F.ctl + CW_BAR) + args.li * XCD_BAR_WORDS, F.MISC + 8);
#define IN(k) (opq(lo) <= (k) && (k) < opq(hi))
#define SEAM(k) do { if (IN(k) && IN((k) + 1)) { xcd_barrier(bar, F.wave); if ((DUP_MASK) & 4096) xcd_barrier(bar, F.wave); } } while (0)

    if (IN(PH_P0)) REP(8) { p0_prologue(F, args.in); } SEAM(PH_P0);
    if (IN(PH_P1)) REP(8) { p1_modreduce(F, args.in[5], args.in[6]); } SEAM(PH_P1);
    if (IN(PH_L0 + O_F1N)) REP(4) { norm_phase(F, F.ws, args.in[0], args.in[2], 0, 0, true, MR); }
#pragma unroll 1
    for (int l = 0; l < 2; ++l) {
        const int pb = PH_L0 + PH_PER_LAYER * l;
        const int MLAT = NB * TT;
        const int m_post = (l == 1) ? MLAT : MR;
        if (IN(pb + O_F1N) && l > 0) REP(4) { unsigned char* ws = F.ws; OPAQUE_S(ws); norm_phase(F, ws, nullptr, nullptr, l, 0, false, MR, 4, (const float*)(ws + WS_MODV) + (size_t)((l - 1) * 5 + 4) * MODN + 8 * DM, 0.5f); } SEAM(pb + O_F1N);
        if (IN(pb + O_F1U)) REP(1) { unsigned char* ws = F.ws; OPAQUE_S(ws);
            GEMM_PHASE(EpiSwiglu, ws + WS_HN, ws + WS_WUP + (size_t)(l * 2) * 44 * MiB, MR, 2 * FF, DM, (bf16*)(ws + WS_HID), FF); } SEAM(pb + O_F1U);
        if (IN(pb + O_F1D)) REP(2) { unsigned char* ws = F.ws; OPAQUE_S(ws);
            GEMM_RESID(ws + WS_HID, ws + WS_WDN + (size_t)(l * 2) * 22 * MiB, MR, DM, FF, 4, (float*)(ws + WS_H), (const float*)(ws + WS_MODV) + (size_t)l * 5 * MODN + 2 * DM, MODN, rep_ ? 0.f : 0.5f); } SEAM(pb + O_F1D);
        if (IN(pb + O_MN)) REP(4) { unsigned char* ws = F.ws; OPAQUE_S(ws); norm_phase(F, ws, nullptr, nullptr, l, 1, false, MR, 4, (const float*)(ws + WS_MODV) + (size_t)(l * 5 + 4) * MODN + 2 * DM, 0.5f); } SEAM(pb + O_MN);
        if (IN(pb + O_MI)) REP(16) { unsigned char* ws = F.ws; OPAQUE_S(ws);
            if (l == 0) { GEMM_PHASE(EpiPlain, ws + WS_HN, ws + WS_WABIN, MR, ZLD, DM, (bf16*)(ws + WS_Z), ZLD, (float*)(ws + WS_GATES), ZB_G / 256);
                GEMM_PHASE(EpiPlain, ws + WS_WABIN + (size_t)ZB_K * DM * 2, ws + WS_HN, 1536, MR, DM, (bf16*)(ws + WS_ZT), MR, nullptr, -1); }
            else GEMM_PHASE(EpiPlain, ws + WS_HN, ws + WS_WCDIN, MR, CD_IN, DM, (bf16*)(ws + WS_Z), CD_IN, nullptr, -1);
        } SEAM(pb + O_MI);
        if (IN(pb + O_MP)) REP(32) { unsigned char* ws = F.ws; OPAQUE_S(ws);
            const int lane = fresh_lane(); const int gw = blockIdx.x * NWAVES + F.wave, NGW = F.G * NWAVES;
            const bf16* Z = (const bf16*)(ws + WS_Z); bf16* KA = (bf16*)(ws + WS_KA); const float* tv = (const float*)(ws + WS_TAB + TB_VEC);
            if (l == 0) { for (int it = gw; it < MR * 2; it += NGW) naive_kprep<0>(it, lane, Z, KA, tv + TV_GK, (const float*)(ws + WS_TAB + TB_ROPEA));
                if (F.wave < 4) for (int u = (int)blockIdx.x * 4 + F.wave; u < ml::NSEQ * 32; u += F.G * 4)
                    ml::l1_unit(u >> 5, (u >> 2) & 7, u & 3, (const bf16*)(ws + WS_ZT), (const float*)(ws + WS_GATES), tv + TV_BGATE, ws + WS_SC1, (LAS float*)(F.lds + RING_OFF) + F.wave * 256); }
            else { for (int it = gw; it < MR; it += NGW) naive_kprep<1>(it, lane, Z, KA, nullptr, (const float*)(ws + WS_TAB + TB_ROPED));
                for (int u = gw; u < NB * 64 * 17; u += NGW) { const int seg = 16 - (u / (NB * 64)), bg = u % (NB * 64);
                    s5::s5_unit<1>(bg >> 6, bg & 63, seg, Z, (const float*)(ws + WS_TAB + TB_S5AB), (const bf16*)(ws + WS_TAB + TB_S5BT), (const bf16*)(ws + WS_TAB + TB_S5CT), (float*)(ws + WS_SC2), nullptr, nullptr, nullptr); } }
        } SEAM(pb + O_MP);
        if (IN(pb + O_MA)) REP(64) { unsigned char* ws = F.ws; OPAQUE_S(ws);
            const int tid = fresh_tid(F.wave);
            const bf16* Z = (const bf16*)(ws + WS_Z); const bf16* KA = (const bf16*)(ws + WS_KA); bf16* CAT = (bf16*)(ws + WS_CAT); const float* tv = (const float*)(ws + WS_TAB + TB_VEC);
            float* SC1 = (float*)(ws + WS_SC1); float* SC2 = (float*)(ws + WS_SC2);
            if (l == 0) { const float* ropeA = (const float*)(ws + WS_TAB + TB_ROPEA);
                REP(256) { const int nv = F.G, v0 = (int)blockIdx.x;
                    for (int u = v0; u < 512; u += nv) { const int b = u >> 7, head = (u >> 4) & 7, qb = u & 15, kvh = head >> 2; const size_t row0 = (size_t)b * TT + qb * 256;
                        att::attn_unit<128, 0>(Z + row0 * ZLD + ZA_Q + head * 128, ZLD, KA + kvh * 128, 256, Z + ZA_V + kvh * 128, ZLD, CAT + row0 * DM + head * 128, b, qb * 256, tv + TV_GQ, ropeA, 0.f, (char*)lds + RING_OFF, F.wave); }
                    for (int u = v0; u < 32; u += nv) { const int b = u >> 3, head = u & 7, kvh = head >> 2; const size_t row0 = (size_t)NB * TT + b * CT;
                        att::attn_unit<128, 1>(Z + row0 * ZLD + ZA_Q + head * 128, ZLD, KA + kvh * 128, 256, Z + ZA_V + kvh * 128, ZLD, CAT + row0 * DM + head * 128, b, 0, tv + TV_GQ, ropeA, 0.f, (char*)lds + RING_OFF, F.wave); } }
                REP(512) for (int u = (int)blockIdx.x; u < NB * 4 * 34; u += F.G) { const int b = u / 136, rem = u % 136, h = rem / 34, bh = rem % 34;
                    ml::l2_unit(b, h, bh >> 1, bh & 1, Z, (const float*)(ws + WS_GATES), tv + TV_BGATE, ws + WS_SC1, SC2, (char*)lds + RING_OFF, (LAS float*)(F.lds + LDSCTL_OFF + 512) + F.wave * 256, F.wave); }
            } else { const float* ropeD = (const float*)(ws + WS_TAB + TB_ROPED);
                REP(1024) { const int nv = F.G, v0 = (int)blockIdx.x;
                    for (int u = v0; u < 1024; u += nv) { const int b = u >> 8, head = (u >> 4) & 15, qb = u & 15, kvh = head >> 3; const size_t row0 = (size_t)b * TT + qb * 256;
                        att::attn_unit<64, 2>(Z + row0 * CD_IN + ZD_Q + head * 64, CD_IN, KA + kvh * 64, 128, Z + ZD_V + kvh * 64, CD_IN, CAT + row0 * DM + 1024 + head * 64, b, qb * 256, nullptr, ropeD, tv[TV_SINK + head], (char*)lds + RING_OFF, F.wave); } }
                REP(2048) { const int gw = blockIdx.x * NWAVES + F.wave, NGW = F.G * NWAVES;
                    for (int u = gw; u < NB * 64 * 16; u += NGW) { const int seg = u / (NB * 64), bg = u % (NB * 64);
                        s5::s5_unit<2>(bg >> 6, bg & 63, seg, Z, (const float*)(ws + WS_TAB + TB_S5AB), (const bf16*)(ws + WS_TAB + TB_S5BT), (const bf16*)(ws + WS_TAB + TB_S5CT), (float*)(ws + WS_SC2), tv + TV_DSKIP, (bf16*)(ws + WS_G),
                                       F.lds + RING_OFF + F.wave * s5::WAVE_LDS); } }
            }
        } SEAM(pb + O_MA);
        if (IN(pb + O_MF)) { unsigned char* ws = F.ws; OPAQUE_S(ws);
            const int lane = fresh_lane(), gw = blockIdx.x * NWAVES + F.wave, NGW = F.G * NWAVES;
            if (l == 0) { for (int it = gw; it < MR * 4; it += NGW) ml::finish_item(it, lane, (const bf16*)(ws + WS_Z), (const float*)(ws + WS_SC2), (const float*)(ws + WS_TAB + TB_VEC) + TV_HEADG, (bf16*)(ws + WS_CAT)); }
        } SEAM(pb + O_MF);
        if (IN(pb + O_MG)) REP(128) { unsigned char* ws = F.ws; OPAQUE_S(ws);
            if (l == 1) GEMM_PHASE(EpiGlu, ws + WS_G, ws + WS_WGLU, MLAT, 1024, 1024, (bf16*)(ws + WS_CAT), DM, (const bf16*)(ws + WS_G), (const float*)(ws + WS_TAB + TB_VEC) + TV_GLUB);
        } SEAM(pb + O_MG);
        if (IN(pb + O_MO)) REP(128) { unsigned char* ws = F.ws; OPAQUE_S(ws);
            GEMM_RESID(ws + WS_CAT, ws + (l == 0 ? WS_WABOUT : WS_WCDOUT), m_post, DM, DM, 4, (float*)(ws + WS_H), (const float*)(ws + WS_MODV) + (size_t)l * 5 * MODN + 5 * DM, MODN, rep_ ? 0.f : 1.0f); } SEAM(pb + O_MO);
        if (IN(pb + O_F2N)) REP(4) { unsigned char* ws = F.ws; OPAQUE_S(ws); norm_phase(F, ws, nullptr, nullptr, l, 2, false, m_post, l == 0 ? 4 : 0, (const float*)(ws + WS_MODV) + (size_t)(l * 5 + 4) * MODN + 5 * DM, 1.0f); } SEAM(pb + O_F2N);
        if (IN(pb + O_F2U)) REP(1) { unsigned char* ws = F.ws; OPAQUE_S(ws);
            GEMM_PHASE(EpiSwiglu, ws + WS_HN, ws + WS_WUP + (size_t)(l * 2 + 1) * 44 * MiB, m_post, 2 * FF, DM, (bf16*)(ws + WS_HID), FF); } SEAM(pb + O_F2U);
        if (IN(pb + O_F2D)) REP(2) { unsigned char* ws = F.ws; OPAQUE_S(ws);
            GEMM_RESID(ws + WS_HID, ws + WS_WDN + (size_t)(l * 2 + 1) * 22 * MiB, m_post, DM, FF, 4, (float*)(ws + WS_H), (const float*)(ws + WS_MODV) + (size_t)l * 5 * MODN + 8 * DM, MODN, rep_ ? 0.f : 0.5f); } SEAM(pb + O_F2D);
    }
    if (IN(PH_FINAL)) REP(4) { unsigned char* ws = F.ws; OPAQUE_S(ws); final_norm_phase(F, ws); }
#undef IN
#undef SEAM
}
extern "C" void kernel_launch(void* const* d_in, const int* in_sizes, int n_in, void* d_out, int out_size, void* d_ws, size_t ws_size, hipStream_t stream) {
    static int grid = 0;
    if (grid == 0) {
        if (n_in != 30 || out_size != NB * TT * DM || ws_size < WS_END) { fprintf(stderr, "kernel_launch: unexpected shapes: n_in %d out %d ws %zu (need %zu)\n", n_in, out_size, ws_size, (size_t)WS_END); grid = -1; return; }
        int dev = 0, cus = 0;
        if (hipGetDevice(&dev) != hipSuccess || hipDeviceGetAttribute(&cus, hipDeviceAttributeMultiprocessorCount, dev) != hipSuccess) { grid = -1; return; }
        if (hipFuncSetAttribute((const void*)fwd, hipFuncAttributeMaxDynamicSharedMemorySize, LDS_BYTES) != hipSuccess) { fprintf(stderr, "kernel_launch: hipFuncSetAttribute failed\n"); grid = -1; return; }
        int per_cu = 0; (void)hipOccupancyMaxActiveBlocksPerMultiprocessor(&per_cu, (const void*)fwd, NWAVES * 64, LDS_BYTES); (void)hipGetLastError();
        if (per_cu < 1) fprintf(stderr, "kernel_launch: occupancy query says %d\n", per_cu);
        grid = cus;
    }
    if (grid < 0) return;
    (void)hipMemsetAsync((char*)d_ws + WS_CTL, 0, CTL_ZERO_BYTES, stream);
    Args a{};
    for (int i = 0; i < 30; ++i) a.in[i] = (const float*)d_in[i];
    a.out = (float*)d_out; a.ws = (unsigned char*)d_ws;
    int li = 0;
    auto run = [&](int lo, int hi) { a.ph_lo = lo; a.ph_hi = hi; a.li = li++; a.pad = 0; hipLaunchKernelGGL(fwd, dim3(grid), dim3(NWAVES * 64), LDS_BYTES, stream, a); };
#ifndef MK_CUTS
#define MK_CUTS 0
#endif
    if (MK_CUTS == 0) run(0, N_PHASES);
    else if (MK_CUTS == 1) { for (int ph = 0; ph < N_PHASES; ++ph) run(ph, ph + 1); }
    else { run(0, PH_L0 + O_MP); run(PH_L0 + O_MP, PH_L0 + O_MO); run(PH_L0 + O_MO, PH_L0 + PH_PER_LAYER + O_MP); run(PH_L0 + PH_PER_LAYER + O_MP, PH_L0 + PH_PER_LAYER + O_MO); run(PH_L0 + PH_PER_LAYER + O_MO, N_PHASES); }
    const hipError_t le = hipPeekAtLastError();
    if (le != hipSuccess) fprintf(stderr, "kernel_launch: launch failed: %s\n", hipGetErrorName(le));
}
```

```cpp
#include <hip/hip_runtime.h>
#include <cstdio>
#include <cstdint>
#include <cmath>
__device__ __forceinline__ int fresh_lane() { int l; asm volatile("v_mbcnt_lo_u32_b32 %0, -1, 0\n\tv_mbcnt_hi_u32_b32 %0, -1, %0" : "=v"(l)); return l; }
__device__ __forceinline__ int fresh_tid(int wave) { return wave * 64 + fresh_lane(); }
namespace pg8 {
#define PG8_LAS __attribute__((address_space(3)))
typedef unsigned short bf16_t;
typedef short bf16x8 __attribute__((ext_vector_type(8)));
typedef float f32x4 __attribute__((ext_vector_type(4)));
typedef unsigned u32x4 __attribute__((ext_vector_type(4)));
constexpr int BM = 256, BK = 64, HALF = 128, HTB = HALF * BK * 2  , STAGE_BYTES = 8 * HTB, NXCD = 8, WGM = 8;

__host__ __device__ __forceinline__ int lds_byte(int r, int c) { const int st = (r >> 4) * 2 + (c >> 5), rr = r & 15, cc = c & 31, ob = rr * 64 + cc * 2; return st * 1024 + (ob ^ (((ob >> 9) & 1) << 5)); }
__host__ __device__ __forceinline__ void stage_rc(int b, int& R, int& C) { const int st = b / 1024, sb = b % 1024, swz = sb ^ (((sb >> 9) & 1) << 5); R = (st >> 1) * 16 + swz / 64; C = (st & 1) * 32 + (swz % 64) / 2; }
__host__ __device__ __forceinline__ int perm32(int rho) { const int n = rho >> 4, i = rho & 15; return 8 * (i >> 2) + 4 * n + (i & 3); }

struct Unit { int pm, pn, kt0, nkt, piece, which; };
struct Gemm { const bf16_t* A; const bf16_t* Bt; int M, N, K; const bf16_t* A2; const bf16_t* Bt2; };

template <int S = 1, int NXM = 1> struct StaticOrderT {
    int nM, nN, nwg, G, c, nt; bool xr;
    __host__ __device__ __forceinline__ void init(int M, int N, int G_, int c_, int K = 0, bool xr_ = false) { nM = M / BM; nN = N / BM; nwg = nM * nN; G = G_; c = c_; nt = K / BK; xr = xr_; }
    __host__ __device__ __forceinline__ bool next(int i, Unit& u) const {
        const int rounds = (nwg + G - 1) / G;
        if (xr && i == rounds) { if (c >= S * NXM * nN) return false; const int x = c / S, piece = c % S;
            u.pm = nM + x % NXM; u.pn = x / NXM; u.piece = piece; u.which = 0; u.kt0 = 2 * ((piece * nt) / (2 * S)); u.nkt = 2 * (((piece + 1) * nt) / (2 * S)) - u.kt0; return true; }
        const long L = (long)i * G + c; if (L >= nwg) return false;
        int wgid = (int)L; { const int q8 = nwg / NXCD, r = nwg % NXCD, xcd = wgid % NXCD, off = wgid / NXCD; wgid = (xcd < r ? xcd * (q8 + 1) : r * (q8 + 1) + (xcd - r) * q8) + off; }
        const int nig = WGM * nN, gid = wgid / nig, fm = gid * WGM, gsz = (nM - fm) < WGM ? (nM - fm) : WGM;
        u.pm = fm + ((wgid % nig) % gsz); u.pn = (wgid % nig) / gsz; u.piece = -1; u.which = 0; u.kt0 = 0; u.nkt = nt; return true;
    }
    __device__ __forceinline__ void a_ready(const Unit&) const {}
    __device__ __forceinline__ void done(const Unit&) const {}
};
typedef StaticOrderT<1, 1> StaticOrder;
struct DualOrder {
    int nM1, nN1, nM2, nN2, n1, n2, G, c, nt;
    __host__ __device__ __forceinline__ void init(int M1, int N1, int M2, int N2, int G_, int c_, int K) { nM1 = M1 / BM; nN1 = N1 / BM; nM2 = M2 / BM; nN2 = N2 / BM; n1 = nM1 * nN1; n2 = nM2 * nN2; G = G_; c = c_; nt = K / BK; }
    __host__ __device__ __forceinline__ bool next(int i, Unit& u) const {
        const long L = (long)i * G + c; if (L >= n1 + n2) return false;
        const bool w = L >= n1; const int nM = w ? nM2 : nM1, nN = w ? nN2 : nN1, nwg = w ? n2 : n1;
        int wgid = (int)(w ? L - n1 : L); { const int q8 = nwg / NXCD, r = nwg % NXCD, xcd = wgid % NXCD, off = wgid / NXCD; wgid = (xcd < r ? xcd * (q8 + 1) : r * (q8 + 1) + (xcd - r) * q8) + off; }
        const int nig = WGM * nN, gid = wgid / nig, fm = gid * WGM, gsz = (nM - fm) < WGM ? (nM - fm) : WGM;
        u.pm = fm + ((wgid % nig) % gsz); u.pn = (wgid % nig) / gsz; u.piece = -1; u.which = w ? 1 : 0; u.kt0 = 0; u.nkt = nt; return true;
    }
    __device__ __forceinline__ void a_ready(const Unit&) const {}
    __device__ __forceinline__ void done(const Unit&) const {}
};

__device__ __forceinline__ unsigned cvt_pk_bf16(float lo, float hi) { unsigned r; asm volatile("v_cvt_pk_bf16_f32 %0, %1, %2" : "=v"(r) : "v"(lo), "v"(hi)); return r; }
typedef float f32x2 __attribute__((ext_vector_type(2)));
__device__ __forceinline__ float fast_sigmoid(float a) { return __builtin_amdgcn_rcpf(1.f + __builtin_amdgcn_exp2f(-1.4426950408889634f * a)); }
struct EpiPlain {
    static constexpr bool PERM = true, AFTER_DRAIN = false;
    bf16_t* O; int ldc; float* gates; int gate_pn;
    __device__ __forceinline__ void operator()(const f32x4 (&acc)[2][2][4][2], const Unit& u, int wr, int wc, int fr, int fq) const {
        const int row0 = u.pm * BM + wr * 64 + fr, col0 = u.pn * BM + wc * 32 + 8 * fq;
#pragma unroll
        for (int ai = 0; ai < 2; ++ai)
#pragma unroll
            for (int m = 0; m < 4; ++m) { const int row = row0 + ai * HALF + m * 16; bf16_t* rowp = O + (size_t)row * ldc + col0;
#pragma unroll
                for (int bj = 0; bj < 2; ++bj) { const f32x4 v0 = acc[ai][bj][m][0], v1 = acc[ai][bj][m][1];
                    u32x4 w; w.x = cvt_pk_bf16(v0[0], v0[1]); w.y = cvt_pk_bf16(v0[2], v0[3]); w.z = cvt_pk_bf16(v1[0], v1[1]); w.w = cvt_pk_bf16(v1[2], v1[3]);
                    *(u32x4*)(rowp + bj * HALF) = w;
                    if (bj == 0 && u.pn == gate_pn && wc == 0 && fq < 2) { float* gp = gates + (size_t)row * 16 + 8 * fq; *(f32x4*)gp = v0; *(f32x4*)(gp + 4) = v1; } } }
    }
};
struct EpiPlain2 {
    static constexpr bool PERM = true, AFTER_DRAIN = false;
    EpiPlain e0, e1;
    __device__ __forceinline__ void operator()(const f32x4 (&acc)[2][2][4][2], const Unit& u, int wr, int wc, int fr, int fq) const {
        EpiPlain e; e.O = u.which ? e1.O : e0.O; e.ldc = u.which ? e1.ldc : e0.ldc; e.gates = u.which ? e1.gates : e0.gates; e.gate_pn = u.which ? e1.gate_pn : e0.gate_pn; e(acc, u, wr, wc, fr, fq);
    }
};
struct EpiSwiglu {
    static constexpr bool PERM = true, AFTER_DRAIN = false;
    bf16_t* O; int ldc;
    __device__ __forceinline__ void operator()(const f32x4 (&acc)[2][2][4][2], const Unit& u, int wr, int wc, int fr, int fq) const {
        const int row0 = u.pm * BM + wr * 64 + fr, col0 = u.pn * HALF + wc * 32 + 8 * fq;
#pragma unroll
        for (int ai = 0; ai < 2; ++ai)
#pragma unroll
            for (int m = 0; m < 4; ++m) { bf16_t* rowp = O + (size_t)(row0 + ai * HALF + m * 16) * ldc + col0;
                float r[8];
#pragma unroll
                for (int n = 0; n < 2; ++n)
#pragma unroll
                    for (int j = 0; j < 4; ++j) { const float a = acc[ai][0][m][n][j], b = acc[ai][1][m][n][j]; r[4 * n + j] = a * fast_sigmoid(a) * b; }
                u32x4 w; w.x = cvt_pk_bf16(r[0], r[1]); w.y = cvt_pk_bf16(r[2], r[3]); w.z = cvt_pk_bf16(r[4], r[5]); w.w = cvt_pk_bf16(r[6], r[7]);
                *(u32x4*)rowp = w; }
    }
};
struct EpiResid {
    static constexpr bool PERM = true, AFTER_DRAIN = false;
    float* H; const float* gate; int gstride; float coef;
    __device__ __forceinline__ void operator()(const f32x4 (&acc)[2][2][4][2], const Unit& u, int wr, int wc, int fr, int fq) const {
        const int row0 = u.pm * BM + wr * 64 + fr, col0 = u.pn * BM + wc * 32 + 8 * fq;
        const int sel = u.pm < 64 ? (u.pm >> 4) : 4;
        const float* gp = gate + (size_t)sel * gstride + col0;
        f32x4 gv[2][2];
#pragma unroll
        for (int bj = 0; bj < 2; ++bj)
#pragma unroll
            for (int n = 0; n < 2; ++n) gv[bj][n] = *(const f32x4*)(gp + bj * HALF + 4 * n) * coef;
#pragma unroll
        for (int ai = 0; ai < 2; ++ai)
#pragma unroll
            for (int m = 0; m < 4; ++m) { float* rowp = H + (size_t)(row0 + ai * HALF + m * 16) * 2048 + col0;
#pragma unroll
                for (int bj = 0; bj < 2; ++bj)
#pragma unroll
                    for (int n = 0; n < 2; ++n) { f32x4* p = (f32x4*)(rowp + bj * HALF + 4 * n); *p = *p + gv[bj][n] * acc[ai][bj][m][n]; } }
    }
};
struct EpiPart {
    static constexpr bool PERM = true, AFTER_DRAIN = false;
    float* P;
    __device__ __forceinline__ void operator()(const f32x4 (&acc)[2][2][4][2], const Unit& u, int wr, int wc, int fr, int fq) const {
        const int row0 = u.pm * BM + wr * 64 + fr, col0 = u.pn * BM + wc * 32 + 8 * fq;
        float* base = P + (size_t)u.piece * (1024 * 2048);
#pragma unroll
        for (int ai = 0; ai < 2; ++ai)
#pragma unroll
            for (int m = 0; m < 4; ++m) { float* rowp = base + (size_t)(row0 + ai * HALF + m * 16) * 2048 + col0;
#pragma unroll
                for (int bj = 0; bj < 2; ++bj)
#pragma unroll
                    for (int n = 0; n < 2; ++n) *(f32x4*)(rowp + bj * HALF + 4 * n) = acc[ai][bj][m][n]; }
    }
};
struct EpiResidPart {
    static constexpr bool PERM = true, AFTER_DRAIN = false;
    float* H; const float* gate; int gstride; float coef; float* P;
    __device__ __forceinline__ void operator()(const f32x4 (&acc)[2][2][4][2], const Unit& u, int wr, int wc, int fr, int fq) const {
        const bool res = u.piece < 0;
        const int row0 = (res ? u.pm : u.pm - 64) * BM + wr * 64 + fr, col0 = u.pn * BM + wc * 32 + 8 * fq;
        float* base = res ? H : P + (size_t)u.piece * (1024 * 2048);
        const int sel = u.pm < 64 ? (u.pm >> 4) : 4;
        const float* gp = gate + (size_t)sel * gstride + col0;
        f32x4 gv[2][2];
#pragma unroll
        for (int bj = 0; bj < 2; ++bj)
#pragma unroll
            for (int n = 0; n < 2; ++n) gv[bj][n] = res ? *(const f32x4*)(gp + bj * HALF + 4 * n) * coef : (f32x4){1.f, 1.f, 1.f, 1.f};
#pragma unroll
        for (int ai = 0; ai < 2; ++ai)
#pragma unroll
            for (int m = 0; m < 4; ++m) { float* rowp = base + (size_t)(row0 + ai * HALF + m * 16) * 2048 + col0;
#pragma unroll
                for (int bj = 0; bj < 2; ++bj)
#pragma unroll
                    for (int n = 0; n < 2; ++n) { f32x4* p = (f32x4*)(rowp + bj * HALF + 4 * n); f32x4 old = {0.f, 0.f, 0.f, 0.f}; if (res) old = *p; *p = old + gv[bj][n] * acc[ai][bj][m][n]; } }
    }
};
struct EpiGlu {
    static constexpr bool PERM = true, AFTER_DRAIN = false;
    bf16_t* O; int ldc; const bf16_t* G; const float* bias;
    __device__ __forceinline__ void operator()(const f32x4 (&acc)[2][2][4][2], const Unit& u, int wr, int wc, int fr, int fq) const {
        const int row0 = u.pm * BM + wr * 64 + fr, col0 = u.pn * BM + wc * 32 + 8 * fq;
#pragma unroll
        for (int ai = 0; ai < 2; ++ai)
#pragma unroll
            for (int m = 0; m < 4; ++m) { const int row = row0 + ai * HALF + m * 16;
#pragma unroll
                for (int bj = 0; bj < 2; ++bj) { const int col = col0 + bj * HALF;
                    const u32x4 gw = *(const u32x4*)(G + (size_t)row * 1024 + col);
                    const f32x4 b0 = *(const f32x4*)(bias + col), b1 = *(const f32x4*)(bias + col + 4);
                    float r[8];
#pragma unroll
                    for (int j = 0; j < 4; ++j) { r[j] = fast_sigmoid(acc[ai][bj][m][0][j] + b0[j]); r[4 + j] = fast_sigmoid(acc[ai][bj][m][1][j] + b1[j]); }
                    const unsigned gws[4] = {gw.x, gw.y, gw.z, gw.w};
#pragma unroll
                    for (int q = 0; q < 4; ++q) { r[2 * q] *= __builtin_bit_cast(float, gws[q] << 16); r[2 * q + 1] *= __builtin_bit_cast(float, gws[q] & 0xffff0000u); }
                    u32x4 w; w.x = cvt_pk_bf16(r[0], r[1]); w.y = cvt_pk_bf16(r[2], r[3]); w.z = cvt_pk_bf16(r[4], r[5]); w.w = cvt_pk_bf16(r[6], r[7]);
                    *(u32x4*)(O + (size_t)row * ldc + col) = w; } }
    }
};
template <class Epi, class Sched, bool ALIGN_EPI = false, bool SP2 = false>
__device__ __forceinline__ void gemm_phase(PG8_LAS unsigned char* lds, const Gemm g, const Sched& S, const Epi& E, int wave_s) {
    const int tid = fresh_tid(wave_s);
    const int wid = __builtin_amdgcn_readfirstlane(tid >> 6), lane = tid & 63, wr = wid >> 2, wc = wid & 3, fr = lane & 15, fq = lane >> 4;
    const int K = g.K, nt = K / BK;
    unsigned voffA[2], voffB[2];
#pragma unroll
    for (int i = 0; i < 2; ++i) { int R, C; stage_rc(tid * 16 + i * 8192, R, C); const int Rb = Epi::PERM ? ((R & ~31) + perm32(R & 31)) : R;
        voffA[i] = (unsigned)(R * K + C) * 2u; voffB[i] = (unsigned)(Rb * K + C) * 2u; }
    const size_t kstep = (size_t)(BK * 2);
    const size_t hstep = (size_t)HALF * K * 2;
    const size_t tstep = 2 * hstep;
    const unsigned ldsw = (unsigned)wid * 1024u;
    const int aoff = lds_byte(wr * 64 + fr, fq * 8), boff = lds_byte(wc * 32 + fr, fq * 8);
#define PG8_SA(b, h) (((b) * 2 + (h)) * HTB)
#define PG8_SB(b, h) ((4 + (b) * 2 + (h)) * HTB)
#define PG8_STAGE(bufoff, gbase, voff) do { _Pragma("unroll") for (int _i = 0; _i < 2; ++_i) \
        __builtin_amdgcn_global_load_lds((const unsigned*)((const char*)(gbase) + (voff)[_i]), (PG8_LAS unsigned*)(lds + (bufoff) + ldsw + _i * 8192), 16, 0, 0); } while (0)
#define PG8_LDA(dst, b, h) do { _Pragma("unroll") for (int m = 0; m < 4; ++m) _Pragma("unroll") for (int k = 0; k < 2; ++k) dst[m][k] = *(const PG8_LAS bf16x8*)(lds + PG8_SA(b, h) + aoff + m * 2048 + k * 1024); } while (0)
#define PG8_LDB(dst, b, h) do { _Pragma("unroll") for (int n = 0; n < 2; ++n) _Pragma("unroll") for (int k = 0; k < 2; ++k) dst[n][k] = *(const PG8_LAS bf16x8*)(lds + PG8_SB(b, h) + boff + n * 2048 + k * 1024); } while (0)
#define PG8_MMA(ai, bj, At, Bt) do { __builtin_amdgcn_s_setprio(1); _Pragma("unroll") for (int m = 0; m < 4; ++m) _Pragma("unroll") for (int n = 0; n < 2; ++n) _Pragma("unroll") for (int k = 0; k < 2; ++k) \
        acc[ai][bj][m][n] = __builtin_amdgcn_mfma_f32_16x16x32_bf16(Bt[n][k], At[m][k], acc[ai][bj][m][n], 0, 0, 0); __builtin_amdgcn_s_setprio(0); } while (0)
#define PG8_WAIT_V(n) asm volatile("s_waitcnt vmcnt(" #n ")" ::: "memory")
#define PG8_WAIT_L(n) asm volatile("s_waitcnt lgkmcnt(" #n ")" ::: "memory")
#define PG8_BAR __builtin_amdgcn_s_barrier()
#define PG8_SCHED __builtin_amdgcn_sched_barrier(0)
    Unit cur, nxt; int ui = 0;
    if (!S.next(0, cur)) return;
    f32x4 acc[2][2][4][2];
#pragma unroll
    for (int a = 0; a < 2; ++a)
#pragma unroll
        for (int b = 0; b < 2; ++b)
#pragma unroll
            for (int m = 0; m < 4; ++m)
#pragma unroll
                for (int n = 0; n < 2; ++n) acc[a][b][m][n] = (f32x4){0.f, 0.f, 0.f, 0.f};
    bf16x8 At[4][2], B0[2][2], B1[2][2];
    const char* cA = (const char*)(cur.which ? g.A2 : g.A) + (size_t)cur.pm * tstep + (size_t)cur.kt0 * kstep; const char* cB = (const char*)(cur.which ? g.Bt2 : g.Bt) + (size_t)cur.pn * tstep + (size_t)cur.kt0 * kstep;
    S.a_ready(cur);
    if constexpr (SP2) {
        PG8_STAGE(PG8_SB(0, 0), cB, voffB); PG8_STAGE(PG8_SB(0, 1), cB + hstep, voffB); PG8_STAGE(PG8_SA(0, 0), cA, voffA); PG8_STAGE(PG8_SA(0, 1), cA + hstep, voffA);
        if (wr == 1) PG8_BAR;
        PG8_WAIT_V(2); PG8_BAR;
        PG8_STAGE(PG8_SB(1, 0), cB + kstep, voffB); PG8_STAGE(PG8_SA(1, 0), cA + kstep, voffA); PG8_STAGE(PG8_SB(1, 1), cB + hstep + kstep, voffB);
        PG8_WAIT_V(6); PG8_BAR;
    } else {
        PG8_STAGE(PG8_SB(0, 0), cB, voffB); PG8_STAGE(PG8_SA(0, 0), cA, voffA); PG8_STAGE(PG8_SB(0, 1), cB + hstep, voffB); PG8_STAGE(PG8_SA(0, 1), cA + hstep, voffA);
        if (wr == 1) PG8_BAR;
        PG8_WAIT_V(4); PG8_BAR;
        PG8_STAGE(PG8_SB(1, 0), cB + kstep, voffB); PG8_STAGE(PG8_SA(1, 0), cA + kstep, voffA); PG8_STAGE(PG8_SB(1, 1), cB + hstep + kstep, voffB);
        PG8_WAIT_V(6); PG8_BAR;
    }
    for (;;) {
        const bool has_next = S.next(ui + 1, nxt);
        const char* nA = has_next ? (const char*)(nxt.which ? g.A2 : g.A) + (size_t)nxt.pm * tstep + (size_t)nxt.kt0 * kstep : cA; const char* nB = has_next ? (const char*)(nxt.which ? g.Bt2 : g.Bt) + (size_t)nxt.pn * tstep + (size_t)nxt.kt0 * kstep : cB;
        const int ntc = cur.nkt;
        for (int t = 0; t < ntc; t += 2) {
            const bool last = (t == ntc - 2);
            const char* a1 = cA + (size_t)(t + 1) * kstep;
            const char* a2 = last ? nA : cA + (size_t)(t + 2) * kstep; const char* b2 = last ? nB : cB + (size_t)(t + 2) * kstep;
            const char* a3 = a2 + kstep; const char* b3 = b2 + kstep;
            if (last && has_next) S.a_ready(nxt);
            if constexpr (SP2) {
            PG8_LDB(B0, 0, 0); PG8_LDB(B1, 0, 1); PG8_SCHED; PG8_LDA(At, 0, 0); PG8_STAGE(PG8_SA(1, 1), a1 + hstep, voffA);
            PG8_WAIT_V(8); PG8_WAIT_L(0); PG8_BAR; PG8_MMA(0, 0, At, B0); PG8_MMA(0, 1, At, B1); PG8_BAR; PG8_SCHED;
            PG8_LDA(At, 0, 1); PG8_STAGE(PG8_SB(0, 0), b2, voffB); PG8_STAGE(PG8_SB(0, 1), b2 + hstep, voffB); PG8_STAGE(PG8_SA(0, 0), a2, voffA);
            PG8_WAIT_V(8); PG8_WAIT_L(0); PG8_BAR; PG8_MMA(1, 0, At, B0); PG8_MMA(1, 1, At, B1); PG8_BAR; PG8_SCHED;
            PG8_LDB(B0, 1, 0); PG8_LDB(B1, 1, 1); PG8_SCHED; PG8_LDA(At, 1, 0); PG8_STAGE(PG8_SA(0, 1), a2 + hstep, voffA);
            PG8_WAIT_V(8); PG8_WAIT_L(0); PG8_BAR; PG8_MMA(0, 0, At, B0); PG8_MMA(0, 1, At, B1); PG8_BAR; PG8_SCHED;
            PG8_LDA(At, 1, 1); PG8_STAGE(PG8_SB(1, 0), b3, voffB); PG8_STAGE(PG8_SB(1, 1), b3 + hstep, voffB); PG8_STAGE(PG8_SA(1, 0), a3, voffA);
            PG8_WAIT_V(8); PG8_WAIT_L(0); PG8_BAR; PG8_MMA(1, 0, At, B0); PG8_MMA(1, 1, At, B1); PG8_BAR; PG8_SCHED;
            } else {
            PG8_LDB(B0, 0, 0); PG8_SCHED; PG8_LDA(At, 0, 0); PG8_STAGE(PG8_SA(1, 1), a1 + hstep, voffA);
            PG8_WAIT_L(8); PG8_BAR; PG8_WAIT_L(0); PG8_MMA(0, 0, At, B0); PG8_BAR; PG8_SCHED;
            PG8_LDB(B1, 0, 1); PG8_STAGE(PG8_SB(0, 0), b2, voffB);
            PG8_BAR; PG8_WAIT_L(0); PG8_MMA(0, 1, At, B1); PG8_BAR;
            PG8_LDA(At, 0, 1); PG8_STAGE(PG8_SA(0, 0), a2, voffA);
            PG8_BAR; PG8_WAIT_L(0); PG8_MMA(1, 0, At, B0); PG8_BAR; PG8_SCHED;
            PG8_STAGE(PG8_SB(0, 1), b2 + hstep, voffB);
            PG8_WAIT_V(6); PG8_BAR; PG8_MMA(1, 1, At, B1); PG8_BAR;
            PG8_LDB(B0, 1, 0); PG8_SCHED; PG8_LDA(At, 1, 0); PG8_STAGE(PG8_SA(0, 1), a2 + hstep, voffA);
            PG8_WAIT_L(8); PG8_BAR; PG8_WAIT_L(0); PG8_MMA(0, 0, At, B0); PG8_BAR; PG8_SCHED;
            PG8_LDB(B1, 1, 1); PG8_STAGE(PG8_SB(1, 0), b3, voffB);
            PG8_BAR; PG8_WAIT_L(0); PG8_MMA(0, 1, At, B1); PG8_BAR;
            PG8_LDA(At, 1, 1); PG8_STAGE(PG8_SA(1, 0), a3, voffA);
            PG8_BAR; PG8_WAIT_L(0); PG8_MMA(1, 0, At, B0); PG8_BAR; PG8_SCHED;
            PG8_STAGE(PG8_SB(1, 1), b3 + hstep, voffB);
            PG8_WAIT_V(6); PG8_BAR; PG8_MMA(1, 1, At, B1); PG8_BAR;
            }
        }
        if constexpr (ALIGN_EPI) { if (wr == 0) PG8_BAR; }
        if constexpr (!Epi::AFTER_DRAIN) { E(acc, cur, wr, wc, fr, fq); S.done(cur); }
        if (!has_next) break;
#pragma unroll
        for (int a = 0; a < 2; ++a)
#pragma unroll
            for (int b = 0; b < 2; ++b)
#pragma unroll
                for (int m = 0; m < 4; ++m)
#pragma unroll
                    for (int n = 0; n < 2; ++n) acc[a][b][m][n] = (f32x4){0.f, 0.f, 0.f, 0.f};
        cur = nxt; cA = nA; cB = nB; ++ui;
        if constexpr (ALIGN_EPI) { if (wr == 1) PG8_BAR; }
    }
    PG8_WAIT_V(0);
    if constexpr (!ALIGN_EPI) { if (wr == 0) PG8_BAR; }
    PG8_BAR;
    if constexpr (Epi::AFTER_DRAIN) { E.fused(acc, cur, wr, wc, fr, fq, lds, wid, lane); S.done(cur); }
#undef PG8_SA
#undef PG8_SB
#undef PG8_STAGE
#undef PG8_LDA
#undef PG8_LDB
#undef PG8_MMA
#undef PG8_WAIT_V
#undef PG8_WAIT_L
#undef PG8_BAR
#undef PG8_SCHED
}
}
#define GAS __attribute__((address_space(1)))
#define LAS __attribute__((address_space(3)))
typedef unsigned short bf16;
typedef unsigned v4u __attribute__((ext_vector_type(4)));
typedef float f32x4 __attribute__((ext_vector_type(4)));
typedef short bf16x8 __attribute__((ext_vector_type(8)));
typedef GAS unsigned gu32;
typedef GAS unsigned long long gu64;
#define RLX_AGENT __ATOMIC_RELAXED, __HIP_MEMORY_SCOPE_AGENT
#define LDS_WAIT() asm volatile("s_waitcnt lgkmcnt(0)" ::: "memory")
#define VM_WAIT() asm volatile("s_waitcnt vmcnt(0)" ::: "memory")
__device__ __forceinline__ unsigned long long rt() { return __builtin_amdgcn_s_memrealtime(); }
__device__ __forceinline__ unsigned f2bf(float f) { unsigned u = __builtin_bit_cast(unsigned, f); return (u + 0x7fffu + ((u >> 16) & 1u)) >> 16; }
__device__ __forceinline__ unsigned pk2(float lo, float hi) { return f2bf(lo) | (f2bf(hi) << 16); }

#define XB_TMO      128
#define XB_XCNT(j)  (256  + 64 * (j))
#define XB_XSUB(j)  (1280 + 64 * (j))
#define XB_XGEN(j)  (2304 + 64 * (j))
#define XB_TOP      3328
#define XB_TOPGEN   3392
#define XCD_BAR_WORDS 3456
#define XB_SPIN_CAP (1u << 18)

__device__ __forceinline__ unsigned xb_ld(unsigned* p)              { return __hip_atomic_load(p, __ATOMIC_RELAXED, __HIP_MEMORY_SCOPE_AGENT); }
__device__ __forceinline__ unsigned xb_add(unsigned* p, unsigned v) { return __hip_atomic_fetch_add(p, v, __ATOMIC_RELAXED, __HIP_MEMORY_SCOPE_AGENT); }
__device__ __forceinline__ unsigned xb_xcc_id() { return (unsigned)__builtin_amdgcn_s_getreg((3 << 11) | 20) & 0xFu; }
#define XB_SPIN(cond, bar) do { unsigned _sp = 0; while (cond) { __builtin_amdgcn_s_sleep(1); \
    if ((++_sp & 255u) == 0u) { if (xb_ld(&(bar)[XB_TMO])) break; if (_sp > XB_SPIN_CAP) { atomicAdd(&(bar)[XB_TMO], 1u); break; } } } } while (0)

struct XcdBarrier {
    unsigned* bar; unsigned x;
    volatile LAS unsigned* st;
};

__device__ __forceinline__ XcdBarrier xcd_barrier_post(unsigned* bar, volatile LAS unsigned* st) {
    XcdBarrier b; b.bar = bar; b.x = xb_xcc_id(); b.st = st;
    if (threadIdx.x == 0) (void)xb_add(&bar[XB_XCNT(b.x)], 1u);
    return b;
}
__device__ __forceinline__ void xcd_barrier_complete(unsigned* bar, unsigned x, unsigned& nloc, unsigned& nx) {
    const unsigned G = gridDim.x * gridDim.y * gridDim.z;
    unsigned sum, cnt, mine, sp = 0u;
    for (;;) {
        sum = 0u; cnt = 0u; mine = 0u;
#pragma unroll
        for (unsigned j = 0; j < 16; ++j) { const unsigned c = xb_ld(&bar[XB_XCNT(j)]); sum += c; cnt += (c > 0u) ? 1u : 0u; mine = (j == x) ? c : mine; }
        if (sum == G) break;
        __builtin_amdgcn_s_sleep(1);
        if ((++sp & 255u) == 0u) { if (xb_ld(&bar[XB_TMO])) break; if (sp > XB_SPIN_CAP) { atomicAdd(&bar[XB_TMO], 1u); break; } }
    }
    nloc = mine > 0u ? mine : 1u; nx = cnt > 0u ? cnt : 1u;
}

__device__ __forceinline__ void xcd_barrier(const XcdBarrier& b, int wave_s) {
    asm volatile("s_waitcnt vmcnt(0)" ::: "memory");
    __syncthreads();
    if (wave_s == 0 && fresh_lane() == 0) {
        unsigned* bar = b.bar;
        __builtin_amdgcn_s_waitcnt(0);
        unsigned nloc = b.st[0], nx = b.st[1];
        if (nloc == 0u) { xcd_barrier_complete(bar, b.x, nloc, nx); b.st[0] = nloc; b.st[1] = nx; }
        const unsigned old = xb_add(&bar[XB_XSUB(b.x)], 1u);
        const unsigned gen = old / nloc;
        if (old + 1u == (gen + 1u) * nloc) {
            __builtin_amdgcn_fence(__ATOMIC_RELEASE, "agent");
            asm volatile("s_waitcnt vmcnt(0)" ::: "memory");
            const unsigned og = xb_add(&bar[XB_TOP], 1u);
            const unsigned tg = og / nx;
            if (og + 1u == (tg + 1u) * nx) xb_add(&bar[XB_TOPGEN], 1u);
            else XB_SPIN(xb_ld(&bar[XB_TOPGEN]) == tg, bar);
            __builtin_amdgcn_fence(__ATOMIC_ACQUIRE, "agent");
            xb_add(&bar[XB_XGEN(b.x)], 1u);
            asm volatile("s_waitcnt vmcnt(0)" ::: "memory");
        } else {
            XB_SPIN(xb_ld(&bar[XB_XGEN(b.x)]) == gen, bar);
            __builtin_amdgcn_fence(__ATOMIC_ACQUIRE, "agent");
            asm volatile("s_waitcnt vmcnt(0)" ::: "memory");
        }
    }
    __syncthreads();
}
constexpr int NWAVES = 8;
constexpr int DM = 2048, NB = 4, TT = 4096, CT = 256, SB = 4352, MR = NB * SB  , FF = 5632;
constexpr int AB_IN = 4624, ZLD = 4864, CD_IN = 2304, NMOD = 9, MODN = NMOD * DM  ;
constexpr float EPS = 1e-6f;
constexpr int ZA_Q = 0, ZA_K = 1024, ZA_V = 1280, ZB_Q = 1536, ZB_K = 2048, ZB_V = 2560, ZB_O = 3584, ZB_G = 4608;
constexpr int ZC_U = 0, ZD_Q = 1024, ZD_K = 2048, ZD_V = 2176;
constexpr int KSPLIT = 32;
constexpr size_t MiB = 1u << 20;
constexpr size_t WS_CTL = 0, CTL_ZERO_BYTES = 1 * MiB;
constexpr size_t WS_WUP = 1 * MiB;
constexpr size_t WS_WDN = WS_WUP + 4 * 44 * MiB;
constexpr size_t WS_WABIN = WS_WDN + 4 * 22 * MiB;
constexpr size_t WS_WABOUT = WS_WABIN + 19 * MiB;
constexpr size_t WS_WCDIN = WS_WABOUT + 8 * MiB;
constexpr size_t WS_WCDOUT = WS_WCDIN + 9 * MiB;
constexpr size_t WS_WGLU = WS_WCDOUT + 8 * MiB;
constexpr size_t WS_MODP = WS_WGLU + 2 * MiB;
constexpr size_t WS_MODV = WS_MODP + 23 * MiB;
constexpr size_t WS_NRM = WS_MODV + 1 * MiB;
constexpr size_t WS_TAB = WS_NRM + 1 * MiB;
constexpr size_t WS_H = WS_TAB + 4 * MiB;
constexpr size_t WS_HN = WS_H + 136 * MiB;
constexpr size_t WS_X = WS_HN + 68 * MiB;
constexpr size_t WS_Z = WS_X, WS_ZT = WS_X + 163 * MiB, WS_HID = WS_X;
constexpr size_t WS_CAT = WS_X + 216 * MiB;
constexpr size_t WS_GATES = WS_CAT + 68 * MiB;
constexpr size_t WS_KA = WS_GATES + 2 * MiB;
constexpr size_t WS_G = WS_KA + 10 * MiB;
constexpr size_t WS_SC1 = WS_G + 34 * MiB;
constexpr size_t WS_SC2 = WS_SC1 + 68 * MiB;
constexpr size_t WS_END = WS_SC2 + 68 * MiB;
static_assert((size_t)MR * ZLD * 2 <= 163 * MiB && (size_t)1536 * MR * 2 <= 53 * MiB && (size_t)MR * FF * 2 <= 216 * MiB, "overlay");
constexpr size_t TB_ROPEA = 0;
constexpr size_t TB_ROPED = 16384;
constexpr size_t TB_S5AB = 32768;
constexpr size_t TB_S5BB = TB_S5AB + 65536;
constexpr size_t TB_VEC = TB_S5BB + 1048576;
constexpr int TV_GK = 0, TV_GQ = 128, TV_BGATE = 256, TV_SINK = 272, TV_HEADG = 512, TV_DSKIP = 1536, TV_GLUB = 2560, TV_FINALG = 3584, TV_N = 5632;
constexpr size_t TB_S5C = TB_VEC + 32768;
constexpr size_t TB_S5BT = TB_S5C + 1048576;
constexpr size_t TB_S5CT = TB_S5BT + 524288;
constexpr size_t TB_END = TB_S5CT + 524288;
static_assert(TB_END <= 4 * MiB, "tables");
constexpr int CW_TMO = 0, CW_BAR = 4096;
constexpr int RING_OFF = 0, RING_BYTES = 131072;
constexpr int LDSCTL_OFF = RING_BYTES, MISC_OFF = LDSCTL_OFF + 320;
constexpr int LDS_BYTES = 147456;
static_assert(MISC_OFF + 128 <= LDSCTL_OFF + 512 && LDSCTL_OFF + 512 + 8 * 1024 <= LDS_BYTES, "LDS map");
__device__ __forceinline__ float bf2f(bf16 v) { return __builtin_bit_cast(float, (unsigned)v << 16); }
__device__ __forceinline__ float wave_sum(float v) {
#pragma unroll
    for (int o = 1; o < 64; o <<= 1) v += __shfl_xor(v, o);
    return v;
}
__device__ __forceinline__ float wave_sum_l(float v, int lane) {
#pragma unroll
    for (int o = 1; o < 64; o <<= 1) v += __builtin_bit_cast(float, __builtin_amdgcn_ds_bpermute((lane ^ o) << 2, __builtin_bit_cast(int, v)));
    return v;
}
#define OPAQUE(x) asm volatile("" : "+v"(x))
__device__ __forceinline__ float silu_acc(float x) { return x / (1.f + expf(-x)); }
__device__ __forceinline__ float logsigmoid_acc(float x) { return x >= 0.f ? -log1pf(expf(-x)) : x - log1pf(expf(x)); }
__device__ __forceinline__ float gelu_tanh(float x) { const float u = 0.7978845608028654f * (x + 0.044715f * x * x * x); return 0.5f * x * (1.f + tanhf(u)); }
__device__ __forceinline__ int row_sel(int m) { return m < NB * TT ? (m >> 12) : 4; }

struct Frame {
    LAS unsigned char* lds;
    volatile LAS unsigned* MISC;
    gu32* ctl;
    int wave, G;
    float* out; unsigned char* ws;
};

__device__ __forceinline__ void p0_transpose_item(const float* W, int K, int N, int Nvalid, bf16* WT, int drow0, int k0, int n0, LAS float* scr, int lane) {
    const int nn = n0 + (lane & 31); const bool ok = nn < Nvalid;
#pragma unroll
    for (int i = 0; i < 32; ++i) { const int kk = 2 * i + (lane >> 5); scr[kk * 33 + (lane & 31)] = ok ? W[(size_t)(k0 + kk) * N + nn] : 0.f; }
    LDS_WAIT(); asm volatile("" ::: "memory");
    const int c = lane & 7;
#pragma unroll
    for (int j = 0; j < 4; ++j) { const int n = (lane >> 3) + 8 * j; const LAS float* s = scr + (8 * c) * 33 + n;
        v4u o; o.x = pk2(s[0 * 33], s[1 * 33]); o.y = pk2(s[2 * 33], s[3 * 33]); o.z = pk2(s[4 * 33], s[5 * 33]); o.w = pk2(s[6 * 33], s[7 * 33]);
        *(GAS v4u*)(WT + (size_t)(drow0 + n) * K + k0 + 8 * c) = o; }
    LDS_WAIT(); asm volatile("" ::: "memory");
}
__device__ __forceinline__ bool p0_mat(int& r, const float* W, int K, int N, int Npad, bf16* WT, int mode  , LAS float* scr, int lane) {
    const int nblk = Npad / 32, items = (K / 64) * nblk;
    if (r >= items) { r -= items; return false; }
    const int kb = r / nblk, nb = r % nblk, n0 = 32 * nb;
    int drow0 = n0; if (mode) drow0 = (n0 >> 7) * 256 + (n0 & 127) + (mode == 2 ? 128 : 0);
    p0_transpose_item(W, K, N, N, WT, drow0, 64 * kb, n0, scr, lane);
    return true;
}
__device__ __forceinline__ void p0_prologue(Frame& F, const float* const (&in)[30]) {
    LAS float* scr = (LAS float*)(F.lds + RING_OFF + F.wave * 16384);
    const int lane = fresh_lane();
    const int gw = blockIdx.x * NWAVES + F.wave, NGW = F.G * NWAVES;
    unsigned char* ws = F.ws;
    {
        constexpr int NCH = MODN / 256, NIT = 2 * KSPLIT * NCH, KPER = DM / KSPLIT;
        for (int it = gw; it < NIT; it += NGW) {
            const int cc = it % NCH, ks = (it / NCH) % KSPLIT, l = it / (NCH * KSPLIT);
            const float* W = in[4] + (size_t)l * DM * MODN + (size_t)(ks * KPER) * MODN + cc * 256 + lane * 4;
            f32x4 a0 = {0, 0, 0, 0}, a1 = a0, a2 = a0, a3 = a0, a4 = a0;
#pragma unroll 16
            for (int k = 0; k < KPER; ++k) {
                const f32x4 w = *(const f32x4*)(W + (size_t)k * MODN); const int kk = ks * KPER + k;
                const float s0 = silu_acc(in[1][kk]), s1 = silu_acc(in[1][DM + kk]), s2 = silu_acc(in[1][2 * DM + kk]), s3 = silu_acc(in[1][3 * DM + kk]), s4 = silu_acc(in[3][kk]);
                a0 += w * s0; a1 += w * s1; a2 += w * s2; a3 += w * s3; a4 += w * s4;
            }
            float* P = (float*)(ws + WS_MODP) + ((size_t)(l * KSPLIT + ks) * 5) * MODN + cc * 256 + lane * 4;
            *(f32x4*)(P) = a0; *(f32x4*)(P + MODN) = a1; *(f32x4*)(P + 2 * MODN) = a2; *(f32x4*)(P + 3 * MODN) = a3; *(f32x4*)(P + 4 * MODN) = a4;
        }
    }
    {
        constexpr int I_UP = (DM / 64) * (FF / 32), I_DN = (FF / 64) * (DM / 32);
        constexpr int NIT = 8 * I_UP + 4 * I_DN + (DM / 64) * (ZLD / 32) + 2 * (DM / 64) * (DM / 32) + (DM / 64) * (CD_IN / 32) + (1024 / 64) * (1024 / 32);
        for (int it = gw; it < NIT; it += NGW) {
            int r = it; bool done = false;
#pragma unroll 1
            for (int lh = 0; lh < 4 && !done; ++lh) {
                bf16* up = (bf16*)(ws + WS_WUP + (size_t)lh * 44 * MiB);
                done = p0_mat(r, in[7] + (size_t)lh * DM * FF, DM, FF, FF, up, 1, scr, lane); if (done) break;
                done = p0_mat(r, in[8] + (size_t)lh * DM * FF, DM, FF, FF, up, 2, scr, lane); if (done) break;
                done = p0_mat(r, in[9] + (size_t)lh * FF * DM, FF, DM, DM, (bf16*)(ws + WS_WDN + (size_t)lh * 22 * MiB), 0, scr, lane);
            }
            if (done) continue;
            {
                const int nblk = ZLD / 32, items = (DM / 64) * nblk;
                if (r < items) { const int kb = r / nblk, nb = r % nblk; p0_transpose_item(in[10], DM, AB_IN, AB_IN, (bf16*)(ws + WS_WABIN), 32 * nb, 64 * kb, 32 * nb, scr, lane); continue; }
                r -= items;
            }
            if (p0_mat(r, in[12], DM, DM, DM, (bf16*)(ws + WS_WABOUT), 0, scr, lane)) continue;
            if (p0_mat(r, in[16], DM, CD_IN, CD_IN, (bf16*)(ws + WS_WCDIN), 0, scr, lane)) continue;
            if (p0_mat(r, in[17], DM, DM, DM, (bf16*)(ws + WS_WCDOUT), 0, scr, lane)) continue;
            p0_mat(r, in[26], 1024, 1024, 1024, (bf16*)(ws + WS_WGLU), 0, scr, lane);
        }
    }
    {
        const int tid_ = fresh_tid(F.wave); const int gt = blockIdx.x * (NWAVES * 64) + tid_, NT = F.G * NWAVES * 64;
        float* ropeA = (float*)(ws + WS_TAB + TB_ROPEA); float* ropeD = (float*)(ws + WS_TAB + TB_ROPED);
        for (int i = gt; i < 64 * 32; i += NT) { const int pos = i >> 5, f = i & 31; const float inv = powf(10000.f, -(float)f / 32.f), a = (float)pos * inv; ropeA[2 * i] = cosf(a); ropeA[2 * i + 1] = sinf(a); }
        for (int i = gt; i < 64 * 16; i += NT) { const int pos = i >> 4, f = i & 15; const float inv = powf(10000.f, -(float)f / 16.f), a = (float)pos * inv; ropeD[2 * i] = cosf(a); ropeD[2 * i + 1] = sinf(a); }
        float* s5ab = (float*)(ws + WS_TAB + TB_S5AB); float* s5bb = (float*)(ws + WS_TAB + TB_S5BB); bf16* s5bt = (bf16*)(ws + WS_TAB + TB_S5BT); bf16* s5ct = (bf16*)(ws + WS_TAB + TB_S5CT);
        for (int i = gt; i < 2 * 64 * 64; i += NT) {
            const int dg = i >> 6;
            const float are = in[18][i], aim = in[19][i], dt = expf(in[20][dg]);
            const float mag = expf(are * dt), abr = mag * cosf(aim * dt), abi = mag * sinf(aim * dt);
            const float den = are * are + aim * aim, nr = abr - 1.f, ni = abi;
            const float kre = (nr * are + ni * aim) / den, kim = (ni * are - nr * aim) / den;
            s5ab[2 * i] = abr; s5ab[2 * i + 1] = abi;
            for (int q = 0; q < 16; ++q) { const float br = in[21][(size_t)i * 16 + q], bi = in[22][(size_t)i * 16 + q];
                const float bbr = kre * br - kim * bi, bbi = kre * bi + kim * br;
                s5bb[((size_t)i * 16 + q) * 2] = bbr; s5bb[((size_t)i * 16 + q) * 2 + 1] = bbi;
                s5bt[((size_t)dg * 128 + (i & 63)) * 16 + q] = (bf16)f2bf(bbr); s5bt[((size_t)dg * 128 + 64 + (i & 63)) * 16 + q] = (bf16)f2bf(bbi); }
        }
        for (int i = gt; i < 2 * 64 * 16 * 128; i += NT) { const int pp = i & 127, dgo = i >> 7;
            s5ct[i] = (bf16)f2bf(pp < 64 ? in[23][(size_t)dgo * 64 + pp] : -in[24][(size_t)dgo * 64 + pp - 64]); }
        float* tv = (float*)(ws + WS_TAB + TB_VEC);
        for (int i = gt; i < TV_N; i += NT) { float v = 0.f;
            if (i < TV_GQ) v = in[14][i]; else if (i < TV_BGATE) v = in[13][i - TV_GQ]; else if (i < TV_SINK) v = in[11][i - TV_BGATE]; else if (i < TV_SINK + 16) v = in[28][i - TV_SINK];
            else if (i >= TV_HEADG && i < TV_DSKIP) v = in[15][i - TV_HEADG]; else if (i >= TV_DSKIP && i < TV_GLUB) v = in[25][i - TV_DSKIP];
            else if (i >= TV_GLUB && i < TV_FINALG) v = in[27][i - TV_GLUB]; else if (i >= TV_FINALG) v = in[29][i - TV_FINALG];
            tv[i] = v; }
        float* s5c = (float*)(ws + WS_TAB + TB_S5C);
        for (int i = gt; i < 2 * 131072; i += NT) s5c[i] = i < 131072 ? in[23][i] : in[24][i - 131072];
    }
}
__device__ __forceinline__ void p1_modreduce(Frame& F, const float* modb, const float* normg) {
    const int tid_ = fresh_tid(F.wave); const int gt = blockIdx.x * (NWAVES * 64) + tid_, NT = F.G * NWAVES * 64;
    const float* P = (const float*)(F.ws + WS_MODP); float* MV = (float*)(F.ws + WS_MODV); float* NR = (float*)(F.ws + WS_NRM);
    for (int i = gt; i < 2 * 5 * DM; i += NT) {
        const int c = i % DM, sel = (i / DM) % 5, l = i / (5 * DM);
        float mv[9];
#pragma unroll
        for (int idx = 0; idx < 9; ++idx) { float s = 0.f;
            for (int ks = 0; ks < KSPLIT; ++ks) s += P[((size_t)(l * KSPLIT + ks) * 5 + sel) * MODN + idx * DM + c];
            s += modb[l * MODN + idx * DM + c]; mv[idx] = s; MV[((size_t)(l * 5 + sel) * 9 + idx) * DM + c] = s; }
#pragma unroll
        for (int w = 0; w < 3; ++w) { const float g = normg[(l * 3 + w) * DM + c];
            NR[(((size_t)(l * 5 + sel) * 3 + w) * 2) * DM + c] = g * (1.f + mv[3 * w + 1]);
            NR[(((size_t)(l * 5 + sel) * 3 + w) * 2 + 1) * DM + c] = mv[3 * w]; }
    }
}
template <int PS>
__device__ __forceinline__ void norm_phase(Frame& F, unsigned char* ws, const float* xin, const float* cin, int l, int which, bool first, int nrows, const float* pgate = nullptr, float pcoef = 0.f) {
    const int lane = fresh_lane();
    const int gw = blockIdx.x * NWAVES + F.wave, NGW = F.G * NWAVES;
    float* H = (float*)(ws + WS_H); bf16* HN = (bf16*)(ws + WS_HN); const float* NR = (const float*)(ws + WS_NRM);
#define NP_SRC(m_) ((const GAS f32x4*)(first ? ((m_) < NB * TT ? xin + (size_t)(m_) * DM : cin + (size_t)((m_) - NB * TT) * DM) : H + (size_t)(m_) * DM) + lane)
    f32x4 vn[8];
    if (gw < nrows) { const GAS f32x4* xr = NP_SRC(gw);
#pragma unroll
        for (int j = 0; j < 8; ++j) vn[j] = xr[64 * j]; }
    for (int m = gw; m < nrows; m += NGW) {
        f32x4 v[8];
#pragma unroll
        for (int j = 0; j < 8; ++j) v[j] = vn[j];
        const int mn = m + NGW;
        if (mn < nrows) { const GAS f32x4* xr = NP_SRC(mn);
#pragma unroll
            for (int j = 0; j < 8; ++j) vn[j] = xr[64 * j]; }
        const int sel = row_sel(m);
        const GAS f32x4* Ap = (const GAS f32x4*)(NR + (((size_t)(l * 5 + sel) * 3 + which) * 2) * DM) + lane; const GAS f32x4* Bp = Ap + DM / 4;
        const bool merge = PS > 0 && m >= NB * TT;
        if (merge) { const GAS f32x4* pp = (const GAS f32x4*)((const float*)(ws + WS_SC1) + (size_t)(m - NB * TT) * DM) + lane; const GAS f32x4* gp = (const GAS f32x4*)pgate + lane;
#pragma unroll
            for (int j = 0; j < 8; ++j) { f32x4 a = pp[64 * j];
#pragma unroll
                for (int q = 1; q < (PS > 0 ? PS : 1); ++q) a += pp[(size_t)q * (1024 * DM / 4) + 64 * j];
                v[j] += gp[64 * j] * pcoef * a; } }
        float s = 0.f;
#pragma unroll
        for (int j = 0; j < 8; ++j) s += (v[j].x * v[j].x + v[j].y * v[j].y) + (v[j].z * v[j].z + v[j].w * v[j].w);
        const float rstd = 1.f / sqrtf(wave_sum_l(s, lane) * (1.f / DM) + EPS);
        if (first || merge) { GAS f32x4* hw = (GAS f32x4*)(H + (size_t)m * DM) + lane;
#pragma unroll
            for (int j = 0; j < 8; ++j) hw[64 * j] = v[j]; }
        GAS unsigned long long* o8 = (GAS unsigned long long*)(HN + (size_t)m * DM) + lane;
#pragma unroll
        for (int j = 0; j < 8; ++j) { const f32x4 a = Ap[64 * j], b = Bp[64 * j]; const f32x4 y = v[j] * rstd * a + b;
            o8[64 * j] = (unsigned long long)pk2(y.x, y.y) | ((unsigned long long)pk2(y.z, y.w) << 32); }
    }
#undef NP_SRC
}
__device__ __forceinline__ void final_norm_phase(Frame& F, unsigned char* ws) {
    const int lane = fresh_lane();
    const int gw = blockIdx.x * NWAVES + F.wave, NGW = F.G * NWAVES;
    const float* H = (const float*)(ws + WS_H);
    f32x4 vn[8];
    { const GAS f32x4* xr = (const GAS f32x4*)(H + (size_t)gw * DM) + lane;
#pragma unroll
      for (int j = 0; j < 8; ++j) vn[j] = xr[64 * j]; }
    for (int m = gw; m < NB * TT; m += NGW) {
        f32x4 v[8]; float s = 0.f;
#pragma unroll
        for (int j = 0; j < 8; ++j) { v[j] = vn[j]; s += (v[j].x * v[j].x + v[j].y * v[j].y) + (v[j].z * v[j].z + v[j].w * v[j].w); }
        if (m + NGW < NB * TT) { const GAS f32x4* xr = (const GAS f32x4*)(H + (size_t)(m + NGW) * DM) + lane;
#pragma unroll
            for (int j = 0; j < 8; ++j) vn[j] = xr[64 * j]; }
        const float rstd = 1.f / sqrtf(wave_sum_l(s, lane) * (1.f / DM) + EPS);
        const GAS f32x4* gp = (const GAS f32x4*)((const float*)(ws + WS_TAB + TB_VEC) + TV_FINALG) + lane; GAS f32x4* o = (GAS f32x4*)(F.out + (size_t)m * DM) + lane;
#pragma unroll
        for (int j = 0; j < 8; ++j) o[64 * j] = v[j] * rstd * gp[64 * j];
    }
}
template <int MODE> __device__ __forceinline__ void naive_kprep(int gw, int lane, const bf16* Z, bf16* KO, const float* gk, const float* rope) {
    if (MODE == 0) {
        if (gw >= MR * 2) return;
        const int m = gw >> 1, kvh = gw & 1; const bf16* zr = Z + (size_t)m * ZLD + ZA_K + kvh * 128;
        float x1 = bf2f(zr[lane]), x2 = bf2f(zr[64 + lane]);
        const float rstd = 1.f / sqrtf(wave_sum_l(x1 * x1 + x2 * x2, lane) * (1.f / 128.f) + EPS);
        x1 *= rstd * gk[lane]; x2 *= rstd * gk[64 + lane];
        if (m < NB * TT) { const int t = m & (TT - 1), pos = lane < 32 ? (t >> 6) : (t & 63), f = lane & 31; const float c = rope[2 * (pos * 32 + f)], s = rope[2 * (pos * 32 + f) + 1];
            const float o1 = x1 * c - x2 * s, o2 = x2 * c + x1 * s; x1 = o1; x2 = o2; }
        KO[(size_t)m * 256 + kvh * 128 + lane] = (bf16)f2bf(x1); KO[(size_t)m * 256 + kvh * 128 + 64 + lane] = (bf16)f2bf(x2);
    } else {
        if (gw >= MR) return;
        const int m = gw, kvh = lane >> 5, j = lane & 31; const bf16* zr = Z + (size_t)m * CD_IN + ZD_K + kvh * 64;
        float x1 = bf2f(zr[j]), x2 = bf2f(zr[32 + j]);
        if (m < NB * TT) { const int t = m & (TT - 1), pos = j < 16 ? (t >> 6) : (t & 63), f = j & 15; const float c = rope[2 * (pos * 16 + f)], s = rope[2 * (pos * 16 + f) + 1];
            const float o1 = x1 * c - x2 * s, o2 = x2 * c + x1 * s; x1 = o1; x2 = o2; }
        KO[(size_t)m * 128 + kvh * 64 + j] = (bf16)f2bf(x1); KO[(size_t)m * 128 + kvh * 64 + 32 + j] = (bf16)f2bf(x2);
    }
}
template <int DH, int MODE> __device__ __forceinline__ void naive_attn(int vb, int vtid, const bf16* Z, const bf16* KB, bf16* CAT, const float* gq, const float* rope, const float* sink) {
    constexpr int H4 = DH / 4, NF = DH / 4, NH = (MODE == 2) ? 16 : 8, QPB = 128;
    constexpr int NQ = (MODE == 1) ? CT : TT, LDZ = (MODE == 2) ? CD_IN : ZLD, LDK = (MODE == 2) ? 128 : 256;
    constexpr int QCOL = (MODE == 2) ? ZD_Q : ZA_Q, VCOL = (MODE == 2) ? ZD_V : ZA_V, OCOL = (MODE == 2) ? 1024 : 0;
    const int nchunk = NQ / QPB; int bid = vb; const int qc = bid % nchunk; bid /= nchunk; const int head = bid % NH, b = bid / NH;
    const int kvh = head / (NH / 2), part = vtid & 3, r = vtid >> 2, qi = qc * QPB + r;
    const int m = (MODE == 1) ? (NB * TT + b * CT + qi) : (b * TT + qi);
    float q[H4], acc[H4];
    const bf16* qp = Z + (size_t)m * LDZ + QCOL + head * DH + part * H4;
#pragma unroll
    for (int i = 0; i < H4; ++i) { q[i] = bf2f(qp[i]); acc[i] = 0.f; }
    if (MODE != 2) { float ss = 0.f;
#pragma unroll
        for (int i = 0; i < H4; ++i) ss += q[i] * q[i];
        ss += __shfl_xor(ss, 1); ss += __shfl_xor(ss, 2); const float rstd = 1.f / sqrtf(ss * (1.f / DH) + EPS);
#pragma unroll
        for (int i = 0; i < H4; ++i) q[i] *= rstd * gq[part * H4 + i]; }
    if (MODE != 1) { const int t = qi;
#pragma unroll
        for (int i = 0; i < H4; ++i) { const int j = (part & 1) * H4 + i;
            const int pos = j < NF ? (t >> 6) : (t & 63), f = j % NF; const float c = rope[2 * (pos * NF + f)], s = rope[2 * (pos * NF + f) + 1];
            const float other = __shfl_xor(q[i], 2); q[i] = part < 2 ? (q[i] * c - other * s) : (q[i] * c + other * s); } }
    const float scale = (DH == 128) ? 0.08838834764831845f : 0.125f;
#pragma unroll
    for (int i = 0; i < H4; ++i) q[i] *= scale;
    float mx = (MODE == 2) ? sink[head] : -1e30f, l = (MODE == 2) ? 1.f : 0.f;
    const int lat_lo = (MODE == 0) ? 0 : (MODE == 2 ? max(0, qc * QPB - 128) : 0), lat_hi = (MODE == 0) ? TT : (MODE == 2 ? min(TT, qc * QPB + QPB + 128) : 0);
    const int nkeys = CT + (lat_hi - lat_lo);
#pragma unroll 2
    for (int kk = 0; kk < nkeys; ++kk) {
        const int kpos = kk - CT + lat_lo;
        const int km = kk < CT ? (NB * TT + b * CT + kk) : (b * TT + kpos);
        const bf16* kp = KB + (size_t)km * LDK + kvh * DH + part * H4;
        float s = 0.f;
#pragma unroll
        for (int i = 0; i < H4; ++i) s += q[i] * bf2f(kp[i]);
        s += __shfl_xor(s, 1); s += __shfl_xor(s, 2);
        if (MODE == 2 && kk >= CT && abs(kpos - qi) > 128) continue;
        const float mn = fmaxf(mx, s), al = expf(mx - mn), p = expf(s - mn);
        l = l * al + p; mx = mn;
        const bf16* vp = Z + (size_t)km * LDZ + VCOL + kvh * DH + part * H4;
#pragma unroll
        for (int i = 0; i < H4; ++i) acc[i] = acc[i] * al + p * bf2f(vp[i]);
    }
    const float il = 1.f / l;
    bf16* op = CAT + (size_t)m * DM + OCOL + head * DH + part * H4;
#pragma unroll
    for (int i = 0; i < H4; ++i) op[i] = (bf16)f2bf(acc[i] * il);
}
__device__ __forceinline__ void naive_mlstm(int seq, int tid, LAS float* sq, const bf16* Z, const float* GATES, const float* bgate, float* HF, float* HB) {
    const int b = seq >> 3, h = (seq >> 1) & 3, dir = seq & 1;
    LAS float* sk = sq + 128; LAS float* sred = sq + 256;
    const int v = tid >> 1, half = tid & 1, lane = tid & 63, wave = tid >> 6;
    float C[64];
#pragma unroll
    for (int j = 0; j < 64; ++j) C[j] = 0.f;
    float nreg = 0.f, mstate = 0.f;
    const float bi = bgate[(2 * dir) * 4 + h], bfg = bgate[(2 * dir + 1) * 4 + h];
    float* HO = dir ? HB : HF;
    for (int p = 0; p < SB; ++p) {
        const int s = dir == 0 ? p : (p < CT ? CT - 1 - p : CT + (SB - 1 - p));
        const int m = s < CT ? (NB * TT + b * CT + s) : (b * TT + s - CT);
        const bf16* zr = Z + (size_t)m * ZLD;
        if (tid < 128) sq[tid] = bf2f(zr[ZB_Q + h * 128 + tid]) * 0.08838834764831845f; else if (tid < 256) sk[tid - 128] = bf2f(zr[ZB_K + h * 128 + tid - 128]);
        const float vv = bf2f(zr[ZB_V + h * 256 + v]);
        const float ig = GATES[(size_t)m * 16 + (2 * dir) * 4 + h] + bi, lf = logsigmoid_acc(GATES[(size_t)m * 16 + (2 * dir + 1) * 4 + h] + bfg);
        const float mn = fmaxf(lf + mstate, ig), ip = expf(ig - mn), fp = expf(lf + mstate - mn); mstate = mn;
        __syncthreads();
        float dpart = 0.f; if (tid < 128) { nreg = fp * nreg + ip * sk[tid]; dpart = nreg * sq[tid]; }
        if (wave < 2) { dpart = wave_sum_l(dpart, lane); if (lane == 0) sred[wave] = dpart; }
        float np = 0.f; const float iv = ip * vv;
#pragma unroll
        for (int j = 0; j < 64; ++j) { C[j] = fp * C[j] + iv * sk[64 * half + j]; np += C[j] * sq[64 * half + j]; }
        np += __builtin_bit_cast(float, __builtin_amdgcn_ds_bpermute((lane ^ 1) << 2, __builtin_bit_cast(int, np)));
        __syncthreads();
        const float den = sred[0] + sred[1];
        if (half == 0) HO[(size_t)m * 1024 + h * 256 + v] = np / fmaxf(fabsf(den), expf(-mn));
        __syncthreads();
    }
}
__device__ __forceinline__ void naive_mlstm_finish(int gw, int lane, const bf16* Z, const float* HF, const float* HB, const float* headg, bf16* CAT) {
    const int m = gw >> 2, h = gw & 3; const size_t o = (size_t)m * 1024 + h * 256 + lane * 4;
    const f32x4 a = *(const f32x4*)(HF + o), bb = *(const f32x4*)(HB + o); const f32x4 hh = a + bb;
    const float rstd = 1.f / sqrtf(wave_sum_l((hh.x * hh.x + hh.y * hh.y) + (hh.z * hh.z + hh.w * hh.w), lane) * (1.f / 256.f) + EPS);
    const bf16* og = Z + (size_t)m * ZLD + ZB_O + h * 256 + lane * 4; bf16* cp = CAT + (size_t)m * DM + 1024 + h * 256 + lane * 4;
#pragma unroll
    for (int j = 0; j < 4; ++j) { const float sg = 1.f / (1.f + expf(-bf2f(og[j]))); cp[j] = (bf16)f2bf(sg * hh[j] * rstd * headg[h * 256 + lane * 4 + j]); }
}
__device__ __forceinline__ void naive_s5(int id, int lane, const bf16* Z, const float* s5ab, const float* s5bb, const float* cre_in, const float* cim_in, float* YF, float* YB) {
    const int b = id >> 7, g = (id >> 1) & 63, dir = id & 1;
    const int i = (dir * 64 + g) * 64 + lane;
    const float ar = s5ab[2 * i], ai = s5ab[2 * i + 1];
    float Br[16], Bi[16], cr[16], ci[16];
#pragma unroll
    for (int q = 0; q < 16; ++q) { Br[q] = s5bb[((size_t)i * 16 + q) * 2]; Bi[q] = s5bb[((size_t)i * 16 + q) * 2 + 1];
        cr[q] = cre_in[((size_t)(dir * 64 + g) * 16 + q) * 64 + lane]; ci[q] = cim_in[((size_t)(dir * 64 + g) * 16 + q) * 64 + lane]; }
    float xr = 0.f, xi = 0.f; float* Y = dir ? YB : YF;
    for (int p = 0; p < SB; ++p) {
        const int s = dir == 0 ? p : (p < CT ? CT - 1 - p : CT + (SB - 1 - p));
        const int m = s < CT ? (NB * TT + b * CT + s) : (b * TT + s - CT);
        const bf16* up = Z + (size_t)m * CD_IN + ZC_U + g * 16;
        float bur = 0.f, bui = 0.f;
#pragma unroll
        for (int q = 0; q < 16; ++q) { const float u = bf2f(up[q]); bur += Br[q] * u; bui += Bi[q] * u; }
        const float nxr = ar * xr - ai * xi + bur, nxi = ar * xi + ai * xr + bui; xr = nxr; xi = nxi;
        if (s >= CT) { float yo = 0.f;
#pragma unroll
            for (int q = 0; q < 16; ++q) { const float val = wave_sum_l(cr[q] * xr - ci[q] * xi, lane); if (lane == q) yo = val; }
            if (lane < 16) Y[(size_t)m * 1024 + g * 16 + lane] = yo; }
    }
}
__device__ __forceinline__ void naive_s5_finish(size_t i, const bf16* Z, const float* YF, const float* YB, const float* dskip, bf16* G) {
    const int m = (int)(i >> 10), c = (int)(i & 1023);
    const float y = YF[i] + YB[i] + dskip[c] * bf2f(Z[(size_t)m * CD_IN + ZC_U + c]);
    G[i] = (bf16)f2bf(gelu_tanh(y));
}
namespace att {
using bf16x8 = __attribute__((ext_vector_type(8))) short;
using s16x4  = __attribute__((ext_vector_type(4))) short;
using f32x16 = __attribute__((ext_vector_type(16))) float;
using u32x4  = __attribute__((ext_vector_type(4))) unsigned;
constexpr int NW = 8, QBLK = 32, KVBLK = 64;
constexpr size_t SHM_V = KVBLK * 128 * 2, SHM_K = KVBLK * 128 * 2, SHM_ATTN = 2 * SHM_V + 2 * SHM_K + NW * 64 * 4;
#define KSWZ(row, colB) ((row) * 256 + ((colB) ^ (((row) & 7) << 4)))
#define SBAR() __builtin_amdgcn_sched_barrier(0)
__device__ __forceinline__ int crow(int r, int hi) { return (r & 3) + 8 * (r >> 2) + 4 * hi; }
__device__ __forceinline__ unsigned cvtpk(float lo, float hi) { unsigned r; asm volatile("v_cvt_pk_bf16_f32 %0, %1, %2" : "=v"(r) : "v"(lo), "v"(hi)); return r; }
template <int DH> struct Cst { static constexpr float SCALE = (DH == 128) ? 0.088388347648318440f : 0.125f; };
constexpr float THR = 8.f;
#ifndef ATT_SDEPTH
#define ATT_SDEPTH 2
#endif
constexpr int SDEPTH = ATT_SDEPTH;
template <int DH> __device__ __forceinline__ void partialSM(f32x16& p0, f32x16& p1, float& m_reg, float& mn, float& alpha) {
  constexpr float SCALE = Cst<DH>::SCALE, C = SCALE * 1.4426950408889634f;
  float pmax = p0[0]; for (int r = 1; r < 16; ++r) pmax = fmaxf(pmax, p0[r]); for (int r = 0; r < 16; ++r) pmax = fmaxf(pmax, p1[r]);
  { auto rr = __builtin_amdgcn_permlane32_swap(__float_as_uint(pmax), __float_as_uint(pmax), false, false);
    pmax = fmaxf(__uint_as_float(rr[0]), __uint_as_float(rr[1])); }
  if (__builtin_expect(__all(pmax - m_reg <= THR / SCALE), 1)) { mn = m_reg; alpha = 1.f; }
  else { mn = fmaxf(m_reg, pmax); alpha = __builtin_amdgcn_exp2f((m_reg - mn) * C); m_reg = mn; }
  float mnC = -mn * C;
  for (int r = 0; r < 16; ++r) p0[r] = fmaf(p0[r], C, mnC); for (int r = 0; r < 16; ++r) p1[r] = fmaf(p1[r], C, mnC);
  for (int r = 0; r < 16; ++r) p0[r] = __builtin_amdgcn_exp2f(p0[r]);
}
__device__ __forceinline__ void finishSM(f32x16& p0, f32x16& p1, float alpha, float& l_reg, bf16x8& pa0, bf16x8& pa1, bf16x8& pa2, bf16x8& pa3) {
  for (int r = 0; r < 16; ++r) p1[r] = __builtin_amdgcn_exp2f(p1[r]);
  float ps = 0; for (int r = 0; r < 16; ++r) ps += p0[r]; for (int r = 0; r < 16; ++r) ps += p1[r];
  { auto rr = __builtin_amdgcn_permlane32_swap(__float_as_uint(ps), __float_as_uint(ps), false, false);
    ps = __uint_as_float(rr[0]) + __uint_as_float(rr[1]); }
  l_reg = l_reg * alpha + ps;
#define PK4(P, BASE, OUT) do { unsigned a0 = cvtpk(P[BASE + 0], P[BASE + 1]), a1 = cvtpk(P[BASE + 2], P[BASE + 3]);   \
    unsigned b0 = cvtpk(P[BASE + 4], P[BASE + 5]), b1 = cvtpk(P[BASE + 6], P[BASE + 7]);                              \
    auto r0 = __builtin_amdgcn_permlane32_swap(a0, b0, false, false); auto r1 = __builtin_amdgcn_permlane32_swap(a1, b1, false, false); \
    u32x4 w = {r0[0], r1[0], r0[1], r1[1]}; OUT = *reinterpret_cast<bf16x8*>(&w); } while (0)
  PK4(p0, 0, pa0); PK4(p0, 8, pa1); PK4(p1, 0, pa2); PK4(p1, 8, pa3);
#undef PK4
}
template <int DH> __device__ __forceinline__ void qkt(f32x16& p0, f32x16& p1, const bf16* Ks, const bf16x8* qr, int r32, int hi) {
  p0 = f32x16{}; p1 = f32x16{};
#pragma unroll
  for (int d0 = 0; d0 < DH / 16; ++d0) { int cb = (d0 * 16 + hi * 8) * 2;
    bf16x8 b0 = *reinterpret_cast<const bf16x8*>((const char*)Ks + KSWZ(r32, cb));
    bf16x8 b1 = *reinterpret_cast<const bf16x8*>((const char*)Ks + KSWZ(32 + r32, cb));
    p0 = __builtin_amdgcn_mfma_f32_32x32x16_bf16(b0, qr[d0], p0, 0, 0, 0);
    p1 = __builtin_amdgcn_mfma_f32_32x32x16_bf16(b1, qr[d0], p1, 0, 0, 0); }
}
__device__ __forceinline__ void wmask(f32x16& p0, f32x16& p1, int kp0, int qpos, int hi) {
#pragma unroll
  for (int r = 0; r < 16; ++r) { const int k = kp0 + crow(r, hi); const int d0 = k - qpos, d1 = k + 32 - qpos;
    if (d0 > 128 || d0 < -128) p0[r] = -1e30f; if (d1 > 128 || d1 < -128) p1[r] = -1e30f; }
}
__device__ __forceinline__ int v_st(int k, int c) { const int kk = (k & ~0xC) | ((k & 4) << 1) | ((k & 8) >> 1); return ((kk >> 3) * 4 + (c >> 5)) * 512 + ((kk & 7) * 32 + (c & 31)) * 2; }
__device__ __forceinline__ int v_rd_base(int lane) { return ((lane & 3) << 3) | (((lane >> 2) & 3) << 6) | (((lane >> 4) & 1) << 5) | (((lane >> 5) & 1) << 8); }
constexpr int v_rd_off(int d0, int ks, int half) { return d0 * 512 + ks * 4096 + half * 2048; }
template <int OFF> __device__ __forceinline__ s16x4 tr_read(int vb) {
  s16x4 r; asm volatile("ds_read_b64_tr_b16 %0, %1 offset:%2" : "=&v"(r) : "v"(vb), "i"(OFF) : "memory"); return r;
}
template <int D0> __device__ __forceinline__ void pv_one(f32x16& od, int vb, bf16x8 pa0, bf16x8 pa1, bf16x8 pa2, bf16x8 pa3) {
  const s16x4 l0 = tr_read<v_rd_off(D0, 0, 0)>(vb), h0 = tr_read<v_rd_off(D0, 0, 1)>(vb), l1 = tr_read<v_rd_off(D0, 1, 0)>(vb), h1 = tr_read<v_rd_off(D0, 1, 1)>(vb);
  const s16x4 l2 = tr_read<v_rd_off(D0, 2, 0)>(vb), h2 = tr_read<v_rd_off(D0, 2, 1)>(vb), l3 = tr_read<v_rd_off(D0, 3, 0)>(vb), h3 = tr_read<v_rd_off(D0, 3, 1)>(vb);
  asm volatile("s_waitcnt lgkmcnt(0)" ::: "memory"); SBAR();
#define PK(L, H) (bf16x8){L[0], L[1], L[2], L[3], H[0], H[1], H[2], H[3]}
  od = __builtin_amdgcn_mfma_f32_32x32x16_bf16(pa0, PK(l0, h0), od, 0, 0, 0);
  od = __builtin_amdgcn_mfma_f32_32x32x16_bf16(pa1, PK(l1, h1), od, 0, 0, 0);
  od = __builtin_amdgcn_mfma_f32_32x32x16_bf16(pa2, PK(l2, h2), od, 0, 0, 0);
  od = __builtin_amdgcn_mfma_f32_32x32x16_bf16(pa3, PK(l3, h3), od, 0, 0, 0);
#undef PK
}
template <int DH> __device__ __forceinline__ void pv_d0(f32x16* o, int vb, bf16x8 pa0, bf16x8 pa1, bf16x8 pa2, bf16x8 pa3) {
  pv_one<0>(o[0], vb, pa0, pa1, pa2, pa3); pv_one<1>(o[1], vb, pa0, pa1, pa2, pa3);
  if (DH == 128) { pv_one<2>(o[2], vb, pa0, pa1, pa2, pa3); pv_one<3>(o[3], vb, pa0, pa1, pa2, pa3); }
}
template <int DH, int MODE>
__device__ __forceinline__ void attn_unit(const bf16* __restrict__ Qb, int LDQ, const bf16* __restrict__ Kb, int LDKK, const bf16* __restrict__ Vb, int LDKV, bf16* __restrict__ Ob,
                                          int b, int i0  , const float* __restrict__ gq, const float* __restrict__ rope, float sinkv, char* lds, int wave_s) {
  const int tid = fresh_tid(wave_s);
  constexpr float SCALE = Cst<DH>::SCALE;
  const int wid = tid >> 6, lane = tid & 63, r32 = lane & 31, hi = lane >> 5;
  bf16* V_lds = (bf16*)lds; bf16* K_lds = (bf16*)(lds + 2 * SHM_V);
  float* ws = (float*)(lds + 2 * SHM_V + 2 * SHM_K) + wid * 64; float* li_l = ws; float* al_l = ws + 32;
  float m_reg = (MODE == 2) ? sinkv / SCALE : -1e30f, l_reg = (MODE == 2) ? 1.f : 0.f; f32x16 o[DH / 32] = {}; bf16x8 qr[DH / 16];
  const int qpos = i0 + wid * QBLK + r32;
  {
    const bf16* Qw = Qb + (long)(wid * QBLK + r32) * LDQ + hi * 8;
    float qf[DH / 16][8];
#pragma unroll
    for (int d0 = 0; d0 < DH / 16; ++d0) { const u32x4 w = *reinterpret_cast<const u32x4*>(Qw + d0 * 16);
#pragma unroll
      for (int e = 0; e < 4; ++e) { qf[d0][2 * e] = __uint_as_float(w[e] << 16); qf[d0][2 * e + 1] = __uint_as_float(w[e] & 0xffff0000u); } }
    if (MODE != 2) { float ss = 0.f;
#pragma unroll
      for (int d0 = 0; d0 < DH / 16; ++d0)
#pragma unroll
        for (int e = 0; e < 8; ++e) ss += qf[d0][e] * qf[d0][e];
      { auto rr = __builtin_amdgcn_permlane32_swap(__float_as_uint(ss), __float_as_uint(ss), false, false); ss = __uint_as_float(rr[0]) + __uint_as_float(rr[1]); }
      const float rstd = 1.f / sqrtf(ss * (1.f / DH) + EPS);
#pragma unroll
      for (int d0 = 0; d0 < DH / 16; ++d0)
#pragma unroll
        for (int e = 0; e < 8; ++e) qf[d0][e] *= rstd * ((const GAS float*)gq)[d0 * 16 + hi * 8 + e]; }
    if (MODE != 1) { constexpr int NF = DH / 4;
#pragma unroll
      for (int d0 = 0; d0 < DH / 32; ++d0)
#pragma unroll
        for (int e = 0; e < 8; ++e) { const int j = d0 * 16 + hi * 8 + e, pos = j < NF ? (qpos >> 6) : (qpos & 63), f = j % NF;
          const float c = ((const GAS float*)rope)[2 * (pos * NF + f)], s = ((const GAS float*)rope)[2 * (pos * NF + f) + 1], x1 = qf[d0][e], x2 = qf[d0 + DH / 32][e];
          qf[d0][e] = x1 * c - x2 * s; qf[d0 + DH / 32][e] = x2 * c + x1 * s; } }
#pragma unroll
    for (int d0 = 0; d0 < DH / 16; ++d0) { u32x4 w = {cvtpk(qf[d0][0], qf[d0][1]), cvtpk(qf[d0][2], qf[d0][3]), cvtpk(qf[d0][4], qf[d0][5]), cvtpk(qf[d0][6], qf[d0][7])}; qr[d0] = *reinterpret_cast<bf16x8*>(&w); }
  }
  const int kl0 = (MODE == 2) ? (i0 - 128 < 0 ? 0 : i0 - 128) : 0;
  const int kl1 = (MODE == 0) ? TT : (MODE == 2 ? (i0 + 384 > TT ? TT : i0 + 384) : 0);
  const int NT = 4 + (kl1 - kl0) / KVBLK;
  const long ctx0 = (long)NB * TT + (long)b * CT, lat0 = (long)b * TT + kl0;
#define TROW(j) ((j) < 4 ? ctx0 + (j) * KVBLK : lat0 + ((j) - 4) * KVBLK)
  const int sr = tid >> 4, sc = (tid & 15) * 8, vst0 = v_st(sr, sc), vst1 = v_st(32 + sr, sc);
  const bool ldok = (DH == 128) || sc < 64;
  const int vb0 = (int)(uintptr_t)V_lds + v_rd_base(lane);
  struct { bf16x8 vs0, vs1, ks0, ks1; } sr_[SDEPTH];
#pragma unroll
  for (int i_ = 0; i_ < SDEPTH; ++i_) sr_[i_].vs0 = sr_[i_].vs1 = sr_[i_].ks0 = sr_[i_].ks1 = bf16x8{};
#define SLOAD(i, j) do { if (ldok) { const long _r = TROW(j); sr_[i].vs0 = *reinterpret_cast<const bf16x8*>(&Vb[(_r + sr) * LDKV + sc]); sr_[i].vs1 = *reinterpret_cast<const bf16x8*>(&Vb[(_r + 32 + sr) * LDKV + sc]); \
    sr_[i].ks0 = *reinterpret_cast<const bf16x8*>(&Kb[(_r + sr) * LDKK + sc]); sr_[i].ks1 = *reinterpret_cast<const bf16x8*>(&Kb[(_r + 32 + sr) * LDKK + sc]); } } while (0)
#define SWRITE(bb, i) do { *(bf16x8*)((char*)V_lds + (bb) * SHM_V + vst0) = sr_[i].vs0;          \
    *(bf16x8*)((char*)V_lds + (bb) * SHM_V + vst1) = sr_[i].vs1; int kc = sc * 2;               \
    *(bf16x8*)((char*)K_lds + (bb) * SHM_K + KSWZ(sr, kc)) = sr_[i].ks0;                       \
    *(bf16x8*)((char*)K_lds + (bb) * SHM_K + KSWZ(32 + sr, kc)) = sr_[i].ks1; } while (0)
#define SWAIT() do { if (SDEPTH == 2) asm volatile("s_waitcnt vmcnt(4)" ::: "memory"); else asm volatile("s_waitcnt vmcnt(0)" ::: "memory"); } while (0)
#define RESC(a) do { if (__any((a) < 1.f)) { if (hi == 0) al_l[r32] = (a); asm volatile("s_waitcnt lgkmcnt(0)" ::: "memory"); \
    for (int d = 0; d < DH / 32; ++d) for (int r = 0; r < 16; ++r) o[d][r] *= al_l[crow(r, hi)]; } } while (0)
#define WMASK(P0, P1, j) do { if (MODE == 2 && (j) >= 4) wmask(P0, P1, kl0 + ((j) - 4) * KVBLK, qpos, hi); } while (0)
  f32x16 pA0, pA1, pB0, pB1; float mnA, mnB, alA, alB; bf16x8 pa0, pa1, pa2, pa3;
  constexpr int SE = 0, SO = SDEPTH - 1;
  SLOAD(SE, 0); asm volatile("s_waitcnt vmcnt(0)" ::: "memory"); SWRITE(0, SE); __syncthreads();
  qkt<DH>(pA0, pA1, K_lds, qr, r32, hi); WMASK(pA0, pA1, 0); partialSM<DH>(pA0, pA1, m_reg, mnA, alA);
  SLOAD(SO, 1); if (SDEPTH == 2) { if (2 < NT) SLOAD(SE, 2); }
  SWAIT(); SWRITE(1, SO); __syncthreads();
  for (int j = 1; j + 1 < NT; j += 2) {
    SBAR(); qkt<DH>(pB0, pB1, (bf16*)((char*)K_lds + SHM_K), qr, r32, hi); WMASK(pB0, pB1, j);
    finishSM(pA0, pA1, alA, l_reg, pa0, pa1, pa2, pa3); SBAR();
    SLOAD(SO, j + SDEPTH < NT ? j + SDEPTH : j); SBAR();
    pv_d0<DH>(o, vb0, pa0, pa1, pa2, pa3); partialSM<DH>(pB0, pB1, m_reg, mnB, alB);
    __syncthreads(); SWAIT(); SWRITE(0, SE);
    RESC(alB); __syncthreads();
    SBAR(); qkt<DH>(pA0, pA1, K_lds, qr, r32, hi); WMASK(pA0, pA1, j + 1);
    finishSM(pB0, pB1, alB, l_reg, pa0, pa1, pa2, pa3); SBAR();
    SLOAD(SE, j + 1 + SDEPTH < NT ? j + 1 + SDEPTH : j + 1); SBAR();
    pv_d0<DH>(o, vb0 + (int)SHM_V, pa0, pa1, pa2, pa3); partialSM<DH>(pA0, pA1, m_reg, mnA, alA);
    __syncthreads(); SWAIT(); SWRITE(1, SO);
    RESC(alA); __syncthreads();
  }
  SBAR(); qkt<DH>(pB0, pB1, (bf16*)((char*)K_lds + SHM_K), qr, r32, hi); WMASK(pB0, pB1, NT - 1);
  finishSM(pA0, pA1, alA, l_reg, pa0, pa1, pa2, pa3); SBAR();
  pv_d0<DH>(o, vb0, pa0, pa1, pa2, pa3); partialSM<DH>(pB0, pB1, m_reg, mnB, alB);
  __syncthreads(); RESC(alB);
  finishSM(pB0, pB1, alB, l_reg, pa0, pa1, pa2, pa3); SBAR();
  pv_d0<DH>(o, vb0 + (int)SHM_V, pa0, pa1, pa2, pa3);
  if (hi == 0) li_l[r32] = l_reg; asm volatile("s_waitcnt lgkmcnt(0)" ::: "memory");
  float rli[16];
#pragma unroll
  for (int r = 0; r < 16; ++r) rli[r] = __builtin_amdgcn_rcpf(li_l[crow(r, hi)]);
  bf16* Ow = Ob + (long)(wid * QBLK) * DM;
#pragma unroll
  for (int r = 0; r < 16; ++r) { int orow = crow(r, hi);
#pragma unroll
    for (int d0 = 0; d0 < DH / 32; ++d0) Ow[(long)orow * DM + d0 * 32 + r32] = (bf16)(cvtpk(o[d0][r] * rli[r], 0.f) & 0xffffu); }
  asm volatile("s_waitcnt vmcnt(0)" ::: "memory"); __syncthreads();
#undef SLOAD
#undef SWRITE
#undef SWAIT
#undef RESC
#undef WMASK
#undef TROW
}
}
namespace s5 {
using bf16x8 = __attribute__((ext_vector_type(8))) short;
using f32x16 = __attribute__((ext_vector_type(16))) float;
using f32x4v = __attribute__((ext_vector_type(4))) float;
using u32x4 = __attribute__((ext_vector_type(4))) unsigned;
using u32x2 = __attribute__((ext_vector_type(2))) unsigned;
constexpr int XROWB = 272;
constexpr int WAVE_LDS = 32 * XROWB;
__device__ __forceinline__ float bperm(float v, int srclane) { return __builtin_bit_cast(float, __builtin_amdgcn_ds_bpermute(srclane << 2, __builtin_bit_cast(int, v))); }
__device__ __forceinline__ float gelu_fast(float x) { const float u = 0.7978845608028654f * (x + 0.044715f * x * x * x); return x * __builtin_amdgcn_rcpf(1.f + __builtin_amdgcn_exp2f(-2.885390081777927f * u)); }
__device__ __forceinline__ void cmul(float& r, float& i, float ar, float ai) { const float nr = ar * r - ai * i, ni = ar * i + ai * r; r = nr; i = ni; }
__device__ __forceinline__ size_t seg_row0(int b, int seg) { return seg < 16 ? (size_t)b * TT + seg * 256 : (size_t)NB * TT + b * CT; }
template <int PASS>
__device__ __forceinline__ void s5_unit(int b, int g, int seg, const bf16* __restrict__ Z2, const float* __restrict__ s5ab, const bf16* __restrict__ BT, const bf16* __restrict__ CTb,
                                        float* __restrict__ SEND, const float* __restrict__ dskip, bf16* __restrict__ G, float* __restrict__ YT, LAS unsigned char* xl) {
  const int lane = fresh_lane();
  const int r32 = lane & 31, hi = lane >> 5, fr = lane & 15, fq = lane >> 4;
  const size_t row0 = seg_row0(b, seg);
  const int tau = 16 * ((r32 >> 2) & 1) + 4 * (r32 >> 3) + (r32 & 3);
#pragma unroll 1
  for (int dir = 0; dir < 2; ++dir) {
    const int dg = dir * 64 + g;
    float ar[2], ai[2], a16r[2], a16i[2];
#pragma unroll
    for (int s = 0; s < 2; ++s) { typedef float f32x2s __attribute__((ext_vector_type(2))); const f32x2s v = *(const GAS f32x2s*)(s5ab + 2 * (dg * 64 + r32 + 32 * s)); ar[s] = v.x; ai[s] = v.y; a16r[s] = v.x; a16i[s] = v.y;
#pragma unroll
      for (int k = 0; k < 4; ++k) cmul(a16r[s], a16i[s], a16r[s], a16i[s]); }
    bf16x8 bfr[4];
#pragma unroll
    for (int k = 0; k < 4; ++k) bfr[k] = *(const GAS bf16x8*)(BT + ((size_t)dg * 128 + 32 * k + r32) * 16 + hi * 8);
    float cr[2] = {0.f, 0.f}, ci[2] = {0.f, 0.f};
    if (PASS == 2) {
      float a256r[2], a256i[2];
#pragma unroll
      for (int s = 0; s < 2; ++s) { a256r[s] = a16r[s]; a256i[s] = a16i[s];
#pragma unroll
        for (int k = 0; k < 4; ++k) cmul(a256r[s], a256i[s], a256r[s], a256i[s]); }
      const float* Sb = SEND + ((size_t)(dir * NB + b) * 64 + g) * 17 * 128;
      { const float* p = Sb + 16 * 128;
#pragma unroll
        for (int s = 0; s < 2; ++s) { cr[s] = p[r32 + 32 * s]; ci[s] = p[64 + r32 + 32 * s]; } }
      const int nprev = dir == 0 ? seg : 15 - seg;
#pragma unroll 1
      for (int k = 0; k < nprev; ++k) { const float* p = Sb + (dir == 0 ? k : 15 - k) * 128;
#pragma unroll
        for (int s = 0; s < 2; ++s) { cmul(cr[s], ci[s], a256r[s], a256i[s]); cr[s] += p[r32 + 32 * s]; ci[s] += p[64 + r32 + 32 * s]; } }
    }
    const bf16* CT_dg = CTb + (size_t)dg * 16 * 128;
    bf16x8 cfr[4]; f32x4v dk = {0.f, 0.f, 0.f, 0.f};
    if (PASS == 2) { dk = *(const GAS f32x4v*)(dskip + g * 16 + 4 * fq);
#pragma unroll
      for (int ks = 0; ks < 4; ++ks) cfr[ks] = *(const GAS bf16x8*)(CT_dg + fr * 128 + 32 * ks + 8 * fq); }
    const int rloc = dir == 0 ? tau : 31 - tau;
    bf16x8 ufr_n = *(const GAS bf16x8*)(Z2 + (row0 + 32 * (dir == 0 ? 0 : 7) + rloc) * CD_IN + ZC_U + g * 16 + hi * 8);
#pragma unroll 1
    for (int qq = 0; qq < 8; ++qq) {
      const int q = dir == 0 ? qq : 7 - qq;
      const bf16x8 ufr = ufr_n;
      { const int qn = qq < 7 ? (dir == 0 ? qq + 1 : 6 - qq) : q;
        ufr_n = *(const GAS bf16x8*)(Z2 + (row0 + 32 * qn + rloc) * CD_IN + ZC_U + g * 16 + hi * 8); }
      f32x4v yfp[2]; u32x2 uwp[2];
      if (PASS == 2 && dir == 1) {
#pragma unroll
        for (int mb = 0; mb < 2; ++mb) { const size_t row = row0 + 32 * q + 16 * mb + fr; yfp[mb] = *(const GAS f32x4v*)(YT + row * 1024 + g * 16 + 4 * fq); uwp[mb] = *(const GAS u32x2*)(Z2 + row * CD_IN + ZC_U + g * 16 + 4 * fq); } }
      f32x16 bu[4];
#pragma unroll
      for (int k = 0; k < 4; ++k) { bu[k] = f32x16{}; bu[k] = __builtin_amdgcn_mfma_f32_32x32x16_bf16(ufr, bfr[k], bu[k], 0, 0, 0); }
      typedef float f2 __attribute__((ext_vector_type(2)));
      const f2 Ar = {ar[0], ar[1]}, Ai = {ai[0], ai[1]}, A16r = {a16r[0], a16r[1]}, A16i = {a16i[0], a16i[1]};
      { f2 xr = {0.f, 0.f}, xi = {0.f, 0.f};
#pragma unroll
        for (int r = 0; r < 16; ++r) { const f2 br = {bu[0][r], bu[1][r]}, bi = {bu[2][r], bu[3][r]};
          const f2 nr = Ar * xr - Ai * xi + br, ni = Ar * xi + Ai * xr + bi; xr = nr; xi = ni; bu[0][r] = xr.x; bu[1][r] = xr.y; bu[2][r] = xi.x; bu[3][r] = xi.y; } }
      { const f2 per = {bperm(bu[0][15], lane ^ 32), bperm(bu[1][15], lane ^ 32)}, pei = {bperm(bu[2][15], lane ^ 32), bperm(bu[3][15], lane ^ 32)};
        const f2 Cr = {cr[0], cr[1]}, Ci = {ci[0], ci[1]};
        const f2 c1r = A16r * Cr - A16i * Ci + per, c1i = A16r * Ci + A16i * Cr + pei;
        f2 cxr = hi ? c1r : Cr, cxi = hi ? c1i : Ci;
#pragma unroll
        for (int r = 0; r < 16; ++r) { const f2 nr = Ar * cxr - Ai * cxi, ni = Ar * cxi + Ai * cxr; cxr = nr; cxi = ni; bu[0][r] += cxr.x; bu[1][r] += cxr.y; bu[2][r] += cxi.x; bu[3][r] += cxi.y; }
#pragma unroll
        for (int s = 0; s < 2; ++s) { const float ner = bperm(bu[s][15], lane ^ 32), nei = bperm(bu[2 + s][15], lane ^ 32);
          cr[s] = hi ? bu[s][15] : ner; ci[s] = hi ? bu[2 + s][15] : nei; } }
      if (PASS == 2) {
#pragma unroll
        for (int k = 0; k < 4; ++k)
#pragma unroll
          for (int r = 0; r < 16; r += 2) { const int st = 16 * hi + r, rl = dir == 0 ? st : 31 - st, rl1 = dir == 0 ? st + 1 : 30 - st;
            const unsigned pk = att::cvtpk(bu[k][r], bu[k][r + 1]);
            *(LAS unsigned short*)(xl + rl * XROWB + (32 * k + r32) * 2) = (unsigned short)pk; *(LAS unsigned short*)(xl + rl1 * XROWB + (32 * k + r32) * 2) = (unsigned short)(pk >> 16); }
        asm volatile("s_waitcnt lgkmcnt(0)" ::: "memory");
        f32x4v acc2[2] = {(f32x4v){0.f, 0.f, 0.f, 0.f}, (f32x4v){0.f, 0.f, 0.f, 0.f}};
#pragma unroll
        for (int ks = 0; ks < 4; ++ks) { const bf16x8 cf = cfr[ks];
#pragma unroll
          for (int mb = 0; mb < 2; ++mb) { const bf16x8 xf = *(const LAS bf16x8*)(xl + (16 * mb + fr) * XROWB + (32 * ks + 8 * fq) * 2);
            acc2[mb] = __builtin_amdgcn_mfma_f32_16x16x32_bf16(cf, xf, acc2[mb], 0, 0, 0); } }
        asm volatile("s_waitcnt lgkmcnt(0)" ::: "memory");
#pragma unroll
        for (int mb = 0; mb < 2; ++mb) { const size_t row = row0 + 32 * q + 16 * mb + fr; float* yt = YT + row * 1024 + g * 16 + 4 * fq;
          if (dir == 0) *(GAS f32x4v*)yt = acc2[mb];
          else { const f32x4v yf = yfp[mb];
            const u32x2 uw = uwp[mb];
            const float u0 = __builtin_bit_cast(float, uw.x << 16), u1 = __builtin_bit_cast(float, uw.x & 0xffff0000u), u2 = __builtin_bit_cast(float, uw.y << 16), u3 = __builtin_bit_cast(float, uw.y & 0xffff0000u);
            const float y0 = gelu_fast(acc2[mb][0] + yf[0] + dk[0] * u0), y1 = gelu_fast(acc2[mb][1] + yf[1] + dk[1] * u1), y2 = gelu_fast(acc2[mb][2] + yf[2] + dk[2] * u2), y3 = gelu_fast(acc2[mb][3] + yf[3] + dk[3] * u3);
            u32x2 w; w.x = pk2(y0, y1); w.y = pk2(y2, y3);
            *(GAS u32x2*)(G + row * 1024 + g * 16 + 4 * fq) = w; } }
      }
    }
    if (PASS == 1) { float* p = SEND + (((size_t)(dir * NB + b) * 64 + g) * 17 + seg) * 128;
      if (hi == 0) {
#pragma unroll
        for (int s = 0; s < 2; ++s) { p[r32 + 32 * s] = cr[s]; p[64 + r32 + 32 * s] = ci[s]; } } }
    if (PASS == 2) asm volatile("s_waitcnt vmcnt(0)" ::: "memory");
  }
}
}
namespace ml {
using bf16x8 = __attribute__((ext_vector_type(8))) short;
using f32x16 = __attribute__((ext_vector_type(16))) float;
using f32x4v = __attribute__((ext_vector_type(4))) float;
using u32x4 = __attribute__((ext_vector_type(4))) unsigned;
using u32x2 = __attribute__((ext_vector_type(2))) unsigned;
constexpr int NSEQ = NB * 4 * 2, NBLK = 17;
constexpr size_t CST_BYTES = (size_t)NSEQ * NBLK * 256 * 128 * 2;
constexpr size_t NST_OFF = CST_BYTES, MST_OFF = NST_OFF + (size_t)NSEQ * NBLK * 128 * 4, ST_END = MST_OFF + (size_t)NSEQ * NBLK * 4;
__device__ __forceinline__ float bperm(float v, int srclane) { return __builtin_bit_cast(float, __builtin_amdgcn_ds_bpermute(srclane << 2, __builtin_bit_cast(int, v))); }
__device__ __forceinline__ float swap_add(float v) { auto rr = __builtin_amdgcn_permlane32_swap(__float_as_uint(v), __float_as_uint(v), false, false); return __uint_as_float(rr[0]) + __uint_as_float(rr[1]); }
__device__ __forceinline__ float wmax(float v, int lane) {
#pragma unroll
  for (int o = 1; o < 64; o <<= 1) v = fmaxf(v, bperm(v, lane ^ o));
  return v;
}
__device__ __forceinline__ size_t blk_row0(int b, int blkid) { return blkid == 0 ? (size_t)NB * TT + b * CT : (size_t)b * TT + (blkid - 1) * 256; }
__device__ __forceinline__ int seq_blk(int dir, int j) { return j == 0 ? 0 : (dir == 0 ? j : 17 - j); }
__device__ __forceinline__ int blk_seq(int dir, int blkid) { return blkid == 0 ? 0 : (dir == 0 ? blkid : 17 - blkid); }
__device__ __forceinline__ void gate_scan(const float* __restrict__ GATES, const float* __restrict__ bg, size_t row0, int h, int dir, int lane, float (&F)[4], float (&Bt)[4], float (&ML)[4], float& b_last, float& bmax) {
  const float bi = ((const GAS float*)bg)[(2 * dir) * 4 + h], bf_ = ((const GAS float*)bg)[(2 * dir + 1) * 4 + h];
  float ig[4], c = 0.f;
#pragma unroll
  for (int i = 0; i < 4; ++i) { const int p = 4 * lane + i, r = dir ? 255 - p : p; const GAS float* gp = (const GAS float*)GATES + (row0 + r) * 16;
    ig[i] = gp[(2 * dir) * 4 + h] + bi; c += logsigmoid_acc(gp[(2 * dir + 1) * 4 + h] + bf_); F[i] = c; }
  float inc = c;
#pragma unroll
  for (int o = 1; o < 64; o <<= 1) { const float t = bperm(inc, lane - o); if (lane >= o) inc += t; }
  const float exc = inc - c;
  b_last = bperm(inc, 63);
  float mx = -3.0e38f;
#pragma unroll
  for (int i = 0; i < 4; ++i) { F[i] += exc; Bt[i] = ig[i] - F[i]; mx = fmaxf(mx, Bt[i]); ML[i] = mx; }
  float imx = mx;
#pragma unroll
  for (int o = 1; o < 64; o <<= 1) { const float t = bperm(imx, lane - o); if (lane >= o) imx = fmaxf(imx, t); }
  const float emx = bperm(imx, lane - 1);
  if (lane > 0) {
#pragma unroll
    for (int i = 0; i < 4; ++i) ML[i] = fmaxf(ML[i], emx); }
  bmax = bperm(imx, 63);
}
__device__ __forceinline__ void l1_unit(int seq, int vblk, int dblk, const bf16* __restrict__ ZT, const float* __restrict__ GATES, const float* __restrict__ bg, unsigned char* __restrict__ ST, LAS float* wt  ) {
  const int lane = fresh_lane();
  const int b = seq >> 3, h = (seq >> 1) & 3, dir = seq & 1, r32 = lane & 31, hi = lane >> 5;
  f32x16 acc = f32x16{}; float npart = 0.f, m = 0.f;
  const bf16* kT = ZT + (size_t)(h * 128 + 32 * dblk + r32) * MR;
  const bf16* vT = ZT + (size_t)(512 + h * 256 + 32 * vblk + r32) * MR;
  bf16* CS = (bf16*)ST; float* NS = (float*)(ST + NST_OFF); float* MS = (float*)(ST + MST_OFF);
#pragma unroll 1
  for (int j = 0; j < NBLK; ++j) {
    { bf16* cp = CS + ((size_t)(seq * NBLK + j) * 256 + 32 * vblk) * 128 + 32 * dblk + r32;
#pragma unroll
      for (int r = 0; r < 16; ++r) cp[(size_t)att::crow(r, hi) * 128] = (bf16)f2bf(acc[r]);
      if (vblk == 0) { const float nt = npart + bperm(npart, lane ^ 32); if (hi == 0) NS[(size_t)(seq * NBLK + j) * 128 + 32 * dblk + r32] = nt; if (dblk == 0 && lane == 0) MS[seq * NBLK + j] = m; } }
    if (j == NBLK - 1) break;
    const size_t row0 = blk_row0(b, seq_blk(dir, j));
    float F[4], Bt[4], ML[4], b_last, bmax;
    gate_scan(GATES, bg, row0, h, dir, lane, F, Bt, ML, b_last, bmax);
    const float Mf = fmaxf(m, bmax), decay = expf(m - Mf);
#pragma unroll
    for (int i = 0; i < 4; ++i) { const int p = 4 * lane + i, r = dir ? 255 - p : p; wt[r] = expf(Bt[i] - Mf); }
    asm volatile("s_waitcnt lgkmcnt(0)" ::: "memory");
    acc = acc * decay; npart *= decay; m = b_last + Mf;
#pragma unroll
    for (int ks = 0; ks < 16; ++ks) { const int tok = 16 * ks + 8 * hi;
      const bf16x8 af = *(const GAS bf16x8*)(vT + row0 + tok); const u32x4 kw = *(const GAS u32x4*)(kT + row0 + tok);
      const f32x4v w0 = *(const LAS f32x4v*)(wt + tok), w1 = *(const LAS f32x4v*)(wt + tok + 4);
      float kf[8];
#pragma unroll
      for (int e = 0; e < 4; ++e) { kf[2 * e] = __uint_as_float(kw[e] << 16); kf[2 * e + 1] = __uint_as_float(kw[e] & 0xffff0000u); }
      kf[0] *= w0[0]; kf[1] *= w0[1]; kf[2] *= w0[2]; kf[3] *= w0[3]; kf[4] *= w1[0]; kf[5] *= w1[1]; kf[6] *= w1[2]; kf[7] *= w1[3];
      npart += ((kf[0] + kf[1]) + (kf[2] + kf[3])) + ((kf[4] + kf[5]) + (kf[6] + kf[7]));
      u32x4 kb = {att::cvtpk(kf[0], kf[1]), att::cvtpk(kf[2], kf[3]), att::cvtpk(kf[4], kf[5]), att::cvtpk(kf[6], kf[7])};
      acc = __builtin_amdgcn_mfma_f32_32x32x16_bf16(af, *reinterpret_cast<bf16x8*>(&kb), acc, 0, 0, 0); }
  }
}
__device__ __forceinline__ void l2_unit(int b, int h, int blkid, int dvh, const bf16* __restrict__ Z, const float* __restrict__ GATES, const float* __restrict__ bg,
                                        const unsigned char* __restrict__ ST, float* __restrict__ HH, char* lds, LAS float* btab, int wave_s) {
  const int tid = fresh_tid(wave_s), wid = tid >> 6, lane = tid & 63, r32 = lane & 31, hi = lane >> 5;
  const size_t row0 = blk_row0(b, blkid);
  const int t0 = wid * 32, t = t0 + r32;
  const bf16* CS = (const bf16*)ST; const float* NS = (const float*)(ST + NST_OFF); const float* MS = (const float*)(ST + MST_OFF);
  { const int sr = tid >> 4, sc = (tid & 15) * 8, vst0 = att::v_st(sr, sc), vst1 = att::v_st(32 + sr, sc), kc = sc * 2;
    const bf16* kb = Z + (row0 + sr) * ZLD + ZB_K + h * 128 + sc; const bf16* vb = Z + (row0 + sr) * ZLD + ZB_V + h * 256 + dvh * 128 + sc;
#pragma unroll
    for (int kt = 0; kt < 4; ++kt) {
      const bf16x8 k0 = *(const GAS bf16x8*)(kb + (size_t)(64 * kt) * ZLD), k1 = *(const GAS bf16x8*)(kb + (size_t)(64 * kt + 32) * ZLD);
      const bf16x8 v0 = *(const GAS bf16x8*)(vb + (size_t)(64 * kt) * ZLD), v1 = *(const GAS bf16x8*)(vb + (size_t)(64 * kt + 32) * ZLD);
      *(bf16x8*)(lds + kt * 16384 + KSWZ(sr, kc)) = k0; *(bf16x8*)(lds + kt * 16384 + KSWZ(32 + sr, kc)) = k1;
      *(bf16x8*)(lds + 65536 + kt * 16384 + vst0) = v0; *(bf16x8*)(lds + 65536 + kt * 16384 + vst1) = v1; } }
  bf16x8 qf[8];
  { const bf16* qp = Z + (row0 + t) * ZLD + ZB_Q + h * 128 + hi * 8;
#pragma unroll
    for (int d0 = 0; d0 < 8; ++d0) { const u32x4 w = *(const GAS u32x4*)(qp + 16 * d0); u32x4 o;
#pragma unroll
      for (int e = 0; e < 4; ++e) o[e] = att::cvtpk(__uint_as_float(w[e] << 16) * 0.08838834764831845f, __uint_as_float(w[e] & 0xffff0000u) * 0.08838834764831845f);
      qf[d0] = *reinterpret_cast<bf16x8*>(&o); } }
  __syncthreads();
  f32x16 o[4];
#pragma unroll
  for (int nb = 0; nb < 4; ++nb) o[nb] = f32x16{};
  const int vbase = (int)(uintptr_t)(lds + 65536) + att::v_rd_base(lane);
#define ML_STILE(kt) f32x16 p0, p1; att::qkt<128>(p0, p1, (const bf16*)(lds + (kt) * 16384), qf, r32, hi); \
      _Pragma("unroll") for (int r = 0; r < 16; ++r) { const int k0i = 64 * (kt) + att::crow(r, hi), k1i = k0i + 32; \
        const bool v0 = dir == 0 ? (k0i <= t) : (k0i >= t), v1 = dir == 0 ? (k1i <= t) : (k1i >= t); \
        p0[r] = v0 ? p0[r] * __expf(btab[k0i] - Mt) : 0.f; p1[r] = v1 ? p1[r] * __expf(btab[k1i] - Mt) : 0.f; }
#pragma unroll
  for (int dir = 0; dir < 2; ++dir) {
    const int seq = (b * 4 + h) * 2 + dir, j = blk_seq(dir, blkid);
    const float m_prev = ((const GAS float*)MS)[seq * NBLK + j];
    float Mt, Ft;
    { float F[4], Bt[4], ML[4], b_last, bmax;
      gate_scan(GATES, bg, row0, h, dir, lane, F, Bt, ML, b_last, bmax);
#pragma unroll
      for (int i = 0; i < 4; ++i) { const int p = 4 * lane + i, r = dir ? 255 - p : p; btab[r] = Bt[i]; }
      const int pp = dir ? 255 - t : t, src = pp >> 2, e = pp & 3;
      const float m0 = bperm(fmaxf(m_prev, ML[0]), src), m1 = bperm(fmaxf(m_prev, ML[1]), src), m2 = bperm(fmaxf(m_prev, ML[2]), src), m3 = bperm(fmaxf(m_prev, ML[3]), src);
      const float f0 = bperm(F[0], src), f1 = bperm(F[1], src), f2 = bperm(F[2], src), f3 = bperm(F[3], src);
      Mt = e == 0 ? m0 : (e == 1 ? m1 : (e == 2 ? m2 : m3)); Ft = e == 0 ? f0 : (e == 1 ? f1 : (e == 2 ? f2 : f3)); }
    asm volatile("s_waitcnt lgkmcnt(0)" ::: "memory");
    const float w_inter = expf(m_prev - Mt), floorv = expf(-Ft - Mt);
    float den;
    { const GAS float* np = (const GAS float*)NS + (size_t)(seq * NBLK + j) * 128 + hi * 8; float dot = 0.f;
#pragma unroll
      for (int d0 = 0; d0 < 8; ++d0) { const u32x4 w = *reinterpret_cast<const u32x4*>(&qf[d0]); const f32x4v n0 = *(const GAS f32x4v*)(np + 16 * d0), n1 = *(const GAS f32x4v*)(np + 16 * d0 + 4);
        dot += __uint_as_float(w[0] << 16) * n0[0] + __uint_as_float(w[0] & 0xffff0000u) * n0[1] + __uint_as_float(w[1] << 16) * n0[2] + __uint_as_float(w[1] & 0xffff0000u) * n0[3]
             + __uint_as_float(w[2] << 16) * n1[0] + __uint_as_float(w[2] & 0xffff0000u) * n1[1] + __uint_as_float(w[3] << 16) * n1[2] + __uint_as_float(w[3] & 0xffff0000u) * n1[3]; }
      den = w_inter * swap_add(dot); }
    { float rsum = 0.f;
#pragma unroll 1
      for (int kt = 0; kt < 4; ++kt) {
        if (dir == 0 ? (64 * kt > t0 + 31) : (64 * kt + 63 < t0)) continue;
        ML_STILE(kt);
#pragma unroll
        for (int r = 0; r < 16; ++r) rsum += p0[r] + p1[r]; }
      den += swap_add(rsum); }
    const float inv = 1.f / fmaxf(fabsf(den), floorv);
    { const float sc = w_inter * inv;
      const bf16* cb = CS + ((size_t)(seq * NBLK + j) * 256 + dvh * 128 + r32) * 128 + hi * 8;
#pragma unroll
      for (int d0 = 0; d0 < 8; ++d0) { const u32x4 w = *reinterpret_cast<const u32x4*>(&qf[d0]); u32x4 qs;
#pragma unroll
        for (int e = 0; e < 4; ++e) qs[e] = att::cvtpk(__uint_as_float(w[e] << 16) * sc, __uint_as_float(w[e] & 0xffff0000u) * sc);
#pragma unroll
        for (int nb = 0; nb < 4; ++nb) { const bf16x8 cf = *(const GAS bf16x8*)(cb + (size_t)(32 * nb) * 128 + 16 * d0); o[nb] = __builtin_amdgcn_mfma_f32_32x32x16_bf16(*reinterpret_cast<bf16x8*>(&qs), cf, o[nb], 0, 0, 0); } } }
#pragma unroll 1
    for (int kt = 0; kt < 4; ++kt) {
      if (dir == 0 ? (64 * kt > t0 + 31) : (64 * kt + 63 < t0)) continue;
      ML_STILE(kt);
#pragma unroll
      for (int r = 0; r < 16; ++r) { p0[r] *= inv; p1[r] *= inv; }
      bf16x8 pa0, pa1, pa2, pa3;
#define PK4(P, BASE, OUT) do { unsigned a0 = att::cvtpk(P[BASE + 0], P[BASE + 1]), a1 = att::cvtpk(P[BASE + 2], P[BASE + 3]);   \
    unsigned b0 = att::cvtpk(P[BASE + 4], P[BASE + 5]), b1 = att::cvtpk(P[BASE + 6], P[BASE + 7]);                              \
    auto r0 = __builtin_amdgcn_permlane32_swap(a0, b0, false, false); auto r1 = __builtin_amdgcn_permlane32_swap(a1, b1, false, false); \
    u32x4 w = {r0[0], r1[0], r0[1], r1[1]}; OUT = *reinterpret_cast<bf16x8*>(&w); } while (0)
      PK4(p0, 0, pa0); PK4(p0, 8, pa1); PK4(p1, 0, pa2); PK4(p1, 8, pa3);
#undef PK4
      att::pv_d0<128>(o, vbase + kt * 16384, pa0, pa1, pa2, pa3);
    }
  }
#undef ML_STILE
  { const int l2_ = fresh_lane(), hi2 = l2_ >> 5; float* Ow = HH + (blk_row0(b, blkid) + wid * 32) * 1024 + h * 256 + dvh * 128 + (l2_ & 31);
#pragma unroll
    for (int r = 0; r < 16; ++r)
#pragma unroll
      for (int nb = 0; nb < 4; ++nb) Ow[(size_t)att::crow(r, hi2) * 1024 + nb * 32] = o[nb][r]; }
  asm volatile("s_waitcnt vmcnt(0)" ::: "memory"); __syncthreads();
}
__device__ __forceinline__ void finish_pass(int gw, int NGW, int lane, const bf16* Z, const float* HH, const float* headg, bf16* CAT) {
  f32x4v hn; u32x2 on;
  { const int m = gw >> 2, h = gw & 3; hn = *(const GAS f32x4v*)(HH + (size_t)m * 1024 + h * 256 + lane * 4); on = *(const GAS u32x2*)(Z + (size_t)m * ZLD + ZB_O + h * 256 + lane * 4); }
  for (int it = gw; it < MR * 4; it += NGW) {
    const int m = it >> 2, h = it & 3; const f32x4v hh = hn; const u32x2 ow = on;
    if (it + NGW < MR * 4) { const int m2 = (it + NGW) >> 2, h2 = (it + NGW) & 3; hn = *(const GAS f32x4v*)(HH + (size_t)m2 * 1024 + h2 * 256 + lane * 4); on = *(const GAS u32x2*)(Z + (size_t)m2 * ZLD + ZB_O + h2 * 256 + lane * 4); }
    const f32x4v g4 = *(const GAS f32x4v*)(headg + h * 256 + lane * 4);
    const float rstd = 1.f / sqrtf(wave_sum_l((hh[0] * hh[0] + hh[1] * hh[1]) + (hh[2] * hh[2] + hh[3] * hh[3]), lane) * (1.f / 256.f) + EPS);
    const float o0 = __uint_as_float(ow.x << 16), o1 = __uint_as_float(ow.x & 0xffff0000u), o2 = __uint_as_float(ow.y << 16), o3 = __uint_as_float(ow.y & 0xffff0000u);
    u32x2 w; w.x = pk2(hh[0] * rstd * g4[0] / (1.f + __expf(-o0)), hh[1] * rstd * g4[1] / (1.f + __expf(-o1))); w.y = pk2(hh[2] * rstd * g4[2] / (1.f + __expf(-o2)), hh[3] * rstd * g4[3] / (1.f + __expf(-o3)));
    *(GAS u32x2*)(CAT + (size_t)m * DM + 1024 + h * 256 + lane * 4) = w;
  }
}
}
struct Args { const float* in[30]; float* out; unsigned char* ws; int ph_lo, ph_hi, li, pad; };
constexpr int PH_P0 = 0, PH_P1 = 1, PH_L0 = 2, PH_PER_LAYER = 13, PH_FINAL = 28, N_PHASES = 29;
enum { O_F1N = 0, O_F1U, O_F1D, O_MN, O_MI, O_MP, O_MA, O_MF, O_MG, O_MO, O_F2N, O_F2U, O_F2D };
#ifndef DUP_MASK
#define DUP_MASK 0
#endif
#ifndef PROBE_K
#define PROBE_K -1
#endif
#define PPOINT(id) do { if (PROBE_K == (id)) t_probe_ = __builtin_amdgcn_s_memrealtime() - t_start_; } while (0)
#define REP(bit) for (int rep_ = 0; rep_ < (((DUP_MASK) & (bit)) ? 2 : 1); ++rep_)
#define OPAQUE_S(p) asm volatile("" : "+s"(p))
__device__ __forceinline__ int opq(int v) { asm volatile("" : "+s"(v)); return v; }
#define GEMM_PHASE(EPI, A_, B_, M_, N_, K_, ...) GEMM_PHASE_S(0, EPI, A_, B_, M_, N_, K_, __VA_ARGS__)
#define GEMM_RESID(A_, B_, M_, N_, K_, SPL, ...) do { pg8::Gemm g{(const bf16*)(A_), (const bf16*)(B_), (M_), (N_), (K_)}; pg8::StaticOrderT<SPL, NB * CT / 256> S; S.init(NB * TT, (N_), F.G, (int)blockIdx.x, (K_), (M_) > NB * TT); \
    pg8::EpiResidPart E{__VA_ARGS__, (float*)(ws + WS_SC1)}; pg8::gemm_phase<pg8::EpiResidPart, pg8::StaticOrderT<SPL, NB * CT / 256>, true, true>(F.lds + RING_OFF, g, S, E, F.wave); } while (0)
#define GEMM_PHASE_S(MODE, EPI, A_, B_, M_, N_, K_, ...) do { pg8::Gemm g{(const bf16*)(A_), (const bf16*)(B_), (M_), (N_), (K_)}; pg8::StaticOrder S; S.init((M_), (N_), F.G, (int)blockIdx.x, (K_)); \
    pg8::EPI E{__VA_ARGS__}; pg8::gemm_phase<pg8::EPI, pg8::StaticOrder, true, true>(F.lds + RING_OFF, g, S, E, F.wave); } while (0)

__global__ void __launch_bounds__(NWAVES * 64, 2) fwd(Args args) {
    extern __shared__ __attribute__((aligned(16))) unsigned char lds[];
    Frame F;
    F.lds = (LAS unsigned char*)lds;
    F.MISC = (volatile LAS unsigned*)(F.lds + MISC_OFF);
    F.wave = __builtin_amdgcn_readfirstlane((int)threadIdx.x >> 6);
    F.G = gridDim.x;
    F.ws = args.ws; F.out = args.out;
    F.ctl = (gu32*)(args.ws + WS_CTL);
    for (int u = threadIdx.x; u < (LDS_BYTES - LDSCTL_OFF) / 4; u += NWAVES * 64) ((LAS unsigned*)(F.lds + LDSCTL_OFF))[u] = 0u;
    __syncthreads();
    const int lo = args.ph_lo, hi = args.ph_hi;
    unsigned long long t_start_ = 0, t_probe_ = 0; if (PROBE_K >= 0) t_start_ = __builtin_amdgcn_s_memrealtime();
    XcdBarrier bar; bar.bar = (unsigned*)(F.ctl + CW_BAR) + args.li * XCD_BAR_WORDS; bar.x = 0; bar.st = nullptr;
    if (hi - lo > 1) bar = xcd_barrier_post((unsigned*)(F.ctl + CW_BAR) + args.li * XCD_BAR_WORDS, F.MISC + 8);
#define IN(k) (opq(lo) <= (k) && (k) < opq(hi))
#define SEAM(k) do { if (IN(k) && IN((k) + 1)) { xcd_barrier(bar, F.wave); if ((DUP_MASK) & 4096) xcd_barrier(bar, F.wave); } if (PROBE_K >= 0 && (k) == PROBE_K) t_probe_ = __builtin_amdgcn_s_memrealtime() - t_start_; } while (0)

    if (IN(PH_P0)) REP(8) { p0_prologue(F, args.in); } SEAM(PH_P0);
    if (IN(PH_P1)) REP(8) { p1_modreduce(F, args.in[5], args.in[6]); } SEAM(PH_P1);
    if (IN(PH_L0 + O_F1N)) REP(4) { norm_phase<0>(F, F.ws, args.in[0], args.in[2], 0, 0, true, MR); }
#pragma unroll 1
    for (int l = 0; l < 2; ++l) {
        const int pb = PH_L0 + PH_PER_LAYER * l;
        const int MLAT = NB * TT;
        const int m_post = (l == 1) ? MLAT : MR;
        if (IN(pb + O_F1N) && l > 0) REP(4) { unsigned char* ws = F.ws; OPAQUE_S(ws); norm_phase<4>(F, ws, nullptr, nullptr, l, 0, false, MR, (const float*)(ws + WS_MODV) + (size_t)((l - 1) * 5 + 4) * MODN + 8 * DM, 0.5f); } SEAM(pb + O_F1N);
        if (IN(pb + O_F1U)) REP(1) { unsigned char* ws = F.ws; OPAQUE_S(ws);
            GEMM_PHASE(EpiSwiglu, ws + WS_HN, ws + WS_WUP + (size_t)(l * 2) * 44 * MiB, MR, 2 * FF, DM, (bf16*)(ws + WS_HID), FF); } SEAM(pb + O_F1U);
        if (IN(pb + O_F1D)) REP(2) { unsigned char* ws = F.ws; OPAQUE_S(ws);
            GEMM_RESID(ws + WS_HID, ws + WS_WDN + (size_t)(l * 2) * 22 * MiB, MR, DM, FF, 4, (float*)(ws + WS_H), (const float*)(ws + WS_MODV) + (size_t)l * 5 * MODN + 2 * DM, MODN, rep_ ? 0.f : 0.5f); } SEAM(pb + O_F1D);
        if (IN(pb + O_MN)) REP(4) { unsigned char* ws = F.ws; OPAQUE_S(ws); norm_phase<4>(F, ws, nullptr, nullptr, l, 1, false, MR, (const float*)(ws + WS_MODV) + (size_t)(l * 5 + 4) * MODN + 2 * DM, 0.5f); } SEAM(pb + O_MN);
        if (IN(pb + O_MI)) REP(16) { unsigned char* ws = F.ws; OPAQUE_S(ws);
            if (l == 0) { pg8::Gemm g{(const bf16*)(ws + WS_HN), (const bf16*)(ws + WS_WABIN), MR, ZLD, DM, (const bf16*)(ws + WS_WABIN + (size_t)ZB_K * DM * 2), (const bf16*)(ws + WS_HN)};
                pg8::DualOrder S; S.init(MR, ZLD, 1536, MR, F.G, (int)blockIdx.x, DM);
                pg8::EpiPlain2 E{{(bf16*)(ws + WS_Z), ZLD, (float*)(ws + WS_GATES), ZB_G / 256}, {(bf16*)(ws + WS_ZT), MR, nullptr, -1}};
                pg8::gemm_phase<pg8::EpiPlain2, pg8::DualOrder, true, true>(F.lds + RING_OFF, g, S, E, F.wave); }
            else GEMM_PHASE(EpiPlain, ws + WS_HN, ws + WS_WCDIN, MR, CD_IN, DM, (bf16*)(ws + WS_Z), CD_IN, nullptr, -1);
        } SEAM(pb + O_MI);
        if (IN(pb + O_MP)) REP(32) { unsigned char* ws = F.ws; OPAQUE_S(ws);
            const int lane = fresh_lane(); const int gw = blockIdx.x * NWAVES + F.wave, NGW = F.G * NWAVES;
            const bf16* Z = (const bf16*)(ws + WS_Z); bf16* KA = (bf16*)(ws + WS_KA); const float* tv = (const float*)(ws + WS_TAB + TB_VEC);
            if (l == 0) { for (int it = gw; it < MR * 2; it += NGW) naive_kprep<0>(it, lane, Z, KA, tv + TV_GK, (const float*)(ws + WS_TAB + TB_ROPEA));
                if (F.wave < 4) for (int u = (int)blockIdx.x * 4 + F.wave; u < ml::NSEQ * 32; u += F.G * 4)
                    ml::l1_unit(u >> 5, (u >> 2) & 7, u & 3, (const bf16*)(ws + WS_ZT), (const float*)(ws + WS_GATES), tv + TV_BGATE, ws + WS_SC1, (LAS float*)(F.lds + RING_OFF) + F.wave * 256); }
            else { for (int it = gw; it < MR; it += NGW) naive_kprep<1>(it, lane, Z, KA, nullptr, (const float*)(ws + WS_TAB + TB_ROPED));
                for (int u = gw; u < NB * 64 * 17; u += NGW) { const int seg = 16 - (u / (NB * 64)), bg = u % (NB * 64);
                    s5::s5_unit<1>(bg >> 6, bg & 63, seg, Z, (const float*)(ws + WS_TAB + TB_S5AB), (const bf16*)(ws + WS_TAB + TB_S5BT), (const bf16*)(ws + WS_TAB + TB_S5CT), (float*)(ws + WS_SC2), nullptr, nullptr, nullptr, nullptr); } }
        } SEAM(pb + O_MP);
        if (IN(pb + O_MA)) REP(64) { unsigned char* ws = F.ws; OPAQUE_S(ws);
            const int tid = fresh_tid(F.wave);
            const bf16* Z = (const bf16*)(ws + WS_Z); const bf16* KA = (const bf16*)(ws + WS_KA); bf16* CAT = (bf16*)(ws + WS_CAT); const float* tv = (const float*)(ws + WS_TAB + TB_VEC);
            float* SC1 = (float*)(ws + WS_SC1); float* SC2 = (float*)(ws + WS_SC2);
            if (l == 0) { const float* ropeA = (const float*)(ws + WS_TAB + TB_ROPEA);
                REP(256) { const int nv = F.G, v0 = (int)blockIdx.x;
                    for (int u = v0; u < 512; u += nv) { const int b = u >> 7, head = (u >> 4) & 7, qb = u & 15, kvh = head >> 2; const size_t row0 = (size_t)b * TT + qb * 256;
                        att::attn_unit<128, 0>(Z + row0 * ZLD + ZA_Q + head * 128, ZLD, KA + kvh * 128, 256, Z + ZA_V + kvh * 128, ZLD, CAT + row0 * DM + head * 128, b, qb * 256, tv + TV_GQ, ropeA, 0.f, (char*)lds + RING_OFF, F.wave); }
                    PPOINT(100);
                    for (int u = v0; u < 32; u += nv) { const int b = u >> 3, head = u & 7, kvh = head >> 2; const size_t row0 = (size_t)NB * TT + b * CT;
                        att::attn_unit<128, 1>(Z + row0 * ZLD + ZA_Q + head * 128, ZLD, KA + kvh * 128, 256, Z + ZA_V + kvh * 128, ZLD, CAT + row0 * DM + head * 128, b, 0, tv + TV_GQ, ropeA, 0.f, (char*)lds + RING_OFF, F.wave); } }
                PPOINT(101);
                REP(512) for (int u = (int)blockIdx.x; u < NB * 4 * 34; u += F.G) { const int b = u / 136, rem = u % 136, h = rem / 34, bh = rem % 34;
                    ml::l2_unit(b, h, bh >> 1, bh & 1, Z, (const float*)(ws + WS_GATES), tv + TV_BGATE, ws + WS_SC1, SC2, (char*)lds + RING_OFF, (LAS float*)(F.lds + LDSCTL_OFF + 512) + F.wave * 256, F.wave); }
            } else { const float* ropeD = (const float*)(ws + WS_TAB + TB_ROPED);
                REP(1024) { const int nv = F.G, v0 = (int)blockIdx.x;
                    for (int u = v0; u < 1024; u += nv) { const int b = u >> 8, head = (u >> 4) & 15, qb = u & 15, kvh = head >> 3; const size_t row0 = (size_t)b * TT + qb * 256;
                        att::attn_unit<64, 2>(Z + row0 * CD_IN + ZD_Q + head * 64, CD_IN, KA + kvh * 64, 128, Z + ZD_V + kvh * 64, CD_IN, CAT + row0 * DM + 1024 + head * 64, b, qb * 256, nullptr, ropeD, tv[TV_SINK + head], (char*)lds + RING_OFF, F.wave); } }
                PPOINT(110);
                REP(2048) { const int gw = blockIdx.x * NWAVES + F.wave, NGW = F.G * NWAVES;
                    for (int u = gw; u < NB * 64 * 16; u += NGW) { const int seg = u / (NB * 64), bg = u % (NB * 64);
                        s5::s5_unit<2>(bg >> 6, bg & 63, seg, Z, (const float*)(ws + WS_TAB + TB_S5AB), (const bf16*)(ws + WS_TAB + TB_S5BT), (const bf16*)(ws + WS_TAB + TB_S5CT), (float*)(ws + WS_SC2), tv + TV_DSKIP, (bf16*)(ws + WS_G), (float*)(ws + WS_SC1),
                                       F.lds + RING_OFF + F.wave * s5::WAVE_LDS); } }
            }
        } SEAM(pb + O_MA);
        if (IN(pb + O_MF)) { unsigned char* ws = F.ws; OPAQUE_S(ws);
            const int lane = fresh_lane(), gw = blockIdx.x * NWAVES + F.wave, NGW = F.G * NWAVES;
            if (l == 0) ml::finish_pass(gw, NGW, lane, (const bf16*)(ws + WS_Z), (const float*)(ws + WS_SC2), (const float*)(ws + WS_TAB + TB_VEC) + TV_HEADG, (bf16*)(ws + WS_CAT));
        } if (l == 0) SEAM(pb + O_MF);
        if (IN(pb + O_MG)) REP(128) { unsigned char* ws = F.ws; OPAQUE_S(ws);
            if (l == 1) GEMM_PHASE(EpiGlu, ws + WS_G, ws + WS_WGLU, MLAT, 1024, 1024, (bf16*)(ws + WS_CAT), DM, (const bf16*)(ws + WS_G), (const float*)(ws + WS_TAB + TB_VEC) + TV_GLUB);
        } if (l == 1) SEAM(pb + O_MG);
        if (IN(pb + O_MO)) REP(128) { unsigned char* ws = F.ws; OPAQUE_S(ws);
            GEMM_RESID(ws + WS_CAT, ws + (l == 0 ? WS_WABOUT : WS_WCDOUT), m_post, DM, DM, 4, (float*)(ws + WS_H), (const float*)(ws + WS_MODV) + (size_t)l * 5 * MODN + 5 * DM, MODN, rep_ ? 0.f : 1.0f); } SEAM(pb + O_MO);
        if (IN(pb + O_F2N)) REP(4) { unsigned char* ws = F.ws; OPAQUE_S(ws); norm_phase<4>(F, ws, nullptr, nullptr, l, 2, false, m_post, (const float*)(ws + WS_MODV) + (size_t)(l * 5 + 4) * MODN + 5 * DM, 1.0f); } SEAM(pb + O_F2N);
        if (IN(pb + O_F2U)) REP(1) { unsigned char* ws = F.ws; OPAQUE_S(ws);
            GEMM_PHASE(EpiSwiglu, ws + WS_HN, ws + WS_WUP + (size_t)(l * 2 + 1) * 44 * MiB, m_post, 2 * FF, DM, (bf16*)(ws + WS_HID), FF); } SEAM(pb + O_F2U);
        if (IN(pb + O_F2D)) REP(2) { unsigned char* ws = F.ws; OPAQUE_S(ws);
            GEMM_RESID(ws + WS_HID, ws + WS_WDN + (size_t)(l * 2 + 1) * 22 * MiB, m_post, DM, FF, 4, (float*)(ws + WS_H), (const float*)(ws + WS_MODV) + (size_t)l * 5 * MODN + 8 * DM, MODN, rep_ ? 0.f : 0.5f); } SEAM(pb + O_F2D);
    }
    if (IN(PH_FINAL)) REP(4) { unsigned char* ws = F.ws; OPAQUE_S(ws); final_norm_phase(F, ws); }
    if (PROBE_K >= 0 && blockIdx.x == 0) { const unsigned long long te_ = __builtin_amdgcn_s_memrealtime(); while (__builtin_amdgcn_s_memrealtime() - te_ < t_probe_) __builtin_amdgcn_s_sleep(8); }
#undef IN
#undef SEAM
}
extern "C" void kernel_launch(void* const* d_in, const int* in_sizes, int n_in, void* d_out, int out_size, void* d_ws, size_t ws_size, hipStream_t stream) {
    static int grid = 0;
    if (grid == 0) {
        if (n_in != 30 || out_size != NB * TT * DM || ws_size < WS_END) { fprintf(stderr, "kernel_launch: unexpected shapes: n_in %d out %d ws %zu (need %zu)\n", n_in, out_size, ws_size, (size_t)WS_END); grid = -1; return; }
        int dev = 0, cus = 0;
        if (hipGetDevice(&dev) != hipSuccess || hipDeviceGetAttribute(&cus, hipDeviceAttributeMultiprocessorCount, dev) != hipSuccess) { grid = -1; return; }
        if (hipFuncSetAttribute((const void*)fwd, hipFuncAttributeMaxDynamicSharedMemorySize, LDS_BYTES) != hipSuccess) { fprintf(stderr, "kernel_launch: hipFuncSetAttribute failed\n"); grid = -1; return; }
        int per_cu = 0; (void)hipOccupancyMaxActiveBlocksPerMultiprocessor(&per_cu, (const void*)fwd, NWAVES * 64, LDS_BYTES); (void)hipGetLastError();
        if (per_cu < 1) fprintf(stderr, "kernel_launch: occupancy query says %d\n", per_cu);
        grid = cus;
    }
    if (grid < 0) return;
    (void)hipMemsetAsync((char*)d_ws + WS_CTL, 0, CTL_ZERO_BYTES, stream);
    Args a{};
    for (int i = 0; i < 30; ++i) a.in[i] = (const float*)d_in[i];
    a.out = (float*)d_out; a.ws = (unsigned char*)d_ws;
    int li = 0;
    auto run = [&](int lo, int hi) { a.ph_lo = lo; a.ph_hi = hi; a.li = li++; a.pad = 0; hipLaunchKernelGGL(fwd, dim3(grid), dim3(NWAVES * 64), LDS_BYTES, stream, a); };
#ifndef MK_CUTS
#define MK_CUTS 0
#endif
    if (MK_CUTS == 0) run(0, N_PHASES);
    else if (MK_CUTS == 1) { for (int ph = 0; ph < N_PHASES; ++ph) run(ph, ph + 1); }
    else { run(0, PH_L0 + O_MP); run(PH_L0 + O_MP, PH_L0 + O_MO); run(PH_L0 + O_MO, PH_L0 + PH_PER_LAYER + O_MP); run(PH_L0 + PH_PER_LAYER + O_MP, PH_L0 + PH_PER_LAYER + O_MO); run(PH_L0 + PH_PER_LAYER + O_MO, N_PHASES); }
    const hipError_t le = hipPeekAtLastError();
    if (le != hipSuccess) fprintf(stderr, "kernel_launch: launch failed: %s\n", hipGetErrorName(le));
}
```

```cpp
#include <hip/hip_runtime.h>
#include <cstdio>
#include <cstdint>
#include <cmath>
__device__ __forceinline__ int fresh_lane() { int l; asm volatile("v_mbcnt_lo_u32_b32 %0, -1, 0\n\tv_mbcnt_hi_u32_b32 %0, -1, %0" : "=v"(l)); return l; }
__device__ __forceinline__ int fresh_tid(int wave) { return wave * 64 + fresh_lane(); }
namespace pg8 {
#define PG8_LAS __attribute__((address_space(3)))
typedef unsigned short bf16_t;
typedef short bf16x8 __attribute__((ext_vector_type(8)));
typedef float f32x4 __attribute__((ext_vector_type(4)));
typedef unsigned u32x4 __attribute__((ext_vector_type(4)));
constexpr int BM = 256, BK = 64, HALF = 128, HTB = HALF * BK * 2  , STAGE_BYTES = 8 * HTB, NXCD = 8, WGM = 8;

__host__ __device__ __forceinline__ int lds_byte(int r, int c) { const int st = (r >> 4) * 2 + (c >> 5), rr = r & 15, cc = c & 31, ob = rr * 64 + cc * 2; return st * 1024 + (ob ^ (((ob >> 9) & 1) << 5)); }
__host__ __device__ __forceinline__ void stage_rc(int b, int& R, int& C) { const int st = b / 1024, sb = b % 1024, swz = sb ^ (((sb >> 9) & 1) << 5); R = (st >> 1) * 16 + swz / 64; C = (st & 1) * 32 + (swz % 64) / 2; }
__host__ __device__ __forceinline__ int perm32(int rho) { const int n = rho >> 4, i = rho & 15; return 8 * (i >> 2) + 4 * n + (i & 3); }

struct Unit { int pm, pn, kt0, nkt, piece, which; };
struct Gemm { const bf16_t* A; const bf16_t* Bt; int M, N, K; const bf16_t* A2; const bf16_t* Bt2; };

template <int S = 1, int NXM = 1> struct StaticOrderT {
    int nM, nN, nwg, G, c, nt; bool xr;
    __host__ __device__ __forceinline__ void init(int M, int N, int G_, int c_, int K = 0, bool xr_ = false) { nM = M / BM; nN = N / BM; nwg = nM * nN; G = G_; c = c_; nt = K / BK; xr = xr_; }
    __host__ __device__ __forceinline__ bool next(int i, Unit& u) const {
        const int rounds = (nwg + G - 1) / G;
        if (xr && i == rounds) { if (c >= S * NXM * nN) return false; const int x = c / S, piece = c % S;
            u.pm = nM + x % NXM; u.pn = x / NXM; u.piece = piece; u.which = 0; u.kt0 = 2 * ((piece * nt) / (2 * S)); u.nkt = 2 * (((piece + 1) * nt) / (2 * S)) - u.kt0; return true; }
        const long L = (long)i * G + c; if (L >= nwg) return false;
        int wgid = (int)L; { const int q8 = nwg / NXCD, r = nwg % NXCD, xcd = wgid % NXCD, off = wgid / NXCD; wgid = (xcd < r ? xcd * (q8 + 1) : r * (q8 + 1) + (xcd - r) * q8) + off; }
        const int nig = WGM * nN, gid = wgid / nig, fm = gid * WGM, gsz = (nM - fm) < WGM ? (nM - fm) : WGM;
        u.pm = fm + ((wgid % nig) % gsz); u.pn = (wgid % nig) / gsz; u.piece = -1; u.which = 0; u.kt0 = 0; u.nkt = nt; return true;
    }
    __device__ __forceinline__ void a_ready(const Unit&) const {}
    __device__ __forceinline__ void done(const Unit&) const {}
};
typedef StaticOrderT<1, 1> StaticOrder;
struct DualOrder {
    int nM1, nN1, nM2, nN2, n1, n2, G, c, nt;
    __host__ __device__ __forceinline__ void init(int M1, int N1, int M2, int N2, int G_, int c_, int K) { nM1 = M1 / BM; nN1 = N1 / BM; nM2 = M2 / BM; nN2 = N2 / BM; n1 = nM1 * nN1; n2 = nM2 * nN2; G = G_; c = c_; nt = K / BK; }
    __host__ __device__ __forceinline__ bool next(int i, Unit& u) const {
        const long L = (long)i * G + c; if (L >= n1 + n2) return false;
        const bool w = L >= n1; const int nM = w ? nM2 : nM1, nN = w ? nN2 : nN1, nwg = w ? n2 : n1;
        int wgid = (int)(w ? L - n1 : L); { const int q8 = nwg / NXCD, r = nwg % NXCD, xcd = wgid % NXCD, off = wgid / NXCD; wgid = (xcd < r ? xcd * (q8 + 1) : r * (q8 + 1) + (xcd - r) * q8) + off; }
        const int nig = WGM * nN, gid = wgid / nig, fm = gid * WGM, gsz = (nM - fm) < WGM ? (nM - fm) : WGM;
        u.pm = fm + ((wgid % nig) % gsz); u.pn = (wgid % nig) / gsz; u.piece = -1; u.which = w ? 1 : 0; u.kt0 = 0; u.nkt = nt; return true;
    }
    __device__ __forceinline__ void a_ready(const Unit&) const {}
    __device__ __forceinline__ void done(const Unit&) const {}
};

__device__ __forceinline__ unsigned cvt_pk_bf16(float lo, float hi) { unsigned r; asm volatile("v_cvt_pk_bf16_f32 %0, %1, %2" : "=v"(r) : "v"(lo), "v"(hi)); return r; }
typedef float f32x2 __attribute__((ext_vector_type(2)));
__device__ __forceinline__ float fast_sigmoid(float a) { return __builtin_amdgcn_rcpf(1.f + __builtin_amdgcn_exp2f(-1.4426950408889634f * a)); }
struct EpiPlain {
    static constexpr bool PERM = true, AFTER_DRAIN = false;
    bf16_t* O; int ldc; float* gates; int gate_pn; const float* gbias;
    __device__ __forceinline__ void operator()(const f32x4 (&acc)[2][2][4][2], const Unit& u, int wr, int wc, int fr, int fq) const {
        const int row0 = u.pm * BM + wr * 64 + fr, col0 = u.pn * BM + wc * 32 + 8 * fq;
#pragma unroll
        for (int ai = 0; ai < 2; ++ai)
#pragma unroll
            for (int m = 0; m < 4; ++m) { const int row = row0 + ai * HALF + m * 16; bf16_t* rowp = O + (size_t)row * ldc + col0;
#pragma unroll
                for (int bj = 0; bj < 2; ++bj) { const f32x4 v0 = acc[ai][bj][m][0], v1 = acc[ai][bj][m][1];
                    u32x4 w; w.x = cvt_pk_bf16(v0[0], v0[1]); w.y = cvt_pk_bf16(v0[2], v0[3]); w.z = cvt_pk_bf16(v1[0], v1[1]); w.w = cvt_pk_bf16(v1[2], v1[3]);
                    *(u32x4*)(rowp + bj * HALF) = w;
                    if (bj == 0 && u.pn == gate_pn && wc == 0 && fq < 2) { float* gp = gates + (size_t)row * 16 + 8 * fq; const f32x4 b0 = *(const f32x4*)(gbias + 8 * fq), b1 = *(const f32x4*)(gbias + 8 * fq + 4);
                        f32x4 lf; for (int q = 0; q < 4; ++q) { const float x = v1[q] + b1[q]; lf[q] = x >= 0.f ? -log1pf(expf(-x)) : x - log1pf(expf(x)); }
                        *(f32x4*)gp = v0 + b0; *(f32x4*)(gp + 4) = lf; } } }
    }
};
struct EpiPlain2 {
    static constexpr bool PERM = true, AFTER_DRAIN = false;
    EpiPlain e0, e1;
    __device__ __forceinline__ void operator()(const f32x4 (&acc)[2][2][4][2], const Unit& u, int wr, int wc, int fr, int fq) const {
        EpiPlain e; e.O = u.which ? e1.O : e0.O; e.ldc = u.which ? e1.ldc : e0.ldc; e.gates = u.which ? e1.gates : e0.gates; e.gate_pn = u.which ? e1.gate_pn : e0.gate_pn; e.gbias = e0.gbias; e(acc, u, wr, wc, fr, fq);
    }
};
struct EpiSwiglu {
    static constexpr bool PERM = true, AFTER_DRAIN = false;
    bf16_t* O; int ldc;
    __device__ __forceinline__ void operator()(const f32x4 (&acc)[2][2][4][2], const Unit& u, int wr, int wc, int fr, int fq) const {
        const int row0 = u.pm * BM + wr * 64 + fr, col0 = u.pn * HALF + wc * 32 + 8 * fq;
#pragma unroll
        for (int ai = 0; ai < 2; ++ai)
#pragma unroll
            for (int m = 0; m < 4; ++m) { bf16_t* rowp = O + (size_t)(row0 + ai * HALF + m * 16) * ldc + col0;
                float r[8];
#pragma unroll
                for (int n = 0; n < 2; ++n)
#pragma unroll
                    for (int j = 0; j < 4; ++j) { const float a = acc[ai][0][m][n][j], b = acc[ai][1][m][n][j]; r[4 * n + j] = a * fast_sigmoid(a) * b; }
                u32x4 w; w.x = cvt_pk_bf16(r[0], r[1]); w.y = cvt_pk_bf16(r[2], r[3]); w.z = cvt_pk_bf16(r[4], r[5]); w.w = cvt_pk_bf16(r[6], r[7]);
                *(u32x4*)rowp = w; }
    }
};
struct EpiResid {
    static constexpr bool PERM = true, AFTER_DRAIN = false;
    float* H; const float* gate; int gstride; float coef;
    __device__ __forceinline__ void operator()(const f32x4 (&acc)[2][2][4][2], const Unit& u, int wr, int wc, int fr, int fq) const {
        const int row0 = u.pm * BM + wr * 64 + fr, col0 = u.pn * BM + wc * 32 + 8 * fq;
        const int sel = u.pm < 64 ? (u.pm >> 4) : 4;
        const float* gp = gate + (size_t)sel * gstride + col0;
        f32x4 gv[2][2];
#pragma unroll
        for (int bj = 0; bj < 2; ++bj)
#pragma unroll
            for (int n = 0; n < 2; ++n) gv[bj][n] = *(const f32x4*)(gp + bj * HALF + 4 * n) * coef;
#pragma unroll
        for (int ai = 0; ai < 2; ++ai)
#pragma unroll
            for (int m = 0; m < 4; ++m) { float* rowp = H + (size_t)(row0 + ai * HALF + m * 16) * 2048 + col0;
#pragma unroll
                for (int bj = 0; bj < 2; ++bj)
#pragma unroll
                    for (int n = 0; n < 2; ++n) { f32x4* p = (f32x4*)(rowp + bj * HALF + 4 * n); *p = *p + gv[bj][n] * acc[ai][bj][m][n]; } }
    }
};
struct EpiPart {
    static constexpr bool PERM = true, AFTER_DRAIN = false;
    float* P;
    __device__ __forceinline__ void operator()(const f32x4 (&acc)[2][2][4][2], const Unit& u, int wr, int wc, int fr, int fq) const {
        const int row0 = u.pm * BM + wr * 64 + fr, col0 = u.pn * BM + wc * 32 + 8 * fq;
        float* base = P + (size_t)u.piece * (1024 * 2048);
#pragma unroll
        for (int ai = 0; ai < 2; ++ai)
#pragma unroll
            for (int m = 0; m < 4; ++m) { float* rowp = base + (size_t)(row0 + ai * HALF + m * 16) * 2048 + col0;
#pragma unroll
                for (int bj = 0; bj < 2; ++bj)
#pragma unroll
                    for (int n = 0; n < 2; ++n) *(f32x4*)(rowp + bj * HALF + 4 * n) = acc[ai][bj][m][n]; }
    }
};
struct EpiResidPart {
    static constexpr bool PERM = true, AFTER_DRAIN = false;
    float* H; const float* gate; int gstride; float coef; float* P;
    __device__ __forceinline__ void operator()(const f32x4 (&acc)[2][2][4][2], const Unit& u, int wr, int wc, int fr, int fq) const {
        const bool res = u.piece < 0;
        const int row0 = (res ? u.pm : u.pm - 64) * BM + wr * 64 + fr, col0 = u.pn * BM + wc * 32 + 8 * fq;
        float* base = res ? H : P + (size_t)u.piece * (1024 * 2048);
        const int sel = u.pm < 64 ? (u.pm >> 4) : 4;
        const float* gp = gate + (size_t)sel * gstride + col0;
        f32x4 gv[2][2];
#pragma unroll
        for (int bj = 0; bj < 2; ++bj)
#pragma unroll
            for (int n = 0; n < 2; ++n) gv[bj][n] = res ? *(const f32x4*)(gp + bj * HALF + 4 * n) * coef : (f32x4){1.f, 1.f, 1.f, 1.f};
#pragma unroll
        for (int ai = 0; ai < 2; ++ai)
#pragma unroll
            for (int m = 0; m < 4; ++m) { float* rowp = base + (size_t)(row0 + ai * HALF + m * 16) * 2048 + col0;
#pragma unroll
                for (int bj = 0; bj < 2; ++bj)
#pragma unroll
                    for (int n = 0; n < 2; ++n) { f32x4* p = (f32x4*)(rowp + bj * HALF + 4 * n); f32x4 old = {0.f, 0.f, 0.f, 0.f}; if (res) old = *p; *p = old + gv[bj][n] * acc[ai][bj][m][n]; } }
    }
};
struct EpiGlu {
    static constexpr bool PERM = true, AFTER_DRAIN = false;
    bf16_t* O; int ldc; const bf16_t* G; const float* bias;
    __device__ __forceinline__ void operator()(const f32x4 (&acc)[2][2][4][2], const Unit& u, int wr, int wc, int fr, int fq) const {
        const int row0 = u.pm * BM + wr * 64 + fr, col0 = u.pn * BM + wc * 32 + 8 * fq;
#pragma unroll
        for (int ai = 0; ai < 2; ++ai)
#pragma unroll
            for (int m = 0; m < 4; ++m) { const int row = row0 + ai * HALF + m * 16;
#pragma unroll
                for (int bj = 0; bj < 2; ++bj) { const int col = col0 + bj * HALF;
                    const u32x4 gw = *(const u32x4*)(G + (size_t)row * 1024 + col);
                    const f32x4 b0 = *(const f32x4*)(bias + col), b1 = *(const f32x4*)(bias + col + 4);
                    float r[8];
#pragma unroll
                    for (int j = 0; j < 4; ++j) { r[j] = fast_sigmoid(acc[ai][bj][m][0][j] + b0[j]); r[4 + j] = fast_sigmoid(acc[ai][bj][m][1][j] + b1[j]); }
                    const unsigned gws[4] = {gw.x, gw.y, gw.z, gw.w};
#pragma unroll
                    for (int q = 0; q < 4; ++q) { r[2 * q] *= __builtin_bit_cast(float, gws[q] << 16); r[2 * q + 1] *= __builtin_bit_cast(float, gws[q] & 0xffff0000u); }
                    u32x4 w; w.x = cvt_pk_bf16(r[0], r[1]); w.y = cvt_pk_bf16(r[2], r[3]); w.z = cvt_pk_bf16(r[4], r[5]); w.w = cvt_pk_bf16(r[6], r[7]);
                    *(u32x4*)(O + (size_t)row * ldc + col) = w; } }
    }
};
template <class Epi, class Sched, bool ALIGN_EPI = false, bool SP2 = false>
__device__ __forceinline__ void gemm_phase(PG8_LAS unsigned char* lds, const Gemm g, const Sched& S, const Epi& E, int wave_s) {
    const int tid = fresh_tid(wave_s);
    const int wid = __builtin_amdgcn_readfirstlane(tid >> 6), lane = tid & 63, wr = wid >> 2, wc = wid & 3, fr = lane & 15, fq = lane >> 4;
    const int K = g.K, nt = K / BK;
    unsigned voffA[2], voffB[2];
#pragma unroll
    for (int i = 0; i < 2; ++i) { int R, C; stage_rc(tid * 16 + i * 8192, R, C); const int Rb = Epi::PERM ? ((R & ~31) + perm32(R & 31)) : R;
        voffA[i] = (unsigned)(R * K + C) * 2u; voffB[i] = (unsigned)(Rb * K + C) * 2u; }
    const size_t kstep = (size_t)(BK * 2);
    const size_t hstep = (size_t)HALF * K * 2;
    const size_t tstep = 2 * hstep;
    const unsigned ldsw = (unsigned)wid * 1024u;
    const int aoff = lds_byte(wr * 64 + fr, fq * 8), boff = lds_byte(wc * 32 + fr, fq * 8);
#define PG8_SA(b, h) (((b) * 2 + (h)) * HTB)
#define PG8_SB(b, h) ((4 + (b) * 2 + (h)) * HTB)
#define PG8_STAGE(bufoff, gbase, voff) do { _Pragma("unroll") for (int _i = 0; _i < 2; ++_i) \
        __builtin_amdgcn_global_load_lds((const unsigned*)((const char*)(gbase) + (voff)[_i]), (PG8_LAS unsigned*)(lds + (bufoff) + ldsw + _i * 8192), 16, 0, 0); } while (0)
#define PG8_LDA(dst, b, h) do { _Pragma("unroll") for (int m = 0; m < 4; ++m) _Pragma("unroll") for (int k = 0; k < 2; ++k) dst[m][k] = *(const PG8_LAS bf16x8*)(lds + PG8_SA(b, h) + aoff + m * 2048 + k * 1024); } while (0)
#define PG8_LDB(dst, b, h) do { _Pragma("unroll") for (int n = 0; n < 2; ++n) _Pragma("unroll") for (int k = 0; k < 2; ++k) dst[n][k] = *(const PG8_LAS bf16x8*)(lds + PG8_SB(b, h) + boff + n * 2048 + k * 1024); } while (0)
#define PG8_MMA(ai, bj, At, Bt) do { __builtin_amdgcn_s_setprio(1); _Pragma("unroll") for (int m = 0; m < 4; ++m) _Pragma("unroll") for (int n = 0; n < 2; ++n) _Pragma("unroll") for (int k = 0; k < 2; ++k) \
        acc[ai][bj][m][n] = __builtin_amdgcn_mfma_f32_16x16x32_bf16(Bt[n][k], At[m][k], acc[ai][bj][m][n], 0, 0, 0); __builtin_amdgcn_s_setprio(0); } while (0)
#define PG8_WAIT_V(n) asm volatile("s_waitcnt vmcnt(" #n ")" ::: "memory")
#define PG8_WAIT_L(n) asm volatile("s_waitcnt lgkmcnt(" #n ")" ::: "memory")
#define PG8_BAR __builtin_amdgcn_s_barrier()
#define PG8_SCHED __builtin_amdgcn_sched_barrier(0)
    Unit cur, nxt; int ui = 0;
    if (!S.next(0, cur)) return;
    f32x4 acc[2][2][4][2];
#pragma unroll
    for (int a = 0; a < 2; ++a)
#pragma unroll
        for (int b = 0; b < 2; ++b)
#pragma unroll
            for (int m = 0; m < 4; ++m)
#pragma unroll
                for (int n = 0; n < 2; ++n) acc[a][b][m][n] = (f32x4){0.f, 0.f, 0.f, 0.f};
    bf16x8 At[4][2], B0[2][2], B1[2][2];
    const char* cA = (const char*)(cur.which ? g.A2 : g.A) + (size_t)cur.pm * tstep + (size_t)cur.kt0 * kstep; const char* cB = (const char*)(cur.which ? g.Bt2 : g.Bt) + (size_t)cur.pn * tstep + (size_t)cur.kt0 * kstep;
    S.a_ready(cur);
    if constexpr (SP2) {
        PG8_STAGE(PG8_SB(0, 0), cB, voffB); PG8_STAGE(PG8_SB(0, 1), cB + hstep, voffB); PG8_STAGE(PG8_SA(0, 0), cA, voffA); PG8_STAGE(PG8_SA(0, 1), cA + hstep, voffA);
        if (wr == 1) PG8_BAR;
        PG8_WAIT_V(2); PG8_BAR;
        PG8_STAGE(PG8_SB(1, 0), cB + kstep, voffB); PG8_STAGE(PG8_SA(1, 0), cA + kstep, voffA); PG8_STAGE(PG8_SB(1, 1), cB + hstep + kstep, voffB);
        PG8_WAIT_V(6); PG8_BAR;
    } else {
        PG8_STAGE(PG8_SB(0, 0), cB, voffB); PG8_STAGE(PG8_SA(0, 0), cA, voffA); PG8_STAGE(PG8_SB(0, 1), cB + hstep, voffB); PG8_STAGE(PG8_SA(0, 1), cA + hstep, voffA);
        if (wr == 1) PG8_BAR;
        PG8_WAIT_V(4); PG8_BAR;
        PG8_STAGE(PG8_SB(1, 0), cB + kstep, voffB); PG8_STAGE(PG8_SA(1, 0), cA + kstep, voffA); PG8_STAGE(PG8_SB(1, 1), cB + hstep + kstep, voffB);
        PG8_WAIT_V(6); PG8_BAR;
    }
    for (;;) {
        const bool has_next = S.next(ui + 1, nxt);
        const char* nA = has_next ? (const char*)(nxt.which ? g.A2 : g.A) + (size_t)nxt.pm * tstep + (size_t)nxt.kt0 * kstep : cA; const char* nB = has_next ? (const char*)(nxt.which ? g.Bt2 : g.Bt) + (size_t)nxt.pn * tstep + (size_t)nxt.kt0 * kstep : cB;
        const int ntc = cur.nkt;
        for (int t = 0; t < ntc; t += 2) {
            const bool last = (t == ntc - 2);
            const char* a1 = cA + (size_t)(t + 1) * kstep;
            const char* a2 = last ? nA : cA + (size_t)(t + 2) * kstep; const char* b2 = last ? nB : cB + (size_t)(t + 2) * kstep;
            const char* a3 = a2 + kstep; const char* b3 = b2 + kstep;
            if (last && has_next) S.a_ready(nxt);
            if constexpr (SP2) {
            PG8_LDB(B0, 0, 0); PG8_LDB(B1, 0, 1); PG8_SCHED; PG8_LDA(At, 0, 0); PG8_STAGE(PG8_SA(1, 1), a1 + hstep, voffA);
            PG8_WAIT_V(8); PG8_WAIT_L(0); PG8_BAR; PG8_MMA(0, 0, At, B0); PG8_MMA(0, 1, At, B1); PG8_BAR; PG8_SCHED;
            PG8_LDA(At, 0, 1); PG8_STAGE(PG8_SB(0, 0), b2, voffB); PG8_STAGE(PG8_SB(0, 1), b2 + hstep, voffB); PG8_STAGE(PG8_SA(0, 0), a2, voffA);
            PG8_WAIT_V(8); PG8_WAIT_L(0); PG8_BAR; PG8_MMA(1, 0, At, B0); PG8_MMA(1, 1, At, B1); PG8_BAR; PG8_SCHED;
            PG8_LDB(B0, 1, 0); PG8_LDB(B1, 1, 1); PG8_SCHED; PG8_LDA(At, 1, 0); PG8_STAGE(PG8_SA(0, 1), a2 + hstep, voffA);
            PG8_WAIT_V(8); PG8_WAIT_L(0); PG8_BAR; PG8_MMA(0, 0, At, B0); PG8_MMA(0, 1, At, B1); PG8_BAR; PG8_SCHED;
            PG8_LDA(At, 1, 1); PG8_STAGE(PG8_SB(1, 0), b3, voffB); PG8_STAGE(PG8_SB(1, 1), b3 + hstep, voffB); PG8_STAGE(PG8_SA(1, 0), a3, voffA);
            PG8_WAIT_V(8); PG8_WAIT_L(0); PG8_BAR; PG8_MMA(1, 0, At, B0); PG8_MMA(1, 1, At, B1); PG8_BAR; PG8_SCHED;
            } else {
            PG8_LDB(B0, 0, 0); PG8_SCHED; PG8_LDA(At, 0, 0); PG8_STAGE(PG8_SA(1, 1), a1 + hstep, voffA);
            PG8_WAIT_L(8); PG8_BAR; PG8_WAIT_L(0); PG8_MMA(0, 0, At, B0); PG8_BAR; PG8_SCHED;
            PG8_LDB(B1, 0, 1); PG8_STAGE(PG8_SB(0, 0), b2, voffB);
            PG8_BAR; PG8_WAIT_L(0); PG8_MMA(0, 1, At, B1); PG8_BAR;
            PG8_LDA(At, 0, 1); PG8_STAGE(PG8_SA(0, 0), a2, voffA);
            PG8_BAR; PG8_WAIT_L(0); PG8_MMA(1, 0, At, B0); PG8_BAR; PG8_SCHED;
            PG8_STAGE(PG8_SB(0, 1), b2 + hstep, voffB);
            PG8_WAIT_V(6); PG8_BAR; PG8_MMA(1, 1, At, B1); PG8_BAR;
            PG8_LDB(B0, 1, 0); PG8_SCHED; PG8_LDA(At, 1, 0); PG8_STAGE(PG8_SA(0, 1), a2 + hstep, voffA);
            PG8_WAIT_L(8); PG8_BAR; PG8_WAIT_L(0); PG8_MMA(0, 0, At, B0); PG8_BAR; PG8_SCHED;
            PG8_LDB(B1, 1, 1); PG8_STAGE(PG8_SB(1, 0), b3, voffB);
            PG8_BAR; PG8_WAIT_L(0); PG8_MMA(0, 1, At, B1); PG8_BAR;
            PG8_LDA(At, 1, 1); PG8_STAGE(PG8_SA(1, 0), a3, voffA);
            PG8_BAR; PG8_WAIT_L(0); PG8_MMA(1, 0, At, B0); PG8_BAR; PG8_SCHED;
            PG8_STAGE(PG8_SB(1, 1), b3 + hstep, voffB);
            PG8_WAIT_V(6); PG8_BAR; PG8_MMA(1, 1, At, B1); PG8_BAR;
            }
        }
        if constexpr (ALIGN_EPI) { if (wr == 0) PG8_BAR; }
        if constexpr (!Epi::AFTER_DRAIN) { E(acc, cur, wr, wc, fr, fq); S.done(cur); }
        if (!has_next) break;
#pragma unroll
        for (int a = 0; a < 2; ++a)
#pragma unroll
            for (int b = 0; b < 2; ++b)
#pragma unroll
                for (int m = 0; m < 4; ++m)
#pragma unroll
                    for (int n = 0; n < 2; ++n) acc[a][b][m][n] = (f32x4){0.f, 0.f, 0.f, 0.f};
        cur = nxt; cA = nA; cB = nB; ++ui;
        if constexpr (ALIGN_EPI) { if (wr == 1) PG8_BAR; }
    }
    PG8_WAIT_V(0);
    if constexpr (!ALIGN_EPI) { if (wr == 0) PG8_BAR; }
    PG8_BAR;
    if constexpr (Epi::AFTER_DRAIN) { E.fused(acc, cur, wr, wc, fr, fq, lds, wid, lane); S.done(cur); }
#undef PG8_SA
#undef PG8_SB
#undef PG8_STAGE
#undef PG8_LDA
#undef PG8_LDB
#undef PG8_MMA
#undef PG8_WAIT_V
#undef PG8_WAIT_L
#undef PG8_BAR
#undef PG8_SCHED
}
}
#define GAS __attribute__((address_space(1)))
#define LAS __attribute__((address_space(3)))
typedef unsigned short bf16;
typedef unsigned v4u __attribute__((ext_vector_type(4)));
typedef float f32x4 __attribute__((ext_vector_type(4)));
typedef short bf16x8 __attribute__((ext_vector_type(8)));
typedef GAS unsigned gu32;
typedef GAS unsigned long long gu64;
#define RLX_AGENT __ATOMIC_RELAXED, __HIP_MEMORY_SCOPE_AGENT
#define LDS_WAIT() asm volatile("s_waitcnt lgkmcnt(0)" ::: "memory")
#define VM_WAIT() asm volatile("s_waitcnt vmcnt(0)" ::: "memory")
__device__ __forceinline__ unsigned long long rt() { return __builtin_amdgcn_s_memrealtime(); }
__device__ __forceinline__ unsigned f2bf(float f) { unsigned u = __builtin_bit_cast(unsigned, f); return (u + 0x7fffu + ((u >> 16) & 1u)) >> 16; }
__device__ __forceinline__ unsigned pk2(float lo, float hi) { return f2bf(lo) | (f2bf(hi) << 16); }

#define XB_TMO      128
#define XB_XCNT(j)  (256  + 64 * (j))
#define XB_XSUB(j)  (1280 + 64 * (j))
#define XB_XGEN(j)  (2304 + 64 * (j))
#define XB_TOP      3328
#define XB_TOPGEN   3392
#define XCD_BAR_WORDS 3456
#define XB_SPIN_CAP (1u << 18)

__device__ __forceinline__ unsigned xb_ld(unsigned* p)              { return __hip_atomic_load(p, __ATOMIC_RELAXED, __HIP_MEMORY_SCOPE_AGENT); }
__device__ __forceinline__ unsigned xb_add(unsigned* p, unsigned v) { return __hip_atomic_fetch_add(p, v, __ATOMIC_RELAXED, __HIP_MEMORY_SCOPE_AGENT); }
__device__ __forceinline__ unsigned xb_xcc_id() { return (unsigned)__builtin_amdgcn_s_getreg((3 << 11) | 20) & 0xFu; }
#define XB_SPIN(cond, bar) do { unsigned _sp = 0; while (cond) { __builtin_amdgcn_s_sleep(1); \
    if ((++_sp & 255u) == 0u) { if (xb_ld(&(bar)[XB_TMO])) break; if (_sp > XB_SPIN_CAP) { atomicAdd(&(bar)[XB_TMO], 1u); break; } } } } while (0)

struct XcdBarrier {
    unsigned* bar; unsigned x;
    volatile LAS unsigned* st;
};

__device__ __forceinline__ XcdBarrier xcd_barrier_post(unsigned* bar, volatile LAS unsigned* st) {
    XcdBarrier b; b.bar = bar; b.x = xb_xcc_id(); b.st = st;
    if (threadIdx.x == 0) (void)xb_add(&bar[XB_XCNT(b.x)], 1u);
    return b;
}
__device__ __forceinline__ void xcd_barrier_complete(unsigned* bar, unsigned x, unsigned& nloc, unsigned& nx) {
    const unsigned G = gridDim.x * gridDim.y * gridDim.z;
    unsigned sum, cnt, mine, sp = 0u;
    for (;;) {
        sum = 0u; cnt = 0u; mine = 0u;
#pragma unroll
        for (unsigned j = 0; j < 16; ++j) { const unsigned c = xb_ld(&bar[XB_XCNT(j)]); sum += c; cnt += (c > 0u) ? 1u : 0u; mine = (j == x) ? c : mine; }
        if (sum == G) break;
        __builtin_amdgcn_s_sleep(1);
        if ((++sp & 255u) == 0u) { if (xb_ld(&bar[XB_TMO])) break; if (sp > XB_SPIN_CAP) { atomicAdd(&bar[XB_TMO], 1u); break; } }
    }
    nloc = mine > 0u ? mine : 1u; nx = cnt > 0u ? cnt : 1u;
}

__device__ __forceinline__ void xcd_barrier(const XcdBarrier& b, int wave_s) {
    asm volatile("s_waitcnt vmcnt(0)" ::: "memory");
    __syncthreads();
    if (wave_s == 0 && fresh_lane() == 0) {
        unsigned* bar = b.bar;
        __builtin_amdgcn_s_waitcnt(0);
        unsigned nloc = b.st[0], nx = b.st[1];
        if (nloc == 0u) { xcd_barrier_complete(bar, b.x, nloc, nx); b.st[0] = nloc; b.st[1] = nx; }
        const unsigned old = xb_add(&bar[XB_XSUB(b.x)], 1u);
        const unsigned gen = old / nloc;
        if (old + 1u == (gen + 1u) * nloc) {
            __builtin_amdgcn_fence(__ATOMIC_RELEASE, "agent");
            asm volatile("s_waitcnt vmcnt(0)" ::: "memory");
            const unsigned og = xb_add(&bar[XB_TOP], 1u);
            const unsigned tg = og / nx;
            if (og + 1u == (tg + 1u) * nx) xb_add(&bar[XB_TOPGEN], 1u);
            else XB_SPIN(xb_ld(&bar[XB_TOPGEN]) == tg, bar);
            __builtin_amdgcn_fence(__ATOMIC_ACQUIRE, "agent");
            xb_add(&bar[XB_XGEN(b.x)], 1u);
            asm volatile("s_waitcnt vmcnt(0)" ::: "memory");
        } else {
            XB_SPIN(xb_ld(&bar[XB_XGEN(b.x)]) == gen, bar);
            __builtin_amdgcn_fence(__ATOMIC_ACQUIRE, "agent");
            asm volatile("s_waitcnt vmcnt(0)" ::: "memory");
        }
    }
    __syncthreads();
}
constexpr int NWAVES = 8;
constexpr int DM = 2048, NB = 4, TT = 4096, CT = 256, SB = 4352, MR = NB * SB  , FF = 5632;
constexpr int AB_IN = 4624, ZLD = 4864, CD_IN = 2304, NMOD = 9, MODN = NMOD * DM  ;
constexpr float EPS = 1e-6f;
constexpr int ZA_Q = 0, ZA_K = 1024, ZA_V = 1280, ZB_Q = 1536, ZB_K = 2048, ZB_V = 2560, ZB_O = 3584, ZB_G = 4608;
constexpr int ZC_U = 0, ZD_Q = 1024, ZD_K = 2048, ZD_V = 2176;
constexpr int KSPLIT = 32;
constexpr size_t MiB = 1u << 20;
constexpr size_t WS_CTL = 0, CTL_ZERO_BYTES = 1 * MiB;
constexpr size_t WS_WUP = 1 * MiB;
constexpr size_t WS_WDN = WS_WUP + 4 * 44 * MiB;
constexpr size_t WS_WABIN = WS_WDN + 4 * 22 * MiB;
constexpr size_t WS_WABOUT = WS_WABIN + 19 * MiB;
constexpr size_t WS_WCDIN = WS_WABOUT + 8 * MiB;
constexpr size_t WS_WCDOUT = WS_WCDIN + 9 * MiB;
constexpr size_t WS_WGLU = WS_WCDOUT + 8 * MiB;
constexpr size_t WS_MODP = WS_WGLU + 2 * MiB;
constexpr size_t WS_MODV = WS_MODP + 23 * MiB;
constexpr size_t WS_NRM = WS_MODV + 1 * MiB;
constexpr size_t WS_TAB = WS_NRM + 1 * MiB;
constexpr size_t WS_H = WS_TAB + 4 * MiB;
constexpr size_t WS_HN = WS_H + 136 * MiB;
constexpr size_t WS_X = WS_HN + 68 * MiB;
constexpr size_t WS_Z = WS_X, WS_ZT = WS_X + 163 * MiB, WS_HID = WS_X;
constexpr size_t WS_CAT = WS_X + 216 * MiB;
constexpr size_t WS_GATES = WS_CAT + 68 * MiB;
constexpr size_t WS_KA = WS_GATES + 2 * MiB;
constexpr size_t WS_G = WS_KA + 10 * MiB;
constexpr size_t WS_SC1 = WS_G + 34 * MiB;
constexpr size_t WS_SC2 = WS_SC1 + 68 * MiB;
constexpr size_t WS_END = WS_SC2 + 68 * MiB;
static_assert((size_t)MR * ZLD * 2 <= 163 * MiB && (size_t)1536 * MR * 2 <= 53 * MiB && (size_t)MR * FF * 2 <= 216 * MiB, "overlay");
constexpr size_t TB_ROPEA = 0;
constexpr size_t TB_ROPED = 16384;
constexpr size_t TB_S5AB = 32768;
constexpr size_t TB_S5BB = TB_S5AB + 65536;
constexpr size_t TB_VEC = TB_S5BB + 1048576;
constexpr int TV_GK = 0, TV_GQ = 128, TV_BGATE = 256, TV_SINK = 272, TV_HEADG = 512, TV_DSKIP = 1536, TV_GLUB = 2560, TV_FINALG = 3584, TV_N = 5632;
constexpr size_t TB_S5C = TB_VEC + 32768;
constexpr size_t TB_S5BT = TB_S5C + 1048576;
constexpr size_t TB_S5CT = TB_S5BT + 524288;
constexpr size_t TB_END = TB_S5CT + 524288;
static_assert(TB_END <= 4 * MiB, "tables");
constexpr int CW_TMO = 0, CW_BAR = 4096;
constexpr int RING_OFF = 0, RING_BYTES = 131072;
constexpr int LDSCTL_OFF = RING_BYTES, MISC_OFF = LDSCTL_OFF + 320;
constexpr int LDS_BYTES = 147456;
static_assert(MISC_OFF + 128 <= LDSCTL_OFF + 512 && LDSCTL_OFF + 512 + 8 * 1024 <= LDS_BYTES, "LDS map");
__device__ __forceinline__ float bf2f(bf16 v) { return __builtin_bit_cast(float, (unsigned)v << 16); }
__device__ __forceinline__ float wave_sum(float v) {
#pragma unroll
    for (int o = 1; o < 64; o <<= 1) v += __shfl_xor(v, o);
    return v;
}
__device__ __forceinline__ float wave_sum_l(float v, int lane) {
#pragma unroll
    for (int o = 1; o < 64; o <<= 1) v += __builtin_bit_cast(float, __builtin_amdgcn_ds_bpermute((lane ^ o) << 2, __builtin_bit_cast(int, v)));
    return v;
}
#define OPAQUE(x) asm volatile("" : "+v"(x))
__device__ __forceinline__ float silu_acc(float x) { return x / (1.f + expf(-x)); }
__device__ __forceinline__ float logsigmoid_acc(float x) { return x >= 0.f ? -log1pf(expf(-x)) : x - log1pf(expf(x)); }
__device__ __forceinline__ float gelu_tanh(float x) { const float u = 0.7978845608028654f * (x + 0.044715f * x * x * x); return 0.5f * x * (1.f + tanhf(u)); }
__device__ __forceinline__ int row_sel(int m) { return m < NB * TT ? (m >> 12) : 4; }

struct Frame {
    LAS unsigned char* lds;
    volatile LAS unsigned* MISC;
    gu32* ctl;
    int wave, G;
    float* out; unsigned char* ws;
};

__device__ __forceinline__ void p0_transpose_item(const float* W, int K, int N, int Nvalid, bf16* WT, int drow0, int k0, int n0, LAS float* scr, int lane) {
    const int nn = n0 + (lane & 31); const bool ok = nn < Nvalid;
#pragma unroll
    for (int i = 0; i < 32; ++i) { const int kk = 2 * i + (lane >> 5); scr[kk * 33 + (lane & 31)] = ok ? __builtin_nontemporal_load(W + (size_t)(k0 + kk) * N + nn) : 0.f; }
    LDS_WAIT(); asm volatile("" ::: "memory");
    const int c = lane & 7;
#pragma unroll
    for (int j = 0; j < 4; ++j) { const int n = (lane >> 3) + 8 * j; const LAS float* s = scr + (8 * c) * 33 + n;
        v4u o; o.x = pk2(s[0 * 33], s[1 * 33]); o.y = pk2(s[2 * 33], s[3 * 33]); o.z = pk2(s[4 * 33], s[5 * 33]); o.w = pk2(s[6 * 33], s[7 * 33]);
        *(GAS v4u*)(WT + (size_t)(drow0 + n) * K + k0 + 8 * c) = o; }
    LDS_WAIT(); asm volatile("" ::: "memory");
}
__device__ __forceinline__ bool p0_mat(int& r, const float* W, int K, int N, int Npad, bf16* WT, int mode  , LAS float* scr, int lane) {
    const int nblk = Npad / 32, items = (K / 64) * nblk;
    if (r >= items) { r -= items; return false; }
    const int kb = 8 * (r / (8 * nblk)) + (r & 7), nb = (r >> 3) % nblk, n0 = 32 * nb;
    int drow0 = n0; if (mode) drow0 = (n0 >> 7) * 256 + (n0 & 127) + (mode == 2 ? 128 : 0);
    p0_transpose_item(W, K, N, N, WT, drow0, 64 * kb, n0, scr, lane);
    return true;
}
__device__ __forceinline__ void p0_prologue(Frame& F, const float* const (&in)[30]) {
    LAS float* scr = (LAS float*)(F.lds + RING_OFF + F.wave * 8448);
    LAS float* ssilu = (LAS float*)(F.lds + RING_OFF + 8 * 8448);
    { const int t = fresh_tid(F.wave); for (int i = t; i < 5 * DM; i += NWAVES * 64) ssilu[i] = silu_acc(i < 4 * DM ? in[1][i] : in[3][i - 4 * DM]); }
    __syncthreads();
    const int lane = fresh_lane();
    const int gw = blockIdx.x * NWAVES + F.wave, NGW = F.G * NWAVES;
    unsigned char* ws = F.ws;
    {
        constexpr int NCH = MODN / 256, NIT = 2 * KSPLIT * NCH, KPER = DM / KSPLIT;
        for (int it = gw; it < NIT; it += NGW) {
            const int cc = it % NCH, ks = (it / NCH) % KSPLIT, l = it / (NCH * KSPLIT);
            const float* W = in[4] + (size_t)l * DM * MODN + (size_t)(ks * KPER) * MODN + cc * 256 + lane * 4;
            f32x4 a0 = {0, 0, 0, 0}, a1 = a0, a2 = a0, a3 = a0, a4 = a0;
#pragma unroll 16
            for (int k = 0; k < KPER; ++k) {
                const f32x4 w = __builtin_nontemporal_load((const f32x4*)(W + (size_t)k * MODN)); const int kk = ks * KPER + k;
                const float s0 = ssilu[kk], s1 = ssilu[DM + kk], s2 = ssilu[2 * DM + kk], s3 = ssilu[3 * DM + kk], s4 = ssilu[4 * DM + kk];
                a0 += w * s0; a1 += w * s1; a2 += w * s2; a3 += w * s3; a4 += w * s4;
            }
            float* P = (float*)(ws + WS_MODP) + ((size_t)(l * KSPLIT + ks) * 5) * MODN + cc * 256 + lane * 4;
            *(f32x4*)(P) = a0; *(f32x4*)(P + MODN) = a1; *(f32x4*)(P + 2 * MODN) = a2; *(f32x4*)(P + 3 * MODN) = a3; *(f32x4*)(P + 4 * MODN) = a4;
        }
    }
    {
        constexpr int I_UP = (DM / 64) * (FF / 32), I_DN = (FF / 64) * (DM / 32);
        constexpr int NIT = 8 * I_UP + 4 * I_DN + (DM / 64) * (ZLD / 32) + 2 * (DM / 64) * (DM / 32) + (DM / 64) * (CD_IN / 32) + (1024 / 64) * (1024 / 32);
        for (int it = gw; it < NIT; it += NGW) {
            int r = it; bool done = false;
#pragma unroll 1
            for (int lh = 0; lh < 4 && !done; ++lh) {
                bf16* up = (bf16*)(ws + WS_WUP + (size_t)lh * 44 * MiB);
                done = p0_mat(r, in[7] + (size_t)lh * DM * FF, DM, FF, FF, up, 1, scr, lane); if (done) break;
                done = p0_mat(r, in[8] + (size_t)lh * DM * FF, DM, FF, FF, up, 2, scr, lane); if (done) break;
                done = p0_mat(r, in[9] + (size_t)lh * FF * DM, FF, DM, DM, (bf16*)(ws + WS_WDN + (size_t)lh * 22 * MiB), 0, scr, lane);
            }
            if (done) continue;
            {
                const int nblk = ZLD / 32, items = (DM / 64) * nblk;
                if (r < items) { const int kb = 8 * (r / (8 * nblk)) + (r & 7), nb = (r >> 3) % nblk; p0_transpose_item(in[10], DM, AB_IN, AB_IN, (bf16*)(ws + WS_WABIN), 32 * nb, 64 * kb, 32 * nb, scr, lane); continue; }
                r -= items;
            }
            if (p0_mat(r, in[12], DM, DM, DM, (bf16*)(ws + WS_WABOUT), 0, scr, lane)) continue;
            if (p0_mat(r, in[16], DM, CD_IN, CD_IN, (bf16*)(ws + WS_WCDIN), 0, scr, lane)) continue;
            if (p0_mat(r, in[17], DM, DM, DM, (bf16*)(ws + WS_WCDOUT), 0, scr, lane)) continue;
            p0_mat(r, in[26], 1024, 1024, 1024, (bf16*)(ws + WS_WGLU), 0, scr, lane);
        }
    }
    {
        const int tid_ = fresh_tid(F.wave); const int gt = blockIdx.x * (NWAVES * 64) + tid_, NT = F.G * NWAVES * 64;
        float* ropeA = (float*)(ws + WS_TAB + TB_ROPEA); float* ropeD = (float*)(ws + WS_TAB + TB_ROPED);
        for (int i = gt; i < 64 * 32; i += NT) { const int pos = i >> 5, f = i & 31; const float inv = powf(10000.f, -(float)f / 32.f), a = (float)pos * inv; ropeA[2 * i] = cosf(a); ropeA[2 * i + 1] = sinf(a); }
        for (int i = gt; i < 64 * 16; i += NT) { const int pos = i >> 4, f = i & 15; const float inv = powf(10000.f, -(float)f / 16.f), a = (float)pos * inv; ropeD[2 * i] = cosf(a); ropeD[2 * i + 1] = sinf(a); }
        float* s5ab = (float*)(ws + WS_TAB + TB_S5AB); float* s5bb = (float*)(ws + WS_TAB + TB_S5BB); bf16* s5bt = (bf16*)(ws + WS_TAB + TB_S5BT); bf16* s5ct = (bf16*)(ws + WS_TAB + TB_S5CT);
        for (int i = gt; i < 2 * 64 * 64; i += NT) {
            const int dg = i >> 6;
            const float are = in[18][i], aim = in[19][i], dt = expf(in[20][dg]);
            const float mag = expf(are * dt), abr = mag * cosf(aim * dt), abi = mag * sinf(aim * dt);
            const float den = are * are + aim * aim, nr = abr - 1.f, ni = abi;
            const float kre = (nr * are + ni * aim) / den, kim = (ni * are - nr * aim) / den;
            s5ab[2 * i] = abr; s5ab[2 * i + 1] = abi;
            for (int q = 0; q < 16; ++q) { const float br = in[21][(size_t)i * 16 + q], bi = in[22][(size_t)i * 16 + q];
                const float bbr = kre * br - kim * bi, bbi = kre * bi + kim * br;
                s5bb[((size_t)i * 16 + q) * 2] = bbr; s5bb[((size_t)i * 16 + q) * 2 + 1] = bbi;
                s5bt[((size_t)dg * 128 + (i & 63)) * 16 + q] = (bf16)f2bf(bbr); s5bt[((size_t)dg * 128 + 64 + (i & 63)) * 16 + q] = (bf16)f2bf(bbi); }
        }
        for (int i = gt; i < 2 * 64 * 16 * 128; i += NT) { const int pp = i & 127, dgo = i >> 7;
            s5ct[i] = (bf16)f2bf(pp < 64 ? in[23][(size_t)dgo * 64 + pp] : -in[24][(size_t)dgo * 64 + pp - 64]); }
        float* tv = (float*)(ws + WS_TAB + TB_VEC);
        for (int i = gt; i < TV_N; i += NT) { float v = 0.f;
            if (i < TV_GQ) v = in[14][i]; else if (i < TV_BGATE) v = in[13][i - TV_GQ]; else if (i < TV_SINK) v = in[11][i - TV_BGATE]; else if (i < TV_SINK + 16) v = in[28][i - TV_SINK];
            else if (i >= TV_HEADG && i < TV_DSKIP) v = in[15][i - TV_HEADG]; else if (i >= TV_DSKIP && i < TV_GLUB) v = in[25][i - TV_DSKIP];
            else if (i >= TV_GLUB && i < TV_FINALG) v = in[27][i - TV_GLUB]; else if (i >= TV_FINALG) v = in[29][i - TV_FINALG];
            tv[i] = v; }
        float* s5c = (float*)(ws + WS_TAB + TB_S5C);
        for (int i = gt; i < 2 * 131072; i += NT) s5c[i] = i < 131072 ? in[23][i] : in[24][i - 131072];
    }
}
__device__ __forceinline__ float p1_sum(const float* P, const float* modb, int l, int sel, int idx, int c) {
    const GAS float* pp = (const GAS float*)P + ((size_t)(l * KSPLIT) * 5 + sel) * MODN + idx * DM + c; float s = 0.f;
#pragma unroll
    for (int ks = 0; ks < KSPLIT; ++ks) s += pp[(size_t)ks * 5 * MODN];
    return s + modb[l * MODN + idx * DM + c];
}
__device__ __forceinline__ void p1_modreduce(Frame& F, const float* modb, const float* normg) {
    const int tid_ = fresh_tid(F.wave); const int gt = blockIdx.x * (NWAVES * 64) + tid_, NT = F.G * NWAVES * 64;
    const float* P = (const float*)(F.ws + WS_MODP); float* MV = (float*)(F.ws + WS_MODV); float* NR = (float*)(F.ws + WS_NRM);
    for (int i = gt; i < 2 * 5 * 9 * DM; i += NT) { const int c = i % DM, idx = (i / DM) % 9, sel = (i / (9 * DM)) % 5, l = i / (45 * DM);
        MV[((size_t)(l * 5 + sel) * 9 + idx) * DM + c] = p1_sum(P, modb, l, sel, idx, c); }
    for (int i = gt; i < 2 * 5 * 3 * DM; i += NT) { const int c = i % DM, w = (i / DM) % 3, sel = (i / (3 * DM)) % 5, l = i / (15 * DM);
        const float g = normg[(l * 3 + w) * DM + c];
        NR[(((size_t)(l * 5 + sel) * 3 + w) * 2) * DM + c] = g * (1.f + p1_sum(P, modb, l, sel, 3 * w + 1, c));
        NR[(((size_t)(l * 5 + sel) * 3 + w) * 2 + 1) * DM + c] = p1_sum(P, modb, l, sel, 3 * w, c); }
}
template <int PS>
__device__ __forceinline__ void norm_phase(Frame& F, unsigned char* ws, const float* xin, const float* cin, int l, int which, bool first, int nrows, const float* pgate = nullptr, float pcoef = 0.f) {
    const int lane = fresh_lane();
    const int gw = blockIdx.x * NWAVES + F.wave, NGW = F.G * NWAVES;
    float* H = (float*)(ws + WS_H); bf16* HN = (bf16*)(ws + WS_HN); const float* NR = (const float*)(ws + WS_NRM);
#define NP_SRC(m_) ((const GAS f32x4*)(first ? ((m_) < NB * TT ? xin + (size_t)(m_) * DM : cin + (size_t)((m_) - NB * TT) * DM) : H + (size_t)(m_) * DM) + lane)
    const bool bal = PS > 0 && nrows == MR && NGW == 2048;
    const int cnt = bal ? (gw < 1024 ? 6 : 11) : (gw < nrows ? (nrows - gw + NGW - 1) / NGW : 0);
#define NROW(i) (bal ? (gw < 1024 ? ((i) < 5 ? 11264 + gw + 1024 * (i) : NB * TT + gw) : (gw - 1024) + 1024 * (i)) : gw + (i) * NGW)
    f32x4 vn[8];
    if (cnt > 0) { const int m0 = NROW(0); const GAS f32x4* xr = NP_SRC(m0);
#pragma unroll
        for (int j = 0; j < 8; ++j) vn[j] = xr[64 * j]; }
    for (int it = 0; it < cnt; ++it) {
        const int m = NROW(it);
        f32x4 v[8];
#pragma unroll
        for (int j = 0; j < 8; ++j) v[j] = vn[j];
        const int mn = NROW(it + 1);
        if (it + 1 < cnt) { const GAS f32x4* xr = NP_SRC(mn);
#pragma unroll
            for (int j = 0; j < 8; ++j) vn[j] = xr[64 * j]; }
        const int sel = row_sel(m);
        const GAS f32x4* Ap = (const GAS f32x4*)(NR + (((size_t)(l * 5 + sel) * 3 + which) * 2) * DM) + lane; const GAS f32x4* Bp = Ap + DM / 4;
        const bool merge = PS > 0 && m >= NB * TT;
        if (merge) { const GAS f32x4* pp = (const GAS f32x4*)((const float*)(ws + WS_SC1) + (size_t)(m - NB * TT) * DM) + lane; const GAS f32x4* gp = (const GAS f32x4*)pgate + lane;
#pragma unroll
            for (int j = 0; j < 8; ++j) { f32x4 a = pp[64 * j];
#pragma unroll
                for (int q = 1; q < (PS > 0 ? PS : 1); ++q) a += pp[(size_t)q * (1024 * DM / 4) + 64 * j];
                v[j] += gp[64 * j] * pcoef * a; } }
        float s = 0.f;
#pragma unroll
        for (int j = 0; j < 8; ++j) s += (v[j].x * v[j].x + v[j].y * v[j].y) + (v[j].z * v[j].z + v[j].w * v[j].w);
        const float rstd = 1.f / sqrtf(wave_sum_l(s, lane) * (1.f / DM) + EPS);
        if (first || merge) { GAS f32x4* hw = (GAS f32x4*)(H + (size_t)m * DM) + lane;
#pragma unroll
            for (int j = 0; j < 8; ++j) hw[64 * j] = v[j]; }
        GAS unsigned long long* o8 = (GAS unsigned long long*)(HN + (size_t)m * DM) + lane;
#pragma unroll
        for (int j = 0; j < 8; ++j) { const f32x4 a = Ap[64 * j], b = Bp[64 * j]; const f32x4 y = v[j] * rstd * a + b;
            o8[64 * j] = (unsigned long long)pk2(y.x, y.y) | ((unsigned long long)pk2(y.z, y.w) << 32); }
    }
#undef NP_SRC
#undef NROW
}
__device__ __forceinline__ void final_norm_phase(Frame& F, unsigned char* ws) {
    const int lane = fresh_lane();
    const int gw = blockIdx.x * NWAVES + F.wave, NGW = F.G * NWAVES;
    const float* H = (const float*)(ws + WS_H);
    f32x4 vn[8];
    { const GAS f32x4* xr = (const GAS f32x4*)(H + (size_t)gw * DM) + lane;
#pragma unroll
      for (int j = 0; j < 8; ++j) vn[j] = xr[64 * j]; }
    for (int m = gw; m < NB * TT; m += NGW) {
        f32x4 v[8]; float s = 0.f;
#pragma unroll
        for (int j = 0; j < 8; ++j) { v[j] = vn[j]; s += (v[j].x * v[j].x + v[j].y * v[j].y) + (v[j].z * v[j].z + v[j].w * v[j].w); }
        if (m + NGW < NB * TT) { const GAS f32x4* xr = (const GAS f32x4*)(H + (size_t)(m + NGW) * DM) + lane;
#pragma unroll
            for (int j = 0; j < 8; ++j) vn[j] = xr[64 * j]; }
        const float rstd = 1.f / sqrtf(wave_sum_l(s, lane) * (1.f / DM) + EPS);
        const GAS f32x4* gp = (const GAS f32x4*)((const float*)(ws + WS_TAB + TB_VEC) + TV_FINALG) + lane; GAS f32x4* o = (GAS f32x4*)(F.out + (size_t)m * DM) + lane;
#pragma unroll
        for (int j = 0; j < 8; ++j) o[64 * j] = v[j] * rstd * gp[64 * j];
    }
}
template <int MODE> __device__ __forceinline__ void naive_kprep(int gw, int lane, const bf16* Z, bf16* KO, const float* gk, const float* rope) {
    if (MODE == 0) {
        if (gw >= MR * 2) return;
        const int m = gw >> 1, kvh = gw & 1; const bf16* zr = Z + (size_t)m * ZLD + ZA_K + kvh * 128;
        float x1 = bf2f(zr[lane]), x2 = bf2f(zr[64 + lane]);
        const float rstd = 1.f / sqrtf(wave_sum_l(x1 * x1 + x2 * x2, lane) * (1.f / 128.f) + EPS);
        x1 *= rstd * gk[lane]; x2 *= rstd * gk[64 + lane];
        if (m < NB * TT) { const int t = m & (TT - 1), pos = lane < 32 ? (t >> 6) : (t & 63), f = lane & 31; const float c = rope[2 * (pos * 32 + f)], s = rope[2 * (pos * 32 + f) + 1];
            const float o1 = x1 * c - x2 * s, o2 = x2 * c + x1 * s; x1 = o1; x2 = o2; }
        KO[(size_t)m * 256 + kvh * 128 + lane] = (bf16)f2bf(x1); KO[(size_t)m * 256 + kvh * 128 + 64 + lane] = (bf16)f2bf(x2);
    } else {
        if (gw >= MR) return;
        const int m = gw, kvh = lane >> 5, j = lane & 31; const bf16* zr = Z + (size_t)m * CD_IN + ZD_K + kvh * 64;
        float x1 = bf2f(zr[j]), x2 = bf2f(zr[32 + j]);
        if (m < NB * TT) { const int t = m & (TT - 1), pos = j < 16 ? (t >> 6) : (t & 63), f = j & 15; const float c = rope[2 * (pos * 16 + f)], s = rope[2 * (pos * 16 + f) + 1];
            const float o1 = x1 * c - x2 * s, o2 = x2 * c + x1 * s; x1 = o1; x2 = o2; }
        KO[(size_t)m * 128 + kvh * 64 + j] = (bf16)f2bf(x1); KO[(size_t)m * 128 + kvh * 64 + 32 + j] = (bf16)f2bf(x2);
    }
}
template <int DH, int MODE> __device__ __forceinline__ void naive_attn(int vb, int vtid, const bf16* Z, const bf16* KB, bf16* CAT, const float* gq, const float* rope, const float* sink) {
    constexpr int H4 = DH / 4, NF = DH / 4, NH = (MODE == 2) ? 16 : 8, QPB = 128;
    constexpr int NQ = (MODE == 1) ? CT : TT, LDZ = (MODE == 2) ? CD_IN : ZLD, LDK = (MODE == 2) ? 128 : 256;
    constexpr int QCOL = (MODE == 2) ? ZD_Q : ZA_Q, VCOL = (MODE == 2) ? ZD_V : ZA_V, OCOL = (MODE == 2) ? 1024 : 0;
    const int nchunk = NQ / QPB; int bid = vb; const int qc = bid % nchunk; bid /= nchunk; const int head = bid % NH, b = bid / NH;
    const int kvh = head / (NH / 2), part = vtid & 3, r = vtid >> 2, qi = qc * QPB + r;
    const int m = (MODE == 1) ? (NB * TT + b * CT + qi) : (b * TT + qi);
    float q[H4], acc[H4];
    const bf16* qp = Z + (size_t)m * LDZ + QCOL + head * DH + part * H4;
#pragma unroll
    for (int i = 0; i < H4; ++i) { q[i] = bf2f(qp[i]); acc[i] = 0.f; }
    if (MODE != 2) { float ss = 0.f;
#pragma unroll
        for (int i = 0; i < H4; ++i) ss += q[i] * q[i];
        ss += __shfl_xor(ss, 1); ss += __shfl_xor(ss, 2); const float rstd = 1.f / sqrtf(ss * (1.f / DH) + EPS);
#pragma unroll
        for (int i = 0; i < H4; ++i) q[i] *= rstd * gq[part * H4 + i]; }
    if (MODE != 1) { const int t = qi;
#pragma unroll
        for (int i = 0; i < H4; ++i) { const int j = (part & 1) * H4 + i;
            const int pos = j < NF ? (t >> 6) : (t & 63), f = j % NF; const float c = rope[2 * (pos * NF + f)], s = rope[2 * (pos * NF + f) + 1];
            const float other = __shfl_xor(q[i], 2); q[i] = part < 2 ? (q[i] * c - other * s) : (q[i] * c + other * s); } }
    const float scale = (DH == 128) ? 0.08838834764831845f : 0.125f;
#pragma unroll
    for (int i = 0; i < H4; ++i) q[i] *= scale;
    float mx = (MODE == 2) ? sink[head] : -1e30f, l = (MODE == 2) ? 1.f : 0.f;
    const int lat_lo = (MODE == 0) ? 0 : (MODE == 2 ? max(0, qc * QPB - 128) : 0), lat_hi = (MODE == 0) ? TT : (MODE == 2 ? min(TT, qc * QPB + QPB + 128) : 0);
    const int nkeys = CT + (lat_hi - lat_lo);
#pragma unroll 2
    for (int kk = 0; kk < nkeys; ++kk) {
        const int kpos = kk - CT + lat_lo;
        const int km = kk < CT ? (NB * TT + b * CT + kk) : (b * TT + kpos);
        const bf16* kp = KB + (size_t)km * LDK + kvh * DH + part * H4;
        float s = 0.f;
#pragma unroll
        for (int i = 0; i < H4; ++i) s += q[i] * bf2f(kp[i]);
        s += __shfl_xor(s, 1); s += __shfl_xor(s, 2);
        if (MODE == 2 && kk >= CT && abs(kpos - qi) > 128) continue;
        const float mn = fmaxf(mx, s), al = expf(mx - mn), p = expf(s - mn);
        l = l * al + p; mx = mn;
        const bf16* vp = Z + (size_t)km * LDZ + VCOL + kvh * DH + part * H4;
#pragma unroll
        for (int i = 0; i < H4; ++i) acc[i] = acc[i] * al + p * bf2f(vp[i]);
    }
    const float il = 1.f / l;
    bf16* op = CAT + (size_t)m * DM + OCOL + head * DH + part * H4;
#pragma unroll
    for (int i = 0; i < H4; ++i) op[i] = (bf16)f2bf(acc[i] * il);
}
__device__ __forceinline__ void naive_mlstm(int seq, int tid, LAS float* sq, const bf16* Z, const float* GATES, const float* bgate, float* HF, float* HB) {
    const int b = seq >> 3, h = (seq >> 1) & 3, dir = seq & 1;
    LAS float* sk = sq + 128; LAS float* sred = sq + 256;
    const int v = tid >> 1, half = tid & 1, lane = tid & 63, wave = tid >> 6;
    float C[64];
#pragma unroll
    for (int j = 0; j < 64; ++j) C[j] = 0.f;
    float nreg = 0.f, mstate = 0.f;
    const float bi = bgate[(2 * dir) * 4 + h], bfg = bgate[(2 * dir + 1) * 4 + h];
    float* HO = dir ? HB : HF;
    for (int p = 0; p < SB; ++p) {
        const int s = dir == 0 ? p : (p < CT ? CT - 1 - p : CT + (SB - 1 - p));
        const int m = s < CT ? (NB * TT + b * CT + s) : (b * TT + s - CT);
        const bf16* zr = Z + (size_t)m * ZLD;
        if (tid < 128) sq[tid] = bf2f(zr[ZB_Q + h * 128 + tid]) * 0.08838834764831845f; else if (tid < 256) sk[tid - 128] = bf2f(zr[ZB_K + h * 128 + tid - 128]);
        const float vv = bf2f(zr[ZB_V + h * 256 + v]);
        const float ig = GATES[(size_t)m * 16 + (2 * dir) * 4 + h] + bi, lf = logsigmoid_acc(GATES[(size_t)m * 16 + (2 * dir + 1) * 4 + h] + bfg);
        const float mn = fmaxf(lf + mstate, ig), ip = expf(ig - mn), fp = expf(lf + mstate - mn); mstate = mn;
        __syncthreads();
        float dpart = 0.f; if (tid < 128) { nreg = fp * nreg + ip * sk[tid]; dpart = nreg * sq[tid]; }
        if (wave < 2) { dpart = wave_sum_l(dpart, lane); if (lane == 0) sred[wave] = dpart; }
        float np = 0.f; const float iv = ip * vv;
#pragma unroll
        for (int j = 0; j < 64; ++j) { C[j] = fp * C[j] + iv * sk[64 * half + j]; np += C[j] * sq[64 * half + j]; }
        np += __builtin_bit_cast(float, __builtin_amdgcn_ds_bpermute((lane ^ 1) << 2, __builtin_bit_cast(int, np)));
        __syncthreads();
        const float den = sred[0] + sred[1];
        if (half == 0) HO[(size_t)m * 1024 + h * 256 + v] = np / fmaxf(fabsf(den), expf(-mn));
        __syncthreads();
    }
}
__device__ __forceinline__ void naive_mlstm_finish(int gw, int lane, const bf16* Z, const float* HF, const float* HB, const float* headg, bf16* CAT) {
    const int m = gw >> 2, h = gw & 3; const size_t o = (size_t)m * 1024 + h * 256 + lane * 4;
    const f32x4 a = *(const f32x4*)(HF + o), bb = *(const f32x4*)(HB + o); const f32x4 hh = a + bb;
    const float rstd = 1.f / sqrtf(wave_sum_l((hh.x * hh.x + hh.y * hh.y) + (hh.z * hh.z + hh.w * hh.w), lane) * (1.f / 256.f) + EPS);
    const bf16* og = Z + (size_t)m * ZLD + ZB_O + h * 256 + lane * 4; bf16* cp = CAT + (size_t)m * DM + 1024 + h * 256 + lane * 4;
#pragma unroll
    for (int j = 0; j < 4; ++j) { const float sg = 1.f / (1.f + expf(-bf2f(og[j]))); cp[j] = (bf16)f2bf(sg * hh[j] * rstd * headg[h * 256 + lane * 4 + j]); }
}
__device__ __forceinline__ void naive_s5(int id, int lane, const bf16* Z, const float* s5ab, const float* s5bb, const float* cre_in, const float* cim_in, float* YF, float* YB) {
    const int b = id >> 7, g = (id >> 1) & 63, dir = id & 1;
    const int i = (dir * 64 + g) * 64 + lane;
    const float ar = s5ab[2 * i], ai = s5ab[2 * i + 1];
    float Br[16], Bi[16], cr[16], ci[16];
#pragma unroll
    for (int q = 0; q < 16; ++q) { Br[q] = s5bb[((size_t)i * 16 + q) * 2]; Bi[q] = s5bb[((size_t)i * 16 + q) * 2 + 1];
        cr[q] = cre_in[((size_t)(dir * 64 + g) * 16 + q) * 64 + lane]; ci[q] = cim_in[((size_t)(dir * 64 + g) * 16 + q) * 64 + lane]; }
    float xr = 0.f, xi = 0.f; float* Y = dir ? YB : YF;
    for (int p = 0; p < SB; ++p) {
        const int s = dir == 0 ? p : (p < CT ? CT - 1 - p : CT + (SB - 1 - p));
        const int m = s < CT ? (NB * TT + b * CT + s) : (b * TT + s - CT);
        const bf16* up = Z + (size_t)m * CD_IN + ZC_U + g * 16;
        float bur = 0.f, bui = 0.f;
#pragma unroll
        for (int q = 0; q < 16; ++q) { const float u = bf2f(up[q]); bur += Br[q] * u; bui += Bi[q] * u; }
        const float nxr = ar * xr - ai * xi + bur, nxi = ar * xi + ai * xr + bui; xr = nxr; xi = nxi;
        if (s >= CT) { float yo = 0.f;
#pragma unroll
            for (int q = 0; q < 16; ++q) { const float val = wave_sum_l(cr[q] * xr - ci[q] * xi, lane); if (lane == q) yo = val; }
            if (lane < 16) Y[(size_t)m * 1024 + g * 16 + lane] = yo; }
    }
}
__device__ __forceinline__ void naive_s5_finish(size_t i, const bf16* Z, const float* YF, const float* YB, const float* dskip, bf16* G) {
    const int m = (int)(i >> 10), c = (int)(i & 1023);
    const float y = YF[i] + YB[i] + dskip[c] * bf2f(Z[(size_t)m * CD_IN + ZC_U + c]);
    G[i] = (bf16)f2bf(gelu_tanh(y));
}
namespace att {
using bf16x8 = __attribute__((ext_vector_type(8))) short;
using s16x4  = __attribute__((ext_vector_type(4))) short;
using f32x16 = __attribute__((ext_vector_type(16))) float;
using u32x4  = __attribute__((ext_vector_type(4))) unsigned;
constexpr int NW = 8, QBLK = 32, KVBLK = 64;
constexpr size_t SHM_V = KVBLK * 128 * 2, SHM_K = KVBLK * 128 * 2, SHM_ATTN = 2 * SHM_V + 2 * SHM_K + NW * 64 * 4;
#define KSWZ(row, colB) ((row) * 256 + ((colB) ^ (((row) & 7) << 4)))
#define SBAR() __builtin_amdgcn_sched_barrier(0)
__device__ __forceinline__ int crow(int r, int hi) { return (r & 3) + 8 * (r >> 2) + 4 * hi; }
__device__ __forceinline__ unsigned cvtpk(float lo, float hi) { unsigned r; asm volatile("v_cvt_pk_bf16_f32 %0, %1, %2" : "=v"(r) : "v"(lo), "v"(hi)); return r; }
template <int DH> struct Cst { static constexpr float SCALE = (DH == 128) ? 0.088388347648318440f : 0.125f; };
constexpr float THR = 8.f;
#ifndef ATT_SDEPTH
#define ATT_SDEPTH 2
#endif
constexpr int SDEPTH = ATT_SDEPTH;
template <int DH> __device__ __forceinline__ void partialSM(f32x16& p0, f32x16& p1, float& m_reg, float& mn, float& alpha) {
  constexpr float SCALE = Cst<DH>::SCALE, C = SCALE * 1.4426950408889634f;
  float pmax = p0[0]; for (int r = 1; r < 16; ++r) pmax = fmaxf(pmax, p0[r]); for (int r = 0; r < 16; ++r) pmax = fmaxf(pmax, p1[r]);
  { auto rr = __builtin_amdgcn_permlane32_swap(__float_as_uint(pmax), __float_as_uint(pmax), false, false);
    pmax = fmaxf(__uint_as_float(rr[0]), __uint_as_float(rr[1])); }
  if (__builtin_expect(__all(pmax - m_reg <= THR / SCALE), 1)) { mn = m_reg; alpha = 1.f; }
  else { mn = fmaxf(m_reg, pmax); alpha = __builtin_amdgcn_exp2f((m_reg - mn) * C); m_reg = mn; }
  float mnC = -mn * C;
  for (int r = 0; r < 16; ++r) p0[r] = fmaf(p0[r], C, mnC); for (int r = 0; r < 16; ++r) p1[r] = fmaf(p1[r], C, mnC);
  for (int r = 0; r < 16; ++r) p0[r] = __builtin_amdgcn_exp2f(p0[r]);
}
__device__ __forceinline__ void finishSM(f32x16& p0, f32x16& p1, float alpha, float& l_reg, bf16x8& pa0, bf16x8& pa1, bf16x8& pa2, bf16x8& pa3) {
  for (int r = 0; r < 16; ++r) p1[r] = __builtin_amdgcn_exp2f(p1[r]);
  float ps = 0; for (int r = 0; r < 16; ++r) ps += p0[r]; for (int r = 0; r < 16; ++r) ps += p1[r];
  { auto rr = __builtin_amdgcn_permlane32_swap(__float_as_uint(ps), __float_as_uint(ps), false, false);
    ps = __uint_as_float(rr[0]) + __uint_as_float(rr[1]); }
  l_reg = l_reg * alpha + ps;
#define PK4(P, BASE, OUT) do { unsigned a0 = cvtpk(P[BASE + 0], P[BASE + 1]), a1 = cvtpk(P[BASE + 2], P[BASE + 3]);   \
    unsigned b0 = cvtpk(P[BASE + 4], P[BASE + 5]), b1 = cvtpk(P[BASE + 6], P[BASE + 7]);                              \
    auto r0 = __builtin_amdgcn_permlane32_swap(a0, b0, false, false); auto r1 = __builtin_amdgcn_permlane32_swap(a1, b1, false, false); \
    u32x4 w = {r0[0], r1[0], r0[1], r1[1]}; OUT = *reinterpret_cast<bf16x8*>(&w); } while (0)
  PK4(p0, 0, pa0); PK4(p0, 8, pa1); PK4(p1, 0, pa2); PK4(p1, 8, pa3);
#undef PK4
}
template <int DH> __device__ __forceinline__ void qkt(f32x16& p0, f32x16& p1, const bf16* Ks, const bf16x8* qr, int r32, int hi) {
  p0 = f32x16{}; p1 = f32x16{};
#pragma unroll
  for (int d0 = 0; d0 < DH / 16; ++d0) { int cb = (d0 * 16 + hi * 8) * 2;
    bf16x8 b0 = *reinterpret_cast<const bf16x8*>((const char*)Ks + KSWZ(r32, cb));
    bf16x8 b1 = *reinterpret_cast<const bf16x8*>((const char*)Ks + KSWZ(32 + r32, cb));
    p0 = __builtin_amdgcn_mfma_f32_32x32x16_bf16(b0, qr[d0], p0, 0, 0, 0);
    p1 = __builtin_amdgcn_mfma_f32_32x32x16_bf16(b1, qr[d0], p1, 0, 0, 0); }
}
__device__ __forceinline__ void wmask(f32x16& p0, f32x16& p1, int kp0, int qpos, int hi) {
#pragma unroll
  for (int r = 0; r < 16; ++r) { const int k = kp0 + crow(r, hi); const int d0 = k - qpos, d1 = k + 32 - qpos;
    if (d0 > 128 || d0 < -128) p0[r] = -1e30f; if (d1 > 128 || d1 < -128) p1[r] = -1e30f; }
}
__device__ __forceinline__ int v_st(int k, int c) { const int kk = (k & ~0xC) | ((k & 4) << 1) | ((k & 8) >> 1); return ((kk >> 3) * 4 + (c >> 5)) * 512 + ((kk & 7) * 32 + (c & 31)) * 2; }
__device__ __forceinline__ int v_rd_base(int lane) { return ((lane & 3) << 3) | (((lane >> 2) & 3) << 6) | (((lane >> 4) & 1) << 5) | (((lane >> 5) & 1) << 8); }
constexpr int v_rd_off(int d0, int ks, int half) { return d0 * 512 + ks * 4096 + half * 2048; }
template <int OFF> __device__ __forceinline__ s16x4 tr_read(int vb) {
  s16x4 r; asm volatile("ds_read_b64_tr_b16 %0, %1 offset:%2" : "=&v"(r) : "v"(vb), "i"(OFF) : "memory"); return r;
}
template <int D0> __device__ __forceinline__ void pv_one(f32x16& od, int vb, bf16x8 pa0, bf16x8 pa1, bf16x8 pa2, bf16x8 pa3) {
  const s16x4 l0 = tr_read<v_rd_off(D0, 0, 0)>(vb), h0 = tr_read<v_rd_off(D0, 0, 1)>(vb), l1 = tr_read<v_rd_off(D0, 1, 0)>(vb), h1 = tr_read<v_rd_off(D0, 1, 1)>(vb);
  const s16x4 l2 = tr_read<v_rd_off(D0, 2, 0)>(vb), h2 = tr_read<v_rd_off(D0, 2, 1)>(vb), l3 = tr_read<v_rd_off(D0, 3, 0)>(vb), h3 = tr_read<v_rd_off(D0, 3, 1)>(vb);
  asm volatile("s_waitcnt lgkmcnt(0)" ::: "memory"); SBAR();
#define PK(L, H) (bf16x8){L[0], L[1], L[2], L[3], H[0], H[1], H[2], H[3]}
  od = __builtin_amdgcn_mfma_f32_32x32x16_bf16(pa0, PK(l0, h0), od, 0, 0, 0);
  od = __builtin_amdgcn_mfma_f32_32x32x16_bf16(pa1, PK(l1, h1), od, 0, 0, 0);
  od = __builtin_amdgcn_mfma_f32_32x32x16_bf16(pa2, PK(l2, h2), od, 0, 0, 0);
  od = __builtin_amdgcn_mfma_f32_32x32x16_bf16(pa3, PK(l3, h3), od, 0, 0, 0);
#undef PK
}
template <int DH> __device__ __forceinline__ void pv_d0(f32x16* o, int vb, bf16x8 pa0, bf16x8 pa1, bf16x8 pa2, bf16x8 pa3) {
  pv_one<0>(o[0], vb, pa0, pa1, pa2, pa3); pv_one<1>(o[1], vb, pa0, pa1, pa2, pa3);
  if (DH == 128) { pv_one<2>(o[2], vb, pa0, pa1, pa2, pa3); pv_one<3>(o[3], vb, pa0, pa1, pa2, pa3); }
}
template <int DH, int MODE>
__device__ __forceinline__ void attn_unit(const bf16* __restrict__ Qb, int LDQ, const bf16* __restrict__ Kb, int LDKK, const bf16* __restrict__ Vb, int LDKV, bf16* __restrict__ Ob,
                                          int b, int i0  , const float* __restrict__ gq, const float* __restrict__ rope, float sinkv, char* lds, int wave_s) {
  const int tid = fresh_tid(wave_s);
  constexpr float SCALE = Cst<DH>::SCALE;
  const int wid = tid >> 6, lane = tid & 63, r32 = lane & 31, hi = lane >> 5;
  bf16* V_lds = (bf16*)lds; bf16* K_lds = (bf16*)(lds + 2 * SHM_V);
  float* ws = (float*)(lds + 2 * SHM_V + 2 * SHM_K) + wid * 64; float* li_l = ws; float* al_l = ws + 32;
  float m_reg = (MODE == 2) ? sinkv / SCALE : -1e30f, l_reg = (MODE == 2) ? 1.f : 0.f; f32x16 o[DH / 32] = {}; bf16x8 qr[DH / 16];
  const int qpos = i0 + wid * QBLK + r32;
  {
    const bf16* Qw = Qb + (long)(wid * QBLK + r32) * LDQ + hi * 8;
    float qf[DH / 16][8];
#pragma unroll
    for (int d0 = 0; d0 < DH / 16; ++d0) { const u32x4 w = *reinterpret_cast<const u32x4*>(Qw + d0 * 16);
#pragma unroll
      for (int e = 0; e < 4; ++e) { qf[d0][2 * e] = __uint_as_float(w[e] << 16); qf[d0][2 * e + 1] = __uint_as_float(w[e] & 0xffff0000u); } }
    if (MODE != 2) { float ss = 0.f;
#pragma unroll
      for (int d0 = 0; d0 < DH / 16; ++d0)
#pragma unroll
        for (int e = 0; e < 8; ++e) ss += qf[d0][e] * qf[d0][e];
      { auto rr = __builtin_amdgcn_permlane32_swap(__float_as_uint(ss), __float_as_uint(ss), false, false); ss = __uint_as_float(rr[0]) + __uint_as_float(rr[1]); }
      const float rstd = 1.f / sqrtf(ss * (1.f / DH) + EPS);
#pragma unroll
      for (int d0 = 0; d0 < DH / 16; ++d0)
#pragma unroll
        for (int e = 0; e < 8; ++e) qf[d0][e] *= rstd * ((const GAS float*)gq)[d0 * 16 + hi * 8 + e]; }
    if (MODE != 1) { constexpr int NF = DH / 4;
#pragma unroll
      for (int d0 = 0; d0 < DH / 32; ++d0)
#pragma unroll
        for (int e = 0; e < 8; ++e) { const int j = d0 * 16 + hi * 8 + e, pos = j < NF ? (qpos >> 6) : (qpos & 63), f = j % NF;
          const float c = ((const GAS float*)rope)[2 * (pos * NF + f)], s = ((const GAS float*)rope)[2 * (pos * NF + f) + 1], x1 = qf[d0][e], x2 = qf[d0 + DH / 32][e];
          qf[d0][e] = x1 * c - x2 * s; qf[d0 + DH / 32][e] = x2 * c + x1 * s; } }
#pragma unroll
    for (int d0 = 0; d0 < DH / 16; ++d0) { u32x4 w = {cvtpk(qf[d0][0], qf[d0][1]), cvtpk(qf[d0][2], qf[d0][3]), cvtpk(qf[d0][4], qf[d0][5]), cvtpk(qf[d0][6], qf[d0][7])}; qr[d0] = *reinterpret_cast<bf16x8*>(&w); }
  }
  const int kl0 = (MODE == 2) ? (i0 - 128 < 0 ? 0 : i0 - 128) : 0;
  const int kl1 = (MODE == 0) ? TT : (MODE == 2 ? (i0 + 384 > TT ? TT : i0 + 384) : 0);
  const int NT = 4 + (kl1 - kl0) / KVBLK;
  const long ctx0 = (long)NB * TT + (long)b * CT, lat0 = (long)b * TT + kl0;
#define TROW(j) ((j) < 4 ? ctx0 + (j) * KVBLK : lat0 + ((j) - 4) * KVBLK)
  const int sr = tid >> 4, sc = (tid & 15) * 8, vst0 = v_st(sr, sc), vst1 = v_st(32 + sr, sc);
  const bool ldok = (DH == 128) || sc < 64;
  const int vb0 = (int)(uintptr_t)V_lds + v_rd_base(lane);
  struct { bf16x8 vs0, vs1, ks0, ks1; } sr_[SDEPTH];
#pragma unroll
  for (int i_ = 0; i_ < SDEPTH; ++i_) sr_[i_].vs0 = sr_[i_].vs1 = sr_[i_].ks0 = sr_[i_].ks1 = bf16x8{};
#define SLOAD(i, j) do { if (ldok) { const long _r = TROW(j); sr_[i].vs0 = *reinterpret_cast<const bf16x8*>(&Vb[(_r + sr) * LDKV + sc]); sr_[i].vs1 = *reinterpret_cast<const bf16x8*>(&Vb[(_r + 32 + sr) * LDKV + sc]); \
    sr_[i].ks0 = *reinterpret_cast<const bf16x8*>(&Kb[(_r + sr) * LDKK + sc]); sr_[i].ks1 = *reinterpret_cast<const bf16x8*>(&Kb[(_r + 32 + sr) * LDKK + sc]); } } while (0)
#define SWRITE(bb, i) do { *(bf16x8*)((char*)V_lds + (bb) * SHM_V + vst0) = sr_[i].vs0;          \
    *(bf16x8*)((char*)V_lds + (bb) * SHM_V + vst1) = sr_[i].vs1; int kc = sc * 2;               \
    *(bf16x8*)((char*)K_lds + (bb) * SHM_K + KSWZ(sr, kc)) = sr_[i].ks0;                       \
    *(bf16x8*)((char*)K_lds + (bb) * SHM_K + KSWZ(32 + sr, kc)) = sr_[i].ks1; } while (0)
#define SWAIT() do { if (SDEPTH == 2) asm volatile("s_waitcnt vmcnt(4)" ::: "memory"); else asm volatile("s_waitcnt vmcnt(0)" ::: "memory"); } while (0)
#define RESC(a) do { if (__any((a) < 1.f)) { if (hi == 0) al_l[r32] = (a); asm volatile("s_waitcnt lgkmcnt(0)" ::: "memory"); \
    for (int d = 0; d < DH / 32; ++d) for (int r = 0; r < 16; ++r) o[d][r] *= al_l[crow(r, hi)]; } } while (0)
#define WMASK(P0, P1, j) do { if (MODE == 2 && (j) >= 4) wmask(P0, P1, kl0 + ((j) - 4) * KVBLK, qpos, hi); } while (0)
  f32x16 pA0, pA1, pB0, pB1; float mnA, mnB, alA, alB; bf16x8 pa0, pa1, pa2, pa3;
  constexpr int SE = 0, SO = SDEPTH - 1;
  SLOAD(SE, 0); asm volatile("s_waitcnt vmcnt(0)" ::: "memory"); SWRITE(0, SE); __syncthreads();
  qkt<DH>(pA0, pA1, K_lds, qr, r32, hi); WMASK(pA0, pA1, 0); partialSM<DH>(pA0, pA1, m_reg, mnA, alA);
  SLOAD(SO, 1); if (SDEPTH == 2) { if (2 < NT) SLOAD(SE, 2); }
  SWAIT(); SWRITE(1, SO); __syncthreads();
  for (int j = 1; j + 1 < NT; j += 2) {
    SBAR(); qkt<DH>(pB0, pB1, (bf16*)((char*)K_lds + SHM_K), qr, r32, hi); WMASK(pB0, pB1, j);
    finishSM(pA0, pA1, alA, l_reg, pa0, pa1, pa2, pa3); SBAR();
    SLOAD(SO, j + SDEPTH < NT ? j + SDEPTH : j); SBAR();
    pv_d0<DH>(o, vb0, pa0, pa1, pa2, pa3); partialSM<DH>(pB0, pB1, m_reg, mnB, alB);
    __syncthreads(); SWAIT(); SWRITE(0, SE);
    RESC(alB); __syncthreads();
    SBAR(); qkt<DH>(pA0, pA1, K_lds, qr, r32, hi); WMASK(pA0, pA1, j + 1);
    finishSM(pB0, pB1, alB, l_reg, pa0, pa1, pa2, pa3); SBAR();
    SLOAD(SE, j + 1 + SDEPTH < NT ? j + 1 + SDEPTH : j + 1); SBAR();
    pv_d0<DH>(o, vb0 + (int)SHM_V, pa0, pa1, pa2, pa3); partialSM<DH>(pA0, pA1, m_reg, mnA, alA);
    __syncthreads(); SWAIT(); SWRITE(1, SO);
    RESC(alA); __syncthreads();
  }
  SBAR(); qkt<DH>(pB0, pB1, (bf16*)((char*)K_lds + SHM_K), qr, r32, hi); WMASK(pB0, pB1, NT - 1);
  finishSM(pA0, pA1, alA, l_reg, pa0, pa1, pa2, pa3); SBAR();
  pv_d0<DH>(o, vb0, pa0, pa1, pa2, pa3); partialSM<DH>(pB0, pB1, m_reg, mnB, alB);
  __syncthreads(); RESC(alB);
  finishSM(pB0, pB1, alB, l_reg, pa0, pa1, pa2, pa3); SBAR();
  pv_d0<DH>(o, vb0 + (int)SHM_V, pa0, pa1, pa2, pa3);
  if (hi == 0) li_l[r32] = l_reg; asm volatile("s_waitcnt lgkmcnt(0)" ::: "memory");
  float rli[16];
#pragma unroll
  for (int r = 0; r < 16; ++r) rli[r] = __builtin_amdgcn_rcpf(li_l[crow(r, hi)]);
  bf16* Ow = Ob + (long)(wid * QBLK) * DM;
#pragma unroll
  for (int r = 0; r < 16; ++r) { int orow = crow(r, hi);
#pragma unroll
    for (int d0 = 0; d0 < DH / 32; ++d0) Ow[(long)orow * DM + d0 * 32 + r32] = (bf16)(cvtpk(o[d0][r] * rli[r], 0.f) & 0xffffu); }
  asm volatile("s_waitcnt vmcnt(0)" ::: "memory"); __syncthreads();
#undef SLOAD
#undef SWRITE
#undef SWAIT
#undef RESC
#undef WMASK
#undef TROW
}
}
namespace s5 {
using bf16x8 = __attribute__((ext_vector_type(8))) short;
using f32x16 = __attribute__((ext_vector_type(16))) float;
using f32x4v = __attribute__((ext_vector_type(4))) float;
using u32x4 = __attribute__((ext_vector_type(4))) unsigned;
using u32x2 = __attribute__((ext_vector_type(2))) unsigned;
constexpr int XROWB = 272;
constexpr int WAVE_LDS = 32 * XROWB;
__device__ __forceinline__ float bperm(float v, int srclane) { return __builtin_bit_cast(float, __builtin_amdgcn_ds_bpermute(srclane << 2, __builtin_bit_cast(int, v))); }
__device__ __forceinline__ float gelu_fast(float x) { const float u = 0.7978845608028654f * (x + 0.044715f * x * x * x); return x * __builtin_amdgcn_rcpf(1.f + __builtin_amdgcn_exp2f(-2.885390081777927f * u)); }
__device__ __forceinline__ void cmul(float& r, float& i, float ar, float ai) { const float nr = ar * r - ai * i, ni = ar * i + ai * r; r = nr; i = ni; }
__device__ __forceinline__ size_t seg_row0(int b, int seg) { return seg < 16 ? (size_t)b * TT + seg * 256 : (size_t)NB * TT + b * CT; }
template <int PASS>
__device__ __forceinline__ void s5_unit(int b, int g, int seg, const bf16* __restrict__ Z2, const float* __restrict__ s5ab, const bf16* __restrict__ BT, const bf16* __restrict__ CTb,
                                        float* __restrict__ SEND, const float* __restrict__ dskip, bf16* __restrict__ G, float* __restrict__ YT, LAS unsigned char* xl) {
  const int lane = fresh_lane();
  const int r32 = lane & 31, hi = lane >> 5, fr = lane & 15, fq = lane >> 4;
  const size_t row0 = seg_row0(b, seg);
  const int tau = 16 * ((r32 >> 2) & 1) + 4 * (r32 >> 3) + (r32 & 3);
#pragma unroll
  for (int dir = 0; dir < 2; ++dir) {
    const int dg = dir * 64 + g;
    float ar[2], ai[2], a16r[2], a16i[2];
#pragma unroll
    for (int s = 0; s < 2; ++s) { typedef float f32x2s __attribute__((ext_vector_type(2))); const f32x2s v = *(const GAS f32x2s*)(s5ab + 2 * (dg * 64 + r32 + 32 * s)); ar[s] = v.x; ai[s] = v.y; a16r[s] = v.x; a16i[s] = v.y;
#pragma unroll
      for (int k = 0; k < 4; ++k) cmul(a16r[s], a16i[s], a16r[s], a16i[s]); }
    bf16x8 bfr[4];
#pragma unroll
    for (int k = 0; k < 4; ++k) bfr[k] = *(const GAS bf16x8*)(BT + ((size_t)dg * 128 + 32 * k + r32) * 16 + hi * 8);
    float cr[2] = {0.f, 0.f}, ci[2] = {0.f, 0.f};
    if (PASS == 2) {
      float a256r[2], a256i[2];
#pragma unroll
      for (int s = 0; s < 2; ++s) { a256r[s] = a16r[s]; a256i[s] = a16i[s];
#pragma unroll
        for (int k = 0; k < 4; ++k) cmul(a256r[s], a256i[s], a256r[s], a256i[s]); }
      const float* Sb = SEND + ((size_t)(dir * NB + b) * 64 + g) * 17 * 128;
      { const float* p = Sb + 16 * 128;
#pragma unroll
        for (int s = 0; s < 2; ++s) { cr[s] = p[r32 + 32 * s]; ci[s] = p[64 + r32 + 32 * s]; } }
      const int nprev = dir == 0 ? seg : 15 - seg;
#pragma unroll 1
      for (int k = 0; k < nprev; ++k) { const float* p = Sb + (dir == 0 ? k : 15 - k) * 128;
#pragma unroll
        for (int s = 0; s < 2; ++s) { cmul(cr[s], ci[s], a256r[s], a256i[s]); cr[s] += p[r32 + 32 * s]; ci[s] += p[64 + r32 + 32 * s]; } }
    }
    const bf16* CT_dg = CTb + (size_t)dg * 16 * 128;
    bf16x8 cfr[4]; f32x4v dk = {0.f, 0.f, 0.f, 0.f};
    if (PASS == 2) { dk = *(const GAS f32x4v*)(dskip + g * 16 + 4 * fq);
#pragma unroll
      for (int ks = 0; ks < 4; ++ks) cfr[ks] = *(const GAS bf16x8*)(CT_dg + fr * 128 + 32 * ks + 8 * fq); }
    const int rloc = dir == 0 ? tau : 31 - tau;
    bf16x8 ufr_n = *(const GAS bf16x8*)(Z2 + (row0 + 32 * (dir == 0 ? 0 : 7) + rloc) * CD_IN + ZC_U + g * 16 + hi * 8);
#pragma unroll 1
    for (int qq = 0; qq < 8; ++qq) {
      const int q = dir == 0 ? qq : 7 - qq;
      const bf16x8 ufr = ufr_n;
      { const int qn = qq < 7 ? (dir == 0 ? qq + 1 : 6 - qq) : q;
        ufr_n = *(const GAS bf16x8*)(Z2 + (row0 + 32 * qn + rloc) * CD_IN + ZC_U + g * 16 + hi * 8); }
      f32x4v yfp[2]; u32x2 uwp[2];
      if (PASS == 2 && dir == 1) {
#pragma unroll
        for (int mb = 0; mb < 2; ++mb) { const size_t row = row0 + 32 * q + 16 * mb + fr; yfp[mb] = *(const GAS f32x4v*)(YT + row * 1024 + g * 16 + 4 * fq); uwp[mb] = *(const GAS u32x2*)(Z2 + row * CD_IN + ZC_U + g * 16 + 4 * fq); } }
      f32x16 bu[4];
#pragma unroll
      for (int k = 0; k < 4; ++k) { bu[k] = f32x16{}; bu[k] = __builtin_amdgcn_mfma_f32_32x32x16_bf16(ufr, bfr[k], bu[k], 0, 0, 0); }
      typedef float f2 __attribute__((ext_vector_type(2)));
      const f2 Ar = {ar[0], ar[1]}, Ai = {ai[0], ai[1]}, A16r = {a16r[0], a16r[1]}, A16i = {a16i[0], a16i[1]};
      { f2 xr = {0.f, 0.f}, xi = {0.f, 0.f};
#pragma unroll
        for (int r = 0; r < 16; ++r) { const f2 br = {bu[0][r], bu[1][r]}, bi = {bu[2][r], bu[3][r]};
          const f2 nr = Ar * xr - Ai * xi + br, ni = Ar * xi + Ai * xr + bi; xr = nr; xi = ni; bu[0][r] = xr.x; bu[1][r] = xr.y; bu[2][r] = xi.x; bu[3][r] = xi.y; } }
      { const f2 per = {bperm(bu[0][15], lane ^ 32), bperm(bu[1][15], lane ^ 32)}, pei = {bperm(bu[2][15], lane ^ 32), bperm(bu[3][15], lane ^ 32)};
        const f2 Cr = {cr[0], cr[1]}, Ci = {ci[0], ci[1]};
        const f2 c1r = A16r * Cr - A16i * Ci + per, c1i = A16r * Ci + A16i * Cr + pei;
        f2 cxr = hi ? c1r : Cr, cxi = hi ? c1i : Ci;
#pragma unroll
        for (int r = 0; r < 16; ++r) { const f2 nr = Ar * cxr - Ai * cxi, ni = Ar * cxi + Ai * cxr; cxr = nr; cxi = ni; bu[0][r] += cxr.x; bu[1][r] += cxr.y; bu[2][r] += cxi.x; bu[3][r] += cxi.y; }
#pragma unroll
        for (int s = 0; s < 2; ++s) { const float ner = bperm(bu[s][15], lane ^ 32), nei = bperm(bu[2 + s][15], lane ^ 32);
          cr[s] = hi ? bu[s][15] : ner; ci[s] = hi ? bu[2 + s][15] : nei; } }
      if (PASS == 2) {
#pragma unroll
        for (int k = 0; k < 4; ++k)
#pragma unroll
          for (int r = 0; r < 16; r += 2) { const int st = 16 * hi + r, rl = dir == 0 ? st : 31 - st, rl1 = dir == 0 ? st + 1 : 30 - st;
            const unsigned pk = att::cvtpk(bu[k][r], bu[k][r + 1]);
            *(LAS unsigned short*)(xl + rl * XROWB + (32 * k + r32) * 2) = (unsigned short)pk; *(LAS unsigned short*)(xl + rl1 * XROWB + (32 * k + r32) * 2) = (unsigned short)(pk >> 16); }
        asm volatile("s_waitcnt lgkmcnt(0)" ::: "memory");
        f32x4v acc2[2] = {(f32x4v){0.f, 0.f, 0.f, 0.f}, (f32x4v){0.f, 0.f, 0.f, 0.f}};
#pragma unroll
        for (int ks = 0; ks < 4; ++ks) { const bf16x8 cf = cfr[ks];
#pragma unroll
          for (int mb = 0; mb < 2; ++mb) { const bf16x8 xf = *(const LAS bf16x8*)(xl + (16 * mb + fr) * XROWB + (32 * ks + 8 * fq) * 2);
            acc2[mb] = __builtin_amdgcn_mfma_f32_16x16x32_bf16(cf, xf, acc2[mb], 0, 0, 0); } }
        asm volatile("s_waitcnt lgkmcnt(0)" ::: "memory");
#pragma unroll
        for (int mb = 0; mb < 2; ++mb) { const size_t row = row0 + 32 * q + 16 * mb + fr; float* yt = YT + row * 1024 + g * 16 + 4 * fq;
          if (dir == 0) *(GAS f32x4v*)yt = acc2[mb];
          else { const f32x4v yf = yfp[mb];
            const u32x2 uw = uwp[mb];
            const float u0 = __builtin_bit_cast(float, uw.x << 16), u1 = __builtin_bit_cast(float, uw.x & 0xffff0000u), u2 = __builtin_bit_cast(float, uw.y << 16), u3 = __builtin_bit_cast(float, uw.y & 0xffff0000u);
            const float y0 = gelu_fast(acc2[mb][0] + yf[0] + dk[0] * u0), y1 = gelu_fast(acc2[mb][1] + yf[1] + dk[1] * u1), y2 = gelu_fast(acc2[mb][2] + yf[2] + dk[2] * u2), y3 = gelu_fast(acc2[mb][3] + yf[3] + dk[3] * u3);
            u32x2 w; w.x = pk2(y0, y1); w.y = pk2(y2, y3);
            *(GAS u32x2*)(G + row * 1024 + g * 16 + 4 * fq) = w; } }
      }
    }
    if (PASS == 1) { float* p = SEND + (((size_t)(dir * NB + b) * 64 + g) * 17 + seg) * 128;
      if (hi == 0) {
#pragma unroll
        for (int s = 0; s < 2; ++s) { p[r32 + 32 * s] = cr[s]; p[64 + r32 + 32 * s] = ci[s]; } } }
    if (PASS == 2) asm volatile("s_waitcnt vmcnt(0)" ::: "memory");
  }
}
}
namespace ml {
using bf16x8 = __attribute__((ext_vector_type(8))) short;
using f32x16 = __attribute__((ext_vector_type(16))) float;
using f32x4v = __attribute__((ext_vector_type(4))) float;
using u32x4 = __attribute__((ext_vector_type(4))) unsigned;
using u32x2 = __attribute__((ext_vector_type(2))) unsigned;
constexpr int NSEQ = NB * 4 * 2, NBLK = 17;
constexpr size_t CST_BYTES = (size_t)NSEQ * NBLK * 256 * 128 * 2;
constexpr size_t NST_OFF = CST_BYTES, MST_OFF = NST_OFF + (size_t)NSEQ * NBLK * 128 * 4, ST_END = MST_OFF + (size_t)NSEQ * NBLK * 4;
__device__ __forceinline__ float bperm(float v, int srclane) { return __builtin_bit_cast(float, __builtin_amdgcn_ds_bpermute(srclane << 2, __builtin_bit_cast(int, v))); }
__device__ __forceinline__ float swap_add(float v) { auto rr = __builtin_amdgcn_permlane32_swap(__float_as_uint(v), __float_as_uint(v), false, false); return __uint_as_float(rr[0]) + __uint_as_float(rr[1]); }
__device__ __forceinline__ float wmax(float v, int lane) {
#pragma unroll
  for (int o = 1; o < 64; o <<= 1) v = fmaxf(v, bperm(v, lane ^ o));
  return v;
}
__device__ __forceinline__ size_t blk_row0(int b, int blkid) { return blkid == 0 ? (size_t)NB * TT + b * CT : (size_t)b * TT + (blkid - 1) * 256; }
__device__ __forceinline__ int seq_blk(int dir, int j) { return j == 0 ? 0 : (dir == 0 ? j : 17 - j); }
__device__ __forceinline__ int blk_seq(int dir, int blkid) { return blkid == 0 ? 0 : (dir == 0 ? blkid : 17 - blkid); }
struct GateRaw { float ig[4], fg[4]; };
__device__ __forceinline__ GateRaw gate_load(const float* __restrict__ GATES, size_t row0, int h, int dir, int lane) {
  GateRaw g;
#pragma unroll
  for (int i = 0; i < 4; ++i) { const int p = 4 * lane + i, r = dir ? 255 - p : p; const GAS float* gp = (const GAS float*)GATES + (row0 + r) * 16; g.ig[i] = gp[(2 * dir) * 4 + h]; g.fg[i] = gp[(2 * dir + 1) * 4 + h]; }
  return g;
}
__device__ __forceinline__ void gate_math(const GateRaw& g, const float* __restrict__ bg, int h, int dir, int lane, float (&F)[4], float (&Bt)[4], float (&ML)[4], float& b_last, float& bmax) {
  float ig[4], c = 0.f;
#pragma unroll
  for (int i = 0; i < 4; ++i) { ig[i] = g.ig[i]; c += g.fg[i]; F[i] = c; }
  float inc = c;
#pragma unroll
  for (int o = 1; o < 64; o <<= 1) { const float t = bperm(inc, lane - o); if (lane >= o) inc += t; }
  const float exc = inc - c;
  b_last = bperm(inc, 63);
  float mx = -3.0e38f;
#pragma unroll
  for (int i = 0; i < 4; ++i) { F[i] += exc; Bt[i] = ig[i] - F[i]; mx = fmaxf(mx, Bt[i]); ML[i] = mx; }
  float imx = mx;
#pragma unroll
  for (int o = 1; o < 64; o <<= 1) { const float t = bperm(imx, lane - o); if (lane >= o) imx = fmaxf(imx, t); }
  const float emx = bperm(imx, lane - 1);
  if (lane > 0) {
#pragma unroll
    for (int i = 0; i < 4; ++i) ML[i] = fmaxf(ML[i], emx); }
  bmax = bperm(imx, 63);
}
__device__ __forceinline__ void gate_scan(const float* __restrict__ GATES, const float* __restrict__ bg, size_t row0, int h, int dir, int lane, float (&F)[4], float (&Bt)[4], float (&ML)[4], float& b_last, float& bmax) {
  const GateRaw g = gate_load(GATES, row0, h, dir, lane); gate_math(g, bg, h, dir, lane, F, Bt, ML, b_last, bmax);
}
__device__ __forceinline__ void l1_unit(int seq, int vblk, int dblk, const bf16* __restrict__ ZT, const float* __restrict__ GATES, const float* __restrict__ bg, unsigned char* __restrict__ ST, LAS float* wt  ) {
  const int lane = fresh_lane();
  const int b = seq >> 3, h = (seq >> 1) & 3, dir = seq & 1, r32 = lane & 31, hi = lane >> 5;
  f32x16 acc = f32x16{}; float npart = 0.f, m = 0.f;
  const bf16* kT = ZT + (size_t)(h * 128 + 32 * dblk + r32) * MR + 8 * hi;
  const bf16* vT = ZT + (size_t)(512 + h * 256 + 32 * vblk + r32) * MR + 8 * hi;
  bf16* CS = (bf16*)ST; float* NS = (float*)(ST + NST_OFF); float* MS = (float*)(ST + MST_OFF);
  bf16x8 fa[8], fb[8]; u32x4 ka[8], kb[8];
  size_t row0 = blk_row0(b, seq_blk(dir, 0));
  GateRaw gr = gate_load(GATES, row0, h, dir, lane);
#pragma unroll
  for (int ks = 0; ks < 8; ++ks) { fa[ks] = *(const GAS bf16x8*)(vT + row0 + 16 * ks); ka[ks] = *(const GAS u32x4*)(kT + row0 + 16 * ks); }
#define L1_STEPS(FV, FK, KS0) _Pragma("unroll") for (int ks = 0; ks < 8; ++ks) { const int tok = 16 * ((KS0) + ks) + 8 * hi; \
      const f32x4v w0 = *(const LAS f32x4v*)(wt + tok), w1 = *(const LAS f32x4v*)(wt + tok + 4); const u32x4 kw = FK[ks]; float kf[8]; \
      _Pragma("unroll") for (int e = 0; e < 4; ++e) { kf[2 * e] = __uint_as_float(kw[e] << 16); kf[2 * e + 1] = __uint_as_float(kw[e] & 0xffff0000u); } \
      kf[0] *= w0[0]; kf[1] *= w0[1]; kf[2] *= w0[2]; kf[3] *= w0[3]; kf[4] *= w1[0]; kf[5] *= w1[1]; kf[6] *= w1[2]; kf[7] *= w1[3]; \
      npart += ((kf[0] + kf[1]) + (kf[2] + kf[3])) + ((kf[4] + kf[5]) + (kf[6] + kf[7])); \
      u32x4 kq = {att::cvtpk(kf[0], kf[1]), att::cvtpk(kf[2], kf[3]), att::cvtpk(kf[4], kf[5]), att::cvtpk(kf[6], kf[7])}; \
      acc = __builtin_amdgcn_mfma_f32_32x32x16_bf16(FV[ks], *reinterpret_cast<bf16x8*>(&kq), acc, 0, 0, 0); }
#pragma unroll 1
  for (int j = 0; j < NBLK; ++j) {
    { bf16* cp = CS + ((size_t)(seq * NBLK + j) * 256 + 32 * vblk) * 128 + 32 * dblk + r32;
#pragma unroll
      for (int r = 0; r < 16; ++r) cp[(size_t)att::crow(r, hi) * 128] = (bf16)f2bf(acc[r]);
      if (vblk == 0) { const float nt = npart + bperm(npart, lane ^ 32); if (hi == 0) NS[(size_t)(seq * NBLK + j) * 128 + 32 * dblk + r32] = nt; if (dblk == 0 && lane == 0) MS[seq * NBLK + j] = m; } }
    if (j == NBLK - 1) break;
    float F[4], Bt[4], ML[4], b_last, bmax;
    gate_math(gr, bg, h, dir, lane, F, Bt, ML, b_last, bmax);
    const size_t row_n = blk_row0(b, seq_blk(dir, j + 1 < NBLK - 1 ? j + 1 : j));
    gr = gate_load(GATES, row_n, h, dir, lane);
    const float Mf = fmaxf(m, bmax), decay = expf(m - Mf);
#pragma unroll
    for (int i = 0; i < 4; ++i) { const int p = 4 * lane + i, r = dir ? 255 - p : p; wt[r] = expf(Bt[i] - Mf); }
    asm volatile("s_waitcnt lgkmcnt(0)" ::: "memory");
    acc = acc * decay; npart *= decay; m = b_last + Mf;
#pragma unroll
    for (int ks = 0; ks < 8; ++ks) { fb[ks] = *(const GAS bf16x8*)(vT + row0 + 128 + 16 * ks); kb[ks] = *(const GAS u32x4*)(kT + row0 + 128 + 16 * ks); }
    L1_STEPS(fa, ka, 0)
#pragma unroll
    for (int ks = 0; ks < 8; ++ks) { fa[ks] = *(const GAS bf16x8*)(vT + row_n + 16 * ks); ka[ks] = *(const GAS u32x4*)(kT + row_n + 16 * ks); }
    L1_STEPS(fb, kb, 8)
    row0 = row_n;
  }
#undef L1_STEPS
}
__device__ __forceinline__ void l2_unit(int b, int h, int blkid, int dvh, const bf16* __restrict__ Z, const float* __restrict__ GATES, const float* __restrict__ bg,
                                        const unsigned char* __restrict__ ST, float* __restrict__ HH, char* lds, LAS float* btab, int wave_s) {
  const int tid = fresh_tid(wave_s), wid = tid >> 6, lane = tid & 63, r32 = lane & 31, hi = lane >> 5;
  const size_t row0 = blk_row0(b, blkid);
  const int t0 = wid * 32, t = t0 + r32;
  const bf16* CS = (const bf16*)ST; const float* NS = (const float*)(ST + NST_OFF); const float* MS = (const float*)(ST + MST_OFF);
  { const int sr = tid >> 4, sc = (tid & 15) * 8, vst0 = att::v_st(sr, sc), vst1 = att::v_st(32 + sr, sc), kc = sc * 2;
    const bf16* kb = Z + (row0 + sr) * ZLD + ZB_K + h * 128 + sc; const bf16* vb = Z + (row0 + sr) * ZLD + ZB_V + h * 256 + dvh * 128 + sc;
#pragma unroll
    for (int kt = 0; kt < 4; ++kt) {
      const bf16x8 k0 = *(const GAS bf16x8*)(kb + (size_t)(64 * kt) * ZLD), k1 = *(const GAS bf16x8*)(kb + (size_t)(64 * kt + 32) * ZLD);
      const bf16x8 v0 = *(const GAS bf16x8*)(vb + (size_t)(64 * kt) * ZLD), v1 = *(const GAS bf16x8*)(vb + (size_t)(64 * kt + 32) * ZLD);
      *(bf16x8*)(lds + kt * 16384 + KSWZ(sr, kc)) = k0; *(bf16x8*)(lds + kt * 16384 + KSWZ(32 + sr, kc)) = k1;
      *(bf16x8*)(lds + 65536 + kt * 16384 + vst0) = v0; *(bf16x8*)(lds + 65536 + kt * 16384 + vst1) = v1; } }
  bf16x8 qf[8];
  { const bf16* qp = Z + (row0 + t) * ZLD + ZB_Q + h * 128 + hi * 8;
#pragma unroll
    for (int d0 = 0; d0 < 8; ++d0) { const u32x4 w = *(const GAS u32x4*)(qp + 16 * d0); u32x4 o;
#pragma unroll
      for (int e = 0; e < 4; ++e) o[e] = att::cvtpk(__uint_as_float(w[e] << 16) * 0.08838834764831845f, __uint_as_float(w[e] & 0xffff0000u) * 0.08838834764831845f);
      qf[d0] = *reinterpret_cast<bf16x8*>(&o); } }
  __syncthreads();
  f32x16 o[4];
#pragma unroll
  for (int nb = 0; nb < 4; ++nb) o[nb] = f32x16{};
  const int vbase = (int)(uintptr_t)(lds + 65536) + att::v_rd_base(lane);
#define ML_STILE(kt) f32x16 p0, p1; att::qkt<128>(p0, p1, (const bf16*)(lds + (kt) * 16384), qf, r32, hi); \
      _Pragma("unroll") for (int r = 0; r < 16; ++r) { const int k0i = 64 * (kt) + att::crow(r, hi), k1i = k0i + 32; \
        const bool v0 = dir == 0 ? (k0i <= t) : (k0i >= t), v1 = dir == 0 ? (k1i <= t) : (k1i >= t); \
        p0[r] = v0 ? p0[r] * __expf(btab[k0i] - Mt) : 0.f; p1[r] = v1 ? p1[r] * __expf(btab[k1i] - Mt) : 0.f; }
#pragma unroll
  for (int dir = 0; dir < 2; ++dir) {
    const int seq = (b * 4 + h) * 2 + dir, j = blk_seq(dir, blkid);
    const float m_prev = ((const GAS float*)MS)[seq * NBLK + j];
    float Mt, Ft;
    { float F[4], Bt[4], ML[4], b_last, bmax;
      gate_scan(GATES, bg, row0, h, dir, lane, F, Bt, ML, b_last, bmax);
#pragma unroll
      for (int i = 0; i < 4; ++i) { const int p = 4 * lane + i, r = dir ? 255 - p : p; btab[r] = Bt[i]; }
      const int pp = dir ? 255 - t : t, src = pp >> 2, e = pp & 3;
      const float m0 = bperm(fmaxf(m_prev, ML[0]), src), m1 = bperm(fmaxf(m_prev, ML[1]), src), m2 = bperm(fmaxf(m_prev, ML[2]), src), m3 = bperm(fmaxf(m_prev, ML[3]), src);
      const float f0 = bperm(F[0], src), f1 = bperm(F[1], src), f2 = bperm(F[2], src), f3 = bperm(F[3], src);
      Mt = e == 0 ? m0 : (e == 1 ? m1 : (e == 2 ? m2 : m3)); Ft = e == 0 ? f0 : (e == 1 ? f1 : (e == 2 ? f2 : f3)); }
    asm volatile("s_waitcnt lgkmcnt(0)" ::: "memory");
    const float w_inter = expf(m_prev - Mt), floorv = expf(-Ft - Mt);
    float den;
    { const GAS float* np = (const GAS float*)NS + (size_t)(seq * NBLK + j) * 128 + hi * 8; float dot = 0.f;
#pragma unroll
      for (int d0 = 0; d0 < 8; ++d0) { const u32x4 w = *reinterpret_cast<const u32x4*>(&qf[d0]); const f32x4v n0 = *(const GAS f32x4v*)(np + 16 * d0), n1 = *(const GAS f32x4v*)(np + 16 * d0 + 4);
        dot += __uint_as_float(w[0] << 16) * n0[0] + __uint_as_float(w[0] & 0xffff0000u) * n0[1] + __uint_as_float(w[1] << 16) * n0[2] + __uint_as_float(w[1] & 0xffff0000u) * n0[3]
             + __uint_as_float(w[2] << 16) * n1[0] + __uint_as_float(w[2] & 0xffff0000u) * n1[1] + __uint_as_float(w[3] << 16) * n1[2] + __uint_as_float(w[3] & 0xffff0000u) * n1[3]; }
      den = w_inter * swap_add(dot); }
    const bf16* cb = CS + ((size_t)(seq * NBLK + j) * 256 + dvh * 128 + r32) * 128 + hi * 8;
    { float rsum = 0.f;
#pragma unroll 1
      for (int kt = 0; kt < 4; ++kt) {
        if (dir == 0 ? (64 * kt > t0 + 31) : (64 * kt + 63 < t0)) continue;
        ML_STILE(kt);
#pragma unroll
        for (int r = 0; r < 16; ++r) rsum += p0[r] + p1[r]; }
      den += swap_add(rsum); }
    const float inv = 1.f / fmaxf(fabsf(den), floorv);
    { const float sc = w_inter * inv;
#pragma unroll
      for (int hb = 0; hb < 2; ++hb) {
        bf16x8 cf[4][4];
#pragma unroll
        for (int d0 = 0; d0 < 4; ++d0)
#pragma unroll
          for (int nb = 0; nb < 4; ++nb) cf[d0][nb] = *(const GAS bf16x8*)(cb + (size_t)(32 * nb) * 128 + 16 * (4 * hb + d0));
#pragma unroll
        for (int d0 = 0; d0 < 4; ++d0) { const u32x4 w = *reinterpret_cast<const u32x4*>(&qf[4 * hb + d0]); u32x4 qs;
#pragma unroll
          for (int e = 0; e < 4; ++e) qs[e] = att::cvtpk(__uint_as_float(w[e] << 16) * sc, __uint_as_float(w[e] & 0xffff0000u) * sc);
#pragma unroll
          for (int nb = 0; nb < 4; ++nb) o[nb] = __builtin_amdgcn_mfma_f32_32x32x16_bf16(*reinterpret_cast<bf16x8*>(&qs), cf[d0][nb], o[nb], 0, 0, 0); }
        __builtin_amdgcn_sched_barrier(0); } }
#pragma unroll 1
    for (int kt = 0; kt < 4; ++kt) {
      if (dir == 0 ? (64 * kt > t0 + 31) : (64 * kt + 63 < t0)) continue;
      ML_STILE(kt);
#pragma unroll
      for (int r = 0; r < 16; ++r) { p0[r] *= inv; p1[r] *= inv; }
      bf16x8 pa0, pa1, pa2, pa3;
#define PK4(P, BASE, OUT) do { unsigned a0 = att::cvtpk(P[BASE + 0], P[BASE + 1]), a1 = att::cvtpk(P[BASE + 2], P[BASE + 3]);   \
    unsigned b0 = att::cvtpk(P[BASE + 4], P[BASE + 5]), b1 = att::cvtpk(P[BASE + 6], P[BASE + 7]);                              \
    auto r0 = __builtin_amdgcn_permlane32_swap(a0, b0, false, false); auto r1 = __builtin_amdgcn_permlane32_swap(a1, b1, false, false); \
    u32x4 w = {r0[0], r1[0], r0[1], r1[1]}; OUT = *reinterpret_cast<bf16x8*>(&w); } while (0)
      PK4(p0, 0, pa0); PK4(p0, 8, pa1); PK4(p1, 0, pa2); PK4(p1, 8, pa3);
#undef PK4
      att::pv_d0<128>(o, vbase + kt * 16384, pa0, pa1, pa2, pa3);
    }
  }
#undef ML_STILE
  { const int l2_ = fresh_lane(), hi2 = l2_ >> 5; float* Ow = HH + (blk_row0(b, blkid) + wid * 32) * 1024 + h * 256 + dvh * 128 + (l2_ & 31);
#pragma unroll
    for (int r = 0; r < 16; ++r)
#pragma unroll
      for (int nb = 0; nb < 4; ++nb) Ow[(size_t)att::crow(r, hi2) * 1024 + nb * 32] = o[nb][r]; }
  asm volatile("s_waitcnt vmcnt(0)" ::: "memory"); __syncthreads();
}
__device__ __forceinline__ void finish_pass(int gw, int NGW, int lane, const bf16* Z, const float* HH, const float* headg, bf16* CAT) {
  f32x4v hn[4]; u32x2 on[4];
  if (gw < MR) {
#pragma unroll
    for (int h = 0; h < 4; ++h) { hn[h] = *(const GAS f32x4v*)(HH + (size_t)gw * 1024 + h * 256 + lane * 4); on[h] = *(const GAS u32x2*)(Z + (size_t)gw * ZLD + ZB_O + h * 256 + lane * 4); } }
  f32x4v g4[4];
#pragma unroll
  for (int h = 0; h < 4; ++h) g4[h] = *(const GAS f32x4v*)(headg + h * 256 + lane * 4);
  for (int m = gw; m < MR; m += NGW) {
    f32x4v hh[4]; u32x2 ow[4];
#pragma unroll
    for (int h = 0; h < 4; ++h) { hh[h] = hn[h]; ow[h] = on[h]; }
    const int m2 = m + NGW;
    if (m2 < MR) {
#pragma unroll
      for (int h = 0; h < 4; ++h) { hn[h] = *(const GAS f32x4v*)(HH + (size_t)m2 * 1024 + h * 256 + lane * 4); on[h] = *(const GAS u32x2*)(Z + (size_t)m2 * ZLD + ZB_O + h * 256 + lane * 4); } }
#pragma unroll
    for (int h = 0; h < 4; ++h) {
      const float rstd = 1.f / sqrtf(wave_sum_l((hh[h][0] * hh[h][0] + hh[h][1] * hh[h][1]) + (hh[h][2] * hh[h][2] + hh[h][3] * hh[h][3]), lane) * (1.f / 256.f) + EPS);
      const float o0 = __uint_as_float(ow[h].x << 16), o1 = __uint_as_float(ow[h].x & 0xffff0000u), o2 = __uint_as_float(ow[h].y << 16), o3 = __uint_as_float(ow[h].y & 0xffff0000u);
      u32x2 w; w.x = pk2(hh[h][0] * rstd * g4[h][0] / (1.f + __expf(-o0)), hh[h][1] * rstd * g4[h][1] / (1.f + __expf(-o1))); w.y = pk2(hh[h][2] * rstd * g4[h][2] / (1.f + __expf(-o2)), hh[h][3] * rstd * g4[h][3] / (1.f + __expf(-o3)));
      *(GAS u32x2*)(CAT + (size_t)m * DM + 1024 + h * 256 + lane * 4) = w; }
  }
}
}
struct Args { const float* in[30]; float* out; unsigned char* ws; int ph_lo, ph_hi, li, pad; };
constexpr int PH_P0 = 0, PH_P1 = 1, PH_L0 = 2, PH_PER_LAYER = 13, PH_FINAL = 28, N_PHASES = 29;
enum { O_F1N = 0, O_F1U, O_F1D, O_MN, O_MI, O_MP, O_MA, O_MF, O_MG, O_MO, O_F2N, O_F2U, O_F2D };
#ifndef DUP_MASK
#define DUP_MASK 0
#endif
#ifndef PROBE_K
#define PROBE_K -1
#endif
#define PPOINT(id) do { if (PROBE_K == (id)) t_probe_ = __builtin_amdgcn_s_memrealtime() - t_start_; } while (0)
#define REP(bit) for (int rep_ = 0; rep_ < (((DUP_MASK) & (bit)) ? 2 : 1); ++rep_)
#define OPAQUE_S(p) asm volatile("" : "+s"(p))
__device__ __forceinline__ int opq(int v) { asm volatile("" : "+s"(v)); return v; }
#define GEMM_PHASE(EPI, A_, B_, M_, N_, K_, ...) GEMM_PHASE_S(0, EPI, A_, B_, M_, N_, K_, __VA_ARGS__)
#define GEMM_RESID(A_, B_, M_, N_, K_, SPL, ...) do { pg8::Gemm g{(const bf16*)(A_), (const bf16*)(B_), (M_), (N_), (K_)}; pg8::StaticOrderT<SPL, NB * CT / 256> S; S.init(NB * TT, (N_), F.G, (int)blockIdx.x, (K_), (M_) > NB * TT); \
    pg8::EpiResidPart E{__VA_ARGS__, (float*)(ws + WS_SC1)}; pg8::gemm_phase<pg8::EpiResidPart, pg8::StaticOrderT<SPL, NB * CT / 256>, true, true>(F.lds + RING_OFF, g, S, E, F.wave); } while (0)
#define GEMM_PHASE_S(MODE, EPI, A_, B_, M_, N_, K_, ...) do { pg8::Gemm g{(const bf16*)(A_), (const bf16*)(B_), (M_), (N_), (K_)}; pg8::StaticOrder S; S.init((M_), (N_), F.G, (int)blockIdx.x, (K_)); \
    pg8::EPI E{__VA_ARGS__}; pg8::gemm_phase<pg8::EPI, pg8::StaticOrder, true, true>(F.lds + RING_OFF, g, S, E, F.wave); } while (0)

__global__ void __launch_bounds__(NWAVES * 64, 2) fwd(Args args) {
    extern __shared__ __attribute__((aligned(16))) unsigned char lds[];
    Frame F;
    F.lds = (LAS unsigned char*)lds;
    F.MISC = (volatile LAS unsigned*)(F.lds + MISC_OFF);
    F.wave = __builtin_amdgcn_readfirstlane((int)threadIdx.x >> 6);
    F.G = gridDim.x;
    F.ws = args.ws; F.out = args.out;
    F.ctl = (gu32*)(args.ws + WS_CTL);
    for (int u = threadIdx.x; u < (LDS_BYTES - LDSCTL_OFF) / 4; u += NWAVES * 64) ((LAS unsigned*)(F.lds + LDSCTL_OFF))[u] = 0u;
    __syncthreads();
    const int lo = args.ph_lo, hi = args.ph_hi;
    unsigned long long t_start_ = 0, t_probe_ = 0; if (PROBE_K >= 0) t_start_ = __builtin_amdgcn_s_memrealtime();
    XcdBarrier bar; bar.bar = (unsigned*)(F.ctl + CW_BAR) + args.li * XCD_BAR_WORDS; bar.x = 0; bar.st = nullptr;
    if (hi - lo > 1) bar = xcd_barrier_post((unsigned*)(F.ctl + CW_BAR) + args.li * XCD_BAR_WORDS, F.MISC + 8);
#define IN(k) (opq(lo) <= (k) && (k) < opq(hi))
#define SEAM(k) do { if (IN(k) && IN((k) + 1)) { xcd_barrier(bar, F.wave); if ((DUP_MASK) & 4096) xcd_barrier(bar, F.wave); } if (PROBE_K >= 0 && (k) == PROBE_K) t_probe_ = __builtin_amdgcn_s_memrealtime() - t_start_; } while (0)

    if (IN(PH_P0)) REP(8) { p0_prologue(F, args.in); } SEAM(PH_P0);
    if (IN(PH_P1)) REP(8) { p1_modreduce(F, args.in[5], args.in[6]); } SEAM(PH_P1);
    if (IN(PH_L0 + O_F1N)) REP(4) { norm_phase<0>(F, F.ws, args.in[0], args.in[2], 0, 0, true, MR); }
#pragma unroll 1
    for (int l = 0; l < 2; ++l) {
        const int pb = PH_L0 + PH_PER_LAYER * l;
        const int MLAT = NB * TT;
        const int m_post = (l == 1) ? MLAT : MR;
        if (IN(pb + O_F1N) && l > 0) REP(4) { unsigned char* ws = F.ws; OPAQUE_S(ws); norm_phase<4>(F, ws, nullptr, nullptr, l, 0, false, MR, (const float*)(ws + WS_MODV) + (size_t)((l - 1) * 5 + 4) * MODN + 8 * DM, 0.5f); } SEAM(pb + O_F1N);
        if (IN(pb + O_F1U)) REP(1) { unsigned char* ws = F.ws; OPAQUE_S(ws);
            GEMM_PHASE(EpiSwiglu, ws + WS_HN, ws + WS_WUP + (size_t)(l * 2) * 44 * MiB, MR, 2 * FF, DM, (bf16*)(ws + WS_HID), FF); } SEAM(pb + O_F1U);
        if (IN(pb + O_F1D)) REP(2) { unsigned char* ws = F.ws; OPAQUE_S(ws);
            GEMM_RESID(ws + WS_HID, ws + WS_WDN + (size_t)(l * 2) * 22 * MiB, MR, DM, FF, 4, (float*)(ws + WS_H), (const float*)(ws + WS_MODV) + (size_t)l * 5 * MODN + 2 * DM, MODN, rep_ ? 0.f : 0.5f); } SEAM(pb + O_F1D);
        if (IN(pb + O_MN)) REP(4) { unsigned char* ws = F.ws; OPAQUE_S(ws); norm_phase<4>(F, ws, nullptr, nullptr, l, 1, false, MR, (const float*)(ws + WS_MODV) + (size_t)(l * 5 + 4) * MODN + 2 * DM, 0.5f); } SEAM(pb + O_MN);
        if (IN(pb + O_MI)) REP(16) { unsigned char* ws = F.ws; OPAQUE_S(ws);
            if (l == 0) { pg8::Gemm g{(const bf16*)(ws + WS_HN), (const bf16*)(ws + WS_WABIN), MR, ZLD, DM, (const bf16*)(ws + WS_WABIN + (size_t)ZB_K * DM * 2), (const bf16*)(ws + WS_HN)};
                pg8::DualOrder S; S.init(MR, ZLD, 1536, MR, F.G, (int)blockIdx.x, DM);
                pg8::EpiPlain2 E{{(bf16*)(ws + WS_Z), ZLD, (float*)(ws + WS_GATES), ZB_G / 256, (const float*)(ws + WS_TAB + TB_VEC) + TV_BGATE}, {(bf16*)(ws + WS_ZT), MR, nullptr, -1, nullptr}};
                pg8::gemm_phase<pg8::EpiPlain2, pg8::DualOrder, true, true>(F.lds + RING_OFF, g, S, E, F.wave); }
            else GEMM_PHASE(EpiPlain, ws + WS_HN, ws + WS_WCDIN, MR, CD_IN, DM, (bf16*)(ws + WS_Z), CD_IN, nullptr, -1, nullptr);
        } SEAM(pb + O_MI);
        if (IN(pb + O_MP)) REP(32) { unsigned char* ws = F.ws; OPAQUE_S(ws);
            const int lane = fresh_lane(); const int gw = blockIdx.x * NWAVES + F.wave, NGW = F.G * NWAVES;
            const bf16* Z = (const bf16*)(ws + WS_Z); bf16* KA = (bf16*)(ws + WS_KA); const float* tv = (const float*)(ws + WS_TAB + TB_VEC);
            if (l == 0) {
                if (F.wave < 4) { for (int u = (int)blockIdx.x * 4 + F.wave; u < ml::NSEQ * 32; u += F.G * 4)
                    ml::l1_unit(u >> 5, (u >> 2) & 7, u & 3, (const bf16*)(ws + WS_ZT), (const float*)(ws + WS_GATES), tv + TV_BGATE, ws + WS_SC1, (LAS float*)(F.lds + RING_OFF) + F.wave * 256); }
                else { for (int it = (int)blockIdx.x * 4 + F.wave - 4; it < MR * 2; it += F.G * 4) naive_kprep<0>(it, lane, Z, KA, tv + TV_GK, (const float*)(ws + WS_TAB + TB_ROPEA)); } }
            else { for (int it = gw; it < MR; it += NGW) naive_kprep<1>(it, lane, Z, KA, nullptr, (const float*)(ws + WS_TAB + TB_ROPED));
                for (int u = gw; u < NB * 64 * 17; u += NGW) { const int seg = 16 - (u / (NB * 64)), bg = u % (NB * 64);
                    s5::s5_unit<1>(bg >> 6, bg & 63, seg, Z, (const float*)(ws + WS_TAB + TB_S5AB), (const bf16*)(ws + WS_TAB + TB_S5BT), (const bf16*)(ws + WS_TAB + TB_S5CT), (float*)(ws + WS_SC2), nullptr, nullptr, nullptr, nullptr); } }
        } SEAM(pb + O_MP);
        if (IN(pb + O_MA)) REP(64) { unsigned char* ws = F.ws; OPAQUE_S(ws);
            const int tid = fresh_tid(F.wave);
            const bf16* Z = (const bf16*)(ws + WS_Z); const bf16* KA = (const bf16*)(ws + WS_KA); bf16* CAT = (bf16*)(ws + WS_CAT); const float* tv = (const float*)(ws + WS_TAB + TB_VEC);
            float* SC1 = (float*)(ws + WS_SC1); float* SC2 = (float*)(ws + WS_SC2);
            if (l == 0) { const float* ropeA = (const float*)(ws + WS_TAB + TB_ROPEA);
                REP(256) { const int nv = F.G, v0 = (int)blockIdx.x;
                    for (int u = v0; u < 512; u += nv) { const int b = u >> 7, head = (u >> 4) & 7, qb = u & 15, kvh = head >> 2; const size_t row0 = (size_t)b * TT + qb * 256;
                        att::attn_unit<128, 0>(Z + row0 * ZLD + ZA_Q + head * 128, ZLD, KA + kvh * 128, 256, Z + ZA_V + kvh * 128, ZLD, CAT + row0 * DM + head * 128, b, qb * 256, tv + TV_GQ, ropeA, 0.f, (char*)lds + RING_OFF, F.wave); }
                    PPOINT(100);
                    for (int u = v0; u < 32; u += nv) { const int b = u >> 3, head = u & 7, kvh = head >> 2; const size_t row0 = (size_t)NB * TT + b * CT;
                        att::attn_unit<128, 1>(Z + row0 * ZLD + ZA_Q + head * 128, ZLD, KA + kvh * 128, 256, Z + ZA_V + kvh * 128, ZLD, CAT + row0 * DM + head * 128, b, 0, tv + TV_GQ, ropeA, 0.f, (char*)lds + RING_OFF, F.wave); } }
                PPOINT(101);
                REP(512) for (int u = (int)blockIdx.x; u < NB * 4 * 34; u += F.G) { const int b = u / 136, rem = u % 136, h = rem / 34, bh = rem % 34;
                    ml::l2_unit(b, h, bh >> 1, bh & 1, Z, (const float*)(ws + WS_GATES), tv + TV_BGATE, ws + WS_SC1, SC2, (char*)lds + RING_OFF, (LAS float*)(F.lds + LDSCTL_OFF + 512) + F.wave * 256, F.wave); }
            } else { const float* ropeD = (const float*)(ws + WS_TAB + TB_ROPED);
                REP(1024) { const int nv = F.G, v0 = (int)blockIdx.x;
                    for (int u = v0; u < 1024; u += nv) { const int b = u >> 8, head = (u >> 4) & 15, qb = u & 15, kvh = head >> 3; const size_t row0 = (size_t)b * TT + qb * 256;
                        att::attn_unit<64, 2>(Z + row0 * CD_IN + ZD_Q + head * 64, CD_IN, KA + kvh * 64, 128, Z + ZD_V + kvh * 64, CD_IN, CAT + row0 * DM + 1024 + head * 64, b, qb * 256, nullptr, ropeD, tv[TV_SINK + head], (char*)lds + RING_OFF, F.wave); } }
                PPOINT(110);
                REP(2048) { const int gw = blockIdx.x * NWAVES + F.wave, NGW = F.G * NWAVES;
                    for (int u = gw; u < NB * 64 * 16; u += NGW) { const int seg = u / (NB * 64), bg = u % (NB * 64);
                        s5::s5_unit<2>(bg >> 6, bg & 63, seg, Z, (const float*)(ws + WS_TAB + TB_S5AB), (const bf16*)(ws + WS_TAB + TB_S5BT), (const bf16*)(ws + WS_TAB + TB_S5CT), (float*)(ws + WS_SC2), tv + TV_DSKIP, (bf16*)(ws + WS_G), (float*)(ws + WS_SC1),
                                       F.lds + RING_OFF + F.wave * s5::WAVE_LDS); } }
            }
        } SEAM(pb + O_MA);
        if (IN(pb + O_MF)) { unsigned char* ws = F.ws; OPAQUE_S(ws);
            const int lane = fresh_lane(), gw = blockIdx.x * NWAVES + F.wave, NGW = F.G * NWAVES;
            if (l == 0) ml::finish_pass(gw, NGW, lane, (const bf16*)(ws + WS_Z), (const float*)(ws + WS_SC2), (const float*)(ws + WS_TAB + TB_VEC) + TV_HEADG, (bf16*)(ws + WS_CAT));
        } if (l == 0) SEAM(pb + O_MF);
        if (IN(pb + O_MG)) REP(128) { unsigned char* ws = F.ws; OPAQUE_S(ws);
            if (l == 1) GEMM_PHASE(EpiGlu, ws + WS_G, ws + WS_WGLU, MLAT, 1024, 1024, (bf16*)(ws + WS_CAT), DM, (const bf16*)(ws + WS_G), (const float*)(ws + WS_TAB + TB_VEC) + TV_GLUB);
        } if (l == 1) SEAM(pb + O_MG);
        if (IN(pb + O_MO)) REP(128) { unsigned char* ws = F.ws; OPAQUE_S(ws);
            GEMM_RESID(ws + WS_CAT, ws + (l == 0 ? WS_WABOUT : WS_WCDOUT), m_post, DM, DM, 4, (float*)(ws + WS_H), (const float*)(ws + WS_MODV) + (size_t)l * 5 * MODN + 5 * DM, MODN, rep_ ? 0.f : 1.0f); } SEAM(pb + O_MO);
        if (IN(pb + O_F2N)) REP(4) { unsigned char* ws = F.ws; OPAQUE_S(ws); norm_phase<4>(F, ws, nullptr, nullptr, l, 2, false, m_post, (const float*)(ws + WS_MODV) + (size_t)(l * 5 + 4) * MODN + 5 * DM, 1.0f); } SEAM(pb + O_F2N);
        if (IN(pb + O_F2U)) REP(1) { unsigned char* ws = F.ws; OPAQUE_S(ws);
            GEMM_PHASE(EpiSwiglu, ws + WS_HN, ws + WS_WUP + (size_t)(l * 2 + 1) * 44 * MiB, m_post, 2 * FF, DM, (bf16*)(ws + WS_HID), FF); } SEAM(pb + O_F2U);
        if (IN(pb + O_F2D)) REP(2) { unsigned char* ws = F.ws; OPAQUE_S(ws);
            GEMM_RESID(ws + WS_HID, ws + WS_WDN + (size_t)(l * 2 + 1) * 22 * MiB, m_post, DM, FF, 4, (float*)(ws + WS_H), (const float*)(ws + WS_MODV) + (size_t)l * 5 * MODN + 8 * DM, MODN, rep_ ? 0.f : 0.5f); } SEAM(pb + O_F2D);
    }
    if (IN(PH_FINAL)) REP(4) { unsigned char* ws = F.ws; OPAQUE_S(ws); final_norm_phase(F, ws); }
    if (PROBE_K >= 0 && blockIdx.x == 0) { const unsigned long long te_ = __builtin_amdgcn_s_memrealtime(); while (__builtin_amdgcn_s_memrealtime() - te_ < t_probe_) __builtin_amdgcn_s_sleep(8); }
#undef IN
#undef SEAM
}
extern "C" void kernel_launch(void* const* d_in, const int* in_sizes, int n_in, void* d_out, int out_size, void* d_ws, size_t ws_size, hipStream_t stream) {
    static int grid = 0;
    if (grid == 0) {
        if (n_in != 30 || out_size != NB * TT * DM || ws_size < WS_END) { fprintf(stderr, "kernel_launch: unexpected shapes: n_in %d out %d ws %zu (need %zu)\n", n_in, out_size, ws_size, (size_t)WS_END); grid = -1; return; }
        int dev = 0, cus = 0;
        if (hipGetDevice(&dev) != hipSuccess || hipDeviceGetAttribute(&cus, hipDeviceAttributeMultiprocessorCount, dev) != hipSuccess) { grid = -1; return; }
        if (hipFuncSetAttribute((const void*)fwd, hipFuncAttributeMaxDynamicSharedMemorySize, LDS_BYTES) != hipSuccess) { fprintf(stderr, "kernel_launch: hipFuncSetAttribute failed\n"); grid = -1; return; }
        int per_cu = 0; (void)hipOccupancyMaxActiveBlocksPerMultiprocessor(&per_cu, (const void*)fwd, NWAVES * 64, LDS_BYTES); (void)hipGetLastError();
        if (per_cu < 1) fprintf(stderr, "kernel_launch: occupancy query says %d\n", per_cu);
        grid = cus;
    }
    if (grid < 0) return;
    (void)hipMemsetAsync((char*)d_ws + WS_CTL, 0, CTL_ZERO_BYTES, stream);
    Args a{};
    for (int i = 0; i < 30; ++i) a.in[i] = (const float*)d_in[i];
    a.out = (float*)d_out; a.ws = (unsigned char*)d_ws;
    int li = 0;
    auto run = [&](int lo, int hi) { a.ph_lo = lo; a.ph_hi = hi; a.li = li++; a.pad = 0; hipLaunchKernelGGL(fwd, dim3(grid), dim3(NWAVES * 64), LDS_BYTES, stream, a); };
#ifndef MK_CUTS
#define MK_CUTS 0
#endif
    if (MK_CUTS == 0) run(0, N_PHASES);
    else if (MK_CUTS == 1) { for (int ph = 0; ph < N_PHASES; ++ph) run(ph, ph + 1); }
    else { run(0, PH_L0 + O_MP); run(PH_L0 + O_MP, PH_L0 + O_MO); run(PH_L0 + O_MO, PH_L0 + PH_PER_LAYER + O_MP); run(PH_L0 + PH_PER_LAYER + O_MP, PH_L0 + PH_PER_LAYER + O_MO); run(PH_L0 + PH_PER_LAYER + O_MO, N_PHASES); }
    const hipError_t le = hipPeekAtLastError();
    if (le != hipSuccess) fprintf(stderr, "kernel_launch: launch failed: %s\n", hipGetErrorName(le));
}
```

```cpp
#include <hip/hip_runtime.h>
#include <cstdio>
#include <cstdint>
#include <cmath>
__device__ __forceinline__ int fresh_lane() { int l; asm volatile("v_mbcnt_lo_u32_b32 %0, -1, 0\n\tv_mbcnt_hi_u32_b32 %0, -1, %0" : "=v"(l)); return l; }
__device__ __forceinline__ int fresh_tid(int wave) { return wave * 64 + fresh_lane(); }
namespace pg8 {
#define PG8_LAS __attribute__((address_space(3)))
typedef unsigned short bf16_t;
typedef short bf16x8 __attribute__((ext_vector_type(8)));
typedef float f32x4 __attribute__((ext_vector_type(4)));
typedef unsigned u32x4 __attribute__((ext_vector_type(4)));
constexpr int BM = 256, BK = 64, HALF = 128, HTB = HALF * BK * 2  , STAGE_BYTES = 8 * HTB, NXCD = 8, WGM = 4;

__host__ __device__ __forceinline__ int lds_byte(int r, int c) { const int st = (r >> 4) * 2 + (c >> 5), rr = r & 15, cc = c & 31, ob = rr * 64 + cc * 2; return st * 1024 + (ob ^ (((ob >> 9) & 1) << 5)); }
__host__ __device__ __forceinline__ void stage_rc(int b, int& R, int& C) { const int st = b / 1024, sb = b % 1024, swz = sb ^ (((sb >> 9) & 1) << 5); R = (st >> 1) * 16 + swz / 64; C = (st & 1) * 32 + (swz % 64) / 2; }
__host__ __device__ __forceinline__ int perm32(int rho) { const int n = rho >> 4, i = rho & 15; return 8 * (i >> 2) + 4 * n + (i & 3); }

struct Unit { int pm, pn, kt0, nkt, piece, which; };
struct Gemm { const bf16_t* A; const bf16_t* Bt; int M, N, K; const bf16_t* A2; const bf16_t* Bt2; };

template <int S = 1, int NXM = 1> struct StaticOrderT {
    int nM, nN, nwg, G, c, nt, wgm; bool xr;
    __host__ __device__ __forceinline__ void init(int M, int N, int G_, int c_, int K = 0, bool xr_ = false, int wgm_ = WGM) { nM = M / BM; nN = N / BM; nwg = nM * nN; G = G_; c = c_; nt = K / BK; xr = xr_; wgm = wgm_; }
    __host__ __device__ __forceinline__ bool next(int i, Unit& u) const {
        const int rounds = (nwg + G - 1) / G;
        if (xr && i == rounds) { if (c >= S * NXM * nN) return false; const int x = c / S, piece = c % S;
            u.pm = nM + x % NXM; u.pn = x / NXM; u.piece = piece; u.which = 0; u.kt0 = 2 * ((piece * nt) / (2 * S)); u.nkt = 2 * (((piece + 1) * nt) / (2 * S)) - u.kt0; return true; }
        const long L = (long)i * G + c; if (L >= nwg) return false;
        int wgid = (int)L; { const int q8 = nwg / NXCD, r = nwg % NXCD, xcd = wgid % NXCD, off = wgid / NXCD; wgid = (xcd < r ? xcd * (q8 + 1) : r * (q8 + 1) + (xcd - r) * q8) + off; }
        const int nig = wgm * nN, gid = wgid / nig, fm = gid * wgm, gsz = (nM - fm) < wgm ? (nM - fm) : wgm;
        u.pm = fm + ((wgid % nig) % gsz); u.pn = (wgid % nig) / gsz; u.piece = -1; u.which = 0; u.kt0 = 0; u.nkt = nt; return true;
    }
    __device__ __forceinline__ void a_ready(const Unit&) const {}
    __device__ __forceinline__ void done(const Unit&) const {}
};
typedef StaticOrderT<1, 1> StaticOrder;
struct DualOrder {
    int nM1, nN1, nM2, nN2, n1, n2, G, c, nt;
    __host__ __device__ __forceinline__ void init(int M1, int N1, int M2, int N2, int G_, int c_, int K) { nM1 = M1 / BM; nN1 = N1 / BM; nM2 = M2 / BM; nN2 = N2 / BM; n1 = nM1 * nN1; n2 = nM2 * nN2; G = G_; c = c_; nt = K / BK; }
    __host__ __device__ __forceinline__ bool next(int i, Unit& u) const {
        const long L = (long)i * G + c; if (L >= n1 + n2) return false;
        const bool w = L >= n1; const int nM = w ? nM2 : nM1, nN = w ? nN2 : nN1, nwg = w ? n2 : n1;
        int wgid = (int)(w ? L - n1 : L); { const int q8 = nwg / NXCD, r = nwg % NXCD, xcd = wgid % NXCD, off = wgid / NXCD; wgid = (xcd < r ? xcd * (q8 + 1) : r * (q8 + 1) + (xcd - r) * q8) + off; }
        const int nig = WGM * nN, gid = wgid / nig, fm = gid * WGM, gsz = (nM - fm) < WGM ? (nM - fm) : WGM;
        u.pm = fm + ((wgid % nig) % gsz); u.pn = (wgid % nig) / gsz; u.piece = -1; u.which = w ? 1 : 0; u.kt0 = 0; u.nkt = nt; return true;
    }
    __device__ __forceinline__ void a_ready(const Unit&) const {}
    __device__ __forceinline__ void done(const Unit&) const {}
};

__device__ __forceinline__ unsigned cvt_pk_bf16(float lo, float hi) { unsigned r; asm volatile("v_cvt_pk_bf16_f32 %0, %1, %2" : "=v"(r) : "v"(lo), "v"(hi)); return r; }
typedef float f32x2 __attribute__((ext_vector_type(2)));
__device__ __forceinline__ float fast_sigmoid(float a) { return __builtin_amdgcn_rcpf(1.f + __builtin_amdgcn_exp2f(-1.4426950408889634f * a)); }
struct EpiPlain {
    static constexpr bool PERM = true, AFTER_DRAIN = false;
    bf16_t* O; int ldc; float* gates; int gate_pn; const float* gbias;
    __device__ __forceinline__ void operator()(const f32x4 (&acc)[2][2][4][2], const Unit& u, int wr, int wc, int fr, int fq) const {
        const int row0 = u.pm * BM + wr * 64 + fr, col0 = u.pn * BM + wc * 32 + 8 * fq;
#pragma unroll
        for (int ai = 0; ai < 2; ++ai)
#pragma unroll
            for (int m = 0; m < 4; ++m) { const int row = row0 + ai * HALF + m * 16; bf16_t* rowp = O + (size_t)row * ldc + col0;
#pragma unroll
                for (int bj = 0; bj < 2; ++bj) { const f32x4 v0 = acc[ai][bj][m][0], v1 = acc[ai][bj][m][1];
                    u32x4 w; w.x = cvt_pk_bf16(v0[0], v0[1]); w.y = cvt_pk_bf16(v0[2], v0[3]); w.z = cvt_pk_bf16(v1[0], v1[1]); w.w = cvt_pk_bf16(v1[2], v1[3]);
                    *(u32x4*)(rowp + bj * HALF) = w;
                    if (bj == 0 && u.pn == gate_pn && wc == 0 && fq < 2) { float* gp = gates + (size_t)row * 16 + 8 * fq; const f32x4 b0 = *(const f32x4*)(gbias + 8 * fq), b1 = *(const f32x4*)(gbias + 8 * fq + 4);
                        f32x4 lf; for (int q = 0; q < 4; ++q) { const float x = v1[q] + b1[q]; lf[q] = x >= 0.f ? -log1pf(expf(-x)) : x - log1pf(expf(x)); }
                        *(f32x4*)gp = v0 + b0; *(f32x4*)(gp + 4) = lf; } } }
    }
};
struct EpiPlain2 {
    static constexpr bool PERM = true, AFTER_DRAIN = false;
    EpiPlain e0, e1;
    __device__ __forceinline__ void operator()(const f32x4 (&acc)[2][2][4][2], const Unit& u, int wr, int wc, int fr, int fq) const {
        EpiPlain e; e.O = u.which ? e1.O : e0.O; e.ldc = u.which ? e1.ldc : e0.ldc; e.gates = u.which ? e1.gates : e0.gates; e.gate_pn = u.which ? e1.gate_pn : e0.gate_pn; e.gbias = e0.gbias; e(acc, u, wr, wc, fr, fq);
    }
};
struct EpiSwiglu {
    static constexpr bool PERM = true, AFTER_DRAIN = false;
    bf16_t* O; int ldc;
    __device__ __forceinline__ void operator()(const f32x4 (&acc)[2][2][4][2], const Unit& u, int wr, int wc, int fr, int fq) const {
        const int row0 = u.pm * BM + wr * 64 + fr, col0 = u.pn * HALF + wc * 32 + 8 * fq;
#pragma unroll
        for (int ai = 0; ai < 2; ++ai)
#pragma unroll
            for (int m = 0; m < 4; ++m) { bf16_t* rowp = O + (size_t)(row0 + ai * HALF + m * 16) * ldc + col0;
                float r[8];
#pragma unroll
                for (int n = 0; n < 2; ++n)
#pragma unroll
                    for (int j = 0; j < 4; ++j) { const float a = acc[ai][0][m][n][j], b = acc[ai][1][m][n][j]; r[4 * n + j] = a * fast_sigmoid(a) * b; }
                u32x4 w; w.x = cvt_pk_bf16(r[0], r[1]); w.y = cvt_pk_bf16(r[2], r[3]); w.z = cvt_pk_bf16(r[4], r[5]); w.w = cvt_pk_bf16(r[6], r[7]);
                *(u32x4*)rowp = w; }
    }
};
struct EpiResid {
    static constexpr bool PERM = true, AFTER_DRAIN = false;
    float* H; const float* gate; int gstride; float coef;
    __device__ __forceinline__ void operator()(const f32x4 (&acc)[2][2][4][2], const Unit& u, int wr, int wc, int fr, int fq) const {
        const int row0 = u.pm * BM + wr * 64 + fr, col0 = u.pn * BM + wc * 32 + 8 * fq;
        const int sel = u.pm < 64 ? (u.pm >> 4) : 4;
        const float* gp = gate + (size_t)sel * gstride + col0;
        f32x4 gv[2][2];
#pragma unroll
        for (int bj = 0; bj < 2; ++bj)
#pragma unroll
            for (int n = 0; n < 2; ++n) gv[bj][n] = *(const f32x4*)(gp + bj * HALF + 4 * n) * coef;
#pragma unroll
        for (int ai = 0; ai < 2; ++ai)
#pragma unroll
            for (int m = 0; m < 4; ++m) { float* rowp = H + (size_t)(row0 + ai * HALF + m * 16) * 2048 + col0;
#pragma unroll
                for (int bj = 0; bj < 2; ++bj)
#pragma unroll
                    for (int n = 0; n < 2; ++n) { f32x4* p = (f32x4*)(rowp + bj * HALF + 4 * n); *p = *p + gv[bj][n] * acc[ai][bj][m][n]; } }
    }
};
struct EpiPart {
    static constexpr bool PERM = true, AFTER_DRAIN = false;
    float* P;
    __device__ __forceinline__ void operator()(const f32x4 (&acc)[2][2][4][2], const Unit& u, int wr, int wc, int fr, int fq) const {
        const int row0 = u.pm * BM + wr * 64 + fr, col0 = u.pn * BM + wc * 32 + 8 * fq;
        float* base = P + (size_t)u.piece * (1024 * 2048);
#pragma unroll
        for (int ai = 0; ai < 2; ++ai)
#pragma unroll
            for (int m = 0; m < 4; ++m) { float* rowp = base + (size_t)(row0 + ai * HALF + m * 16) * 2048 + col0;
#pragma unroll
                for (int bj = 0; bj < 2; ++bj)
#pragma unroll
                    for (int n = 0; n < 2; ++n) *(f32x4*)(rowp + bj * HALF + 4 * n) = acc[ai][bj][m][n]; }
    }
};
struct EpiResidPart {
    static constexpr bool PERM = true, AFTER_DRAIN = false;
    float* H; const float* gate; int gstride; float coef; float* P;
    __device__ __forceinline__ void operator()(const f32x4 (&acc)[2][2][4][2], const Unit& u, int wr, int wc, int fr, int fq) const {
        const bool res = u.piece < 0;
        const int row0 = (res ? u.pm : u.pm - 64) * BM + wr * 64 + fr, col0 = u.pn * BM + wc * 32 + 8 * fq;
        float* base = res ? H : P + (size_t)u.piece * (1024 * 2048);
        const int sel = u.pm < 64 ? (u.pm >> 4) : 4;
        const float* gp = gate + (size_t)sel * gstride + col0;
        f32x4 gv[2][2];
#pragma unroll
        for (int bj = 0; bj < 2; ++bj)
#pragma unroll
            for (int n = 0; n < 2; ++n) gv[bj][n] = res ? *(const f32x4*)(gp + bj * HALF + 4 * n) * coef : (f32x4){1.f, 1.f, 1.f, 1.f};
#pragma unroll
        for (int ai = 0; ai < 2; ++ai)
#pragma unroll
            for (int m = 0; m < 4; ++m) { float* rowp = base + (size_t)(row0 + ai * HALF + m * 16) * 2048 + col0;
#pragma unroll
                for (int bj = 0; bj < 2; ++bj)
#pragma unroll
                    for (int n = 0; n < 2; ++n) { f32x4* p = (f32x4*)(rowp + bj * HALF + 4 * n); f32x4 old = {0.f, 0.f, 0.f, 0.f}; if (res) old = *p; *p = old + gv[bj][n] * acc[ai][bj][m][n]; } }
    }
};
struct EpiGlu {
    static constexpr bool PERM = true, AFTER_DRAIN = false;
    bf16_t* O; int ldc; const bf16_t* G; const float* bias;
    __device__ __forceinline__ void operator()(const f32x4 (&acc)[2][2][4][2], const Unit& u, int wr, int wc, int fr, int fq) const {
        const int row0 = u.pm * BM + wr * 64 + fr, col0 = u.pn * BM + wc * 32 + 8 * fq;
#pragma unroll
        for (int ai = 0; ai < 2; ++ai)
#pragma unroll
            for (int m = 0; m < 4; ++m) { const int row = row0 + ai * HALF + m * 16;
#pragma unroll
                for (int bj = 0; bj < 2; ++bj) { const int col = col0 + bj * HALF;
                    const u32x4 gw = *(const u32x4*)(G + (size_t)row * 1024 + col);
                    const f32x4 b0 = *(const f32x4*)(bias + col), b1 = *(const f32x4*)(bias + col + 4);
                    float r[8];
#pragma unroll
                    for (int j = 0; j < 4; ++j) { r[j] = fast_sigmoid(acc[ai][bj][m][0][j] + b0[j]); r[4 + j] = fast_sigmoid(acc[ai][bj][m][1][j] + b1[j]); }
                    const unsigned gws[4] = {gw.x, gw.y, gw.z, gw.w};
#pragma unroll
                    for (int q = 0; q < 4; ++q) { r[2 * q] *= __builtin_bit_cast(float, gws[q] << 16); r[2 * q + 1] *= __builtin_bit_cast(float, gws[q] & 0xffff0000u); }
                    u32x4 w; w.x = cvt_pk_bf16(r[0], r[1]); w.y = cvt_pk_bf16(r[2], r[3]); w.z = cvt_pk_bf16(r[4], r[5]); w.w = cvt_pk_bf16(r[6], r[7]);
                    *(u32x4*)(O + (size_t)row * ldc + col) = w; } }
    }
};
template <class Epi, class Sched, bool ALIGN_EPI = false, bool SP2 = false>
__device__ __forceinline__ void gemm_phase(PG8_LAS unsigned char* lds, const Gemm g, const Sched& S, const Epi& E, int wave_s) {
    const int tid = fresh_tid(wave_s);
    const int wid = __builtin_amdgcn_readfirstlane(tid >> 6), lane = tid & 63, wr = wid >> 2, wc = wid & 3, fr = lane & 15, fq = lane >> 4;
    const int K = g.K, nt = K / BK;
    unsigned voffA[2], voffB[2];
#pragma unroll
    for (int i = 0; i < 2; ++i) { int R, C; stage_rc(tid * 16 + i * 8192, R, C); const int Rb = Epi::PERM ? ((R & ~31) + perm32(R & 31)) : R;
        voffA[i] = (unsigned)(R * K + C) * 2u; voffB[i] = (unsigned)(Rb * K + C) * 2u; }
    const size_t kstep = (size_t)(BK * 2);
    const size_t hstep = (size_t)HALF * K * 2;
    const size_t tstep = 2 * hstep;
    const unsigned ldsw = (unsigned)wid * 1024u;
    const int aoff = lds_byte(wr * 64 + fr, fq * 8), boff = lds_byte(wc * 32 + fr, fq * 8);
#define PG8_SA(b, h) (((b) * 2 + (h)) * HTB)
#define PG8_SB(b, h) ((4 + (b) * 2 + (h)) * HTB)
#define PG8_STAGE(bufoff, gbase, voff) do { _Pragma("unroll") for (int _i = 0; _i < 2; ++_i) \
        __builtin_amdgcn_global_load_lds((const unsigned*)((const char*)(gbase) + (voff)[_i]), (PG8_LAS unsigned*)(lds + (bufoff) + ldsw + _i * 8192), 16, 0, 0); } while (0)
#define PG8_LDA(dst, b, h) do { _Pragma("unroll") for (int m = 0; m < 4; ++m) _Pragma("unroll") for (int k = 0; k < 2; ++k) dst[m][k] = *(const PG8_LAS bf16x8*)(lds + PG8_SA(b, h) + aoff + m * 2048 + k * 1024); } while (0)
#define PG8_LDB(dst, b, h) do { _Pragma("unroll") for (int n = 0; n < 2; ++n) _Pragma("unroll") for (int k = 0; k < 2; ++k) dst[n][k] = *(const PG8_LAS bf16x8*)(lds + PG8_SB(b, h) + boff + n * 2048 + k * 1024); } while (0)
#define PG8_MMA(ai, bj, At, Bt) do { __builtin_amdgcn_s_setprio(1); _Pragma("unroll") for (int m = 0; m < 4; ++m) _Pragma("unroll") for (int n = 0; n < 2; ++n) _Pragma("unroll") for (int k = 0; k < 2; ++k) \
        acc[ai][bj][m][n] = __builtin_amdgcn_mfma_f32_16x16x32_bf16(Bt[n][k], At[m][k], acc[ai][bj][m][n], 0, 0, 0); __builtin_amdgcn_s_setprio(0); } while (0)
#define PG8_WAIT_V(n) asm volatile("s_waitcnt vmcnt(" #n ")" ::: "memory")
#define PG8_WAIT_L(n) asm volatile("s_waitcnt lgkmcnt(" #n ")" ::: "memory")
#define PG8_BAR __builtin_amdgcn_s_barrier()
#define PG8_SCHED __builtin_amdgcn_sched_barrier(0)
    Unit cur, nxt; int ui = 0;
    if (!S.next(0, cur)) return;
    f32x4 acc[2][2][4][2];
#pragma unroll
    for (int a = 0; a < 2; ++a)
#pragma unroll
        for (int b = 0; b < 2; ++b)
#pragma unroll
            for (int m = 0; m < 4; ++m)
#pragma unroll
                for (int n = 0; n < 2; ++n) acc[a][b][m][n] = (f32x4){0.f, 0.f, 0.f, 0.f};
    bf16x8 At[4][2], B0[2][2], B1[2][2];
    const char* cA = (const char*)(cur.which ? g.A2 : g.A) + (size_t)cur.pm * tstep + (size_t)cur.kt0 * kstep; const char* cB = (const char*)(cur.which ? g.Bt2 : g.Bt) + (size_t)cur.pn * tstep + (size_t)cur.kt0 * kstep;
    S.a_ready(cur);
    if constexpr (SP2) {
        PG8_STAGE(PG8_SB(0, 0), cB, voffB); PG8_STAGE(PG8_SB(0, 1), cB + hstep, voffB); PG8_STAGE(PG8_SA(0, 0), cA, voffA); PG8_STAGE(PG8_SA(0, 1), cA + hstep, voffA);
        if (wr == 1) PG8_BAR;
        PG8_WAIT_V(2); PG8_BAR;
        PG8_STAGE(PG8_SB(1, 0), cB + kstep, voffB); PG8_STAGE(PG8_SA(1, 0), cA + kstep, voffA); PG8_STAGE(PG8_SB(1, 1), cB + hstep + kstep, voffB);
        PG8_WAIT_V(6); PG8_BAR;
    } else {
        PG8_STAGE(PG8_SB(0, 0), cB, voffB); PG8_STAGE(PG8_SA(0, 0), cA, voffA); PG8_STAGE(PG8_SB(0, 1), cB + hstep, voffB); PG8_STAGE(PG8_SA(0, 1), cA + hstep, voffA);
        if (wr == 1) PG8_BAR;
        PG8_WAIT_V(4); PG8_BAR;
        PG8_STAGE(PG8_SB(1, 0), cB + kstep, voffB); PG8_STAGE(PG8_SA(1, 0), cA + kstep, voffA); PG8_STAGE(PG8_SB(1, 1), cB + hstep + kstep, voffB);
        PG8_WAIT_V(6); PG8_BAR;
    }
    for (;;) {
        const bool has_next = S.next(ui + 1, nxt);
        const char* nA = has_next ? (const char*)(nxt.which ? g.A2 : g.A) + (size_t)nxt.pm * tstep + (size_t)nxt.kt0 * kstep : cA; const char* nB = has_next ? (const char*)(nxt.which ? g.Bt2 : g.Bt) + (size_t)nxt.pn * tstep + (size_t)nxt.kt0 * kstep : cB;
        const int ntc = cur.nkt;
        for (int t = 0; t < ntc; t += 2) {
            const bool last = (t == ntc - 2);
            const char* a1 = cA + (size_t)(t + 1) * kstep;
            const char* a2 = last ? nA : cA + (size_t)(t + 2) * kstep; const char* b2 = last ? nB : cB + (size_t)(t + 2) * kstep;
            const char* a3 = a2 + kstep; const char* b3 = b2 + kstep;
            if (last && has_next) S.a_ready(nxt);
            if constexpr (SP2) {
            PG8_LDB(B0, 0, 0); PG8_LDB(B1, 0, 1); PG8_SCHED; PG8_LDA(At, 0, 0); PG8_STAGE(PG8_SA(1, 1), a1 + hstep, voffA);
            PG8_WAIT_V(8); PG8_WAIT_L(0); PG8_BAR; PG8_MMA(0, 0, At, B0); PG8_MMA(0, 1, At, B1); PG8_BAR; PG8_SCHED;
            PG8_LDA(At, 0, 1); PG8_STAGE(PG8_SB(0, 0), b2, voffB); PG8_STAGE(PG8_SB(0, 1), b2 + hstep, voffB); PG8_STAGE(PG8_SA(0, 0), a2, voffA);
            PG8_WAIT_V(8); PG8_WAIT_L(0); PG8_BAR; PG8_MMA(1, 0, At, B0); PG8_MMA(1, 1, At, B1); PG8_BAR; PG8_SCHED;
            PG8_LDB(B0, 1, 0); PG8_LDB(B1, 1, 1); PG8_SCHED; PG8_LDA(At, 1, 0); PG8_STAGE(PG8_SA(0, 1), a2 + hstep, voffA);
            PG8_WAIT_V(8); PG8_WAIT_L(0); PG8_BAR; PG8_MMA(0, 0, At, B0); PG8_MMA(0, 1, At, B1); PG8_BAR; PG8_SCHED;
            PG8_LDA(At, 1, 1); PG8_STAGE(PG8_SB(1, 0), b3, voffB); PG8_STAGE(PG8_SB(1, 1), b3 + hstep, voffB); PG8_STAGE(PG8_SA(1, 0), a3, voffA);
            PG8_WAIT_V(8); PG8_WAIT_L(0); PG8_BAR; PG8_MMA(1, 0, At, B0); PG8_MMA(1, 1, At, B1); PG8_BAR; PG8_SCHED;
            } else {
            PG8_LDB(B0, 0, 0); PG8_SCHED; PG8_LDA(At, 0, 0); PG8_STAGE(PG8_SA(1, 1), a1 + hstep, voffA);
            PG8_WAIT_L(8); PG8_BAR; PG8_WAIT_L(0); PG8_MMA(0, 0, At, B0); PG8_BAR; PG8_SCHED;
            PG8_LDB(B1, 0, 1); PG8_STAGE(PG8_SB(0, 0), b2, voffB);
            PG8_BAR; PG8_WAIT_L(0); PG8_MMA(0, 1, At, B1); PG8_BAR;
            PG8_LDA(At, 0, 1); PG8_STAGE(PG8_SA(0, 0), a2, voffA);
            PG8_BAR; PG8_WAIT_L(0); PG8_MMA(1, 0, At, B0); PG8_BAR; PG8_SCHED;
            PG8_STAGE(PG8_SB(0, 1), b2 + hstep, voffB);
            PG8_WAIT_V(6); PG8_BAR; PG8_MMA(1, 1, At, B1); PG8_BAR;
            PG8_LDB(B0, 1, 0); PG8_SCHED; PG8_LDA(At, 1, 0); PG8_STAGE(PG8_SA(0, 1), a2 + hstep, voffA);
            PG8_WAIT_L(8); PG8_BAR; PG8_WAIT_L(0); PG8_MMA(0, 0, At, B0); PG8_BAR; PG8_SCHED;
            PG8_LDB(B1, 1, 1); PG8_STAGE(PG8_SB(1, 0), b3, voffB);
            PG8_BAR; PG8_WAIT_L(0); PG8_MMA(0, 1, At, B1); PG8_BAR;
            PG8_LDA(At, 1, 1); PG8_STAGE(PG8_SA(1, 0), a3, voffA);
            PG8_BAR; PG8_WAIT_L(0); PG8_MMA(1, 0, At, B0); PG8_BAR; PG8_SCHED;
            PG8_STAGE(PG8_SB(1, 1), b3 + hstep, voffB);
            PG8_WAIT_V(6); PG8_BAR; PG8_MMA(1, 1, At, B1); PG8_BAR;
            }
        }
        if constexpr (ALIGN_EPI) { if (wr == 0) PG8_BAR; }
        if constexpr (!Epi::AFTER_DRAIN) { E(acc, cur, wr, wc, fr, fq); S.done(cur); }
        if (!has_next) break;
#pragma unroll
        for (int a = 0; a < 2; ++a)
#pragma unroll
            for (int b = 0; b < 2; ++b)
#pragma unroll
                for (int m = 0; m < 4; ++m)
#pragma unroll
                    for (int n = 0; n < 2; ++n) acc[a][b][m][n] = (f32x4){0.f, 0.f, 0.f, 0.f};
        cur = nxt; cA = nA; cB = nB; ++ui;
        if constexpr (ALIGN_EPI) { if (wr == 1) PG8_BAR; }
    }
    PG8_WAIT_V(0);
    if constexpr (!ALIGN_EPI) { if (wr == 0) PG8_BAR; }
    PG8_BAR;
    if constexpr (Epi::AFTER_DRAIN) { E.fused(acc, cur, wr, wc, fr, fq, lds, wid, lane); S.done(cur); }
#undef PG8_SA
#undef PG8_SB
#undef PG8_STAGE
#undef PG8_LDA
#undef PG8_LDB
#undef PG8_MMA
#undef PG8_WAIT_V
#undef PG8_WAIT_L
#undef PG8_BAR
#undef PG8_SCHED
}
}
#define GAS __attribute__((address_space(1)))
#define LAS __attribute__((address_space(3)))
typedef unsigned short bf16;
typedef unsigned v4u __attribute__((ext_vector_type(4)));
typedef float f32x4 __attribute__((ext_vector_type(4)));
typedef short bf16x8 __attribute__((ext_vector_type(8)));
typedef GAS unsigned gu32;
typedef GAS unsigned long long gu64;
#define RLX_AGENT __ATOMIC_RELAXED, __HIP_MEMORY_SCOPE_AGENT
#define LDS_WAIT() asm volatile("s_waitcnt lgkmcnt(0)" ::: "memory")
#define VM_WAIT() asm volatile("s_waitcnt vmcnt(0)" ::: "memory")
__device__ __forceinline__ unsigned long long rt() { return __builtin_amdgcn_s_memrealtime(); }
__device__ __forceinline__ unsigned f2bf(float f) { unsigned u = __builtin_bit_cast(unsigned, f); return (u + 0x7fffu + ((u >> 16) & 1u)) >> 16; }
__device__ __forceinline__ unsigned pk2(float lo, float hi) { return f2bf(lo) | (f2bf(hi) << 16); }

#define XB_TMO      128
#define XB_XCNT(j)  (256  + 64 * (j))
#define XB_XSUB(j)  (1280 + 64 * (j))
#define XB_XGEN(j)  (2304 + 64 * (j))
#define XB_TOP      3328
#define XB_TOPGEN   3392
#define XCD_BAR_WORDS 3456
#define XB_SPIN_CAP (1u << 18)

__device__ __forceinline__ unsigned xb_ld(unsigned* p)              { return __hip_atomic_load(p, __ATOMIC_RELAXED, __HIP_MEMORY_SCOPE_AGENT); }
__device__ __forceinline__ unsigned xb_add(unsigned* p, unsigned v) { return __hip_atomic_fetch_add(p, v, __ATOMIC_RELAXED, __HIP_MEMORY_SCOPE_AGENT); }
__device__ __forceinline__ unsigned xb_xcc_id() { return (unsigned)__builtin_amdgcn_s_getreg((3 << 11) | 20) & 0xFu; }
#define XB_SPIN(cond, bar) do { unsigned _sp = 0; while (cond) { __builtin_amdgcn_s_sleep(1); \
    if ((++_sp & 255u) == 0u) { if (xb_ld(&(bar)[XB_TMO])) break; if (_sp > XB_SPIN_CAP) { atomicAdd(&(bar)[XB_TMO], 1u); break; } } } } while (0)

struct XcdBarrier {
    unsigned* bar; unsigned x;
    volatile LAS unsigned* st;
};

__device__ __forceinline__ XcdBarrier xcd_barrier_post(unsigned* bar, volatile LAS unsigned* st) {
    XcdBarrier b; b.bar = bar; b.x = xb_xcc_id(); b.st = st;
    if (threadIdx.x == 0) (void)xb_add(&bar[XB_XCNT(b.x)], 1u);
    return b;
}
__device__ __forceinline__ void xcd_barrier_complete(unsigned* bar, unsigned x, unsigned& nloc, unsigned& nx) {
    const unsigned G = gridDim.x * gridDim.y * gridDim.z;
    unsigned sum, cnt, mine, sp = 0u;
    for (;;) {
        sum = 0u; cnt = 0u; mine = 0u;
#pragma unroll
        for (unsigned j = 0; j < 16; ++j) { const unsigned c = xb_ld(&bar[XB_XCNT(j)]); sum += c; cnt += (c > 0u) ? 1u : 0u; mine = (j == x) ? c : mine; }
        if (sum == G) break;
        __builtin_amdgcn_s_sleep(1);
        if ((++sp & 255u) == 0u) { if (xb_ld(&bar[XB_TMO])) break; if (sp > XB_SPIN_CAP) { atomicAdd(&bar[XB_TMO], 1u); break; } }
    }
    nloc = mine > 0u ? mine : 1u; nx = cnt > 0u ? cnt : 1u;
}

__device__ __forceinline__ void xcd_barrier(const XcdBarrier& b, int wave_s) {
    asm volatile("s_waitcnt vmcnt(0)" ::: "memory");
    __syncthreads();
    if (wave_s == 0 && fresh_lane() == 0) {
        unsigned* bar = b.bar;
        __builtin_amdgcn_s_waitcnt(0);
        unsigned nloc = b.st[0], nx = b.st[1];
        if (nloc == 0u) { xcd_barrier_complete(bar, b.x, nloc, nx); b.st[0] = nloc; b.st[1] = nx; }
        const unsigned old = xb_add(&bar[XB_XSUB(b.x)], 1u);
        const unsigned gen = old / nloc;
        if (old + 1u == (gen + 1u) * nloc) {
            __builtin_amdgcn_fence(__ATOMIC_RELEASE, "agent");
            asm volatile("s_waitcnt vmcnt(0)" ::: "memory");
            const unsigned og = xb_add(&bar[XB_TOP], 1u);
            const unsigned tg = og / nx;
            if (og + 1u == (tg + 1u) * nx) xb_add(&bar[XB_TOPGEN], 1u);
            else XB_SPIN(xb_ld(&bar[XB_TOPGEN]) == tg, bar);
            __builtin_amdgcn_fence(__ATOMIC_ACQUIRE, "agent");
            xb_add(&bar[XB_XGEN(b.x)], 1u);
            asm volatile("s_waitcnt vmcnt(0)" ::: "memory");
        } else {
            XB_SPIN(xb_ld(&bar[XB_XGEN(b.x)]) == gen, bar);
            __builtin_amdgcn_fence(__ATOMIC_ACQUIRE, "agent");
            asm volatile("s_waitcnt vmcnt(0)" ::: "memory");
        }
    }
    __syncthreads();
}
constexpr int NWAVES = 8;
constexpr int DM = 2048, NB = 4, TT = 4096, CT = 256, SB = 4352, MR = NB * SB  , FF = 5632;
constexpr int AB_IN = 4624, ZLD = 4864, CD_IN = 2304, NMOD = 9, MODN = NMOD * DM  ;
constexpr float EPS = 1e-6f;
constexpr int ZA_Q = 0, ZA_K = 1024, ZA_V = 1280, ZB_Q = 1536, ZB_K = 2048, ZB_V = 2560, ZB_O = 3584, ZB_G = 4608;
constexpr int ZC_U = 0, ZD_Q = 1024, ZD_K = 2048, ZD_V = 2176;
constexpr int KSPLIT = 32;
constexpr size_t MiB = 1u << 20;
constexpr size_t WS_CTL = 0, CTL_ZERO_BYTES = 1 * MiB;
constexpr size_t WS_WUP = 1 * MiB;
constexpr size_t WS_WDN = WS_WUP + 4 * 44 * MiB;
constexpr size_t WS_WABIN = WS_WDN + 4 * 22 * MiB;
constexpr size_t WS_WABOUT = WS_WABIN + 19 * MiB;
constexpr size_t WS_WCDIN = WS_WABOUT + 8 * MiB;
constexpr size_t WS_WCDOUT = WS_WCDIN + 9 * MiB;
constexpr size_t WS_WGLU = WS_WCDOUT + 8 * MiB;
constexpr size_t WS_MODP = WS_WGLU + 2 * MiB;
constexpr size_t WS_MODV = WS_MODP + 23 * MiB;
constexpr size_t WS_NRM = WS_MODV + 1 * MiB;
constexpr size_t WS_TAB = WS_NRM + 1 * MiB;
constexpr size_t WS_H = WS_TAB + 4 * MiB;
constexpr size_t WS_HN = WS_H + 136 * MiB;
constexpr size_t WS_X = WS_HN + 68 * MiB;
constexpr size_t WS_Z = WS_X, WS_ZT = WS_X + 163 * MiB, WS_HID = WS_X;
constexpr size_t WS_CAT = WS_X + 216 * MiB;
constexpr size_t WS_GATES = WS_CAT + 68 * MiB;
constexpr size_t WS_KA = WS_GATES + 2 * MiB;
constexpr size_t WS_G = WS_KA + 10 * MiB;
constexpr size_t WS_SC1 = WS_G + 34 * MiB;
constexpr size_t WS_SC2 = WS_SC1 + 68 * MiB;
constexpr size_t WS_END = WS_SC2 + 68 * MiB;
static_assert((size_t)MR * ZLD * 2 <= 163 * MiB && (size_t)1536 * MR * 2 <= 53 * MiB && (size_t)MR * FF * 2 <= 216 * MiB, "overlay");
constexpr size_t TB_ROPEA = 0;
constexpr size_t TB_ROPED = 16384;
constexpr size_t TB_S5AB = 32768;
constexpr size_t TB_S5BB = TB_S5AB + 65536;
constexpr size_t TB_VEC = TB_S5BB + 1048576;
constexpr int TV_GK = 0, TV_GQ = 128, TV_BGATE = 256, TV_SINK = 272, TV_HEADG = 512, TV_DSKIP = 1536, TV_GLUB = 2560, TV_FINALG = 3584, TV_N = 5632;
constexpr size_t TB_S5C = TB_VEC + 32768;
constexpr size_t TB_S5BT = TB_S5C + 1048576;
constexpr size_t TB_S5CT = TB_S5BT + 524288;
constexpr size_t TB_END = TB_S5CT + 524288;
static_assert(TB_END <= 4 * MiB, "tables");
constexpr int CW_TMO = 0, CW_BAR = 4096;
constexpr int RING_OFF = 0, RING_BYTES = 131072;
constexpr int LDSCTL_OFF = RING_BYTES, MISC_OFF = LDSCTL_OFF + 320;
constexpr int LDS_BYTES = 147456;
static_assert(MISC_OFF + 128 <= LDSCTL_OFF + 512 && LDSCTL_OFF + 512 + 8 * 1024 <= LDS_BYTES, "LDS map");
__device__ __forceinline__ float bf2f(bf16 v) { return __builtin_bit_cast(float, (unsigned)v << 16); }
__device__ __forceinline__ float wave_sum(float v) {
#pragma unroll
    for (int o = 1; o < 64; o <<= 1) v += __shfl_xor(v, o);
    return v;
}
__device__ __forceinline__ float wave_sum_l(float v, int lane) {
#pragma unroll
    for (int o = 1; o < 64; o <<= 1) v += __builtin_bit_cast(float, __builtin_amdgcn_ds_bpermute((lane ^ o) << 2, __builtin_bit_cast(int, v)));
    return v;
}
#define OPAQUE(x) asm volatile("" : "+v"(x))
__device__ __forceinline__ float silu_acc(float x) { return x / (1.f + expf(-x)); }
__device__ __forceinline__ float logsigmoid_acc(float x) { return x >= 0.f ? -log1pf(expf(-x)) : x - log1pf(expf(x)); }
__device__ __forceinline__ float gelu_tanh(float x) { const float u = 0.7978845608028654f * (x + 0.044715f * x * x * x); return 0.5f * x * (1.f + tanhf(u)); }
__device__ __forceinline__ int row_sel(int m) { return m < NB * TT ? (m >> 12) : 4; }

struct Frame {
    LAS unsigned char* lds;
    volatile LAS unsigned* MISC;
    gu32* ctl;
    int wave, G;
    float* out; unsigned char* ws;
};

__device__ __forceinline__ void p0_transpose_item(const float* W, int K, int N, int Nvalid, bf16* WT, int drow0, int k0, int n0, LAS float* scr, int lane) {
    const int nn = n0 + (lane & 31); const bool ok = nn < Nvalid;
#pragma unroll
    for (int i = 0; i < 32; ++i) { const int kk = 2 * i + (lane >> 5); scr[kk * 33 + (lane & 31)] = ok ? __builtin_nontemporal_load(W + (size_t)(k0 + kk) * N + nn) : 0.f; }
    LDS_WAIT(); asm volatile("" ::: "memory");
    const int c = lane & 7;
#pragma unroll
    for (int j = 0; j < 4; ++j) { const int n = (lane >> 3) + 8 * j; const LAS float* s = scr + (8 * c) * 33 + n;
        v4u o; o.x = pk2(s[0 * 33], s[1 * 33]); o.y = pk2(s[2 * 33], s[3 * 33]); o.z = pk2(s[4 * 33], s[5 * 33]); o.w = pk2(s[6 * 33], s[7 * 33]);
        *(GAS v4u*)(WT + (size_t)(drow0 + n) * K + k0 + 8 * c) = o; }
    LDS_WAIT(); asm volatile("" ::: "memory");
}
__device__ __forceinline__ bool p0_mat(int& r, const float* W, int K, int N, int Npad, bf16* WT, int mode  , LAS float* scr, int lane) {
    const int nblk = Npad / 32, items = (K / 64) * nblk;
    if (r >= items) { r -= items; return false; }
    const int kb = 8 * (r / (8 * nblk)) + (r & 7), nb = (r >> 3) % nblk, n0 = 32 * nb;
    int drow0 = n0; if (mode) drow0 = (n0 >> 7) * 256 + (n0 & 127) + (mode == 2 ? 128 : 0);
    p0_transpose_item(W, K, N, N, WT, drow0, 64 * kb, n0, scr, lane);
    return true;
}
__device__ __forceinline__ void p0_prologue(Frame& F, const float* const (&in)[30]) {
    LAS float* scr = (LAS float*)(F.lds + RING_OFF + F.wave * 8448);
    LAS float* ssilu = (LAS float*)(F.lds + RING_OFF + 8 * 8448);
    { const int t = fresh_tid(F.wave); for (int i = t; i < 5 * DM; i += NWAVES * 64) ssilu[i] = silu_acc(i < 4 * DM ? in[1][i] : in[3][i - 4 * DM]); }
    __syncthreads();
    const int lane = fresh_lane();
    const int gw = blockIdx.x * NWAVES + F.wave, NGW = F.G * NWAVES;
    unsigned char* ws = F.ws;
    {
        constexpr int NCH = MODN / 256, NIT = 2 * KSPLIT * NCH, KPER = DM / KSPLIT;
        for (int it = gw; it < NIT; it += NGW) {
            const int cc = it % NCH, ks = (it / NCH) % KSPLIT, l = it / (NCH * KSPLIT);
            const float* W = in[4] + (size_t)l * DM * MODN + (size_t)(ks * KPER) * MODN + cc * 256 + lane * 4;
            f32x4 a0 = {0, 0, 0, 0}, a1 = a0, a2 = a0, a3 = a0, a4 = a0;
#pragma unroll 16
            for (int k = 0; k < KPER; ++k) {
                const f32x4 w = __builtin_nontemporal_load((const f32x4*)(W + (size_t)k * MODN)); const int kk = ks * KPER + k;
                const float s0 = ssilu[kk], s1 = ssilu[DM + kk], s2 = ssilu[2 * DM + kk], s3 = ssilu[3 * DM + kk], s4 = ssilu[4 * DM + kk];
                a0 += w * s0; a1 += w * s1; a2 += w * s2; a3 += w * s3; a4 += w * s4;
            }
            float* P = (float*)(ws + WS_MODP) + ((size_t)(l * KSPLIT + ks) * 5) * MODN + cc * 256 + lane * 4;
            *(f32x4*)(P) = a0; *(f32x4*)(P + MODN) = a1; *(f32x4*)(P + 2 * MODN) = a2; *(f32x4*)(P + 3 * MODN) = a3; *(f32x4*)(P + 4 * MODN) = a4;
        }
    }
    {
        constexpr int I_UP = (DM / 64) * (FF / 32), I_DN = (FF / 64) * (DM / 32);
        constexpr int NIT = 8 * I_UP + 4 * I_DN + (DM / 64) * (ZLD / 32) + 2 * (DM / 64) * (DM / 32) + (DM / 64) * (CD_IN / 32) + (1024 / 64) * (1024 / 32);
        for (int it = gw; it < NIT; it += NGW) {
            int r = it; bool done = false;
#pragma unroll 1
            for (int lh = 0; lh < 4 && !done; ++lh) {
                bf16* up = (bf16*)(ws + WS_WUP + (size_t)lh * 44 * MiB);
                done = p0_mat(r, in[7] + (size_t)lh * DM * FF, DM, FF, FF, up, 1, scr, lane); if (done) break;
                done = p0_mat(r, in[8] + (size_t)lh * DM * FF, DM, FF, FF, up, 2, scr, lane); if (done) break;
                done = p0_mat(r, in[9] + (size_t)lh * FF * DM, FF, DM, DM, (bf16*)(ws + WS_WDN + (size_t)lh * 22 * MiB), 0, scr, lane);
            }
            if (done) continue;
            {
                const int nblk = ZLD / 32, items = (DM / 64) * nblk;
                if (r < items) { const int kb = 8 * (r / (8 * nblk)) + (r & 7), nb = (r >> 3) % nblk; p0_transpose_item(in[10], DM, AB_IN, AB_IN, (bf16*)(ws + WS_WABIN), 32 * nb, 64 * kb, 32 * nb, scr, lane); continue; }
                r -= items;
            }
            if (p0_mat(r, in[12], DM, DM, DM, (bf16*)(ws + WS_WABOUT), 0, scr, lane)) continue;
            if (p0_mat(r, in[16], DM, CD_IN, CD_IN, (bf16*)(ws + WS_WCDIN), 0, scr, lane)) continue;
            if (p0_mat(r, in[17], DM, DM, DM, (bf16*)(ws + WS_WCDOUT), 0, scr, lane)) continue;
            p0_mat(r, in[26], 1024, 1024, 1024, (bf16*)(ws + WS_WGLU), 0, scr, lane);
        }
    }
    {
        const int tid_ = fresh_tid(F.wave); const int gt = blockIdx.x * (NWAVES * 64) + tid_, NT = F.G * NWAVES * 64;
        float* ropeA = (float*)(ws + WS_TAB + TB_ROPEA); float* ropeD = (float*)(ws + WS_TAB + TB_ROPED);
        for (int i = gt; i < 64 * 32; i += NT) { const int pos = i >> 5, f = i & 31; const float inv = powf(10000.f, -(float)f / 32.f), a = (float)pos * inv; ropeA[2 * i] = cosf(a); ropeA[2 * i + 1] = sinf(a); }
        for (int i = gt; i < 64 * 16; i += NT) { const int pos = i >> 4, f = i & 15; const float inv = powf(10000.f, -(float)f / 16.f), a = (float)pos * inv; ropeD[2 * i] = cosf(a); ropeD[2 * i + 1] = sinf(a); }
        float* s5ab = (float*)(ws + WS_TAB + TB_S5AB); float* s5bb = (float*)(ws + WS_TAB + TB_S5BB); bf16* s5bt = (bf16*)(ws + WS_TAB + TB_S5BT); bf16* s5ct = (bf16*)(ws + WS_TAB + TB_S5CT);
        for (int i = gt; i < 2 * 64 * 64; i += NT) {
            const int dg = i >> 6;
            const float are = in[18][i], aim = in[19][i], dt = expf(in[20][dg]);
            const float mag = expf(are * dt), abr = mag * cosf(aim * dt), abi = mag * sinf(aim * dt);
            const float den = are * are + aim * aim, nr = abr - 1.f, ni = abi;
            const float kre = (nr * are + ni * aim) / den, kim = (ni * are - nr * aim) / den;
            s5ab[2 * i] = abr; s5ab[2 * i + 1] = abi;
            for (int q = 0; q < 16; ++q) { const float br = in[21][(size_t)i * 16 + q], bi = in[22][(size_t)i * 16 + q];
                const float bbr = kre * br - kim * bi, bbi = kre * bi + kim * br;
                s5bb[((size_t)i * 16 + q) * 2] = bbr; s5bb[((size_t)i * 16 + q) * 2 + 1] = bbi;
                s5bt[((size_t)dg * 128 + (i & 63)) * 16 + q] = (bf16)f2bf(bbr); s5bt[((size_t)dg * 128 + 64 + (i & 63)) * 16 + q] = (bf16)f2bf(bbi); }
        }
        for (int i = gt; i < 2 * 64 * 16 * 128; i += NT) { const int pp = i & 127, dgo = i >> 7;
            s5ct[i] = (bf16)f2bf(pp < 64 ? in[23][(size_t)dgo * 64 + pp] : -in[24][(size_t)dgo * 64 + pp - 64]); }
        float* tv = (float*)(ws + WS_TAB + TB_VEC);
        for (int i = gt; i < TV_N; i += NT) { float v = 0.f;
            if (i < TV_GQ) v = in[14][i]; else if (i < TV_BGATE) v = in[13][i - TV_GQ]; else if (i < TV_SINK) v = in[11][i - TV_BGATE]; else if (i < TV_SINK + 16) v = in[28][i - TV_SINK];
            else if (i >= TV_HEADG && i < TV_DSKIP) v = in[15][i - TV_HEADG]; else if (i >= TV_DSKIP && i < TV_GLUB) v = in[25][i - TV_DSKIP];
            else if (i >= TV_GLUB && i < TV_FINALG) v = in[27][i - TV_GLUB]; else if (i >= TV_FINALG) v = in[29][i - TV_FINALG];
            tv[i] = v; }
        float* s5c = (float*)(ws + WS_TAB + TB_S5C);
        for (int i = gt; i < 2 * 131072; i += NT) s5c[i] = i < 131072 ? in[23][i] : in[24][i - 131072];
    }
}
__device__ __forceinline__ float p1_sum(const float* P, const float* modb, int l, int sel, int idx, int c) {
    const GAS float* pp = (const GAS float*)P + ((size_t)(l * KSPLIT) * 5 + sel) * MODN + idx * DM + c; float s = 0.f;
#pragma unroll
    for (int ks = 0; ks < KSPLIT; ++ks) s += pp[(size_t)ks * 5 * MODN];
    return s + modb[l * MODN + idx * DM + c];
}
__device__ __forceinline__ void p1_modreduce(Frame& F, const float* modb, const float* normg) {
    const int tid_ = fresh_tid(F.wave); const int gt = blockIdx.x * (NWAVES * 64) + tid_, NT = F.G * NWAVES * 64;
    const float* P = (const float*)(F.ws + WS_MODP); float* MV = (float*)(F.ws + WS_MODV); float* NR = (float*)(F.ws + WS_NRM);
    for (int i = gt; i < 2 * 5 * 9 * DM; i += NT) { const int c = i % DM, idx = (i / DM) % 9, sel = (i / (9 * DM)) % 5, l = i / (45 * DM);
        MV[((size_t)(l * 5 + sel) * 9 + idx) * DM + c] = p1_sum(P, modb, l, sel, idx, c); }
    for (int i = gt; i < 2 * 5 * 3 * DM; i += NT) { const int c = i % DM, w = (i / DM) % 3, sel = (i / (3 * DM)) % 5, l = i / (15 * DM);
        const float g = normg[(l * 3 + w) * DM + c];
        NR[(((size_t)(l * 5 + sel) * 3 + w) * 2) * DM + c] = g * (1.f + p1_sum(P, modb, l, sel, 3 * w + 1, c));
        NR[(((size_t)(l * 5 + sel) * 3 + w) * 2 + 1) * DM + c] = p1_sum(P, modb, l, sel, 3 * w, c); }
}
template <int PS>
__device__ __forceinline__ void norm_phase(Frame& F, unsigned char* ws, const float* xin, const float* cin, int l, int which, bool first, int nrows, const float* pgate = nullptr, float pcoef = 0.f) {
    const int lane = fresh_lane();
    const int gw = blockIdx.x * NWAVES + F.wave, NGW = F.G * NWAVES;
    float* H = (float*)(ws + WS_H); bf16* HN = (bf16*)(ws + WS_HN); const float* NR = (const float*)(ws + WS_NRM);
#define NP_SRC(m_) ((const GAS f32x4*)(first ? ((m_) < NB * TT ? xin + (size_t)(m_) * DM : cin + (size_t)((m_) - NB * TT) * DM) : H + (size_t)(m_) * DM) + lane)
    const bool bal = PS > 0 && nrows == MR && NGW == 2048;
    const int cnt = bal ? (gw < 1024 ? 6 : 11) : (gw < nrows ? (nrows - gw + NGW - 1) / NGW : 0);
#define NROW(i) (bal ? (gw < 1024 ? ((i) < 5 ? 11264 + gw + 1024 * (i) : NB * TT + gw) : (gw - 1024) + 1024 * (i)) : gw + (i) * NGW)
    f32x4 vn[8];
    if (cnt > 0) { const int m0 = NROW(0); const GAS f32x4* xr = NP_SRC(m0);
#pragma unroll
        for (int j = 0; j < 8; ++j) vn[j] = xr[64 * j]; }
    for (int it = 0; it < cnt; ++it) {
        const int m = NROW(it);
        f32x4 v[8];
#pragma unroll
        for (int j = 0; j < 8; ++j) v[j] = vn[j];
        const int mn = NROW(it + 1);
        if (it + 1 < cnt) { const GAS f32x4* xr = NP_SRC(mn);
#pragma unroll
            for (int j = 0; j < 8; ++j) vn[j] = xr[64 * j]; }
        const int sel = row_sel(m);
        const GAS f32x4* Ap = (const GAS f32x4*)(NR + (((size_t)(l * 5 + sel) * 3 + which) * 2) * DM) + lane; const GAS f32x4* Bp = Ap + DM / 4;
        const bool merge = PS > 0 && m >= NB * TT;
        if (merge) { const GAS f32x4* pp = (const GAS f32x4*)((const float*)(ws + WS_SC1) + (size_t)(m - NB * TT) * DM) + lane; const GAS f32x4* gp = (const GAS f32x4*)pgate + lane;
#pragma unroll
            for (int j = 0; j < 8; ++j) { f32x4 a = pp[64 * j];
#pragma unroll
                for (int q = 1; q < (PS > 0 ? PS : 1); ++q) a += pp[(size_t)q * (1024 * DM / 4) + 64 * j];
                v[j] += gp[64 * j] * pcoef * a; } }
        float s = 0.f;
#pragma unroll
        for (int j = 0; j < 8; ++j) s += (v[j].x * v[j].x + v[j].y * v[j].y) + (v[j].z * v[j].z + v[j].w * v[j].w);
        const float rstd = 1.f / sqrtf(wave_sum_l(s, lane) * (1.f / DM) + EPS);
        if (first || merge) { GAS f32x4* hw = (GAS f32x4*)(H + (size_t)m * DM) + lane;
#pragma unroll
            for (int j = 0; j < 8; ++j) hw[64 * j] = v[j]; }
        GAS unsigned long long* o8 = (GAS unsigned long long*)(HN + (size_t)m * DM) + lane;
#pragma unroll
        for (int j = 0; j < 8; ++j) { const f32x4 a = Ap[64 * j], b = Bp[64 * j]; const f32x4 y = v[j] * rstd * a + b;
            o8[64 * j] = (unsigned long long)pk2(y.x, y.y) | ((unsigned long long)pk2(y.z, y.w) << 32); }
    }
#undef NP_SRC
#undef NROW
}
__device__ __forceinline__ void final_norm_phase(Frame& F, unsigned char* ws) {
    const int lane = fresh_lane();
    const int gw = blockIdx.x * NWAVES + F.wave, NGW = F.G * NWAVES;
    const float* H = (const float*)(ws + WS_H);
    f32x4 vn[8];
    { const GAS f32x4* xr = (const GAS f32x4*)(H + (size_t)gw * DM) + lane;
#pragma unroll
      for (int j = 0; j < 8; ++j) vn[j] = xr[64 * j]; }
    for (int m = gw; m < NB * TT; m += NGW) {
        f32x4 v[8]; float s = 0.f;
#pragma unroll
        for (int j = 0; j < 8; ++j) { v[j] = vn[j]; s += (v[j].x * v[j].x + v[j].y * v[j].y) + (v[j].z * v[j].z + v[j].w * v[j].w); }
        if (m + NGW < NB * TT) { const GAS f32x4* xr = (const GAS f32x4*)(H + (size_t)(m + NGW) * DM) + lane;
#pragma unroll
            for (int j = 0; j < 8; ++j) vn[j] = xr[64 * j]; }
        const float rstd = 1.f / sqrtf(wave_sum_l(s, lane) * (1.f / DM) + EPS);
        const GAS f32x4* gp = (const GAS f32x4*)((const float*)(ws + WS_TAB + TB_VEC) + TV_FINALG) + lane; GAS f32x4* o = (GAS f32x4*)(F.out + (size_t)m * DM) + lane;
#pragma unroll
        for (int j = 0; j < 8; ++j) o[64 * j] = v[j] * rstd * gp[64 * j];
    }
}
template <int MODE> __device__ __forceinline__ void naive_kprep(int gw, int lane, const bf16* Z, bf16* KO, const float* gk, const float* rope) {
    if (MODE == 0) {
        if (gw >= MR * 2) return;
        const int m = gw >> 1, kvh = gw & 1; const bf16* zr = Z + (size_t)m * ZLD + ZA_K + kvh * 128;
        float x1 = bf2f(zr[lane]), x2 = bf2f(zr[64 + lane]);
        const float rstd = 1.f / sqrtf(wave_sum_l(x1 * x1 + x2 * x2, lane) * (1.f / 128.f) + EPS);
        x1 *= rstd * gk[lane]; x2 *= rstd * gk[64 + lane];
        if (m < NB * TT) { const int t = m & (TT - 1), pos = lane < 32 ? (t >> 6) : (t & 63), f = lane & 31; const float c = rope[2 * (pos * 32 + f)], s = rope[2 * (pos * 32 + f) + 1];
            const float o1 = x1 * c - x2 * s, o2 = x2 * c + x1 * s; x1 = o1; x2 = o2; }
        KO[(size_t)m * 256 + kvh * 128 + lane] = (bf16)f2bf(x1); KO[(size_t)m * 256 + kvh * 128 + 64 + lane] = (bf16)f2bf(x2);
    } else {
        if (gw >= MR) return;
        const int m = gw, kvh = lane >> 5, j = lane & 31; const bf16* zr = Z + (size_t)m * CD_IN + ZD_K + kvh * 64;
        float x1 = bf2f(zr[j]), x2 = bf2f(zr[32 + j]);
        if (m < NB * TT) { const int t = m & (TT - 1), pos = j < 16 ? (t >> 6) : (t & 63), f = j & 15; const float c = rope[2 * (pos * 16 + f)], s = rope[2 * (pos * 16 + f) + 1];
            const float o1 = x1 * c - x2 * s, o2 = x2 * c + x1 * s; x1 = o1; x2 = o2; }
        KO[(size_t)m * 128 + kvh * 64 + j] = (bf16)f2bf(x1); KO[(size_t)m * 128 + kvh * 64 + 32 + j] = (bf16)f2bf(x2);
    }
}
template <int DH, int MODE> __device__ __forceinline__ void naive_attn(int vb, int vtid, const bf16* Z, const bf16* KB, bf16* CAT, const float* gq, const float* rope, const float* sink) {
    constexpr int H4 = DH / 4, NF = DH / 4, NH = (MODE == 2) ? 16 : 8, QPB = 128;
    constexpr int NQ = (MODE == 1) ? CT : TT, LDZ = (MODE == 2) ? CD_IN : ZLD, LDK = (MODE == 2) ? 128 : 256;
    constexpr int QCOL = (MODE == 2) ? ZD_Q : ZA_Q, VCOL = (MODE == 2) ? ZD_V : ZA_V, OCOL = (MODE == 2) ? 1024 : 0;
    const int nchunk = NQ / QPB; int bid = vb; const int qc = bid % nchunk; bid /= nchunk; const int head = bid % NH, b = bid / NH;
    const int kvh = head / (NH / 2), part = vtid & 3, r = vtid >> 2, qi = qc * QPB + r;
    const int m = (MODE == 1) ? (NB * TT + b * CT + qi) : (b * TT + qi);
    float q[H4], acc[H4];
    const bf16* qp = Z + (size_t)m * LDZ + QCOL + head * DH + part * H4;
#pragma unroll
    for (int i = 0; i < H4; ++i) { q[i] = bf2f(qp[i]); acc[i] = 0.f; }
    if (MODE != 2) { float ss = 0.f;
#pragma unroll
        for (int i = 0; i < H4; ++i) ss += q[i] * q[i];
        ss += __shfl_xor(ss, 1); ss += __shfl_xor(ss, 2); const float rstd = 1.f / sqrtf(ss * (1.f / DH) + EPS);
#pragma unroll
        for (int i = 0; i < H4; ++i) q[i] *= rstd * gq[part * H4 + i]; }
    if (MODE != 1) { const int t = qi;
#pragma unroll
        for (int i = 0; i < H4; ++i) { const int j = (part & 1) * H4 + i;
            const int pos = j < NF ? (t >> 6) : (t & 63), f = j % NF; const float c = rope[2 * (pos * NF + f)], s = rope[2 * (pos * NF + f) + 1];
            const float other = __shfl_xor(q[i], 2); q[i] = part < 2 ? (q[i] * c - other * s) : (q[i] * c + other * s); } }
    const float scale = (DH == 128) ? 0.08838834764831845f : 0.125f;
#pragma unroll
    for (int i = 0; i < H4; ++i) q[i] *= scale;
    float mx = (MODE == 2) ? sink[head] : -1e30f, l = (MODE == 2) ? 1.f : 0.f;
    const int lat_lo = (MODE == 0) ? 0 : (MODE == 2 ? max(0, qc * QPB - 128) : 0), lat_hi = (MODE == 0) ? TT : (MODE == 2 ? min(TT, qc * QPB + QPB + 128) : 0);
    const int nkeys = CT + (lat_hi - lat_lo);
#pragma unroll 2
    for (int kk = 0; kk < nkeys; ++kk) {
        const int kpos = kk - CT + lat_lo;
        const int km = kk < CT ? (NB * TT + b * CT + kk) : (b * TT + kpos);
        const bf16* kp = KB + (size_t)km * LDK + kvh * DH + part * H4;
        float s = 0.f;
#pragma unroll
        for (int i = 0; i < H4; ++i) s += q[i] * bf2f(kp[i]);
        s += __shfl_xor(s, 1); s += __shfl_xor(s, 2);
        if (MODE == 2 && kk >= CT && abs(kpos - qi) > 128) continue;
        const float mn = fmaxf(mx, s), al = expf(mx - mn), p = expf(s - mn);
        l = l * al + p; mx = mn;
        const bf16* vp = Z + (size_t)km * LDZ + VCOL + kvh * DH + part * H4;
#pragma unroll
        for (int i = 0; i < H4; ++i) acc[i] = acc[i] * al + p * bf2f(vp[i]);
    }
    const float il = 1.f / l;
    bf16* op = CAT + (size_t)m * DM + OCOL + head * DH + part * H4;
#pragma unroll
    for (int i = 0; i < H4; ++i) op[i] = (bf16)f2bf(acc[i] * il);
}
__device__ __forceinline__ void naive_mlstm(int seq, int tid, LAS float* sq, const bf16* Z, const float* GATES, const float* bgate, float* HF, float* HB) {
    const int b = seq >> 3, h = (seq >> 1) & 3, dir = seq & 1;
    LAS float* sk = sq + 128; LAS float* sred = sq + 256;
    const int v = tid >> 1, half = tid & 1, lane = tid & 63, wave = tid >> 6;
    float C[64];
#pragma unroll
    for (int j = 0; j < 64; ++j) C[j] = 0.f;
    float nreg = 0.f, mstate = 0.f;
    const float bi = bgate[(2 * dir) * 4 + h], bfg = bgate[(2 * dir + 1) * 4 + h];
    float* HO = dir ? HB : HF;
    for (int p = 0; p < SB; ++p) {
        const int s = dir == 0 ? p : (p < CT ? CT - 1 - p : CT + (SB - 1 - p));
        const int m = s < CT ? (NB * TT + b * CT + s) : (b * TT + s - CT);
        const bf16* zr = Z + (size_t)m * ZLD;
        if (tid < 128) sq[tid] = bf2f(zr[ZB_Q + h * 128 + tid]) * 0.08838834764831845f; else if (tid < 256) sk[tid - 128] = bf2f(zr[ZB_K + h * 128 + tid - 128]);
        const float vv = bf2f(zr[ZB_V + h * 256 + v]);
        const float ig = GATES[(size_t)m * 16 + (2 * dir) * 4 + h] + bi, lf = logsigmoid_acc(GATES[(size_t)m * 16 + (2 * dir + 1) * 4 + h] + bfg);
        const float mn = fmaxf(lf + mstate, ig), ip = expf(ig - mn), fp = expf(lf + mstate - mn); mstate = mn;
        __syncthreads();
        float dpart = 0.f; if (tid < 128) { nreg = fp * nreg + ip * sk[tid]; dpart = nreg * sq[tid]; }
        if (wave < 2) { dpart = wave_sum_l(dpart, lane); if (lane == 0) sred[wave] = dpart; }
        float np = 0.f; const float iv = ip * vv;
#pragma unroll
        for (int j = 0; j < 64; ++j) { C[j] = fp * C[j] + iv * sk[64 * half + j]; np += C[j] * sq[64 * half + j]; }
        np += __builtin_bit_cast(float, __builtin_amdgcn_ds_bpermute((lane ^ 1) << 2, __builtin_bit_cast(int, np)));
        __syncthreads();
        const float den = sred[0] + sred[1];
        if (half == 0) HO[(size_t)m * 1024 + h * 256 + v] = np / fmaxf(fabsf(den), expf(-mn));
        __syncthreads();
    }
}
__device__ __forceinline__ void naive_mlstm_finish(int gw, int lane, const bf16* Z, const float* HF, const float* HB, const float* headg, bf16* CAT) {
    const int m = gw >> 2, h = gw & 3; const size_t o = (size_t)m * 1024 + h * 256 + lane * 4;
    const f32x4 a = *(const f32x4*)(HF + o), bb = *(const f32x4*)(HB + o); const f32x4 hh = a + bb;
    const float rstd = 1.f / sqrtf(wave_sum_l((hh.x * hh.x + hh.y * hh.y) + (hh.z * hh.z + hh.w * hh.w), lane) * (1.f / 256.f) + EPS);
    const bf16* og = Z + (size_t)m * ZLD + ZB_O + h * 256 + lane * 4; bf16* cp = CAT + (size_t)m * DM + 1024 + h * 256 + lane * 4;
#pragma unroll
    for (int j = 0; j < 4; ++j) { const float sg = 1.f / (1.f + expf(-bf2f(og[j]))); cp[j] = (bf16)f2bf(sg * hh[j] * rstd * headg[h * 256 + lane * 4 + j]); }
}
__device__ __forceinline__ void naive_s5(int id, int lane, const bf16* Z, const float* s5ab, const float* s5bb, const float* cre_in, const float* cim_in, float* YF, float* YB) {
    const int b = id >> 7, g = (id >> 1) & 63, dir = id & 1;
    const int i = (dir * 64 + g) * 64 + lane;
    const float ar = s5ab[2 * i], ai = s5ab[2 * i + 1];
    float Br[16], Bi[16], cr[16], ci[16];
#pragma unroll
    for (int q = 0; q < 16; ++q) { Br[q] = s5bb[((size_t)i * 16 + q) * 2]; Bi[q] = s5bb[((size_t)i * 16 + q) * 2 + 1];
        cr[q] = cre_in[((size_t)(dir * 64 + g) * 16 + q) * 64 + lane]; ci[q] = cim_in[((size_t)(dir * 64 + g) * 16 + q) * 64 + lane]; }
    float xr = 0.f, xi = 0.f; float* Y = dir ? YB : YF;
    for (int p = 0; p < SB; ++p) {
        const int s = dir == 0 ? p : (p < CT ? CT - 1 - p : CT + (SB - 1 - p));
        const int m = s < CT ? (NB * TT + b * CT + s) : (b * TT + s - CT);
        const bf16* up = Z + (size_t)m * CD_IN + ZC_U + g * 16;
        float bur = 0.f, bui = 0.f;
#pragma unroll
        for (int q = 0; q < 16; ++q) { const float u = bf2f(up[q]); bur += Br[q] * u; bui += Bi[q] * u; }
        const float nxr = ar * xr - ai * xi + bur, nxi = ar * xi + ai * xr + bui; xr = nxr; xi = nxi;
        if (s >= CT) { float yo = 0.f;
#pragma unroll
            for (int q = 0; q < 16; ++q) { const float val = wave_sum_l(cr[q] * xr - ci[q] * xi, lane); if (lane == q) yo = val; }
            if (lane < 16) Y[(size_t)m * 1024 + g * 16 + lane] = yo; }
    }
}
__device__ __forceinline__ void naive_s5_finish(size_t i, const bf16* Z, const float* YF, const float* YB, const float* dskip, bf16* G) {
    const int m = (int)(i >> 10), c = (int)(i & 1023);
    const float y = YF[i] + YB[i] + dskip[c] * bf2f(Z[(size_t)m * CD_IN + ZC_U + c]);
    G[i] = (bf16)f2bf(gelu_tanh(y));
}
namespace att {
using bf16x8 = __attribute__((ext_vector_type(8))) short;
using s16x4  = __attribute__((ext_vector_type(4))) short;
using f32x16 = __attribute__((ext_vector_type(16))) float;
using u32x4  = __attribute__((ext_vector_type(4))) unsigned;
constexpr int NW = 8, QBLK = 32, KVBLK = 64;
constexpr size_t SHM_V = KVBLK * 128 * 2, SHM_K = KVBLK * 128 * 2, SHM_ATTN = 2 * SHM_V + 2 * SHM_K + NW * 64 * 4;
#define KSWZ(row, colB) ((row) * 256 + ((colB) ^ (((row) & 7) << 4)))
#define SBAR() __builtin_amdgcn_sched_barrier(0)
__device__ __forceinline__ int crow(int r, int hi) { return (r & 3) + 8 * (r >> 2) + 4 * hi; }
__device__ __forceinline__ unsigned cvtpk(float lo, float hi) { unsigned r; asm volatile("v_cvt_pk_bf16_f32 %0, %1, %2" : "=v"(r) : "v"(lo), "v"(hi)); return r; }
template <int DH> struct Cst { static constexpr float SCALE = (DH == 128) ? 0.088388347648318440f : 0.125f; };
constexpr float THR = 8.f;
#ifndef ATT_SDEPTH
#define ATT_SDEPTH 2
#endif
constexpr int SDEPTH = ATT_SDEPTH;
template <int DH> __device__ __forceinline__ void partialSM(f32x16& p0, f32x16& p1, float& m_reg, float& mn, float& alpha) {
  constexpr float SCALE = Cst<DH>::SCALE, C = SCALE * 1.4426950408889634f;
  float pmax = p0[0]; for (int r = 1; r < 16; ++r) pmax = fmaxf(pmax, p0[r]); for (int r = 0; r < 16; ++r) pmax = fmaxf(pmax, p1[r]);
  { auto rr = __builtin_amdgcn_permlane32_swap(__float_as_uint(pmax), __float_as_uint(pmax), false, false);
    pmax = fmaxf(__uint_as_float(rr[0]), __uint_as_float(rr[1])); }
  if (__builtin_expect(__all(pmax - m_reg <= THR / SCALE), 1)) { mn = m_reg; alpha = 1.f; }
  else { mn = fmaxf(m_reg, pmax); alpha = __builtin_amdgcn_exp2f((m_reg - mn) * C); m_reg = mn; }
  float mnC = -mn * C;
  for (int r = 0; r < 16; ++r) p0[r] = fmaf(p0[r], C, mnC); for (int r = 0; r < 16; ++r) p1[r] = fmaf(p1[r], C, mnC);
  for (int r = 0; r < 16; ++r) p0[r] = __builtin_amdgcn_exp2f(p0[r]);
}
__device__ __forceinline__ void finishSM(f32x16& p0, f32x16& p1, float alpha, float& l_reg, bf16x8& pa0, bf16x8& pa1, bf16x8& pa2, bf16x8& pa3) {
  for (int r = 0; r < 16; ++r) p1[r] = __builtin_amdgcn_exp2f(p1[r]);
  float ps = 0; for (int r = 0; r < 16; ++r) ps += p0[r]; for (int r = 0; r < 16; ++r) ps += p1[r];
  { auto rr = __builtin_amdgcn_permlane32_swap(__float_as_uint(ps), __float_as_uint(ps), false, false);
    ps = __uint_as_float(rr[0]) + __uint_as_float(rr[1]); }
  l_reg = l_reg * alpha + ps;
#define PK4(P, BASE, OUT) do { unsigned a0 = cvtpk(P[BASE + 0], P[BASE + 1]), a1 = cvtpk(P[BASE + 2], P[BASE + 3]);   \
    unsigned b0 = cvtpk(P[BASE + 4], P[BASE + 5]), b1 = cvtpk(P[BASE + 6], P[BASE + 7]);                              \
    auto r0 = __builtin_amdgcn_permlane32_swap(a0, b0, false, false); auto r1 = __builtin_amdgcn_permlane32_swap(a1, b1, false, false); \
    u32x4 w = {r0[0], r1[0], r0[1], r1[1]}; OUT = *reinterpret_cast<bf16x8*>(&w); } while (0)
  PK4(p0, 0, pa0); PK4(p0, 8, pa1); PK4(p1, 0, pa2); PK4(p1, 8, pa3);
#undef PK4
}
template <int DH> __device__ __forceinline__ void qkt(f32x16& p0, f32x16& p1, const bf16* Ks, const bf16x8* qr, int r32, int hi) {
  p0 = f32x16{}; p1 = f32x16{};
#pragma unroll
  for (int d0 = 0; d0 < DH / 16; ++d0) { int cb = (d0 * 16 + hi * 8) * 2;
    bf16x8 b0 = *reinterpret_cast<const bf16x8*>((const char*)Ks + KSWZ(r32, cb));
    bf16x8 b1 = *reinterpret_cast<const bf16x8*>((const char*)Ks + KSWZ(32 + r32, cb));
    p0 = __builtin_amdgcn_mfma_f32_32x32x16_bf16(b0, qr[d0], p0, 0, 0, 0);
    p1 = __builtin_amdgcn_mfma_f32_32x32x16_bf16(b1, qr[d0], p1, 0, 0, 0); }
}
__device__ __forceinline__ void wmask(f32x16& p0, f32x16& p1, int kp0, int qpos, int hi) {
#pragma unroll
  for (int r = 0; r < 16; ++r) { const int k = kp0 + crow(r, hi); const int d0 = k - qpos, d1 = k + 32 - qpos;
    if (d0 > 128 || d0 < -128) p0[r] = -1e30f; if (d1 > 128 || d1 < -128) p1[r] = -1e30f; }
}
__device__ __forceinline__ int v_st(int k, int c) { const int kk = (k & ~0xC) | ((k & 4) << 1) | ((k & 8) >> 1); return ((kk >> 3) * 4 + (c >> 5)) * 512 + ((kk & 7) * 32 + (c & 31)) * 2; }
__device__ __forceinline__ int v_rd_base(int lane) { return ((lane & 3) << 3) | (((lane >> 2) & 3) << 6) | (((lane >> 4) & 1) << 5) | (((lane >> 5) & 1) << 8); }
constexpr int v_rd_off(int d0, int ks, int half) { return d0 * 512 + ks * 4096 + half * 2048; }
template <int OFF> __device__ __forceinline__ s16x4 tr_read(int vb) {
  s16x4 r; asm volatile("ds_read_b64_tr_b16 %0, %1 offset:%2" : "=&v"(r) : "v"(vb), "i"(OFF) : "memory"); return r;
}
template <int D0> __device__ __forceinline__ void pv_one(f32x16& od, int vb, bf16x8 pa0, bf16x8 pa1, bf16x8 pa2, bf16x8 pa3) {
  const s16x4 l0 = tr_read<v_rd_off(D0, 0, 0)>(vb), h0 = tr_read<v_rd_off(D0, 0, 1)>(vb), l1 = tr_read<v_rd_off(D0, 1, 0)>(vb), h1 = tr_read<v_rd_off(D0, 1, 1)>(vb);
  const s16x4 l2 = tr_read<v_rd_off(D0, 2, 0)>(vb), h2 = tr_read<v_rd_off(D0, 2, 1)>(vb), l3 = tr_read<v_rd_off(D0, 3, 0)>(vb), h3 = tr_read<v_rd_off(D0, 3, 1)>(vb);
  asm volatile("s_waitcnt lgkmcnt(0)" ::: "memory"); SBAR();
#define PK(L, H) (bf16x8){L[0], L[1], L[2], L[3], H[0], H[1], H[2], H[3]}
  od = __builtin_amdgcn_mfma_f32_32x32x16_bf16(pa0, PK(l0, h0), od, 0, 0, 0);
  od = __builtin_amdgcn_mfma_f32_32x32x16_bf16(pa1, PK(l1, h1), od, 0, 0, 0);
  od = __builtin_amdgcn_mfma_f32_32x32x16_bf16(pa2, PK(l2, h2), od, 0, 0, 0);
  od = __builtin_amdgcn_mfma_f32_32x32x16_bf16(pa3, PK(l3, h3), od, 0, 0, 0);
#undef PK
}
template <int DH> __device__ __forceinline__ void pv_d0(f32x16* o, int vb, bf16x8 pa0, bf16x8 pa1, bf16x8 pa2, bf16x8 pa3) {
  pv_one<0>(o[0], vb, pa0, pa1, pa2, pa3); pv_one<1>(o[1], vb, pa0, pa1, pa2, pa3);
  if (DH == 128) { pv_one<2>(o[2], vb, pa0, pa1, pa2, pa3); pv_one<3>(o[3], vb, pa0, pa1, pa2, pa3); }
}
template <int DH, int MODE>
__device__ __forceinline__ void attn_unit(const bf16* __restrict__ Qb, int LDQ, const bf16* __restrict__ Kb, int LDKK, const bf16* __restrict__ Vb, int LDKV, bf16* __restrict__ Ob,
                                          int b, int i0  , const float* __restrict__ gq, const float* __restrict__ rope, float sinkv, char* lds, int wave_s) {
  const int tid = fresh_tid(wave_s);
  constexpr float SCALE = Cst<DH>::SCALE;
  const int wid = tid >> 6, lane = tid & 63, r32 = lane & 31, hi = lane >> 5;
  bf16* V_lds = (bf16*)lds; bf16* K_lds = (bf16*)(lds + 2 * SHM_V);
  float* ws = (float*)(lds + 2 * SHM_V + 2 * SHM_K) + wid * 64; float* li_l = ws; float* al_l = ws + 32;
  float m_reg = (MODE == 2) ? sinkv / SCALE : -1e30f, l_reg = (MODE == 2) ? 1.f : 0.f; f32x16 o[DH / 32] = {}; bf16x8 qr[DH / 16];
  const int qpos = i0 + wid * QBLK + r32;
  {
    const bf16* Qw = Qb + (long)(wid * QBLK + r32) * LDQ + hi * 8;
    float qf[DH / 16][8];
#pragma unroll
    for (int d0 = 0; d0 < DH / 16; ++d0) { const u32x4 w = *reinterpret_cast<const u32x4*>(Qw + d0 * 16);
#pragma unroll
      for (int e = 0; e < 4; ++e) { qf[d0][2 * e] = __uint_as_float(w[e] << 16); qf[d0][2 * e + 1] = __uint_as_float(w[e] & 0xffff0000u); } }
    if (MODE != 2) { float ss = 0.f;
#pragma unroll
      for (int d0 = 0; d0 < DH / 16; ++d0)
#pragma unroll
        for (int e = 0; e < 8; ++e) ss += qf[d0][e] * qf[d0][e];
      { auto rr = __builtin_amdgcn_permlane32_swap(__float_as_uint(ss), __float_as_uint(ss), false, false); ss = __uint_as_float(rr[0]) + __uint_as_float(rr[1]); }
      const float rstd = 1.f / sqrtf(ss * (1.f / DH) + EPS);
#pragma unroll
      for (int d0 = 0; d0 < DH / 16; ++d0)
#pragma unroll
        for (int e = 0; e < 8; ++e) qf[d0][e] *= rstd * ((const GAS float*)gq)[d0 * 16 + hi * 8 + e]; }
    if (MODE != 1) { constexpr int NF = DH / 4;
#pragma unroll
      for (int d0 = 0; d0 < DH / 32; ++d0)
#pragma unroll
        for (int e = 0; e < 8; ++e) { const int j = d0 * 16 + hi * 8 + e, pos = j < NF ? (qpos >> 6) : (qpos & 63), f = j % NF;
          const float c = ((const GAS float*)rope)[2 * (pos * NF + f)], s = ((const GAS float*)rope)[2 * (pos * NF + f) + 1], x1 = qf[d0][e], x2 = qf[d0 + DH / 32][e];
          qf[d0][e] = x1 * c - x2 * s; qf[d0 + DH / 32][e] = x2 * c + x1 * s; } }
#pragma unroll
    for (int d0 = 0; d0 < DH / 16; ++d0) { u32x4 w = {cvtpk(qf[d0][0], qf[d0][1]), cvtpk(qf[d0][2], qf[d0][3]), cvtpk(qf[d0][4], qf[d0][5]), cvtpk(qf[d0][6], qf[d0][7])}; qr[d0] = *reinterpret_cast<bf16x8*>(&w); }
  }
  const int kl0 = (MODE == 2) ? (i0 - 128 < 0 ? 0 : i0 - 128) : 0;
  const int kl1 = (MODE == 0) ? TT : (MODE == 2 ? (i0 + 384 > TT ? TT : i0 + 384) : 0);
  const int NT = 4 + (kl1 - kl0) / KVBLK;
  const long ctx0 = (long)NB * TT + (long)b * CT, lat0 = (long)b * TT + kl0;
#define TROW(j) ((j) < 4 ? ctx0 + (j) * KVBLK : lat0 + ((j) - 4) * KVBLK)
  const int sr = tid >> 4, sc = (tid & 15) * 8, vst0 = v_st(sr, sc), vst1 = v_st(32 + sr, sc);
  const bool ldok = (DH == 128) || sc < 64;
  const int vb0 = (int)(uintptr_t)V_lds + v_rd_base(lane);
  struct { bf16x8 vs0, vs1, ks0, ks1; } sr_[SDEPTH];
#pragma unroll
  for (int i_ = 0; i_ < SDEPTH; ++i_) sr_[i_].vs0 = sr_[i_].vs1 = sr_[i_].ks0 = sr_[i_].ks1 = bf16x8{};
#define SLOAD(i, j) do { if (ldok) { const long _r = TROW(j); sr_[i].vs0 = *reinterpret_cast<const bf16x8*>(&Vb[(_r + sr) * LDKV + sc]); sr_[i].vs1 = *reinterpret_cast<const bf16x8*>(&Vb[(_r + 32 + sr) * LDKV + sc]); \
    sr_[i].ks0 = *reinterpret_cast<const bf16x8*>(&Kb[(_r + sr) * LDKK + sc]); sr_[i].ks1 = *reinterpret_cast<const bf16x8*>(&Kb[(_r + 32 + sr) * LDKK + sc]); } } while (0)
#define SWRITE(bb, i) do { *(bf16x8*)((char*)V_lds + (bb) * SHM_V + vst0) = sr_[i].vs0;          \
    *(bf16x8*)((char*)V_lds + (bb) * SHM_V + vst1) = sr_[i].vs1; int kc = sc * 2;               \
    *(bf16x8*)((char*)K_lds + (bb) * SHM_K + KSWZ(sr, kc)) = sr_[i].ks0;                       \
    *(bf16x8*)((char*)K_lds + (bb) * SHM_K + KSWZ(32 + sr, kc)) = sr_[i].ks1; } while (0)
#define SWAIT() do { if (SDEPTH == 2) asm volatile("s_waitcnt vmcnt(4)" ::: "memory"); else asm volatile("s_waitcnt vmcnt(0)" ::: "memory"); } while (0)
#define RESC(a) do { if (__any((a) < 1.f)) { if (hi == 0) al_l[r32] = (a); asm volatile("s_waitcnt lgkmcnt(0)" ::: "memory"); \
    for (int d = 0; d < DH / 32; ++d) for (int r = 0; r < 16; ++r) o[d][r] *= al_l[crow(r, hi)]; } } while (0)
#define WMASK(P0, P1, j) do { if (MODE == 2 && (j) >= 4) wmask(P0, P1, kl0 + ((j) - 4) * KVBLK, qpos, hi); } while (0)
  f32x16 pA0, pA1, pB0, pB1; float mnA, mnB, alA, alB; bf16x8 pa0, pa1, pa2, pa3;
  constexpr int SE = 0, SO = SDEPTH - 1;
  SLOAD(SE, 0); asm volatile("s_waitcnt vmcnt(0)" ::: "memory"); SWRITE(0, SE); __syncthreads();
  qkt<DH>(pA0, pA1, K_lds, qr, r32, hi); WMASK(pA0, pA1, 0); partialSM<DH>(pA0, pA1, m_reg, mnA, alA);
  SLOAD(SO, 1); if (SDEPTH == 2) { if (2 < NT) SLOAD(SE, 2); }
  SWAIT(); SWRITE(1, SO); __syncthreads();
  for (int j = 1; j + 1 < NT; j += 2) {
    SBAR(); qkt<DH>(pB0, pB1, (bf16*)((char*)K_lds + SHM_K), qr, r32, hi); WMASK(pB0, pB1, j);
    finishSM(pA0, pA1, alA, l_reg, pa0, pa1, pa2, pa3); SBAR();
    SLOAD(SO, j + SDEPTH < NT ? j + SDEPTH : j); SBAR();
    pv_d0<DH>(o, vb0, pa0, pa1, pa2, pa3); partialSM<DH>(pB0, pB1, m_reg, mnB, alB);
    __syncthreads(); SWAIT(); SWRITE(0, SE);
    RESC(alB); __syncthreads();
    SBAR(); qkt<DH>(pA0, pA1, K_lds, qr, r32, hi); WMASK(pA0, pA1, j + 1);
    finishSM(pB0, pB1, alB, l_reg, pa0, pa1, pa2, pa3); SBAR();
    SLOAD(SE, j + 1 + SDEPTH < NT ? j + 1 + SDEPTH : j + 1); SBAR();
    pv_d0<DH>(o, vb0 + (int)SHM_V, pa0, pa1, pa2, pa3); partialSM<DH>(pA0, pA1, m_reg, mnA, alA);
    __syncthreads(); SWAIT(); SWRITE(1, SO);
    RESC(alA); __syncthreads();
  }
  SBAR(); qkt<DH>(pB0, pB1, (bf16*)((char*)K_lds + SHM_K), qr, r32, hi); WMASK(pB0, pB1, NT - 1);
  finishSM(pA0, pA1, alA, l_reg, pa0, pa1, pa2, pa3); SBAR();
  pv_d0<DH>(o, vb0, pa0, pa1, pa2, pa3); partialSM<DH>(pB0, pB1, m_reg, mnB, alB);
  __syncthreads(); RESC(alB);
  finishSM(pB0, pB1, alB, l_reg, pa0, pa1, pa2, pa3); SBAR();
  pv_d0<DH>(o, vb0 + (int)SHM_V, pa0, pa1, pa2, pa3);
  if (hi == 0) li_l[r32] = l_reg; asm volatile("s_waitcnt lgkmcnt(0)" ::: "memory");
  float rli[16];
#pragma unroll
  for (int r = 0; r < 16; ++r) rli[r] = __builtin_amdgcn_rcpf(li_l[crow(r, hi)]);
  bf16* Ow = Ob + (long)(wid * QBLK) * DM;
#pragma unroll
  for (int r = 0; r < 16; ++r) { int orow = crow(r, hi);
#pragma unroll
    for (int d0 = 0; d0 < DH / 32; ++d0) Ow[(long)orow * DM + d0 * 32 + r32] = (bf16)(cvtpk(o[d0][r] * rli[r], 0.f) & 0xffffu); }
  asm volatile("s_waitcnt vmcnt(0)" ::: "memory"); __syncthreads();
#undef SLOAD
#undef SWRITE
#undef SWAIT
#undef RESC
#undef WMASK
#undef TROW
}
}
namespace s5 {
using bf16x8 = __attribute__((ext_vector_type(8))) short;
using f32x16 = __attribute__((ext_vector_type(16))) float;
using f32x4v = __attribute__((ext_vector_type(4))) float;
using u32x4 = __attribute__((ext_vector_type(4))) unsigned;
using u32x2 = __attribute__((ext_vector_type(2))) unsigned;
constexpr int XROWB = 272;
constexpr int WAVE_LDS = 32 * XROWB;
__device__ __forceinline__ float bperm(float v, int srclane) { return __builtin_bit_cast(float, __builtin_amdgcn_ds_bpermute(srclane << 2, __builtin_bit_cast(int, v))); }
__device__ __forceinline__ float gelu_fast(float x) { const float u = 0.7978845608028654f * (x + 0.044715f * x * x * x); return x * __builtin_amdgcn_rcpf(1.f + __builtin_amdgcn_exp2f(-2.885390081777927f * u)); }
__device__ __forceinline__ void cmul(float& r, float& i, float ar, float ai) { const float nr = ar * r - ai * i, ni = ar * i + ai * r; r = nr; i = ni; }
__device__ __forceinline__ size_t seg_row0(int b, int seg) { return seg < 16 ? (size_t)b * TT + seg * 256 : (size_t)NB * TT + b * CT; }
template <int PASS>
__device__ __forceinline__ void s5_unit(int b, int g, int seg, const bf16* __restrict__ Z2, const float* __restrict__ s5ab, const bf16* __restrict__ BT, const bf16* __restrict__ CTb,
                                        float* __restrict__ SEND, const float* __restrict__ dskip, bf16* __restrict__ G, float* __restrict__ YT, LAS unsigned char* xl) {
  const int lane = fresh_lane();
  const int r32 = lane & 31, hi = lane >> 5, fr = lane & 15, fq = lane >> 4;
  const size_t row0 = seg_row0(b, seg);
  const int tau = 16 * ((r32 >> 2) & 1) + 4 * (r32 >> 3) + (r32 & 3);
#pragma unroll 1
  for (int dir = 0; dir < 2; ++dir) {
    const int dg = dir * 64 + g;
    float ar[2], ai[2], a16r[2], a16i[2];
#pragma unroll
    for (int s = 0; s < 2; ++s) { typedef float f32x2s __attribute__((ext_vector_type(2))); const f32x2s v = *(const GAS f32x2s*)(s5ab + 2 * (dg * 64 + r32 + 32 * s)); ar[s] = v.x; ai[s] = v.y; a16r[s] = v.x; a16i[s] = v.y;
#pragma unroll
      for (int k = 0; k < 4; ++k) cmul(a16r[s], a16i[s], a16r[s], a16i[s]); }
    bf16x8 bfr[4];
#pragma unroll
    for (int k = 0; k < 4; ++k) bfr[k] = *(const GAS bf16x8*)(BT + ((size_t)dg * 128 + 32 * k + r32) * 16 + hi * 8);
    float cr[2] = {0.f, 0.f}, ci[2] = {0.f, 0.f};
    if (PASS == 2) {
      float a256r[2], a256i[2];
#pragma unroll
      for (int s = 0; s < 2; ++s) { a256r[s] = a16r[s]; a256i[s] = a16i[s];
#pragma unroll
        for (int k = 0; k < 4; ++k) cmul(a256r[s], a256i[s], a256r[s], a256i[s]); }
      const float* Sb = SEND + ((size_t)(dir * NB + b) * 64 + g) * 17 * 128;
      { const float* p = Sb + 16 * 128;
#pragma unroll
        for (int s = 0; s < 2; ++s) { cr[s] = p[r32 + 32 * s]; ci[s] = p[64 + r32 + 32 * s]; } }
      const int nprev = dir == 0 ? seg : 15 - seg;
#pragma unroll 1
      for (int k = 0; k < nprev; ++k) { const float* p = Sb + (dir == 0 ? k : 15 - k) * 128;
#pragma unroll
        for (int s = 0; s < 2; ++s) { cmul(cr[s], ci[s], a256r[s], a256i[s]); cr[s] += p[r32 + 32 * s]; ci[s] += p[64 + r32 + 32 * s]; } }
    }
    const bf16* CT_dg = CTb + (size_t)dg * 16 * 128;
    bf16x8 cfr[4]; f32x4v dk = {0.f, 0.f, 0.f, 0.f};
    if (PASS == 2) { dk = *(const GAS f32x4v*)(dskip + g * 16 + 4 * fq);
#pragma unroll
      for (int ks = 0; ks < 4; ++ks) cfr[ks] = *(const GAS bf16x8*)(CT_dg + fr * 128 + 32 * ks + 8 * fq); }
    const int rloc = dir == 0 ? tau : 31 - tau;
    bf16x8 ufr_n = *(const GAS bf16x8*)(Z2 + (row0 + 32 * (dir == 0 ? 0 : 7) + rloc) * CD_IN + ZC_U + g * 16 + hi * 8);
#pragma unroll 1
    for (int qq = 0; qq < 8; ++qq) {
      const int q = dir == 0 ? qq : 7 - qq;
      const bf16x8 ufr = ufr_n;
      { const int qn = qq < 7 ? (dir == 0 ? qq + 1 : 6 - qq) : q;
        ufr_n = *(const GAS bf16x8*)(Z2 + (row0 + 32 * qn + rloc) * CD_IN + ZC_U + g * 16 + hi * 8); }
      f32x4v yfp[2]; u32x2 uwp[2];
      if (PASS == 2 && dir == 1) {
#pragma unroll
        for (int mb = 0; mb < 2; ++mb) { const size_t row = row0 + 32 * q + 16 * mb + fr; yfp[mb] = *(const GAS f32x4v*)(YT + row * 1024 + g * 16 + 4 * fq); uwp[mb] = *(const GAS u32x2*)(Z2 + row * CD_IN + ZC_U + g * 16 + 4 * fq); } }
      f32x16 bu[4];
#pragma unroll
      for (int k = 0; k < 4; ++k) { bu[k] = f32x16{}; bu[k] = __builtin_amdgcn_mfma_f32_32x32x16_bf16(ufr, bfr[k], bu[k], 0, 0, 0); }
      typedef float f2 __attribute__((ext_vector_type(2)));
      const f2 Ar = {ar[0], ar[1]}, Ai = {ai[0], ai[1]}, A16r = {a16r[0], a16r[1]}, A16i = {a16i[0], a16i[1]};
      { f2 xr = {0.f, 0.f}, xi = {0.f, 0.f};
#pragma unroll
        for (int r = 0; r < 16; ++r) { const f2 br = {bu[0][r], bu[1][r]}, bi = {bu[2][r], bu[3][r]};
          const f2 nr = Ar * xr - Ai * xi + br, ni = Ar * xi + Ai * xr + bi; xr = nr; xi = ni; bu[0][r] = xr.x; bu[1][r] = xr.y; bu[2][r] = xi.x; bu[3][r] = xi.y; } }
      { const f2 per = {bperm(bu[0][15], lane ^ 32), bperm(bu[1][15], lane ^ 32)}, pei = {bperm(bu[2][15], lane ^ 32), bperm(bu[3][15], lane ^ 32)};
        const f2 Cr = {cr[0], cr[1]}, Ci = {ci[0], ci[1]};
        const f2 c1r = A16r * Cr - A16i * Ci + per, c1i = A16r * Ci + A16i * Cr + pei;
        f2 cxr = hi ? c1r : Cr, cxi = hi ? c1i : Ci;
#pragma unroll
        for (int r = 0; r < 16; ++r) { const f2 nr = Ar * cxr - Ai * cxi, ni = Ar * cxi + Ai * cxr; cxr = nr; cxi = ni; bu[0][r] += cxr.x; bu[1][r] += cxr.y; bu[2][r] += cxi.x; bu[3][r] += cxi.y; }
#pragma unroll
        for (int s = 0; s < 2; ++s) { const float ner = bperm(bu[s][15], lane ^ 32), nei = bperm(bu[2 + s][15], lane ^ 32);
          cr[s] = hi ? bu[s][15] : ner; ci[s] = hi ? bu[2 + s][15] : nei; } }
      if (PASS == 2) {
#pragma unroll
        for (int k = 0; k < 4; ++k)
#pragma unroll
          for (int r = 0; r < 16; r += 2) { const int st = 16 * hi + r, rl = dir == 0 ? st : 31 - st, rl1 = dir == 0 ? st + 1 : 30 - st;
            const unsigned pk = att::cvtpk(bu[k][r], bu[k][r + 1]);
            *(LAS unsigned short*)(xl + rl * XROWB + (32 * k + r32) * 2) = (unsigned short)pk; *(LAS unsigned short*)(xl + rl1 * XROWB + (32 * k + r32) * 2) = (unsigned short)(pk >> 16); }
        asm volatile("s_waitcnt lgkmcnt(0)" ::: "memory");
        f32x4v acc2[2] = {(f32x4v){0.f, 0.f, 0.f, 0.f}, (f32x4v){0.f, 0.f, 0.f, 0.f}};
#pragma unroll
        for (int ks = 0; ks < 4; ++ks) { const bf16x8 cf = cfr[ks];
#pragma unroll
          for (int mb = 0; mb < 2; ++mb) { const bf16x8 xf = *(const LAS bf16x8*)(xl + (16 * mb + fr) * XROWB + (32 * ks + 8 * fq) * 2);
            acc2[mb] = __builtin_amdgcn_mfma_f32_16x16x32_bf16(cf, xf, acc2[mb], 0, 0, 0); } }
        asm volatile("s_waitcnt lgkmcnt(0)" ::: "memory");
#pragma unroll
        for (int mb = 0; mb < 2; ++mb) { const size_t row = row0 + 32 * q + 16 * mb + fr; float* yt = YT + row * 1024 + g * 16 + 4 * fq;
          if (dir == 0) *(GAS f32x4v*)yt = acc2[mb];
          else { const f32x4v yf = yfp[mb];
            const u32x2 uw = uwp[mb];
            const float u0 = __builtin_bit_cast(float, uw.x << 16), u1 = __builtin_bit_cast(float, uw.x & 0xffff0000u), u2 = __builtin_bit_cast(float, uw.y << 16), u3 = __builtin_bit_cast(float, uw.y & 0xffff0000u);
            const float y0 = gelu_fast(acc2[mb][0] + yf[0] + dk[0] * u0), y1 = gelu_fast(acc2[mb][1] + yf[1] + dk[1] * u1), y2 = gelu_fast(acc2[mb][2] + yf[2] + dk[2] * u2), y3 = gelu_fast(acc2[mb][3] + yf[3] + dk[3] * u3);
            u32x2 w; w.x = pk2(y0, y1); w.y = pk2(y2, y3);
            *(GAS u32x2*)(G + row * 1024 + g * 16 + 4 * fq) = w; } }
      }
    }
    if (PASS == 1) { float* p = SEND + (((size_t)(dir * NB + b) * 64 + g) * 17 + seg) * 128;
      if (hi == 0) {
#pragma unroll
        for (int s = 0; s < 2; ++s) { p[r32 + 32 * s] = cr[s]; p[64 + r32 + 32 * s] = ci[s]; } } }
    if (PASS == 2) asm volatile("s_waitcnt vmcnt(0)" ::: "memory");
  }
}
}
namespace ml {
using bf16x8 = __attribute__((ext_vector_type(8))) short;
using f32x16 = __attribute__((ext_vector_type(16))) float;
using f32x4v = __attribute__((ext_vector_type(4))) float;
using u32x4 = __attribute__((ext_vector_type(4))) unsigned;
using u32x2 = __attribute__((ext_vector_type(2))) unsigned;
constexpr int NSEQ = NB * 4 * 2, NBLK = 17;
constexpr size_t CST_BYTES = (size_t)NSEQ * NBLK * 256 * 128 * 2;
constexpr size_t NST_OFF = CST_BYTES, MST_OFF = NST_OFF + (size_t)NSEQ * NBLK * 128 * 4, ST_END = MST_OFF + (size_t)NSEQ * NBLK * 4;
__device__ __forceinline__ float bperm(float v, int srclane) { return __builtin_bit_cast(float, __builtin_amdgcn_ds_bpermute(srclane << 2, __builtin_bit_cast(int, v))); }
__device__ __forceinline__ float swap_add(float v) { auto rr = __builtin_amdgcn_permlane32_swap(__float_as_uint(v), __float_as_uint(v), false, false); return __uint_as_float(rr[0]) + __uint_as_float(rr[1]); }
__device__ __forceinline__ float wmax(float v, int lane) {
#pragma unroll
  for (int o = 1; o < 64; o <<= 1) v = fmaxf(v, bperm(v, lane ^ o));
  return v;
}
__device__ __forceinline__ size_t blk_row0(int b, int blkid) { return blkid == 0 ? (size_t)NB * TT + b * CT : (size_t)b * TT + (blkid - 1) * 256; }
__device__ __forceinline__ int seq_blk(int dir, int j) { return j == 0 ? 0 : (dir == 0 ? j : 17 - j); }
__device__ __forceinline__ int blk_seq(int dir, int blkid) { return blkid == 0 ? 0 : (dir == 0 ? blkid : 17 - blkid); }
struct GateRaw { float ig[4], fg[4]; };
__device__ __forceinline__ GateRaw gate_load(const float* __restrict__ GATES, size_t row0, int h, int dir, int lane) {
  GateRaw g;
#pragma unroll
  for (int i = 0; i < 4; ++i) { const int p = 4 * lane + i, r = dir ? 255 - p : p; const GAS float* gp = (const GAS float*)GATES + (row0 + r) * 16; g.ig[i] = gp[(2 * dir) * 4 + h]; g.fg[i] = gp[(2 * dir + 1) * 4 + h]; }
  return g;
}
__device__ __forceinline__ void gate_math(const GateRaw& g, const float* __restrict__ bg, int h, int dir, int lane, float (&F)[4], float (&Bt)[4], float (&ML)[4], float& b_last, float& bmax) {
  float ig[4], c = 0.f;
#pragma unroll
  for (int i = 0; i < 4; ++i) { ig[i] = g.ig[i]; c += g.fg[i]; F[i] = c; }
  float inc = c;
#pragma unroll
  for (int o = 1; o < 64; o <<= 1) { const float t = bperm(inc, lane - o); if (lane >= o) inc += t; }
  const float exc = inc - c;
  b_last = bperm(inc, 63);
  float mx = -3.0e38f;
#pragma unroll
  for (int i = 0; i < 4; ++i) { F[i] += exc; Bt[i] = ig[i] - F[i]; mx = fmaxf(mx, Bt[i]); ML[i] = mx; }
  float imx = mx;
#pragma unroll
  for (int o = 1; o < 64; o <<= 1) { const float t = bperm(imx, lane - o); if (lane >= o) imx = fmaxf(imx, t); }
  const float emx = bperm(imx, lane - 1);
  if (lane > 0) {
#pragma unroll
    for (int i = 0; i < 4; ++i) ML[i] = fmaxf(ML[i], emx); }
  bmax = bperm(imx, 63);
}
__device__ __forceinline__ void gate_scan(const float* __restrict__ GATES, const float* __restrict__ bg, size_t row0, int h, int dir, int lane, float (&F)[4], float (&Bt)[4], float (&ML)[4], float& b_last, float& bmax) {
  const GateRaw g = gate_load(GATES, row0, h, dir, lane); gate_math(g, bg, h, dir, lane, F, Bt, ML, b_last, bmax);
}
__device__ __forceinline__ void l1_unit(int seq, int vblk, int dblk, const bf16* __restrict__ ZT, const float* __restrict__ GATES, const float* __restrict__ bg, unsigned char* __restrict__ ST, LAS float* wt  ) {
  const int lane = fresh_lane();
  const int b = seq >> 3, h = (seq >> 1) & 3, dir = seq & 1, r32 = lane & 31, hi = lane >> 5;
  f32x16 acc = f32x16{}; float npart = 0.f, m = 0.f;
  const bf16* kT = ZT + (size_t)(h * 128 + 32 * dblk + r32) * MR + 8 * hi;
  const bf16* vT = ZT + (size_t)(512 + h * 256 + 32 * vblk + r32) * MR + 8 * hi;
  bf16* CS = (bf16*)ST; float* NS = (float*)(ST + NST_OFF); float* MS = (float*)(ST + MST_OFF);
  bf16x8 fa[8], fb[8]; u32x4 ka[8], kb[8];
  size_t row0 = blk_row0(b, seq_blk(dir, 0));
  GateRaw gr = gate_load(GATES, row0, h, dir, lane);
#pragma unroll
  for (int ks = 0; ks < 8; ++ks) { fa[ks] = *(const GAS bf16x8*)(vT + row0 + 16 * ks); ka[ks] = *(const GAS u32x4*)(kT + row0 + 16 * ks); }
#define L1_STEPS(FV, FK, KS0) _Pragma("unroll") for (int ks = 0; ks < 8; ++ks) { const int tok = 16 * ((KS0) + ks) + 8 * hi; \
      const f32x4v w0 = *(const LAS f32x4v*)(wt + tok), w1 = *(const LAS f32x4v*)(wt + tok + 4); const u32x4 kw = FK[ks]; float kf[8]; \
      _Pragma("unroll") for (int e = 0; e < 4; ++e) { kf[2 * e] = __uint_as_float(kw[e] << 16); kf[2 * e + 1] = __uint_as_float(kw[e] & 0xffff0000u); } \
      kf[0] *= w0[0]; kf[1] *= w0[1]; kf[2] *= w0[2]; kf[3] *= w0[3]; kf[4] *= w1[0]; kf[5] *= w1[1]; kf[6] *= w1[2]; kf[7] *= w1[3]; \
      npart += ((kf[0] + kf[1]) + (kf[2] + kf[3])) + ((kf[4] + kf[5]) + (kf[6] + kf[7])); \
      u32x4 kq = {att::cvtpk(kf[0], kf[1]), att::cvtpk(kf[2], kf[3]), att::cvtpk(kf[4], kf[5]), att::cvtpk(kf[6], kf[7])}; \
      acc = __builtin_amdgcn_mfma_f32_32x32x16_bf16(FV[ks], *reinterpret_cast<bf16x8*>(&kq), acc, 0, 0, 0); }
#pragma unroll 1
  for (int j = 0; j < NBLK; ++j) {
    { bf16* cp = CS + ((size_t)(seq * NBLK + j) * 256 + 32 * vblk) * 128 + 32 * dblk + r32;
#pragma unroll
      for (int r = 0; r < 16; ++r) cp[(size_t)att::crow(r, hi) * 128] = (bf16)f2bf(acc[r]);
      if (vblk == 0) { const float nt = npart + bperm(npart, lane ^ 32); if (hi == 0) NS[(size_t)(seq * NBLK + j) * 128 + 32 * dblk + r32] = nt; if (dblk == 0 && lane == 0) MS[seq * NBLK + j] = m; } }
    if (j == NBLK - 1) break;
    float F[4], Bt[4], ML[4], b_last, bmax;
    gate_math(gr, bg, h, dir, lane, F, Bt, ML, b_last, bmax);
    const size_t row_n = blk_row0(b, seq_blk(dir, j + 1 < NBLK - 1 ? j + 1 : j));
    gr = gate_load(GATES, row_n, h, dir, lane);
    const float Mf = fmaxf(m, bmax), decay = expf(m - Mf);
#pragma unroll
    for (int i = 0; i < 4; ++i) { const int p = 4 * lane + i, r = dir ? 255 - p : p; wt[r] = expf(Bt[i] - Mf); }
    asm volatile("s_waitcnt lgkmcnt(0)" ::: "memory");
    acc = acc * decay; npart *= decay; m = b_last + Mf;
#pragma unroll
    for (int ks = 0; ks < 8; ++ks) { fb[ks] = *(const GAS bf16x8*)(vT + row0 + 128 + 16 * ks); kb[ks] = *(const GAS u32x4*)(kT + row0 + 128 + 16 * ks); }
    L1_STEPS(fa, ka, 0)
#pragma unroll
    for (int ks = 0; ks < 8; ++ks) { fa[ks] = *(const GAS bf16x8*)(vT + row_n + 16 * ks); ka[ks] = *(const GAS u32x4*)(kT + row_n + 16 * ks); }
    L1_STEPS(fb, kb, 8)
    row0 = row_n;
  }
#undef L1_STEPS
}
__device__ __forceinline__ void l2_unit(int b, int h, int blkid, int dvh, const bf16* __restrict__ Z, const float* __restrict__ GATES, const float* __restrict__ bg,
                                        const unsigned char* __restrict__ ST, float* __restrict__ HH, char* lds, LAS float* btab, int wave_s) {
  const int tid = fresh_tid(wave_s), wid = tid >> 6, lane = tid & 63, r32 = lane & 31, hi = lane >> 5;
  const size_t row0 = blk_row0(b, blkid);
  const int t0 = wid * 32, t = t0 + r32;
  const bf16* CS = (const bf16*)ST; const float* NS = (const float*)(ST + NST_OFF); const float* MS = (const float*)(ST + MST_OFF);
  { const int sr = tid >> 4, sc = (tid & 15) * 8, vst0 = att::v_st(sr, sc), vst1 = att::v_st(32 + sr, sc), kc = sc * 2;
    const bf16* kb = Z + (row0 + sr) * ZLD + ZB_K + h * 128 + sc; const bf16* vb = Z + (row0 + sr) * ZLD + ZB_V + h * 256 + dvh * 128 + sc;
#pragma unroll
    for (int kt = 0; kt < 4; ++kt) {
      const bf16x8 k0 = *(const GAS bf16x8*)(kb + (size_t)(64 * kt) * ZLD), k1 = *(const GAS bf16x8*)(kb + (size_t)(64 * kt + 32) * ZLD);
      const bf16x8 v0 = *(const GAS bf16x8*)(vb + (size_t)(64 * kt) * ZLD), v1 = *(const GAS bf16x8*)(vb + (size_t)(64 * kt + 32) * ZLD);
      *(bf16x8*)(lds + kt * 16384 + KSWZ(sr, kc)) = k0; *(bf16x8*)(lds + kt * 16384 + KSWZ(32 + sr, kc)) = k1;
      *(bf16x8*)(lds + 65536 + kt * 16384 + vst0) = v0; *(bf16x8*)(lds + 65536 + kt * 16384 + vst1) = v1; } }
  bf16x8 qf[8];
  { const bf16* qp = Z + (row0 + t) * ZLD + ZB_Q + h * 128 + hi * 8;
#pragma unroll
    for (int d0 = 0; d0 < 8; ++d0) { const u32x4 w = *(const GAS u32x4*)(qp + 16 * d0); u32x4 o;
#pragma unroll
      for (int e = 0; e < 4; ++e) o[e] = att::cvtpk(__uint_as_float(w[e] << 16) * 0.08838834764831845f, __uint_as_float(w[e] & 0xffff0000u) * 0.08838834764831845f);
      qf[d0] = *reinterpret_cast<bf16x8*>(&o); } }
  __syncthreads();
  f32x16 o[4];
#pragma unroll
  for (int nb = 0; nb < 4; ++nb) o[nb] = f32x16{};
  const int vbase = (int)(uintptr_t)(lds + 65536) + att::v_rd_base(lane);
#define ML_STILE(kt) f32x16 p0, p1; att::qkt<128>(p0, p1, (const bf16*)(lds + (kt) * 16384), qf, r32, hi); \
      _Pragma("unroll") for (int r = 0; r < 16; ++r) { const int k0i = 64 * (kt) + att::crow(r, hi), k1i = k0i + 32; \
        const bool v0 = dir == 0 ? (k0i <= t) : (k0i >= t), v1 = dir == 0 ? (k1i <= t) : (k1i >= t); \
        p0[r] = v0 ? p0[r] * __expf(btab[k0i] - Mt) : 0.f; p1[r] = v1 ? p1[r] * __expf(btab[k1i] - Mt) : 0.f; }
#pragma unroll
  for (int dir = 0; dir < 2; ++dir) {
    const int seq = (b * 4 + h) * 2 + dir, j = blk_seq(dir, blkid);
    const float m_prev = ((const GAS float*)MS)[seq * NBLK + j];
    float Mt, Ft;
    { float F[4], Bt[4], ML[4], b_last, bmax;
      gate_scan(GATES, bg, row0, h, dir, lane, F, Bt, ML, b_last, bmax);
#pragma unroll
      for (int i = 0; i < 4; ++i) { const int p = 4 * lane + i, r = dir ? 255 - p : p; btab[r] = Bt[i]; }
      const int pp = dir ? 255 - t : t, src = pp >> 2, e = pp & 3;
      const float m0 = bperm(fmaxf(m_prev, ML[0]), src), m1 = bperm(fmaxf(m_prev, ML[1]), src), m2 = bperm(fmaxf(m_prev, ML[2]), src), m3 = bperm(fmaxf(m_prev, ML[3]), src);
      const float f0 = bperm(F[0], src), f1 = bperm(F[1], src), f2 = bperm(F[2], src), f3 = bperm(F[3], src);
      Mt = e == 0 ? m0 : (e == 1 ? m1 : (e == 2 ? m2 : m3)); Ft = e == 0 ? f0 : (e == 1 ? f1 : (e == 2 ? f2 : f3)); }
    asm volatile("s_waitcnt lgkmcnt(0)" ::: "memory");
    const float w_inter = expf(m_prev - Mt), floorv = expf(-Ft - Mt);
    float den;
    { const GAS float* np = (const GAS float*)NS + (size_t)(seq * NBLK + j) * 128 + hi * 8; float dot = 0.f;
#pragma unroll
      for (int d0 = 0; d0 < 8; ++d0) { const u32x4 w = *reinterpret_cast<const u32x4*>(&qf[d0]); const f32x4v n0 = *(const GAS f32x4v*)(np + 16 * d0), n1 = *(const GAS f32x4v*)(np + 16 * d0 + 4);
        dot += __uint_as_float(w[0] << 16) * n0[0] + __uint_as_float(w[0] & 0xffff0000u) * n0[1] + __uint_as_float(w[1] << 16) * n0[2] + __uint_as_float(w[1] & 0xffff0000u) * n0[3]
             + __uint_as_float(w[2] << 16) * n1[0] + __uint_as_float(w[2] & 0xffff0000u) * n1[1] + __uint_as_float(w[3] << 16) * n1[2] + __uint_as_float(w[3] & 0xffff0000u) * n1[3]; }
      den = w_inter * swap_add(dot); }
    const bf16* cb = CS + ((size_t)(seq * NBLK + j) * 256 + dvh * 128 + r32) * 128 + hi * 8;
    { float rsum = 0.f;
#pragma unroll 1
      for (int kt = 0; kt < 4; ++kt) {
        if (dir == 0 ? (64 * kt > t0 + 31) : (64 * kt + 63 < t0)) continue;
        ML_STILE(kt);
#pragma unroll
        for (int r = 0; r < 16; ++r) rsum += p0[r] + p1[r]; }
      den += swap_add(rsum); }
    const float inv = 1.f / fmaxf(fabsf(den), floorv);
    { const float sc = w_inter * inv;
#pragma unroll
      for (int hb = 0; hb < 2; ++hb) {
        bf16x8 cf[4][4];
#pragma unroll
        for (int d0 = 0; d0 < 4; ++d0)
#pragma unroll
          for (int nb = 0; nb < 4; ++nb) cf[d0][nb] = *(const GAS bf16x8*)(cb + (size_t)(32 * nb) * 128 + 16 * (4 * hb + d0));
#pragma unroll
        for (int d0 = 0; d0 < 4; ++d0) { const u32x4 w = *reinterpret_cast<const u32x4*>(&qf[4 * hb + d0]); u32x4 qs;
#pragma unroll
          for (int e = 0; e < 4; ++e) qs[e] = att::cvtpk(__uint_as_float(w[e] << 16) * sc, __uint_as_float(w[e] & 0xffff0000u) * sc);
#pragma unroll
          for (int nb = 0; nb < 4; ++nb) o[nb] = __builtin_amdgcn_mfma_f32_32x32x16_bf16(*reinterpret_cast<bf16x8*>(&qs), cf[d0][nb], o[nb], 0, 0, 0); }
        __builtin_amdgcn_sched_barrier(0); } }
#pragma unroll 1
    for (int kt = 0; kt < 4; ++kt) {
      if (dir == 0 ? (64 * kt > t0 + 31) : (64 * kt + 63 < t0)) continue;
      ML_STILE(kt);
#pragma unroll
      for (int r = 0; r < 16; ++r) { p0[r] *= inv; p1[r] *= inv; }
      bf16x8 pa0, pa1, pa2, pa3;
#define PK4(P, BASE, OUT) do { unsigned a0 = att::cvtpk(P[BASE + 0], P[BASE + 1]), a1 = att::cvtpk(P[BASE + 2], P[BASE + 3]);   \
    unsigned b0 = att::cvtpk(P[BASE + 4], P[BASE + 5]), b1 = att::cvtpk(P[BASE + 6], P[BASE + 7]);                              \
    auto r0 = __builtin_amdgcn_permlane32_swap(a0, b0, false, false); auto r1 = __builtin_amdgcn_permlane32_swap(a1, b1, false, false); \
    u32x4 w = {r0[0], r1[0], r0[1], r1[1]}; OUT = *reinterpret_cast<bf16x8*>(&w); } while (0)
      PK4(p0, 0, pa0); PK4(p0, 8, pa1); PK4(p1, 0, pa2); PK4(p1, 8, pa3);
#undef PK4
      att::pv_d0<128>(o, vbase + kt * 16384, pa0, pa1, pa2, pa3);
    }
  }
#undef ML_STILE
  { const int l2_ = fresh_lane(), hi2 = l2_ >> 5; float* Ow = HH + (blk_row0(b, blkid) + wid * 32) * 1024 + h * 256 + dvh * 128 + (l2_ & 31);
#pragma unroll
    for (int r = 0; r < 16; ++r)
#pragma unroll
      for (int nb = 0; nb < 4; ++nb) Ow[(size_t)att::crow(r, hi2) * 1024 + nb * 32] = o[nb][r]; }
  asm volatile("s_waitcnt vmcnt(0)" ::: "memory"); __syncthreads();
}
__device__ __forceinline__ void finish_pass(int gw, int NGW, int lane, const bf16* Z, const float* HH, const float* headg, bf16* CAT) {
  f32x4v hn[4]; u32x2 on[4];
  if (gw < MR) {
#pragma unroll
    for (int h = 0; h < 4; ++h) { hn[h] = *(const GAS f32x4v*)(HH + (size_t)gw * 1024 + h * 256 + lane * 4); on[h] = *(const GAS u32x2*)(Z + (size_t)gw * ZLD + ZB_O + h * 256 + lane * 4); } }
  f32x4v g4[4];
#pragma unroll
  for (int h = 0; h < 4; ++h) g4[h] = *(const GAS f32x4v*)(headg + h * 256 + lane * 4);
  for (int m = gw; m < MR; m += NGW) {
    f32x4v hh[4]; u32x2 ow[4];
#pragma unroll
    for (int h = 0; h < 4; ++h) { hh[h] = hn[h]; ow[h] = on[h]; }
    const int m2 = m + NGW;
    if (m2 < MR) {
#pragma unroll
      for (int h = 0; h < 4; ++h) { hn[h] = *(const GAS f32x4v*)(HH + (size_t)m2 * 1024 + h * 256 + lane * 4); on[h] = *(const GAS u32x2*)(Z + (size_t)m2 * ZLD + ZB_O + h * 256 + lane * 4); } }
#pragma unroll
    for (int h = 0; h < 4; ++h) {
      const float rstd = 1.f / sqrtf(wave_sum_l((hh[h][0] * hh[h][0] + hh[h][1] * hh[h][1]) + (hh[h][2] * hh[h][2] + hh[h][3] * hh[h][3]), lane) * (1.f / 256.f) + EPS);
      const float o0 = __uint_as_float(ow[h].x << 16), o1 = __uint_as_float(ow[h].x & 0xffff0000u), o2 = __uint_as_float(ow[h].y << 16), o3 = __uint_as_float(ow[h].y & 0xffff0000u);
      u32x2 w; w.x = pk2(hh[h][0] * rstd * g4[h][0] / (1.f + __expf(-o0)), hh[h][1] * rstd * g4[h][1] / (1.f + __expf(-o1))); w.y = pk2(hh[h][2] * rstd * g4[h][2] / (1.f + __expf(-o2)), hh[h][3] * rstd * g4[h][3] / (1.f + __expf(-o3)));
      *(GAS u32x2*)(CAT + (size_t)m * DM + 1024 + h * 256 + lane * 4) = w; }
  }
}
}
struct Args { const float* in[30]; float* out; unsigned char* ws; int ph_lo, ph_hi, li, pad; };
constexpr int PH_P0 = 0, PH_P1 = 1, PH_L0 = 2, PH_PER_LAYER = 13, PH_FINAL = 28, N_PHASES = 29;
enum { O_F1N = 0, O_F1U, O_F1D, O_MN, O_MI, O_MP, O_MA, O_MF, O_MG, O_MO, O_F2N, O_F2U, O_F2D };
#ifndef DUP_MASK
#define DUP_MASK 0
#endif
#ifndef WGM_UP
#define WGM_UP 4
#endif
#ifndef WGM_DN
#define WGM_DN 4
#endif
#ifndef WGM_MISC
#define WGM_MISC 8
#endif
#ifndef PROBE_K
#define PROBE_K -1
#endif
#define PPOINT(id) do { if (PROBE_K == (id)) t_probe_ = __builtin_amdgcn_s_memrealtime() - t_start_; } while (0)
#define REP(bit) for (int rep_ = 0; rep_ < (((DUP_MASK) & (bit)) ? 2 : 1); ++rep_)
#define OPAQUE_S(p) asm volatile("" : "+s"(p))
__device__ __forceinline__ int opq(int v) { asm volatile("" : "+s"(v)); return v; }
#define GEMM_PHASE(EPI, A_, B_, M_, N_, K_, ...) GEMM_PHASE_S(WGM_MISC, EPI, A_, B_, M_, N_, K_, __VA_ARGS__)
#define GEMM_RESID(A_, B_, M_, N_, K_, SPL, ...) do { pg8::Gemm g{(const bf16*)(A_), (const bf16*)(B_), (M_), (N_), (K_)}; pg8::StaticOrderT<SPL, NB * CT / 256> S; S.init(NB * TT, (N_), F.G, (int)blockIdx.x, (K_), (M_) > NB * TT, WGM_DN); \
    pg8::EpiResidPart E{__VA_ARGS__, (float*)(ws + WS_SC1)}; pg8::gemm_phase<pg8::EpiResidPart, pg8::StaticOrderT<SPL, NB * CT / 256>, true, true>(F.lds + RING_OFF, g, S, E, F.wave); } while (0)
#define GEMM_PHASE_S(MODE, EPI, A_, B_, M_, N_, K_, ...) do { pg8::Gemm g{(const bf16*)(A_), (const bf16*)(B_), (M_), (N_), (K_)}; pg8::StaticOrder S; S.init((M_), (N_), F.G, (int)blockIdx.x, (K_), false, (MODE)); \
    pg8::EPI E{__VA_ARGS__}; pg8::gemm_phase<pg8::EPI, pg8::StaticOrder, true, true>(F.lds + RING_OFF, g, S, E, F.wave); } while (0)

__global__ void __launch_bounds__(NWAVES * 64, 2) fwd(Args args) {
    extern __shared__ __attribute__((aligned(16))) unsigned char lds[];
    Frame F;
    F.lds = (LAS unsigned char*)lds;
    F.MISC = (volatile LAS unsigned*)(F.lds + MISC_OFF);
    F.wave = __builtin_amdgcn_readfirstlane((int)threadIdx.x >> 6);
    F.G = gridDim.x;
    F.ws = args.ws; F.out = args.out;
    F.ctl = (gu32*)(args.ws + WS_CTL);
    for (int u = threadIdx.x; u < (LDS_BYTES - LDSCTL_OFF) / 4; u += NWAVES * 64) ((LAS unsigned*)(F.lds + LDSCTL_OFF))[u] = 0u;
    __syncthreads();
    const int lo = args.ph_lo, hi = args.ph_hi;
    unsigned long long t_start_ = 0, t_probe_ = 0; if (PROBE_K >= 0) t_start_ = __builtin_amdgcn_s_memrealtime();
    XcdBarrier bar; bar.bar = (unsigned*)(F.ctl + CW_BAR) + args.li * XCD_BAR_WORDS; bar.x = 0; bar.st = nullptr;
    if (hi - lo > 1) bar = xcd_barrier_post((unsigned*)(F.ctl + CW_BAR) + args.li * XCD_BAR_WORDS, F.MISC + 8);
#define IN(k) (opq(lo) <= (k) && (k) < opq(hi))
#define SEAM(k) do { if (IN(k) && IN((k) + 1)) { xcd_barrier(bar, F.wave); if ((DUP_MASK) & 4096) xcd_barrier(bar, F.wave); } if (PROBE_K >= 0 && (k) == PROBE_K) t_probe_ = __builtin_amdgcn_s_memrealtime() - t_start_; } while (0)

    if (IN(PH_P0)) REP(8) { p0_prologue(F, args.in); } SEAM(PH_P0);
    if (IN(PH_P1)) REP(8) { p1_modreduce(F, args.in[5], args.in[6]); } SEAM(PH_P1);
    if (IN(PH_L0 + O_F1N)) REP(4) { norm_phase<0>(F, F.ws, args.in[0], args.in[2], 0, 0, true, MR); }
#pragma unroll 1
    for (int l = 0; l < 2; ++l) {
        const int pb = PH_L0 + PH_PER_LAYER * l;
        const int MLAT = NB * TT;
        const int m_post = (l == 1) ? MLAT : MR;
        if (IN(pb + O_F1N) && l > 0) REP(4) { unsigned char* ws = F.ws; OPAQUE_S(ws); norm_phase<4>(F, ws, nullptr, nullptr, l, 0, false, MR, (const float*)(ws + WS_MODV) + (size_t)((l - 1) * 5 + 4) * MODN + 8 * DM, 0.5f); } SEAM(pb + O_F1N);
        if (IN(pb + O_F1U)) REP(1) { unsigned char* ws = F.ws; OPAQUE_S(ws);
            GEMM_PHASE_S(WGM_UP, EpiSwiglu, ws + WS_HN, ws + WS_WUP + (size_t)(l * 2) * 44 * MiB, MR, 2 * FF, DM, (bf16*)(ws + WS_HID), FF); } SEAM(pb + O_F1U);
        if (IN(pb + O_F1D)) REP(2) { unsigned char* ws = F.ws; OPAQUE_S(ws);
            GEMM_RESID(ws + WS_HID, ws + WS_WDN + (size_t)(l * 2) * 22 * MiB, MR, DM, FF, 4, (float*)(ws + WS_H), (const float*)(ws + WS_MODV) + (size_t)l * 5 * MODN + 2 * DM, MODN, rep_ ? 0.f : 0.5f); } SEAM(pb + O_F1D);
        if (IN(pb + O_MN)) REP(4) { unsigned char* ws = F.ws; OPAQUE_S(ws); norm_phase<4>(F, ws, nullptr, nullptr, l, 1, false, MR, (const float*)(ws + WS_MODV) + (size_t)(l * 5 + 4) * MODN + 2 * DM, 0.5f); } SEAM(pb + O_MN);
        if (IN(pb + O_MI)) REP(16) { unsigned char* ws = F.ws; OPAQUE_S(ws);
            if (l == 0) { pg8::Gemm g{(const bf16*)(ws + WS_HN), (const bf16*)(ws + WS_WABIN), MR, ZLD, DM, (const bf16*)(ws + WS_WABIN + (size_t)ZB_K * DM * 2), (const bf16*)(ws + WS_HN)};
                pg8::DualOrder S; S.init(MR, ZLD, 1536, MR, F.G, (int)blockIdx.x, DM);
                pg8::EpiPlain2 E{{(bf16*)(ws + WS_Z), ZLD, (float*)(ws + WS_GATES), ZB_G / 256, (const float*)(ws + WS_TAB + TB_VEC) + TV_BGATE}, {(bf16*)(ws + WS_ZT), MR, nullptr, -1, nullptr}};
                pg8::gemm_phase<pg8::EpiPlain2, pg8::DualOrder, true, true>(F.lds + RING_OFF, g, S, E, F.wave); }
            else GEMM_PHASE(EpiPlain, ws + WS_HN, ws + WS_WCDIN, MR, CD_IN, DM, (bf16*)(ws + WS_Z), CD_IN, nullptr, -1, nullptr);
        } SEAM(pb + O_MI);
        if (IN(pb + O_MP)) REP(32) { unsigned char* ws = F.ws; OPAQUE_S(ws);
            const int lane = fresh_lane(); const int gw = blockIdx.x * NWAVES + F.wave, NGW = F.G * NWAVES;
            const bf16* Z = (const bf16*)(ws + WS_Z); bf16* KA = (bf16*)(ws + WS_KA); const float* tv = (const float*)(ws + WS_TAB + TB_VEC);
            if (l == 0) {
                if (F.wave < 4) { for (int u = (int)blockIdx.x * 4 + F.wave; u < ml::NSEQ * 32; u += F.G * 4)
                    ml::l1_unit(u >> 5, (u >> 2) & 7, u & 3, (const bf16*)(ws + WS_ZT), (const float*)(ws + WS_GATES), tv + TV_BGATE, ws + WS_SC1, (LAS float*)(F.lds + RING_OFF) + F.wave * 256); }
                else { for (int it = (int)blockIdx.x * 4 + F.wave - 4; it < MR * 2; it += F.G * 4) naive_kprep<0>(it, lane, Z, KA, tv + TV_GK, (const float*)(ws + WS_TAB + TB_ROPEA)); } }
            else { for (int it = gw; it < MR; it += NGW) naive_kprep<1>(it, lane, Z, KA, nullptr, (const float*)(ws + WS_TAB + TB_ROPED));
                for (int u = gw; u < NB * 64 * 17; u += NGW) { const int seg = 16 - (u / (NB * 64)), bg = u % (NB * 64);
                    s5::s5_unit<1>(bg >> 6, bg & 63, seg, Z, (const float*)(ws + WS_TAB + TB_S5AB), (const bf16*)(ws + WS_TAB + TB_S5BT), (const bf16*)(ws + WS_TAB + TB_S5CT), (float*)(ws + WS_SC2), nullptr, nullptr, nullptr, nullptr); } }
        } SEAM(pb + O_MP);
        if (IN(pb + O_MA)) REP(64) { unsigned char* ws = F.ws; OPAQUE_S(ws);
            const int tid = fresh_tid(F.wave);
            const bf16* Z = (const bf16*)(ws + WS_Z); const bf16* KA = (const bf16*)(ws + WS_KA); bf16* CAT = (bf16*)(ws + WS_CAT); const float* tv = (const float*)(ws + WS_TAB + TB_VEC);
            float* SC1 = (float*)(ws + WS_SC1); float* SC2 = (float*)(ws + WS_SC2);
            if (l == 0) { const float* ropeA = (const float*)(ws + WS_TAB + TB_ROPEA);
                REP(256) { const int nv = F.G, v0 = (int)blockIdx.x;
                    for (int u = v0; u < 512; u += nv) { const int b = u >> 7, head = (u >> 4) & 7, qb = u & 15, kvh = head >> 2; const size_t row0 = (size_t)b * TT + qb * 256;
                        att::attn_unit<128, 0>(Z + row0 * ZLD + ZA_Q + head * 128, ZLD, KA + kvh * 128, 256, Z + ZA_V + kvh * 128, ZLD, CAT + row0 * DM + head * 128, b, qb * 256, tv + TV_GQ, ropeA, 0.f, (char*)lds + RING_OFF, F.wave); }
                    PPOINT(100);
                    for (int u = v0; u < 32; u += nv) { const int b = u >> 3, head = u & 7, kvh = head >> 2; const size_t row0 = (size_t)NB * TT + b * CT;
                        att::attn_unit<128, 1>(Z + row0 * ZLD + ZA_Q + head * 128, ZLD, KA + kvh * 128, 256, Z + ZA_V + kvh * 128, ZLD, CAT + row0 * DM + head * 128, b, 0, tv + TV_GQ, ropeA, 0.f, (char*)lds + RING_OFF, F.wave); } }
                PPOINT(101);
                REP(512) for (int u = (int)blockIdx.x; u < NB * 4 * 34; u += F.G) { const int b = u / 136, rem = u % 136, h = rem / 34, bh = rem % 34;
                    ml::l2_unit(b, h, bh >> 1, bh & 1, Z, (const float*)(ws + WS_GATES), tv + TV_BGATE, ws + WS_SC1, SC2, (char*)lds + RING_OFF, (LAS float*)(F.lds + LDSCTL_OFF + 512) + F.wave * 256, F.wave); }
            } else { const float* ropeD = (const float*)(ws + WS_TAB + TB_ROPED);
                REP(1024) { const int nv = F.G, v0 = (int)blockIdx.x;
                    for (int u = v0; u < 1024; u += nv) { const int b = u >> 8, head = (u >> 4) & 15, qb = u & 15, kvh = head >> 3; const size_t row0 = (size_t)b * TT + qb * 256;
                        att::attn_unit<64, 2>(Z + row0 * CD_IN + ZD_Q + head * 64, CD_IN, KA + kvh * 64, 128, Z + ZD_V + kvh * 64, CD_IN, CAT + row0 * DM + 1024 + head * 64, b, qb * 256, nullptr, ropeD, tv[TV_SINK + head], (char*)lds + RING_OFF, F.wave); } }
                PPOINT(110);
                REP(2048) { const int gw = blockIdx.x * NWAVES + F.wave, NGW = F.G * NWAVES;
                    for (int u = gw; u < NB * 64 * 16; u += NGW) { const int seg = u / (NB * 64), bg = u % (NB * 64);
                        s5::s5_unit<2>(bg >> 6, bg & 63, seg, Z, (const float*)(ws + WS_TAB + TB_S5AB), (const bf16*)(ws + WS_TAB + TB_S5BT), (const bf16*)(ws + WS_TAB + TB_S5CT), (float*)(ws + WS_SC2), tv + TV_DSKIP, (bf16*)(ws + WS_G), (float*)(ws + WS_SC1),
                                       F.lds + RING_OFF + F.wave * s5::WAVE_LDS); } }
            }
        } SEAM(pb + O_MA);
        if (IN(pb + O_MF)) { unsigned char* ws = F.ws; OPAQUE_S(ws);
            const int lane = fresh_lane(), gw = blockIdx.x * NWAVES + F.wave, NGW = F.G * NWAVES;
            if (l == 0) ml::finish_pass(gw, NGW, lane, (const bf16*)(ws + WS_Z), (const float*)(ws + WS_SC2), (const float*)(ws + WS_TAB + TB_VEC) + TV_HEADG, (bf16*)(ws + WS_CAT));
        } if (l == 0) SEAM(pb + O_MF);
        if (IN(pb + O_MG)) REP(128) { unsigned char* ws = F.ws; OPAQUE_S(ws);
            if (l == 1) GEMM_PHASE(EpiGlu, ws + WS_G, ws + WS_WGLU, MLAT, 1024, 1024, (bf16*)(ws + WS_CAT), DM, (const bf16*)(ws + WS_G), (const float*)(ws + WS_TAB + TB_VEC) + TV_GLUB);
        } if (l == 1) SEAM(pb + O_MG);
        if (IN(pb + O_MO)) REP(128) { unsigned char* ws = F.ws; OPAQUE_S(ws);
            GEMM_RESID(ws + WS_CAT, ws + (l == 0 ? WS_WABOUT : WS_WCDOUT), m_post, DM, DM, 4, (float*)(ws + WS_H), (const float*)(ws + WS_MODV) + (size_t)l * 5 * MODN + 5 * DM, MODN, rep_ ? 0.f : 1.0f); } SEAM(pb + O_MO);
        if (IN(pb + O_F2N)) REP(4) { unsigned char* ws = F.ws; OPAQUE_S(ws); norm_phase<4>(F, ws, nullptr, nullptr, l, 2, false, m_post, (const float*)(ws + WS_MODV) + (size_t)(l * 5 + 4) * MODN + 5 * DM, 1.0f); } SEAM(pb + O_F2N);
        if (IN(pb + O_F2U)) REP(1) { unsigned char* ws = F.ws; OPAQUE_S(ws);
            GEMM_PHASE_S(WGM_UP, EpiSwiglu, ws + WS_HN, ws + WS_WUP + (size_t)(l * 2 + 1) * 44 * MiB, m_post, 2 * FF, DM, (bf16*)(ws + WS_HID), FF); } SEAM(pb + O_F2U);
        if (IN(pb + O_F2D)) REP(2) { unsigned char* ws = F.ws; OPAQUE_S(ws);
            GEMM_RESID(ws + WS_HID, ws + WS_WDN + (size_t)(l * 2 + 1) * 22 * MiB, m_post, DM, FF, 4, (float*)(ws + WS_H), (const float*)(ws + WS_MODV) + (size_t)l * 5 * MODN + 8 * DM, MODN, rep_ ? 0.f : 0.5f); } SEAM(pb + O_F2D);
    }
    if (IN(PH_FINAL)) REP(4) { unsigned char* ws = F.ws; OPAQUE_S(ws); final_norm_phase(F, ws); }
    if (PROBE_K >= 0 && blockIdx.x == 0) { const unsigned long long te_ = __builtin_amdgcn_s_memrealtime(); while (__builtin_amdgcn_s_memrealtime() - te_ < t_probe_) __builtin_amdgcn_s_sleep(8); }
#undef IN
#undef SEAM
}
extern "C" void kernel_launch(void* const* d_in, const int* in_sizes, int n_in, void* d_out, int out_size, void* d_ws, size_t ws_size, hipStream_t stream) {
    static int grid = 0;
    if (grid == 0) {
        if (n_in != 30 || out_size != NB * TT * DM || ws_size < WS_END) { fprintf(stderr, "kernel_launch: unexpected shapes: n_in %d out %d ws %zu (need %zu)\n", n_in, out_size, ws_size, (size_t)WS_END); grid = -1; return; }
        int dev = 0, cus = 0;
        if (hipGetDevice(&dev) != hipSuccess || hipDeviceGetAttribute(&cus, hipDeviceAttributeMultiprocessorCount, dev) != hipSuccess) { grid = -1; return; }
        if (hipFuncSetAttribute((const void*)fwd, hipFuncAttributeMaxDynamicSharedMemorySize, LDS_BYTES) != hipSuccess) { fprintf(stderr, "kernel_launch: hipFuncSetAttribute failed\n"); grid = -1; return; }
        int per_cu = 0; (void)hipOccupancyMaxActiveBlocksPerMultiprocessor(&per_cu, (const void*)fwd, NWAVES * 64, LDS_BYTES); (void)hipGetLastError();
        if (per_cu < 1) fprintf(stderr, "kernel_launch: occupancy query says %d\n", per_cu);
        grid = cus;
    }
    if (grid < 0) return;
    (void)hipMemsetAsync((char*)d_ws + WS_CTL, 0, CTL_ZERO_BYTES, stream);
    Args a{};
    for (int i = 0; i < 30; ++i) a.in[i] = (const float*)d_in[i];
    a.out = (float*)d_out; a.ws = (unsigned char*)d_ws;
    int li = 0;
    auto run = [&](int lo, int hi) { a.ph_lo = lo; a.ph_hi = hi; a.li = li++; a.pad = 0; hipLaunchKernelGGL(fwd, dim3(grid), dim3(NWAVES * 64), LDS_BYTES, stream, a); };
#ifndef MK_CUTS
#define MK_CUTS 0
#endif
    if (MK_CUTS == 0) run(0, N_PHASES);
    else if (MK_CUTS == 1) { for (int ph = 0; ph < N_PHASES; ++ph) run(ph, ph + 1); }
    else { run(0, PH_L0 + O_MP); run(PH_L0 + O_MP, PH_L0 + O_MO); run(PH_L0 + O_MO, PH_L0 + PH_PER_LAYER + O_MP); run(PH_L0 + PH_PER_LAYER + O_MP, PH_L0 + PH_PER_LAYER + O_MO); run(PH_L0 + PH_PER_LAYER + O_MO, N_PHASES); }
    const hipError_t le = hipPeekAtLastError();
    if (le != hipSuccess) fprintf(stderr, "kernel_launch: launch failed: %s\n", hipGetErrorName(le));
}
```
